# Optimizing an MI355X kernel written in HIP

```python
import math
import jax
import jax.numpy as jnp
from jax import lax
import numpy as np

D_MODEL = 1024
BATCH = 4
SEQ = 8192
DEPTH = 4

PLE_DIM = 256
D_FF = 2816
HEAD_DIM = 64
QBLK = 128
NUM_BUCKETS = 32
MAX_DISTANCE = 128
NEG = -1e30
FORCE = 1e6
EPS = 1e-6

NSA_HEADS = 6
NSA_KV_HEADS = 2
NSA_GROUP = NSA_HEADS // NSA_KV_HEADS
CMP_BLOCK = 32
CMP_STRIDE = 16
CMP_HIDDEN = 256
SLC_BLOCK = 64
N_SELECT = 16
WINDOW = 512

DIFF_HEADS = 4
DIFF_QK_DIM = HEAD_DIM // 2

HGRN_HEADS = 6
HGRN_KEY_DIM = 64
HGRN_VAL_DIM = 64
HGRN_CHUNK = 64

NSA_WIDTH = NSA_HEADS * HEAD_DIM
KV_WIDTH = NSA_KV_HEADS * HEAD_DIM
DIFF_WIDTH = DIFF_HEADS * HEAD_DIM
HGRN_WIDTH = HGRN_HEADS * HGRN_VAL_DIM
HGRN_KEY_WIDTH = HGRN_HEADS * HGRN_KEY_DIM
MIX_WIDTH = NSA_WIDTH + DIFF_WIDTH + HGRN_WIDTH
N_BIAS_HEADS = NSA_HEADS + DIFF_HEADS

IN_SIZES = (NSA_WIDTH, KV_WIDTH, KV_WIDTH, KV_WIDTH, KV_WIDTH, KV_WIDTH, KV_WIDTH, NSA_HEADS * 3,
            DIFF_WIDTH, DIFF_WIDTH, DIFF_WIDTH,
            HGRN_KEY_WIDTH, HGRN_KEY_WIDTH, HGRN_WIDTH, HGRN_WIDTH)
IN_WIDTH = NSA_WIDTH + 6 * KV_WIDTH + 3 * NSA_HEADS + 3 * DIFF_WIDTH + 2 * HGRN_KEY_WIDTH + 2 * HGRN_WIDTH

kernel_name = 'hybrid_nsa_diff_hgrn2_macaron'


def rms_norm(x, gain):
    xf = x.astype(jnp.float32)
    xf = xf * lax.rsqrt(jnp.mean(xf * xf, axis=-1, keepdims=True) + EPS)
    return (xf * gain.astype(jnp.float32)).astype(x.dtype)


def swiglu(h, w_gate, w_up, w_down):
    return (jax.nn.silu(h @ w_gate) * (h @ w_up)) @ w_down


def t5_bucket(dist):
    n = jnp.maximum(dist, 0)
    max_exact = NUM_BUCKETS // 2
    nf = jnp.maximum(n, 1).astype(jnp.float32)
    far = max_exact + (jnp.log(nf / max_exact) / math.log(MAX_DISTANCE / max_exact)
                       * (NUM_BUCKETS - max_exact)).astype(jnp.int32)
    return jnp.where(n < max_exact, n, jnp.minimum(far, NUM_BUCKETS - 1))


def split_cols(z):
    bounds = np.cumsum(IN_SIZES)[:-1].tolist()
    return jnp.split(z, bounds, axis=-1)


def nsa_compress(kv, pos, w1, w2):
    b, t, hk, d = kv.shape
    halves = kv.reshape(b, t // CMP_STRIDE, CMP_STRIDE, hk, d)
    win = jnp.concatenate([halves[:, :-1], halves[:, 1:]], axis=2)
    win = win + pos[:, None, :]
    n = win.shape[1]
    flat = jnp.moveaxis(win, 3, 2).reshape(b, n, hk, CMP_BLOCK * d)
    return jax.nn.gelu(flat @ w1) @ w2


def nsa_attention(q, kc, vc, ks, vs, kw, vw, gates, bias_tab):
    b, t = q.shape[:2]
    n_cmp = kc.shape[1]
    n_slc = t // SLC_BLOCK
    n_sel = min(N_SELECT, n_slc)
    scale = HEAD_DIM ** -0.5
    qg = q.reshape(b, t, NSA_KV_HEADS, NSA_GROUP, HEAD_DIM)
    gg = gates.reshape(b, t, NSA_KV_HEADS, NSA_GROUP, 3)
    ks_blk = ks.reshape(b, n_slc, SLC_BLOCK, NSA_KV_HEADS, HEAD_DIM).transpose(0, 3, 1, 2, 4)
    vs_blk = vs.reshape(b, n_slc, SLC_BLOCK, NSA_KV_HEADS, HEAD_DIM).transpose(0, 3, 1, 2, 4)
    kw_pad = jnp.pad(kw, ((0, 0), (WINDOW, 0), (0, 0), (0, 0)))
    vw_pad = jnp.pad(vw, ((0, 0), (WINDOW, 0), (0, 0), (0, 0)))
    cmp_start = jnp.arange(n_cmp) * CMP_STRIDE
    slc_start = jnp.arange(n_slc) * SLC_BLOCK
    overlap = (jnp.maximum(jnp.minimum(cmp_start[:, None] + CMP_BLOCK, slc_start[None, :] + SLC_BLOCK)
                           - jnp.maximum(cmp_start[:, None], slc_start[None, :]), 0) / CMP_BLOCK).astype(jnp.float32)
    tab_sel = bias_tab.reshape(NUM_BUCKETS, NSA_KV_HEADS, NSA_GROUP).transpose(2, 1, 0).reshape(
        NSA_GROUP, NSA_KV_HEADS * NUM_BUCKETS)
    b_idx = jnp.arange(b)[:, None, None, None]
    g_idx = jnp.arange(NSA_KV_HEADS)[None, :, None, None]
    qoff = jnp.arange(QBLK)
    woff = jnp.arange(WINDOW + QBLK)
    tokoff = jnp.arange(SLC_BLOCK)

    def block(qb):
        q0 = qb * QBLK
        tpos = q0 + qoff
        qblk = lax.dynamic_slice_in_dim(qg, q0, QBLK, axis=1)
        s_c = jnp.einsum('bqgrd,bngd->bgrqn', qblk, kc).astype(jnp.float32) * scale
        valid_c = (cmp_start + CMP_BLOCK - 1)[None, :] <= tpos[:, None]
        p_c = jax.nn.softmax(jnp.where(valid_c, s_c, NEG), axis=-1) * jnp.any(valid_c, axis=-1)[:, None]
        o_c = jnp.einsum('bgrqn,bngd->bqgrd', p_c.astype(vc.dtype), vc)
        imp = jnp.einsum('bgrqn,nm->bgqm', p_c, overlap)
        blk = jnp.arange(n_slc)[None, :]
        cur = (tpos // SLC_BLOCK)[:, None]
        forced = (blk == 0) | (blk == cur) | (blk == cur - 1)
        imp = jnp.where(forced, FORCE, imp)
        imp = jnp.where(blk * SLC_BLOCK > tpos[:, None], NEG, imp)
        _, sel = lax.top_k(imp, n_sel)
        k_sel = ks_blk[b_idx, g_idx, sel].reshape(b, NSA_KV_HEADS, QBLK, n_sel * SLC_BLOCK, HEAD_DIM)
        v_sel = vs_blk[b_idx, g_idx, sel].reshape(b, NSA_KV_HEADS, QBLK, n_sel * SLC_BLOCK, HEAD_DIM)
        s_pos = (sel[..., None] * SLC_BLOCK + tokoff).reshape(b, NSA_KV_HEADS, QBLK, n_sel * SLC_BLOCK)
        dist = tpos[:, None] - s_pos
        bias = jnp.take(tab_sel, g_idx * NUM_BUCKETS + t5_bucket(dist), axis=1)
        s_s = jnp.einsum('bqgrd,bgqkd->bgrqk', qblk, k_sel).astype(jnp.float32) * scale + jnp.moveaxis(bias, 0, 2)
        p_s = jax.nn.softmax(jnp.where((dist >= 0)[:, :, None], s_s, NEG), axis=-1)
        o_s = jnp.einsum('bgrqk,bgqkd->bqgrd', p_s.astype(vs.dtype), v_sel)
        k_win = lax.dynamic_slice_in_dim(kw_pad, q0, WINDOW + QBLK, axis=1)
        v_win = lax.dynamic_slice_in_dim(vw_pad, q0, WINDOW + QBLK, axis=1)
        w_pos = q0 - WINDOW + woff
        dist_w = tpos[:, None] - w_pos[None, :]
        valid_w = (dist_w >= 0) & (dist_w < WINDOW) & (w_pos >= 0)[None, :]
        bias_w = bias_tab[t5_bucket(dist_w)].transpose(2, 0, 1).reshape(NSA_KV_HEADS, NSA_GROUP, QBLK, WINDOW + QBLK)
        s_w = jnp.einsum('bqgrd,bkgd->bgrqk', qblk, k_win).astype(jnp.float32) * scale + bias_w
        p_w = jax.nn.softmax(jnp.where(valid_w, s_w, NEG), axis=-1)
        o_w = jnp.einsum('bgrqk,bkgd->bqgrd', p_w.astype(vw.dtype), v_win)
        g = lax.dynamic_slice_in_dim(gg, q0, QBLK, axis=1)
        out = g[..., 0:1] * o_c + g[..., 1:2] * o_s + g[..., 2:3] * o_w
        return out.reshape(b, QBLK, NSA_WIDTH)

    out = lax.map(block, jnp.arange(t // QBLK))
    return jnp.moveaxis(out, 0, 1).reshape(b, t, NSA_WIDTH)


def diff_attention(q, k, v, lam, bias_tab):
    b, t = q.shape[:2]
    scale = DIFF_QK_DIM ** -0.5
    kpos = jnp.arange(t)
    qoff = jnp.arange(QBLK)

    def block(qb):
        q0 = qb * QBLK
        tpos = q0 + qoff
        qblk = lax.dynamic_slice_in_dim(q, q0, QBLK, axis=1)
        dist = tpos[:, None] - kpos[None, :]
        bias = bias_tab[t5_bucket(dist)].transpose(2, 0, 1)[None, :, None]
        s = jnp.einsum('bqhmd,bkhmd->bhmqk', qblk, k).astype(jnp.float32) * scale + bias
        p = jax.nn.softmax(jnp.where(dist >= 0, s, NEG), axis=-1)
        a = p[:, :, 0] - lam * p[:, :, 1]
        return jnp.einsum('bhqk,bkhd->bqhd', a.astype(v.dtype), v)

    out = lax.map(block, jnp.arange(t // QBLK))
    return jnp.moveaxis(out, 0, 1).reshape(b, t, DIFF_HEADS, HEAD_DIM)


def hgrn2_scan(q, k, v, log_f):
    b, t, h, dk = q.shape
    dv = v.shape[-1]
    nc = t // HGRN_CHUNK

    def chunks(a):
        return a.astype(jnp.float32).reshape(b, nc, HGRN_CHUNK, h, a.shape[-1]).transpose(1, 0, 3, 2, 4)

    causal = jnp.tril(jnp.ones((HGRN_CHUNK, HGRN_CHUNK), dtype=bool))

    def step(state, inp):
        qc, kc, vc, gc = inp
        cum = jnp.cumsum(gc, axis=2)
        inter = jnp.einsum('bhck,bhkv->bhcv', qc * jnp.exp(cum), state)
        decay = jnp.exp(jnp.where(causal[:, :, None], cum[:, :, :, None, :] - cum[:, :, None, :, :], -jnp.inf))
        scores = jnp.einsum('bhtk,bhsk,bhtsk->bhts', qc, kc, decay)
        intra = jnp.einsum('bhts,bhsv->bhtv', scores, vc)
        last = cum[:, :, -1:, :]
        new_state = jnp.exp(last[:, :, 0, :])[..., None] * state + jnp.einsum(
            'bhsk,bhsv->bhkv', kc * jnp.exp(last - cum), vc)
        return new_state, inter + intra

    s0 = jnp.zeros((b, h, dk, dv), jnp.float32)
    _, o = lax.scan(step, s0, (chunks(q), chunks(k), chunks(v), chunks(log_f)))
    return o.transpose(1, 0, 3, 2, 4).reshape(b, t, h, dv).astype(v.dtype)


def hybrid_mixer(h, layer, w_in, w_out, rel_bias, hgrn_lb, nsa_q_norm, nsa_k_norm, nsa_cmp_pos,
                 nsa_cmp_w1, nsa_cmp_w2, diff_q_norm, diff_k_norm, diff_lambda, diff_subln, hgrn_out_norm):
    b, t, _ = h.shape
    (nq, ck, cv, sk, sv, wk, wv, ng, dq, dk, dv, hq, hf, hi, hg) = split_cols(h @ w_in)

    def kvh(a):
        return a.reshape(b, t, NSA_KV_HEADS, HEAD_DIM)

    q_n = rms_norm(nq.reshape(b, t, NSA_HEADS, HEAD_DIM), nsa_q_norm)
    k_c = rms_norm(nsa_compress(kvh(ck), nsa_cmp_pos[0], nsa_cmp_w1[0], nsa_cmp_w2[0]), nsa_k_norm[0])
    v_c = nsa_compress(kvh(cv), nsa_cmp_pos[1], nsa_cmp_w1[1], nsa_cmp_w2[1])
    k_s = rms_norm(kvh(sk), nsa_k_norm[1])
    k_w = rms_norm(kvh(wk), nsa_k_norm[2])
    gates = jax.nn.sigmoid(ng.reshape(b, t, NSA_HEADS, 3))
    o_nsa = nsa_attention(q_n, k_c, v_c, k_s, kvh(sv), k_w, kvh(wv), gates, rel_bias[:, :NSA_HEADS])

    q_d = rms_norm(dq.reshape(b, t, DIFF_HEADS, 2, DIFF_QK_DIM), diff_q_norm)
    k_d = rms_norm(dk.reshape(b, t, DIFF_HEADS, 2, DIFF_QK_DIM), diff_k_norm)
    v_d = dv.reshape(b, t, DIFF_HEADS, HEAD_DIM)
    lam_init = 0.8 - 0.6 * math.exp(-0.3 * layer)
    lp = diff_lambda.astype(jnp.float32)
    lam = jnp.exp(jnp.sum(lp[0] * lp[1])) - jnp.exp(jnp.sum(lp[2] * lp[3])) + lam_init
    o_d = diff_attention(q_d, k_d, v_d, lam, rel_bias[:, NSA_HEADS:])
    o_d = rms_norm(o_d, diff_subln) * (1.0 - lam_init)

    fr = hf.reshape(b, t, HGRN_HEADS, HGRN_KEY_DIM).astype(jnp.float32)
    lb = hgrn_lb.reshape(HGRN_HEADS, HGRN_KEY_DIM)
    log_f = jnp.logaddexp(jnp.log(lb), jnp.log1p(-lb) + jax.nn.log_sigmoid(fr))
    i_gate = (1.0 - lb) * jax.nn.sigmoid(-fr)
    q_h = jax.nn.silu(hq.reshape(b, t, HGRN_HEADS, HGRN_KEY_DIM))
    o_h = hgrn2_scan(q_h, i_gate, hi.reshape(b, t, HGRN_HEADS, HGRN_VAL_DIM), log_f)
    o_h = rms_norm(o_h, hgrn_out_norm) * jax.nn.silu(hg.reshape(b, t, HGRN_HEADS, HGRN_VAL_DIM))

    mixed = jnp.concatenate([o_nsa, o_d.reshape(b, t, DIFF_WIDTH), o_h.reshape(b, t, HGRN_WIDTH)], axis=-1)
    return mixed @ w_out


def setup_inputs(seed: int = 0) -> dict:
    key = jax.random.key(seed)
    keys = iter(jax.random.split(key, 40))

    def normal(shape, scale):
        return jax.random.normal(next(keys), shape, jnp.float32) * scale

    def gain(shape):
        return 1.0 + 0.05 * jax.random.normal(next(keys), shape, jnp.float32)

    return {
        'x': normal((BATCH, SEQ, D_MODEL), 1.0),
        'p': normal((DEPTH, BATCH, SEQ, PLE_DIM), 1.0),
        'rel_bias': normal((NUM_BUCKETS, N_BIAS_HEADS), 0.2),
        'hgrn_lb_logits': normal((DEPTH, HGRN_KEY_WIDTH), 0.5),
        'ffn1_norm': gain((DEPTH, D_MODEL)),
        'ffn1_w_gate': normal((DEPTH, D_MODEL, D_FF), D_MODEL ** -0.5),
        'ffn1_w_up': normal((DEPTH, D_MODEL, D_FF), D_MODEL ** -0.5),
        'ffn1_w_down': normal((DEPTH, D_FF, D_MODEL), D_FF ** -0.5),
        'mix_norm': gain((DEPTH, D_MODEL)),
        'w_in': normal((DEPTH, D_MODEL, IN_WIDTH), D_MODEL ** -0.5),
        'w_out': normal((DEPTH, MIX_WIDTH, D_MODEL), MIX_WIDTH ** -0.5),
        'nsa_q_norm': gain((DEPTH, HEAD_DIM)),
        'nsa_k_norm': gain((DEPTH, 3, HEAD_DIM)),
        'nsa_cmp_pos': normal((DEPTH, 2, CMP_BLOCK, HEAD_DIM), 0.2),
        'nsa_cmp_w1': normal((DEPTH, 2, CMP_BLOCK * HEAD_DIM, CMP_HIDDEN), (CMP_BLOCK * HEAD_DIM) ** -0.5),
        'nsa_cmp_w2': normal((DEPTH, 2, CMP_HIDDEN, HEAD_DIM), CMP_HIDDEN ** -0.5),
        'diff_q_norm': gain((DEPTH, DIFF_QK_DIM)),
        'diff_k_norm': gain((DEPTH, DIFF_QK_DIM)),
        'diff_lambda': normal((DEPTH, 4, DIFF_QK_DIM), 0.1),
        'diff_subln': gain((DEPTH, HEAD_DIM)),
        'hgrn_out_norm': gain((DEPTH, HGRN_VAL_DIM)),
        'ffn2_norm': gain((DEPTH, D_MODEL)),
        'ffn2_w_gate': normal((DEPTH, D_MODEL, D_FF), D_MODEL ** -0.5),
        'ffn2_w_up': normal((DEPTH, D_MODEL, D_FF), D_MODEL ** -0.5),
        'ffn2_w_down': normal((DEPTH, D_FF, D_MODEL), D_FF ** -0.5),
        'ple_norm': gain((DEPTH, D_MODEL)),
        'ple_w_gate': normal((DEPTH, D_MODEL, D_MODEL), D_MODEL ** -0.5),
        'ple_w_proj': normal((DEPTH, PLE_DIM, D_MODEL), PLE_DIM ** -0.5),
        'ple_post_norm': gain((DEPTH, D_MODEL)),
    }


def reference(x, p, rel_bias, hgrn_lb_logits, ffn1_norm, ffn1_w_gate, ffn1_w_up, ffn1_w_down,
              mix_norm, w_in, w_out, nsa_q_norm, nsa_k_norm, nsa_cmp_pos, nsa_cmp_w1, nsa_cmp_w2,
              diff_q_norm, diff_k_norm, diff_lambda, diff_subln, hgrn_out_norm,
              ffn2_norm, ffn2_w_gate, ffn2_w_up, ffn2_w_down,
              ple_norm, ple_w_gate, ple_w_proj, ple_post_norm):
    lb_all = jnp.cumsum(jax.nn.softmax(hgrn_lb_logits.astype(jnp.float32), axis=0), axis=0)
    lb_all = lb_all - lb_all[0:1]
    for i in range(DEPTH):
        x = x + 0.5 * swiglu(rms_norm(x, ffn1_norm[i]), ffn1_w_gate[i], ffn1_w_up[i], ffn1_w_down[i])
        x = x + hybrid_mixer(rms_norm(x, mix_norm[i]), i, w_in[i], w_out[i], rel_bias, lb_all[i],
                             nsa_q_norm[i], nsa_k_norm[i], nsa_cmp_pos[i], nsa_cmp_w1[i], nsa_cmp_w2[i],
                             diff_q_norm[i], diff_k_norm[i], diff_lambda[i], diff_subln[i], hgrn_out_norm[i])
        x = x + 0.5 * swiglu(rms_norm(x, ffn2_norm[i]), ffn2_w_gate[i], ffn2_w_up[i], ffn2_w_down[i])
        gate = jax.nn.sigmoid(rms_norm(x, ple_norm[i]) @ ple_w_gate[i])
        x = x + gate * rms_norm(p[i] @ ple_w_proj[i], ple_post_norm[i])
    return x
```

```cpp
#include <hip/hip_runtime.h>
#include <hip/hip_cooperative_groups.h>
#include <cstdio>
#include <cstdint>
namespace cg = cooperative_groups;
__device__ __forceinline__ int TID() { int t = threadIdx.x; asm volatile("" : "+v"(t)); return t; }
namespace pg8 {
#define PG8_LAS __attribute__((address_space(3)))
typedef unsigned short bf16_t;
typedef short bf16x8 __attribute__((ext_vector_type(8)));
typedef float f32x4 __attribute__((ext_vector_type(4)));
typedef unsigned u32x4 __attribute__((ext_vector_type(4)));
constexpr int BM = 256, BK = 64, HALF = 128, HTB = HALF * BK * 2  , STAGE_BYTES = 8 * HTB, NXCD = 8, WGM = 8;

__host__ __device__ __forceinline__ int lds_byte(int r, int c) { const int st = (r >> 4) * 2 + (c >> 5), rr = r & 15, cc = c & 31, ob = rr * 64 + cc * 2; return st * 1024 + (ob ^ (((ob >> 9) & 1) << 5)); }
__host__ __device__ __forceinline__ void stage_rc(int b, int& R, int& C) { const int st = b / 1024, sb = b % 1024, swz = sb ^ (((sb >> 9) & 1) << 5); R = (st >> 1) * 16 + swz / 64; C = (st & 1) * 32 + (swz % 64) / 2; }
__host__ __device__ __forceinline__ int perm32(int rho) { const int n = rho >> 4, i = rho & 15; return 8 * (i >> 2) + 4 * n + (i & 3); }

struct Unit { int pm, pn; };
struct Gemm { const bf16_t* A; const bf16_t* Bt; int M, N, K; };

struct StaticOrder {
    int nM, nN, nwg, G, c;
    __host__ __device__ void init(int M, int N, int G_, int c_) { nM = M / BM; nN = N / BM; nwg = nM * nN; G = G_; c = c_; }
    __host__ __device__ bool next(int i, Unit& u) const {
        const long L = (long)i * G + c; if (L >= nwg) return false;
        int wgid = (int)L; { const int q = nwg / NXCD, r = nwg % NXCD, xcd = wgid % NXCD, off = wgid / NXCD; wgid = (xcd < r ? xcd * (q + 1) : r * (q + 1) + (xcd - r) * q) + off; }
        const int nig = WGM * nN, gid = wgid / nig, fm = gid * WGM, gsz = (nM - fm) < WGM ? (nM - fm) : WGM;
        u.pm = fm + ((wgid % nig) % gsz); u.pn = (wgid % nig) / gsz; return true;
    }
    __device__ __forceinline__ void a_ready(const Unit&) const {}
    __device__ __forceinline__ void done(const Unit&) const {}
};

template <class Epi, class Sched, bool ALIGN_EPI = false, bool SP2 = false>
__device__ __forceinline__ void gemm_phase(PG8_LAS unsigned char* lds, const Gemm g, const Sched& S, const Epi& E) {
    const int tid = TID(), wid = __builtin_amdgcn_readfirstlane(tid >> 6), lane = tid & 63, wr = wid >> 2, wc = wid & 3, fr = lane & 15, fq = lane >> 4;
    const int K = g.K, nt = K / BK;
    unsigned voffA[2], voffB[2];
#pragma unroll
    for (int i = 0; i < 2; ++i) { int R, C; stage_rc(tid * 16 + i * 8192, R, C); const int Rb = Epi::PERM ? ((R & ~31) + perm32(R & 31)) : R;
        voffA[i] = (unsigned)(R * K + C) * 2u; voffB[i] = (unsigned)(Rb * K + C) * 2u; }
    const size_t kstep = (size_t)(BK * 2);
    const size_t hstep = (size_t)HALF * K * 2;
    const size_t tstep = 2 * hstep;
    const unsigned ldsw = (unsigned)wid * 1024u;
    const int aoff = lds_byte(wr * 64 + fr, fq * 8), boff = lds_byte(wc * 32 + fr, fq * 8);
#define PG8_SA(b, h) (((b) * 2 + (h)) * HTB)
#define PG8_SB(b, h) ((4 + (b) * 2 + (h)) * HTB)
#define PG8_STAGE(bufoff, gbase, voff) do { _Pragma("unroll") for (int _i = 0; _i < 2; ++_i) \
        __builtin_amdgcn_global_load_lds((const unsigned*)((const char*)(gbase) + (voff)[_i]), (PG8_LAS unsigned*)(lds + (bufoff) + ldsw + _i * 8192), 16, 0, 0); } while (0)
#define PG8_LDA(dst, b, h) do { _Pragma("unroll") for (int m = 0; m < 4; ++m) _Pragma("unroll") for (int k = 0; k < 2; ++k) dst[m][k] = *(const PG8_LAS bf16x8*)(lds + PG8_SA(b, h) + aoff + m * 2048 + k * 1024); } while (0)
#define PG8_LDB(dst, b, h) do { _Pragma("unroll") for (int n = 0; n < 2; ++n) _Pragma("unroll") for (int k = 0; k < 2; ++k) dst[n][k] = *(const PG8_LAS bf16x8*)(lds + PG8_SB(b, h) + boff + n * 2048 + k * 1024); } while (0)
#define PG8_MMA(ai, bj, At, Bt) do { __builtin_amdgcn_s_setprio(1); _Pragma("unroll") for (int m = 0; m < 4; ++m) _Pragma("unroll") for (int n = 0; n < 2; ++n) _Pragma("unroll") for (int k = 0; k < 2; ++k) \
        acc[ai][bj][m][n] = __builtin_amdgcn_mfma_f32_16x16x32_bf16(Bt[n][k], At[m][k], acc[ai][bj][m][n], 0, 0, 0); __builtin_amdgcn_s_setprio(0); } while (0)
#define PG8_WAIT_V(n) asm volatile("s_waitcnt vmcnt(" #n ")" ::: "memory")
#define PG8_WAIT_L(n) asm volatile("s_waitcnt lgkmcnt(" #n ")" ::: "memory")
#define PG8_BAR __builtin_amdgcn_s_barrier()
#define PG8_SCHED __builtin_amdgcn_sched_barrier(0)
    Unit cur, nxt; int ui = 0;
    if (!S.next(0, cur)) return;
    f32x4 acc[2][2][4][2];
#pragma unroll
    for (int a = 0; a < 2; ++a)
#pragma unroll
        for (int b = 0; b < 2; ++b)
#pragma unroll
            for (int m = 0; m < 4; ++m)
#pragma unroll
                for (int n = 0; n < 2; ++n) acc[a][b][m][n] = (f32x4){0.f, 0.f, 0.f, 0.f};
    bf16x8 At[4][2], B0[2][2], B1[2][2];
    const char* cA = (const char*)g.A + (size_t)cur.pm * tstep; const char* cB = (const char*)g.Bt + (size_t)cur.pn * tstep;
    S.a_ready(cur);
    if constexpr (SP2) {
        PG8_STAGE(PG8_SB(0, 0), cB, voffB); PG8_STAGE(PG8_SB(0, 1), cB + hstep, voffB); PG8_STAGE(PG8_SA(0, 0), cA, voffA); PG8_STAGE(PG8_SA(0, 1), cA + hstep, voffA);
        if (wr == 1) PG8_BAR;
        PG8_WAIT_V(2); PG8_BAR;
        PG8_STAGE(PG8_SB(1, 0), cB + kstep, voffB); PG8_STAGE(PG8_SA(1, 0), cA + kstep, voffA); PG8_STAGE(PG8_SB(1, 1), cB + hstep + kstep, voffB);
        PG8_WAIT_V(6); PG8_BAR;
    } else {
        PG8_STAGE(PG8_SB(0, 0), cB, voffB); PG8_STAGE(PG8_SA(0, 0), cA, voffA); PG8_STAGE(PG8_SB(0, 1), cB + hstep, voffB); PG8_STAGE(PG8_SA(0, 1), cA + hstep, voffA);
        if (wr == 1) PG8_BAR;
        PG8_WAIT_V(4); PG8_BAR;
        PG8_STAGE(PG8_SB(1, 0), cB + kstep, voffB); PG8_STAGE(PG8_SA(1, 0), cA + kstep, voffA); PG8_STAGE(PG8_SB(1, 1), cB + hstep + kstep, voffB);
        PG8_WAIT_V(6); PG8_BAR;
    }
    for (;;) {
        const bool has_next = S.next(ui + 1, nxt);
        const char* nA = has_next ? (const char*)g.A + (size_t)nxt.pm * tstep : cA; const char* nB = has_next ? (const char*)g.Bt + (size_t)nxt.pn * tstep : cB;
        for (int t = 0; t < nt; t += 2) {
            const bool last = (t == nt - 2);
            const char* a1 = cA + (size_t)(t + 1) * kstep;
            const char* a2 = last ? nA : cA + (size_t)(t + 2) * kstep; const char* b2 = last ? nB : cB + (size_t)(t + 2) * kstep;
            const char* a3 = a2 + kstep; const char* b3 = b2 + kstep;
            if (last && has_next) S.a_ready(nxt);
            if constexpr (SP2) {
            PG8_LDB(B0, 0, 0); PG8_LDB(B1, 0, 1); PG8_SCHED; PG8_LDA(At, 0, 0); PG8_STAGE(PG8_SA(1, 1), a1 + hstep, voffA);
            PG8_WAIT_V(8); PG8_WAIT_L(0); PG8_BAR; PG8_MMA(0, 0, At, B0); PG8_MMA(0, 1, At, B1); PG8_BAR; PG8_SCHED;
            PG8_LDA(At, 0, 1); PG8_STAGE(PG8_SB(0, 0), b2, voffB); PG8_STAGE(PG8_SB(0, 1), b2 + hstep, voffB); PG8_STAGE(PG8_SA(0, 0), a2, voffA);
            PG8_WAIT_V(8); PG8_WAIT_L(0); PG8_BAR; PG8_MMA(1, 0, At, B0); PG8_MMA(1, 1, At, B1); PG8_BAR; PG8_SCHED;
            PG8_LDB(B0, 1, 0); PG8_LDB(B1, 1, 1); PG8_SCHED; PG8_LDA(At, 1, 0); PG8_STAGE(PG8_SA(0, 1), a2 + hstep, voffA);
            PG8_WAIT_V(8); PG8_WAIT_L(0); PG8_BAR; PG8_MMA(0, 0, At, B0); PG8_MMA(0, 1, At, B1); PG8_BAR; PG8_SCHED;
            PG8_LDA(At, 1, 1); PG8_STAGE(PG8_SB(1, 0), b3, voffB); PG8_STAGE(PG8_SB(1, 1), b3 + hstep, voffB); PG8_STAGE(PG8_SA(1, 0), a3, voffA);
            PG8_WAIT_V(8); PG8_WAIT_L(0); PG8_BAR; PG8_MMA(1, 0, At, B0); PG8_MMA(1, 1, At, B1); PG8_BAR; PG8_SCHED;
            } else {
            PG8_LDB(B0, 0, 0); PG8_SCHED; PG8_LDA(At, 0, 0); PG8_STAGE(PG8_SA(1, 1), a1 + hstep, voffA);
            PG8_WAIT_L(8); PG8_BAR; PG8_WAIT_L(0); PG8_MMA(0, 0, At, B0); PG8_BAR; PG8_SCHED;
            PG8_LDB(B1, 0, 1); PG8_STAGE(PG8_SB(0, 0), b2, voffB);
            PG8_BAR; PG8_WAIT_L(0); PG8_MMA(0, 1, At, B1); PG8_BAR;
            PG8_LDA(At, 0, 1); PG8_STAGE(PG8_SA(0, 0), a2, voffA);
            PG8_BAR; PG8_WAIT_L(0); PG8_MMA(1, 0, At, B0); PG8_BAR; PG8_SCHED;
            PG8_STAGE(PG8_SB(0, 1), b2 + hstep, voffB);
            PG8_WAIT_V(6); PG8_BAR; PG8_MMA(1, 1, At, B1); PG8_BAR;
            PG8_LDB(B0, 1, 0); PG8_SCHED; PG8_LDA(At, 1, 0); PG8_STAGE(PG8_SA(0, 1), a2 + hstep, voffA);
            PG8_WAIT_L(8); PG8_BAR; PG8_WAIT_L(0); PG8_MMA(0, 0, At, B0); PG8_BAR; PG8_SCHED;
            PG8_LDB(B1, 1, 1); PG8_STAGE(PG8_SB(1, 0), b3, voffB);
            PG8_BAR; PG8_WAIT_L(0); PG8_MMA(0, 1, At, B1); PG8_BAR;
            PG8_LDA(At, 1, 1); PG8_STAGE(PG8_SA(1, 0), a3, voffA);
            PG8_BAR; PG8_WAIT_L(0); PG8_MMA(1, 0, At, B0); PG8_BAR; PG8_SCHED;
            PG8_STAGE(PG8_SB(1, 1), b3 + hstep, voffB);
            PG8_WAIT_V(6); PG8_BAR; PG8_MMA(1, 1, At, B1); PG8_BAR;
            }
        }
        if constexpr (ALIGN_EPI) { if (wr == 0) PG8_BAR; }
        if constexpr (!Epi::AFTER_DRAIN) { E(acc, cur, wr, wc, fr, fq); S.done(cur); }
        if (!has_next) break;
#pragma unroll
        for (int a = 0; a < 2; ++a)
#pragma unroll
            for (int b = 0; b < 2; ++b)
#pragma unroll
                for (int m = 0; m < 4; ++m)
#pragma unroll
                    for (int n = 0; n < 2; ++n) acc[a][b][m][n] = (f32x4){0.f, 0.f, 0.f, 0.f};
        cur = nxt; cA = nA; cB = nB; ++ui;
        if constexpr (ALIGN_EPI) { if (wr == 1) PG8_BAR; }
    }
    PG8_WAIT_V(0);
    if constexpr (!ALIGN_EPI) { if (wr == 0) PG8_BAR; }
    PG8_BAR;
    if constexpr (Epi::AFTER_DRAIN) { E.fused(acc, cur, wr, wc, fr, fq, lds, wid, lane); S.done(cur); }
#undef PG8_SA
#undef PG8_SB
#undef PG8_STAGE
#undef PG8_LDA
#undef PG8_LDB
#undef PG8_MMA
#undef PG8_WAIT_V
#undef PG8_WAIT_L
#undef PG8_BAR
#undef PG8_SCHED
}
}

#define LAS __attribute__((address_space(3)))
typedef unsigned short bf16_t;
typedef short bf16x8 __attribute__((ext_vector_type(8)));
typedef float f32x4 __attribute__((ext_vector_type(4)));
typedef float f32x16 __attribute__((ext_vector_type(16)));
typedef unsigned u32x4 __attribute__((ext_vector_type(4)));
typedef unsigned u32x2 __attribute__((ext_vector_type(2)));

constexpr int NB = 4, T = 8192, DM = 1024, M = NB * T, DEPTH = 4, PLE = 256, FF = 2816, ZW = 3584, INW = 3474;
constexpr int C_NQ = 0, C_CK = 384, C_CV = 512, C_SK = 640, C_SV = 768, C_WK = 896, C_WV = 1024, C_DQ = 1152, C_DK = 1408, C_DV = 1664,
              C_HQ = 1920, C_HF = 2304, C_HI = 2688, C_HG = 3072, C_NG = 3456;
constexpr float EPS = 1e-6f, LOG2E = 1.4426950408889634f;
enum { I_X = 0, I_P, I_RELB, I_LBLOG, I_F1N, I_F1G, I_F1U, I_F1D, I_MIXN, I_WIN, I_WOUT, I_NQN, I_NKN, I_CPOS, I_CW1, I_CW2,
       I_DQN, I_DKN, I_DLAM, I_DSUB, I_HON, I_F2N, I_F2G, I_F2U, I_F2D, I_PLN, I_PLG, I_PLP, I_PLPOST, N_IN };
constexpr size_t MiB = 1u << 20;
constexpr size_t WS_CTL = 0, WS_W = 1 * MiB, WS_PB = 53 * MiB, WS_XB = 69 * MiB, WS_R1 = 133 * MiB, WS_MIX = 357 * MiB, WS_VT = 421 * MiB,
                 WS_HS = 453 * MiB, WS_KC = 501 * MiB, WS_VCT = WS_KC + 512 * 1024, WS_SELM = 503 * MiB, WS_RSQ0 = 504 * MiB, WS_RSQ1 = 506 * MiB,
                 WS_RSQP = 508 * MiB, WS_HD = 510 * MiB, WS_XB1 = 511 * MiB, WS_END = 575 * MiB;
constexpr size_t W_GU1 = 0, W_D1 = 11 * MiB, W_GU2 = W_D1 + 5 * MiB + 512 * 1024, W_D2 = W_GU2 + 11 * MiB, W_IN = 33 * MiB, W_OUT = 40 * MiB, W_PG = 42 * MiB,
                 W_PP = 44 * MiB, W_1T = W_PP + 512 * 1024, W_2T = W_1T + 2 * MiB, W_POSB = W_2T + 64 * 1024;
static_assert(W_D2 + 5 * MiB + 512 * 1024 == W_IN, "weight map");
constexpr int LDS_BYTES = 132 * 1024, LDS_MISC = 131072;

__device__ __forceinline__ float bf2f(unsigned short u) { return __uint_as_float(((unsigned)u) << 16); }
__device__ __forceinline__ float bflo(unsigned w) { return __uint_as_float(w << 16); }
__device__ __forceinline__ float bfhi(unsigned w) { return __uint_as_float(w & 0xffff0000u); }
typedef float f32x2_t __attribute__((ext_vector_type(2))); typedef __bf16 bf16x2_t __attribute__((ext_vector_type(2)));
__device__ __forceinline__ unsigned pk2(float lo, float hi) { f32x2_t v = {lo, hi}; bf16x2_t b = __builtin_convertvector(v, bf16x2_t); return __builtin_bit_cast(unsigned, b); }
__device__ __forceinline__ bf16_t f2bf(float f) { return (bf16_t)(pk2(f, 0.f) & 0xffffu); }
__device__ __forceinline__ float ex2(float x) { return __builtin_amdgcn_exp2f(x); }
__device__ __forceinline__ float sigmoidf_(float x) { return 1.0f / (1.0f + __expf(-x)); }
__device__ __forceinline__ int crow(int r, int hi) { return (r & 3) + 8 * (r >> 2) + 4 * hi; }
__device__ __forceinline__ f32x16 mfma32(bf16x8 a, bf16x8 b, f32x16 c) { return __builtin_amdgcn_mfma_f32_32x32x16_bf16(a, b, c, 0, 0, 0); }
__device__ __forceinline__ f32x4 mfma16(bf16x8 a, bf16x8 b, f32x4 c) { return __builtin_amdgcn_mfma_f32_16x16x32_bf16(a, b, c, 0, 0, 0); }
__device__ __forceinline__ bf16x8 as_bf16x8(u32x4 v) { return __builtin_bit_cast(bf16x8, v); }
#define LDSW() asm volatile("s_waitcnt lgkmcnt(0)" ::: "memory")
#define CFENCE() asm volatile("" ::: "memory")
__device__ __forceinline__ const float* inp(int i) { asm volatile("" : "+s"(i)); return ((const float* const __attribute__((address_space(4)))*)__builtin_amdgcn_kernarg_segment_ptr())[i]; }

__device__ __forceinline__ float row_rinv(const float* rsq, int row) {
    const f32x4* p = (const f32x4*)(rsq + (size_t)row * 16);
    const f32x4 a = p[0], b = p[1], c = p[2], d = p[3];
    const float s = ((a.x + a.y) + (a.z + a.w)) + ((b.x + b.y) + (b.z + b.w)) + ((c.x + c.y) + (c.z + c.w)) + ((d.x + d.y) + (d.z + d.w));
    return rsqrtf(s * (1.0f / 1024.0f) + EPS);
}
struct EpiSwiGLU {
    static constexpr bool PERM = true, AFTER_DRAIN = false;
    bf16_t* O; const float* rsq;
    __device__ __forceinline__ void operator()(const f32x4 (&acc)[2][2][4][2], const pg8::Unit& u, int wr, int wc, int fr, int fq) const {
#pragma unroll
        for (int ai = 0; ai < 2; ++ai)
#pragma unroll
            for (int m = 0; m < 4; ++m) {
                const int row = u.pm * 256 + ai * 128 + wr * 64 + m * 16 + fr;
                const float r = row_rinv(rsq, row);
                float o[8];
#pragma unroll
                for (int n = 0; n < 2; ++n)
#pragma unroll
                    for (int e = 0; e < 4; ++e) { const float g = acc[ai][0][m][n][e] * r, up = acc[ai][1][m][n][e] * r; o[n * 4 + e] = g * sigmoidf_(g) * up; }
                u32x4 w; w.x = pk2(o[0], o[1]); w.y = pk2(o[2], o[3]); w.z = pk2(o[4], o[5]); w.w = pk2(o[6], o[7]);
                *(u32x4*)(O + (size_t)row * FF + u.pn * 128 + wc * 32 + 8 * fq) = w;
                CFENCE();
            }
    }
};
struct EpiZ {
    static constexpr bool PERM = true, AFTER_DRAIN = false;
    bf16_t* Z; const float* rsq;
    __device__ __forceinline__ void operator()(const f32x4 (&acc)[2][2][4][2], const pg8::Unit& u, int wr, int wc, int fr, int fq) const {
#pragma unroll
        for (int ai = 0; ai < 2; ++ai)
#pragma unroll
            for (int m = 0; m < 4; ++m) {
                const int row = u.pm * 256 + ai * 128 + wr * 64 + m * 16 + fr;
                const float r = row_rinv(rsq, row);
#pragma unroll
                for (int bj = 0; bj < 2; ++bj) {
                    const f32x4 v0 = acc[ai][bj][m][0] * r, v1 = acc[ai][bj][m][1] * r;
                    u32x4 w; w.x = pk2(v0[0], v0[1]); w.y = pk2(v0[2], v0[3]); w.z = pk2(v1[0], v1[1]); w.w = pk2(v1[2], v1[3]);
                    *(u32x4*)(Z + (size_t)row * ZW + u.pn * 256 + bj * 128 + wc * 32 + 8 * fq) = w;
                }
                CFENCE();
            }
    }
};
template <int MODE> struct EpiRes {
    static constexpr bool PERM = false, AFTER_DRAIN = false;
    float* X; bf16_t* XB; float* rsq_out; float alpha; const float* rsq_in; const bf16_t* P; const float* rsqp; const float* post; bf16_t* Pout;
    __device__ __forceinline__ void operator()(const f32x4 (&acc)[2][2][4][2], const pg8::Unit& u, int wr, int wc, int fr, int fq) const {
#pragma unroll
        for (int ai = 0; ai < 2; ++ai)
#pragma unroll
            for (int m = 0; m < 4; ++m) {
                const int row = u.pm * 256 + ai * 128 + wr * 64 + m * 16 + fr;
                float r = 1.f, rp = 1.f;
                if (MODE == 1) { r = row_rinv(rsq_in, row); rp = row_rinv(rsqp, row); }
                float ss = 0.f;
#pragma unroll
                for (int bj = 0; bj < 2; ++bj)
#pragma unroll
                    for (int n = 0; n < 2; ++n) {
                        const int c0 = u.pn * 256 + bj * 128 + wc * 32 + 16 * n + 4 * fq;
                        const size_t off = (size_t)row * DM + c0;
                        const f32x4 a = acc[ai][bj][m][n];
                        if (MODE == 2) {
                            u32x2 w; w.x = pk2(a[0], a[1]); w.y = pk2(a[2], a[3]);
                            *(u32x2*)(Pout + off) = w;
                            ss += (a[0] * a[0] + a[1] * a[1]) + (a[2] * a[2] + a[3] * a[3]);
                        } else {
                            f32x4 xv = *(const f32x4*)(X + off);
                            if (MODE == 0) xv += a * alpha;
                            else {
                                const u32x2 pw = *(const u32x2*)(P + off); const f32x4 po = *(const f32x4*)(post + c0);
                                xv[0] += sigmoidf_(a[0] * r) * (bflo(pw.x) * rp * po[0]);
                                xv[1] += sigmoidf_(a[1] * r) * (bfhi(pw.x) * rp * po[1]);
                                xv[2] += sigmoidf_(a[2] * r) * (bflo(pw.y) * rp * po[2]);
                                xv[3] += sigmoidf_(a[3] * r) * (bfhi(pw.y) * rp * po[3]);
                            }
                            *(f32x4*)(X + off) = xv;
                            u32x2 w; w.x = pk2(xv[0], xv[1]); w.y = pk2(xv[2], xv[3]);
                            *(u32x2*)(XB + off) = w;
                            ss += (xv[0] * xv[0] + xv[1] * xv[1]) + (xv[2] * xv[2] + xv[3] * xv[3]);
                        }
                    }
                ss += __shfl_xor(ss, 16); ss += __shfl_xor(ss, 32);
                if (fq == 0) rsq_out[(size_t)row * 16 + u.pn * 4 + wc] = ss;
                CFENCE();
            }
    }
};

template <class Epi> __device__ __forceinline__ void run_gemm(LAS unsigned char* lds, const bf16_t* A, const bf16_t* Bt, int N, int K, const Epi& E) {
    pg8::Gemm g{A, Bt, M, N, K}; int bx = blockIdx.x; asm volatile("" : "+s"(bx)); asm volatile("" : "+s"(K)); asm volatile("" : "+s"(N)); pg8::StaticOrder S; S.init(M, N, (int)gridDim.x, bx);
    pg8::gemm_phase<Epi, pg8::StaticOrder, true, true>(lds, g, S, E);
    __syncthreads();
}

__device__ __forceinline__ int next_task(unsigned* ctr, LAS int* slot) {
    __syncthreads();
    if (TID() == 0) *slot = (int)atomicAdd(ctr, 1u);
    __syncthreads();
    return *slot;
}

__device__ __forceinline__ int colmap(int mode, int n) {
    if (mode == 1) return 256 * (n >> 7) + (n & 127);
    if (mode == 2) return 256 * (n >> 7) + 128 + (n & 127);
    if (mode == 3) return n < 1152 ? n : (n < 1170 ? 3456 + (n - 1152) : n - 18);
    return n;
}
__device__ __forceinline__ void conv_item(const float* W, int K, int N, bf16_t* WT, const float* gain, int mode, LAS float* scr, int item, int lane) {
    const int nblk = (N + 31) >> 5, kb = item / nblk, nb = item % nblk, k0 = 64 * kb, n0 = 32 * nb;
#pragma unroll 8
    for (int i = 0; i < 32; ++i) {
        const int kk = 2 * i + (lane >> 5), n = n0 + (lane & 31);
        float v = (n < N) ? W[(size_t)(k0 + kk) * N + n] : 0.f;
        if (gain) v *= gain[k0 + kk];
        scr[kk * 33 + (lane & 31)] = v;
    }
    LDSW();
    const int c = lane & 7;
#pragma unroll
    for (int j = 0; j < 4; ++j) {
        const int nl = (lane >> 3) + 8 * j, n = n0 + nl;
        const LAS float* s = scr + (8 * c) * 33 + nl;
        u32x4 o; o.x = pk2(s[0], s[33]); o.y = pk2(s[2 * 33], s[3 * 33]); o.z = pk2(s[4 * 33], s[5 * 33]); o.w = pk2(s[6 * 33], s[7 * 33]);
        if (n < N) *(u32x4*)(WT + (size_t)colmap(mode, n) * K + k0 + 8 * c) = o;
    }
    LDSW();
}

__device__ __forceinline__ void phase_convert(const float* const* in, unsigned char* ws, float* out, int L, LAS unsigned char* lds) {
    const int tid = TID(), lane = tid & 63, wave = tid >> 6;
    const int gw = blockIdx.x * 8 + wave, NGW = gridDim.x * 8;
    LAS float* scr = (LAS float*)(lds + wave * 8704);
    unsigned char* wb = ws + WS_W;
    const size_t ffo = (size_t)L * DM * FF;
    constexpr int IT_GU = (DM / 64) * (FF / 32), IT_D = (FF / 64) * (DM / 32), IT_IN = (DM / 64) * ((INW + 31) / 32), IT_SQ = (DM / 64) * (DM / 32),
                  IT_PP = (PLE / 64) * (DM / 32), IT_W1 = (2048 / 64) * (256 / 32), IT_W2 = (256 / 64) * (64 / 32);
    constexpr int total = 4 * IT_GU + 2 * IT_D + IT_IN + 2 * IT_SQ + IT_PP + 2 * IT_W1 + 2 * IT_W2;
    for (int it = gw; it < total; it += NGW) {
        const float* W = nullptr; int K = 0, N = 0; bf16_t* WT = nullptr; const float* gain = nullptr; int mode = 0, rr = -1, r = it;
#define JOB(Wp, Kk, Nn, WTp, gp, md, items) { if (rr < 0 && r < (items)) { W = (Wp); K = (Kk); N = (Nn); WT = (bf16_t*)(WTp); gain = (gp); mode = (md); rr = r; } r -= (items); }
        JOB(inp(I_F1G) + ffo, DM, FF, wb + W_GU1, inp(I_F1N) + L * DM, 1, IT_GU)
        JOB(inp(I_F1U) + ffo, DM, FF, wb + W_GU1, inp(I_F1N) + L * DM, 2, IT_GU)
        JOB(inp(I_F1D) + ffo, FF, DM, wb + W_D1, nullptr, 0, IT_D)
        JOB(inp(I_F2G) + ffo, DM, FF, wb + W_GU2, inp(I_F2N) + L * DM, 1, IT_GU)
        JOB(inp(I_F2U) + ffo, DM, FF, wb + W_GU2, inp(I_F2N) + L * DM, 2, IT_GU)
        JOB(inp(I_F2D) + ffo, FF, DM, wb + W_D2, nullptr, 0, IT_D)
        JOB(inp(I_WIN) + (size_t)L * DM * INW, DM, INW, wb + W_IN, inp(I_MIXN) + L * DM, 3, IT_IN)
        JOB(inp(I_WOUT) + (size_t)L * DM * DM, DM, DM, wb + W_OUT, nullptr, 0, IT_SQ)
        JOB(inp(I_PLG) + (size_t)L * DM * DM, DM, DM, wb + W_PG, inp(I_PLN) + L * DM, 0, IT_SQ)
        JOB(inp(I_PLP) + (size_t)L * PLE * DM, PLE, DM, wb + W_PP, nullptr, 0, IT_PP)
        JOB(inp(I_CW1) + (size_t)(L * 2 + 0) * 2048 * 256, 2048, 256, wb + W_1T, nullptr, 0, IT_W1)
        JOB(inp(I_CW1) + (size_t)(L * 2 + 1) * 2048 * 256, 2048, 256, wb + W_1T + 256 * 2048 * 2, nullptr, 0, IT_W1)
        JOB(inp(I_CW2) + (size_t)(L * 2 + 0) * 256 * 64, 256, 64, wb + W_2T, nullptr, 0, IT_W2)
        JOB(inp(I_CW2) + (size_t)(L * 2 + 1) * 256 * 64, 256, 64, wb + W_2T + 64 * 256 * 2, nullptr, 0, IT_W2)
#undef JOB
        conv_item(W, K, N, WT, gain, mode, scr, rr, lane);
    }
    {
        u32x4* z = (u32x4*)((bf16_t*)(wb + W_IN) + (size_t)INW * DM);
        const int n16 = (ZW - INW) * DM / 8;
        for (int i = blockIdx.x * 512 + tid; i < n16; i += gridDim.x * 512) z[i] = (u32x4){0u, 0u, 0u, 0u};
    }
    {
        const f32x4* src = (const f32x4*)(inp(I_P) + (size_t)L * M * PLE); u32x4* dst = (u32x4*)(ws + WS_PB);
        const int n8 = M * PLE / 8;
        for (int i = blockIdx.x * 512 + tid; i < n8; i += gridDim.x * 512) {
            const f32x4 a = src[2 * i], b = src[2 * i + 1];
            u32x4 w; w.x = pk2(a[0], a[1]); w.y = pk2(a[2], a[3]); w.z = pk2(b[0], b[1]); w.w = pk2(b[2], b[3]); dst[i] = w;
        }
    }
    if (gw < 64) {
        const int ty = gw >> 5, ng = (gw >> 3) & 3, ks = gw & 7, n = ng * 64 + lane;
        const float* w1 = inp(I_CW1) + (size_t)(L * 2 + ty) * 2048 * 256; const float* pos = inp(I_CPOS) + (size_t)(L * 2 + ty) * 2048;
        float acc = 0.f;
        for (int k = ks * 256; k < ks * 256 + 256; ++k) acc += pos[k] * w1[(size_t)k * 256 + n];
        ((float*)(wb + W_POSB))[(ty * 8 + ks) * 256 + n] = acc;
    }
    if (L == 0) {
        const float* x = inp(I_X); bf16_t* xb = (bf16_t*)(ws + WS_XB); float* rsq = (float*)(ws + WS_RSQ0);
        for (int m = gw; m < M; m += NGW) {
            const f32x4* xr = (const f32x4*)(x + (size_t)m * DM) + lane; f32x4* orow = (f32x4*)(out + (size_t)m * DM) + lane;
            u32x2* xbr = (u32x2*)(xb + (size_t)m * DM) + lane;
            float s = 0.f;
#pragma unroll
            for (int j = 0; j < 4; ++j) { const f32x4 v = xr[64 * j]; orow[64 * j] = v; u32x2 w; w.x = pk2(v[0], v[1]); w.y = pk2(v[2], v[3]); xbr[64 * j] = w; s += (v[0] * v[0] + v[1] * v[1]) + (v[2] * v[2] + v[3] * v[3]); }
#pragma unroll
            for (int o = 1; o < 64; o <<= 1) s += __shfl_xor(s, o);
            if (lane < 16) rsq[(size_t)m * 16 + lane] = (lane == 0) ? s : 0.f;
        }
    }
}

__device__ __forceinline__ void task_prep(const float* const* in, unsigned char* ws, int L, int tile, LAS unsigned char* lds) {
    const int tid = TID(), lane = tid & 63, wave = tid >> 6;
    bf16_t* z = (bf16_t*)(ws + WS_R1);
    const int row0 = tile * 64;
    for (int tt = wave; tt < 64; tt += 8) {
        bf16_t* zr = z + (size_t)(row0 + tt) * ZW;
#pragma unroll
        for (int pass = 0; pass < 3; ++pass) {
            const int seg = pass * 64 + lane;
            int col = 0, gs = 8; const float* gp = inp(I_NQN); float scale = 1.f;
            if (seg < 48) { col = C_NQ + 8 * seg; gp = inp(I_NQN) + L * 64 + ((8 * seg) & 63); scale = 0.125f * LOG2E; }
            else if (seg < 64) { col = C_SK + 8 * (seg - 48); gp = inp(I_NKN) + (L * 3 + 1) * 64 + ((8 * seg) & 63); }
            else if (seg < 80) { col = C_WK + 8 * (seg - 64); gp = inp(I_NKN) + (L * 3 + 2) * 64 + ((8 * seg) & 63); }
            else if (seg < 112) { col = C_DQ + 8 * (seg - 80); gp = inp(I_DQN) + L * 32 + ((8 * seg) & 31); gs = 4; scale = 0.17677669529663689f * LOG2E; }
            else { col = C_DK + 8 * (seg - 112); gp = inp(I_DKN) + L * 32 + ((8 * seg) & 31); gs = 4; }
            const bool act = seg < 144;
            u32x4 w = (u32x4){0u, 0u, 0u, 0u};
            if (act) w = *(const u32x4*)(zr + col);
            float v[8] = {bflo(w.x), bfhi(w.x), bflo(w.y), bfhi(w.y), bflo(w.z), bfhi(w.z), bflo(w.w), bfhi(w.w)};
            float ss = 0.f;
#pragma unroll
            for (int e = 0; e < 8; ++e) ss += v[e] * v[e];
            ss += __shfl_xor(ss, 1); ss += __shfl_xor(ss, 2);
            const float t4 = __shfl_xor(ss, 4); if (gs == 8) ss += t4;
            const float r = rsqrtf(ss / (float)(gs * 8) + EPS) * scale;
            if (act) {
                const f32x4 g0 = *(const f32x4*)gp, g1 = *(const f32x4*)(gp + 4);
                u32x4 o; o.x = pk2(v[0] * r * g0[0], v[1] * r * g0[1]); o.y = pk2(v[2] * r * g0[2], v[3] * r * g0[3]);
                o.z = pk2(v[4] * r * g1[0], v[5] * r * g1[1]); o.w = pk2(v[6] * r * g1[2], v[7] * r * g1[3]);
                *(u32x4*)(zr + col) = o;
            }
        }
    }
    LAS bf16_t* tl = (LAS bf16_t*)lds;
#pragma unroll
    for (int i = 0; i < 8; ++i) {
        const int id = i * 512 + tid, row = id >> 6, ch = id & 63;
        const int col = ch < 16 ? C_SV + 8 * ch : (ch < 32 ? C_WV + 8 * (ch - 16) : C_DV + 8 * (ch - 32));
        *(LAS u32x4*)(tl + row * 520 + 8 * ch) = *(const u32x4*)(z + (size_t)(row0 + row) * ZW + col);
    }
    __syncthreads();
    const int b = row0 / T, t0 = row0 % T;
    bf16_t* vt = (bf16_t*)(ws + WS_VT);
#pragma unroll
    for (int i = 0; i < 8; ++i) {
        const int orow = tid, tch = i;
        const LAS bf16_t* s = tl + (tch * 8) * 520 + orow;
        u32x4 o;
        o.x = (unsigned)s[0] | ((unsigned)s[520] << 16); o.y = (unsigned)s[2 * 520] | ((unsigned)s[3 * 520] << 16);
        o.z = (unsigned)s[4 * 520] | ((unsigned)s[5 * 520] << 16); o.w = (unsigned)s[6 * 520] | ((unsigned)s[7 * 520] << 16);
        *(u32x4*)(vt + ((size_t)(b * 8) * 64 + orow) * T + t0 + 8 * tch) = o;
    }
}

__device__ __forceinline__ float gelu_tanh(float x) {
    const float y = 0.7978845608028654f * (x + 0.044715f * x * x * x);
    const float th = 1.0f - 2.0f / (1.0f + __expf(2.0f * y));
    return 0.5f * x * (1.0f + th);
}
__device__ __forceinline__ void task_compress(const float* const* in, unsigned char* ws, int L, int task, LAS unsigned char* lds) {
    const int tid = TID(), lane = tid & 63, wave = tid >> 6;
    const int ty = task >> 8, b = (task >> 6) & 3, g = (task >> 5) & 1, i0 = (task & 31) * 16;
    const bf16_t* z = (const bf16_t*)(ws + WS_R1);
    LAS bf16_t* zt = (LAS bf16_t*)lds;
    LAS bf16_t* hid = (LAS bf16_t*)(lds + 39168);
    LAS float* ofp = (LAS float*)(lds + 39168 + 8448);
    const int ccol = (ty ? C_CV : C_CK) + 64 * g;
    for (int id = tid; id < 272 * 8; id += 512) {
        const int row = id >> 3, ch = id & 7, tok = 16 * i0 + row;
        u32x4 v = (u32x4){0u, 0u, 0u, 0u};
        if (tok < T) v = *(const u32x4*)(z + (size_t)(b * T + tok) * ZW + ccol + 8 * ch);
        *(LAS u32x4*)(zt + row * 72 + 8 * ch) = v;
    }
    __syncthreads();
    const bf16_t* w1t = (const bf16_t*)(ws + WS_W + W_1T) + (size_t)ty * 256 * 2048;
    const bf16_t* w2t = (const bf16_t*)(ws + WS_W + W_2T) + (size_t)ty * 64 * 256;
    const float* posb = (const float*)(ws + WS_W + W_POSB) + ty * 8 * 256;
    const int r16 = lane & 15, kq = lane >> 4;
    f32x4 acc[2] = {(f32x4){0.f, 0.f, 0.f, 0.f}, (f32x4){0.f, 0.f, 0.f, 0.f}};
    const bf16_t* b0p = w1t + (size_t)(16 * (2 * wave) + r16) * 2048 + 8 * kq;
    const bf16_t* b1p = b0p + 16 * 2048;
#pragma unroll 4
    for (int kc = 0; kc < 64; ++kc) {
        const bf16x8 a = *(const LAS bf16x8*)(zt + (16 * r16 + (kc >> 1)) * 72 + (kc & 1) * 32 + 8 * kq);
        const bf16x8 w0 = *(const bf16x8*)(b0p + 32 * kc), w1 = *(const bf16x8*)(b1p + 32 * kc);
        acc[0] = mfma16(a, w0, acc[0]); acc[1] = mfma16(a, w1, acc[1]);
    }
#pragma unroll
    for (int j = 0; j < 2; ++j) {
        const int n = 16 * (2 * wave + j) + r16;
        float pbias = 0.f;
#pragma unroll
        for (int ks = 0; ks < 8; ++ks) pbias += posb[ks * 256 + n];
#pragma unroll
        for (int i = 0; i < 4; ++i) hid[(4 * kq + i) * 264 + n] = f2bf(gelu_tanh(acc[j][i] + pbias));
    }
    __syncthreads();
    if (wave < 4) {
        f32x4 a2 = (f32x4){0.f, 0.f, 0.f, 0.f};
        const bf16_t* bp = w2t + (size_t)(16 * wave + r16) * 256 + 8 * kq;
#pragma unroll
        for (int kc = 0; kc < 8; ++kc) {
            const bf16x8 a = *(const LAS bf16x8*)(hid + r16 * 264 + 32 * kc + 8 * kq);
            const bf16x8 w = *(const bf16x8*)(bp + 32 * kc);
            a2 = mfma16(a, w, a2);
        }
#pragma unroll
        for (int i = 0; i < 4; ++i) ofp[(4 * kq + i) * 64 + 16 * wave + r16] = a2[i];
    }
    __syncthreads();
    if (tid < 256) {
        const int row = tid >> 4, c4 = (tid & 15) * 4, i = i0 + row;
        f32x4 o = *(const LAS f32x4*)(ofp + row * 64 + c4);
        float ss = (o[0] * o[0] + o[1] * o[1]) + (o[2] * o[2] + o[3] * o[3]);
        ss += __shfl_xor(ss, 1); ss += __shfl_xor(ss, 2); ss += __shfl_xor(ss, 4); ss += __shfl_xor(ss, 8);
        if (ty == 0) {
            const float r = rsqrtf(ss * (1.0f / 64.0f) + EPS);
            const f32x4 gn = *(const f32x4*)(inp(I_NKN) + (L * 3 + 0) * 64 + c4);
            o = o * r * gn;
        }
        if (i >= 511) o = (f32x4){0.f, 0.f, 0.f, 0.f};
        if (ty == 0) {
            u32x2 w; w.x = pk2(o[0], o[1]); w.y = pk2(o[2], o[3]);
            *(u32x2*)((bf16_t*)(ws + WS_KC) + ((size_t)(b * 2 + g) * 512 + i) * 64 + c4) = w;
        } else {
            bf16_t* vct = (bf16_t*)(ws + WS_VCT) + (size_t)(b * 2 + g) * 64 * 512;
#pragma unroll
            for (int e = 0; e < 4; ++e) vct[(size_t)(c4 + e) * 512 + i] = f2bf(o[e]);
        }
    }
}

__device__ __forceinline__ float hgrn_lb(const float* logits, int L, int j) {
    if (L == 0) return 0.f;
    const float a0 = logits[j], a1 = logits[384 + j], a2 = logits[768 + j], a3 = logits[1152 + j];
    const float mx = fmaxf(fmaxf(a0, a1), fmaxf(a2, a3));
    const float e0 = __expf(a0 - mx), e1 = __expf(a1 - mx), e2 = __expf(a2 - mx), e3 = __expf(a3 - mx);
    const float inv = 1.0f / (e0 + e1 + e2 + e3);
    float s = e1; if (L >= 2) s += e2; if (L >= 3) s += e3;
    return s * inv;
}
__device__ __forceinline__ void task_hgrn_local(const float* const* in, unsigned char* ws, int L, int task, LAS unsigned char* lds) {
    const int tid = TID(), lane = tid & 63, wave = tid >> 6;
    if (wave < 6) {
        const int chunk = task * 6 + wave;
        const int bh = chunk >> 7, c = chunk & 127, b = bh / 6, h = bh % 6;
        const bf16_t* z = (const bf16_t*)(ws + WS_R1) + (size_t)(b * T + c * 64) * ZW;
        LAS bf16_t* klT = (LAS bf16_t*)(lds + wave * 18432);
        LAS bf16_t* vT = klT + 64 * 72;
        const float lb = hgrn_lb(inp(I_LBLOG), L, h * 64 + lane);
        float suffix = 0.f;
        for (int s = 63; s >= 0; --s) {
            const float fr = bf2f(z[(size_t)s * ZW + C_HF + 64 * h + lane]);
            const float vv = bf2f(z[(size_t)s * ZW + C_HI + 64 * h + lane]);
            const float sg = sigmoidf_(fr);
            const float f = lb + (1.0f - lb) * sg;
            const float ig = (1.0f - lb) * (1.0f - sg);
            klT[lane * 72 + s] = f2bf(ig * __expf(suffix));
            vT[lane * 72 + s] = f2bf(vv);
            suffix += __logf(f);
        }
        ((float*)(ws + WS_HD))[(size_t)chunk * 64 + lane] = __expf(suffix);
        LDSW();
        const int r32 = lane & 31, hi = lane >> 5;
        float* hs = (float*)(ws + WS_HS) + (size_t)chunk * 4096;
#pragma unroll
        for (int kb = 0; kb < 2; ++kb)
#pragma unroll
            for (int vb = 0; vb < 2; ++vb) {
                f32x16 cacc = {};
#pragma unroll
                for (int cc = 0; cc < 4; ++cc) {
                    const bf16x8 a = *(const LAS bf16x8*)(klT + (32 * kb + r32) * 72 + 16 * cc + 8 * hi);
                    const bf16x8 bb = *(const LAS bf16x8*)(vT + (32 * vb + r32) * 72 + 16 * cc + 8 * hi);
                    cacc = mfma32(a, bb, cacc);
                }
#pragma unroll
                for (int r = 0; r < 16; ++r) hs[(32 * kb + crow(r, hi)) * 64 + 32 * vb + r32] = cacc[r];
            }
    }
}
__device__ __forceinline__ void task_hgrn_scan(unsigned char* ws, int task) {
    const int tid = TID();
    const int bh = task >> 3, k = (task & 7) * 8 + (tid >> 6), v = tid & 63;
    float* hs = (float*)(ws + WS_HS) + (size_t)bh * 128 * 4096 + k * 64 + v;
    const float* hd = (const float*)(ws + WS_HD) + (size_t)bh * 128 * 64 + k;
    float S = 0.f;
#pragma unroll 8
    for (int c = 0; c < 128; ++c) {
        const float a = hs[(size_t)c * 4096], d = hd[c * 64];
        hs[(size_t)c * 4096] = S;
        S = d * S + a;
    }
}
__device__ __forceinline__ void task_hgrn_out(const float* const* in, unsigned char* ws, int L, int task, LAS unsigned char* lds) {
    const int tid = TID(), lane = tid & 63, wave = tid >> 6;
    if (wave < 3) {
        const int chunk = task * 3 + wave;
        const int bh = chunk >> 7, c = chunk & 127, b = bh / 6, h = bh % 6;
        const size_t row0 = (size_t)(b * T + c * 64);
        const bf16_t* z = (const bf16_t*)(ws + WS_R1) + row0 * ZW;
        LAS bf16_t* ke = (LAS bf16_t*)(lds + wave * 36864);
        LAS bf16_t* qe = ke + 64 * 72;
        LAS bf16_t* vT = qe + 64 * 72;
        LAS bf16_t* sT = vT + 64 * 72;
        const float lb = hgrn_lb(inp(I_LBLOG), L, h * 64 + lane);
        float ref = 0.f;
        for (int s = 0; s < 32; ++s) {
            const float fr = bf2f(z[(size_t)s * ZW + C_HF + 64 * h + lane]);
            ref += __logf(lb + (1.0f - lb) * sigmoidf_(fr));
        }
        float cum = 0.f;
        for (int s = 0; s < 64; ++s) {
            const float fr = bf2f(z[(size_t)s * ZW + C_HF + 64 * h + lane]);
            const float qv = bf2f(z[(size_t)s * ZW + C_HQ + 64 * h + lane]);
            const float vv = bf2f(z[(size_t)s * ZW + C_HI + 64 * h + lane]);
            const float sg = sigmoidf_(fr);
            const float f = lb + (1.0f - lb) * sg;
            const float ig = (1.0f - lb) * (1.0f - sg);
            cum += __logf(f);
            qe[s * 72 + lane] = f2bf(qv * sigmoidf_(qv) * __expf(cum - ref));
            ke[s * 72 + lane] = f2bf(ig * __expf(ref - cum));
            vT[lane * 72 + s] = f2bf(vv);
        }
        const float* hs = (const float*)(ws + WS_HS) + (size_t)chunk * 4096;
        const float eref = __expf(ref);
        for (int k = 0; k < 64; ++k) {
            const float er = __shfl(eref, k);
            sT[lane * 72 + k] = f2bf(hs[k * 64 + lane] * er);
        }
        LDSW();
        const int r32 = lane & 31, hi = lane >> 5;
        f32x16 O[2][2] = {};
#pragma unroll
        for (int tb = 0; tb < 2; ++tb) {
            bf16x8 qf[4];
#pragma unroll
            for (int cc = 0; cc < 4; ++cc) qf[cc] = *(const LAS bf16x8*)(qe + (32 * tb + r32) * 72 + 16 * cc + 8 * hi);
#pragma unroll
            for (int vb = 0; vb < 2; ++vb)
#pragma unroll
                for (int cc = 0; cc < 4; ++cc) {
                    const bf16x8 a = *(const LAS bf16x8*)(sT + (32 * vb + r32) * 72 + 16 * cc + 8 * hi);
                    O[vb][tb] = mfma32(a, qf[cc], O[vb][tb]);
                }
#pragma unroll
            for (int sb = 0; sb <= tb; ++sb) {
                f32x16 sc = {};
#pragma unroll
                for (int cc = 0; cc < 4; ++cc) {
                    const bf16x8 a = *(const LAS bf16x8*)(ke + (32 * sb + r32) * 72 + 16 * cc + 8 * hi);
                    sc = mfma32(a, qf[cc], sc);
                }
                unsigned P[8];
#pragma unroll
                for (int j = 0; j < 8; ++j) {
                    float p0 = sc[2 * j], p1 = sc[2 * j + 1];
                    if (sb == tb) { if (crow(2 * j, hi) > r32) p0 = 0.f; if (crow(2 * j + 1, hi) > r32) p1 = 0.f; }
                    P[j] = pk2(p0, p1);
                }
#pragma unroll
                for (int vb = 0; vb < 2; ++vb)
#pragma unroll
                    for (int c2 = 0; c2 < 2; ++c2) {
                        const u32x2 a0 = *(const LAS u32x2*)(vT + (32 * vb + r32) * 72 + 32 * sb + 16 * c2 + 4 * hi);
                        const u32x2 a1 = *(const LAS u32x2*)(vT + (32 * vb + r32) * 72 + 32 * sb + 16 * c2 + 8 + 4 * hi);
                        const bf16x8 vf = as_bf16x8((u32x4){a0.x, a0.y, a1.x, a1.y});
                        const bf16x8 pf = as_bf16x8((u32x4){P[4 * c2], P[4 * c2 + 1], P[4 * c2 + 2], P[4 * c2 + 3]});
                        O[vb][tb] = mfma32(vf, pf, O[vb][tb]);
                    }
            }
        }
        LDSW();
        const float* on = inp(I_HON) + L * 64;
#pragma unroll
        for (int tb = 0; tb < 2; ++tb) {
            float ss = 0.f;
#pragma unroll
            for (int vb = 0; vb < 2; ++vb)
#pragma unroll
                for (int r = 0; r < 16; ++r) ss += O[vb][tb][r] * O[vb][tb][r];
            ss += __shfl_xor(ss, 32);
            const float rn = rsqrtf(ss * (1.0f / 64.0f) + EPS);
#pragma unroll
            for (int vb = 0; vb < 2; ++vb)
#pragma unroll
                for (int r = 0; r < 16; ++r) { const int v = 32 * vb + crow(r, hi); ke[(32 * tb + r32) * 72 + v] = f2bf(O[vb][tb][r] * rn * on[v]); }
        }
        LDSW();
        bf16_t* mixed = (bf16_t*)(ws + WS_MIX) + row0 * DM + 640 + 64 * h;
#pragma unroll
        for (int i = 0; i < 8; ++i) {
            const int t = i * 8 + (lane >> 3), ch = lane & 7;
            const u32x4 ov = *(const LAS u32x4*)(ke + t * 72 + 8 * ch);
            const u32x4 gv = *(const u32x4*)(z + (size_t)t * ZW + C_HG + 64 * h + 8 * ch);
            u32x4 w;
            { const float g0 = bflo(gv.x), g1 = bfhi(gv.x); w.x = pk2(bflo(ov.x) * g0 * sigmoidf_(g0), bfhi(ov.x) * g1 * sigmoidf_(g1)); }
            { const float g0 = bflo(gv.y), g1 = bfhi(gv.y); w.y = pk2(bflo(ov.y) * g0 * sigmoidf_(g0), bfhi(ov.y) * g1 * sigmoidf_(g1)); }
            { const float g0 = bflo(gv.z), g1 = bfhi(gv.z); w.z = pk2(bflo(ov.z) * g0 * sigmoidf_(g0), bfhi(ov.z) * g1 * sigmoidf_(g1)); }
            { const float g0 = bflo(gv.w), g1 = bfhi(gv.w); w.w = pk2(bflo(ov.w) * g0 * sigmoidf_(g0), bfhi(ov.w) * g1 * sigmoidf_(g1)); }
            *(u32x4*)(mixed + (size_t)t * DM + 8 * ch) = w;
        }
    }
}

constexpr int ATT_K = 0, ATT_V = 18432, ATT_LUT = 35840, ATT_STAGE = 36864;
__device__ __forceinline__ void build_lut(LAS float* lut, const float* rel_bias, int head) {
    const int d = TID();
    if (d <= 128) {
        int bk = d;
        if (d >= 16) { const int far = 16 + (int)(__logf((float)d * (1.0f / 16.0f)) / 2.0794415416798357f * 16.0f); bk = far < 31 ? far : 31; }
        lut[d] = rel_bias[bk * 10 + head] * LOG2E;
    }
}
template <int NMAP, bool HAS_SEL>
__device__ __forceinline__ void attn_pass(LAS unsigned char* lds, const bf16_t* Kth, size_t kts, const bf16_t* Vth, int m_lo, int m_hi,
                                          const bf16x8 (&qr)[4], int tq, int qw0, int win, const LAS float* lut, u32x4 selw,
                                          f32x16 (&O)[NMAP][2], float (&l)[NMAP]) {
    const int tid = TID(), lane = tid & 63, r32 = lane & 31, hi = lane >> 5;
    const float c31 = lut[128];
    u32x4 kreg = *(const u32x4*)(Kth + (size_t)m_lo * kts), vreg = *(const u32x4*)(Vth + (size_t)m_lo * 64);
    int buf = 0;
    for (int m = m_lo; m <= m_hi; ++m) {
        *(LAS u32x4*)(lds + ATT_K + buf * 9216 + (tid >> 3) * 144 + (tid & 7) * 16) = kreg;
        { LAS u32x2* vp = (LAS u32x2*)(lds + ATT_V + buf * 8704 + (tid >> 3) * 136 + (tid & 7) * 16); vp[0] = (u32x2){vreg.x, vreg.y}; vp[1] = (u32x2){vreg.z, vreg.w}; }
        __syncthreads();
        if (m < m_hi) { kreg = *(const u32x4*)(Kth + (size_t)(m + 1) * kts); vreg = *(const u32x4*)(Vth + (size_t)(m + 1) * 64); }
        const int k0 = 64 * m, dmin = qw0 - (k0 + 63), dmax = qw0 + 31 - k0;
        bool sel = true;
        if (HAS_SEL) { const unsigned w = m < 32 ? selw.x : (m < 64 ? selw.y : (m < 96 ? selw.z : selw.w)); sel = (w >> (m & 31)) & 1u; }
        bool active = dmax >= 0 && dmin < win;
        if (HAS_SEL) active = active && (__any(sel) != 0);
        if (active) {
            const bool fast = dmin >= 128 && dmax < win;
            const LAS unsigned char* Kb = lds + ATT_K + buf * 9216;
            const LAS unsigned char* Vb = lds + ATT_V + buf * 8704;
            unsigned P[NMAP][2][8];
#pragma unroll
            for (int kh2 = 0; kh2 < 2; ++kh2) {
                f32x16 S[NMAP];
#pragma unroll
                for (int mp = 0; mp < NMAP; ++mp) { const float ini = fast ? c31 : 0.f;
#pragma unroll
                    for (int r = 0; r < 16; ++r) S[mp][r] = ini; }
#pragma unroll
                for (int c = 0; c < 4; ++c) {
                    const bf16x8 kf = *(const LAS bf16x8*)(Kb + (32 * kh2 + r32) * 144 + (16 * c + 8 * hi) * 2);
                    const int mp = (NMAP == 2) ? (c >> 1) : 0;
                    S[mp] = mfma32(kf, qr[c], S[mp]);
                }
#pragma unroll
                for (int mp = 0; mp < NMAP; ++mp) {
                    float p[16];
                    if (fast) {
#pragma unroll
                        for (int r = 0; r < 16; ++r) { const float e = ex2(S[mp][r]); p[r] = sel ? e : 0.f; }
                    } else {
#pragma unroll
                        for (int r = 0; r < 16; ++r) {
                            const int d = tq - (k0 + 32 * kh2 + crow(r, hi));
                            const bool valid = sel && d >= 0 && d < win;
                            const int dc = d < 0 ? 0 : (d > 128 ? 128 : d);
                            const float e = ex2(S[mp][r] + lut[dc]);
                            p[r] = valid ? e : 0.f;
                        }
                    }
                    float s = 0.f;
#pragma unroll
                    for (int r = 0; r < 16; ++r) s += p[r];
                    l[mp] += s;
#pragma unroll
                    for (int j = 0; j < 8; ++j) P[mp][kh2][j] = pk2(p[2 * j], p[2 * j + 1]);
                }
            }
#pragma unroll
            for (int db = 0; db < 2; ++db)
#pragma unroll
                for (int cc = 0; cc < 4; ++cc) {
                    const u32x2 a0 = *(const LAS u32x2*)(Vb + (32 * db + r32) * 136 + (16 * cc + 4 * hi) * 2);
                    const u32x2 a1 = *(const LAS u32x2*)(Vb + (32 * db + r32) * 136 + (16 * cc + 8 + 4 * hi) * 2);
                    const bf16x8 vf = as_bf16x8((u32x4){a0.x, a0.y, a1.x, a1.y});
#pragma unroll
                    for (int mp = 0; mp < NMAP; ++mp) {
                        const bf16x8 pf = as_bf16x8((u32x4){P[mp][cc >> 1][4 * (cc & 1)], P[mp][cc >> 1][4 * (cc & 1) + 1], P[mp][cc >> 1][4 * (cc & 1) + 2], P[mp][cc >> 1][4 * (cc & 1) + 3]});
                        O[mp][db] = mfma32(vf, pf, O[mp][db]);
                    }
                }
        }
        buf ^= 1;
    }
    __syncthreads();
}
template <bool ADD>
__device__ __forceinline__ void store_ot(LAS unsigned char* stage, const float (&val)[2][16], bf16_t* dst, int ld) {
    const int lane = TID() & 63, r32 = lane & 31, hi = lane >> 5;
    LAS bf16_t* st = (LAS bf16_t*)stage;
#pragma unroll
    for (int db = 0; db < 2; ++db)
#pragma unroll
        for (int r = 0; r < 16; ++r) st[r32 * 72 + 32 * db + crow(r, hi)] = f2bf(val[db][r]);
    LDSW();
#pragma unroll
    for (int i = 0; i < 4; ++i) {
        const int row = i * 8 + (lane >> 3), ch = lane & 7;
        u32x4 v = *(const LAS u32x4*)(st + row * 72 + 8 * ch);
        bf16_t* gp = dst + (size_t)row * ld + 8 * ch;
        if (ADD) {
            const u32x4 o = *(const u32x4*)gp;
            v.x = pk2(bflo(v.x) + bflo(o.x), bfhi(v.x) + bfhi(o.x)); v.y = pk2(bflo(v.y) + bflo(o.y), bfhi(v.y) + bfhi(o.y));
            v.z = pk2(bflo(v.z) + bflo(o.z), bfhi(v.z) + bfhi(o.z)); v.w = pk2(bflo(v.w) + bflo(o.w), bfhi(v.w) + bfhi(o.w));
        }
        *(u32x4*)gp = v;
    }
    LDSW();
}

__device__ __forceinline__ void task_diff(const float* const* in, unsigned char* ws, int L, int task, LAS unsigned char* lds) {
    const int tid = TID(), lane = tid & 63, wave = tid >> 6, r32 = lane & 31, hi = lane >> 5;
    const int qb = 31 - (task >> 4), b = (task >> 2) & 3, hd = task & 3;
    const bf16_t* z = (const bf16_t*)(ws + WS_R1);
    LAS float* lut = (LAS float*)(lds + ATT_LUT);
    build_lut(lut, inp(I_RELB), 6 + hd);
    __syncthreads();
    const int q0 = 256 * qb, qw0 = q0 + 32 * wave, tq = qw0 + r32;
    bf16x8 qr[4];
#pragma unroll
    for (int c = 0; c < 4; ++c) qr[c] = *(const bf16x8*)(z + (size_t)(b * T + tq) * ZW + C_DQ + 64 * hd + 16 * c + 8 * hi);
    const bf16_t* Kth = z + (size_t)(b * T + (tid >> 3)) * ZW + C_DK + 64 * hd + (tid & 7) * 8;
    const bf16_t* Vth = (const bf16_t*)(ws + WS_VT) + ((size_t)(b * 8 + 4 + hd) * 64 + (tid >> 3)) * T + (tid & 7) * 8;
    f32x16 O[2][2] = {}; float l[2] = {0.f, 0.f};
    attn_pass<2, false>(lds, Kth, (size_t)64 * ZW, Vth, 0, 4 * qb + 3, qr, tq, qw0, 1 << 30, lut, (u32x4){0u, 0u, 0u, 0u}, O, l);
    const float* lp = inp(I_DLAM) + L * 128;
    float s01 = 0.f, s23 = 0.f;
#pragma unroll
    for (int i = 0; i < 32; ++i) { s01 += lp[i] * lp[32 + i]; s23 += lp[64 + i] * lp[96 + i]; }
    const float lam_init = 0.8f - 0.6f * __expf(-0.3f * (float)L);
    const float lam = __expf(s01) - __expf(s23) + lam_init;
    const float l0 = l[0] + __shfl_xor(l[0], 32), l1 = l[1] + __shfl_xor(l[1], 32);
    const float i0 = 1.0f / l0, i1 = lam / l1;
    float val[2][16]; float ss = 0.f;
#pragma unroll
    for (int db = 0; db < 2; ++db)
#pragma unroll
        for (int r = 0; r < 16; ++r) { const float o = O[0][db][r] * i0 - O[1][db][r] * i1; val[db][r] = o; ss += o * o; }
    ss += __shfl_xor(ss, 32);
    const float rn = rsqrtf(ss * (1.0f / 64.0f) + EPS) * (1.0f - lam_init);
    const float* sub = inp(I_DSUB) + L * 64;
#pragma unroll
    for (int db = 0; db < 2; ++db)
#pragma unroll
        for (int r = 0; r < 16; ++r) val[db][r] *= rn * sub[32 * db + crow(r, hi)];
    store_ot<false>(lds + ATT_STAGE + wave * 4608, val, (bf16_t*)(ws + WS_MIX) + (size_t)(b * T + qw0) * DM + 384 + 64 * hd, DM);
}

__device__ __forceinline__ void task_nsa_sw(const float* const* in, unsigned char* ws, int L, int task, LAS unsigned char* lds) {
    const int tid = TID(), lane = tid & 63, wave = tid >> 6, r32 = lane & 31, hi = lane >> 5;
    const int qb = 31 - task / 24, rem = task % 24, b = rem / 6, h = rem % 6, g = h / 3;
    const bf16_t* z = (const bf16_t*)(ws + WS_R1);
    LAS float* lut = (LAS float*)(lds + ATT_LUT);
    build_lut(lut, inp(I_RELB), h);
    __syncthreads();
    const int q0 = 256 * qb, qw0 = q0 + 32 * wave, tq = qw0 + r32;
    const bf16_t* zq = z + (size_t)(b * T + tq) * ZW;
    bf16x8 qr[4];
#pragma unroll
    for (int c = 0; c < 4; ++c) qr[c] = *(const bf16x8*)(zq + C_NQ + 64 * h + 16 * c + 8 * hi);
    const u32x4 selw = *(const u32x4*)((const unsigned*)(ws + WS_SELM) + ((size_t)(b * 2 + g) * T + tq) * 4);
    const float g1 = sigmoidf_(bf2f(zq[C_NG + 3 * h + 1])), g2 = sigmoidf_(bf2f(zq[C_NG + 3 * h + 2]));
    float val[2][16];
    {
        const bf16_t* Kth = z + (size_t)(b * T + (tid >> 3)) * ZW + C_SK + 64 * g + (tid & 7) * 8;
        const bf16_t* Vth = (const bf16_t*)(ws + WS_VT) + ((size_t)(b * 8 + g) * 64 + (tid >> 3)) * T + (tid & 7) * 8;
        f32x16 O[1][2] = {}; float l[1] = {0.f};
        attn_pass<1, true>(lds, Kth, (size_t)64 * ZW, Vth, 0, 4 * qb + 3, qr, tq, qw0, 1 << 30, lut, selw, O, l);
        const float lt = l[0] + __shfl_xor(l[0], 32), sc = g1 / lt;
#pragma unroll
        for (int db = 0; db < 2; ++db)
#pragma unroll
            for (int r = 0; r < 16; ++r) val[db][r] = O[0][db][r] * sc;
    }
    {
        const bf16_t* Kth = z + (size_t)(b * T + (tid >> 3)) * ZW + C_WK + 64 * g + (tid & 7) * 8;
        const bf16_t* Vth = (const bf16_t*)(ws + WS_VT) + ((size_t)(b * 8 + 2 + g) * 64 + (tid >> 3)) * T + (tid & 7) * 8;
        f32x16 O[1][2] = {}; float l[1] = {0.f};
        const int m_lo = q0 >= 512 ? (q0 >> 6) - 8 : 0;
        attn_pass<1, false>(lds, Kth, (size_t)64 * ZW, Vth, m_lo, 4 * qb + 3, qr, tq, qw0, 512, lut, (u32x4){0u, 0u, 0u, 0u}, O, l);
        const float lt = l[0] + __shfl_xor(l[0], 32), sc = g2 / lt;
#pragma unroll
        for (int db = 0; db < 2; ++db)
#pragma unroll
            for (int r = 0; r < 16; ++r) val[db][r] += O[0][db][r] * sc;
    }
    store_ot<true>(lds + ATT_STAGE + wave * 4608, val, (bf16_t*)(ws + WS_MIX) + (size_t)(b * T + qw0) * DM + 64 * h, DM);
}

constexpr int NC_IMP = 18432, NC_IMPW = 129, NC_LINV = NC_IMP + 3 * 64 * NC_IMPW * 4;
__device__ __forceinline__ void task_nsa_c(const float* const* in, unsigned char* ws, int L, int task, LAS unsigned char* lds) {
    const int tid = TID(), lane = tid & 63, wave = tid >> 6, r32 = lane & 31, hi = lane >> 5;
    const int cur = 127 - (task >> 3), b = (task >> 1) & 3, g = task & 1;
    const bf16_t* z = (const bf16_t*)(ws + WS_R1);
    LAS float* imp = (LAS float*)(lds + NC_IMP);
    LAS float* linv = (LAS float*)(lds + NC_LINV);
    const int q0 = 64 * cur;
    const int rh = wave >> 1, half = wave & 1, h = 3 * g + (rh < 3 ? rh : 0);
    const int ql = 32 * half + r32, tq = q0 + ql;
    const bf16_t* zq = z + (size_t)(b * T + tq) * ZW;
    bf16x8 qr[4];
#pragma unroll
    for (int c = 0; c < 4; ++c) qr[c] = *(const bf16x8*)(zq + C_NQ + 64 * h + 16 * c + 8 * hi);
    const bf16_t* Kth = (const bf16_t*)(ws + WS_KC) + ((size_t)(b * 2 + g) * 512 + (tid >> 3)) * 64 + (tid & 7) * 8;
    const bf16_t* Vth = (const bf16_t*)(ws + WS_VCT) + ((size_t)(b * 2 + g) * 64 + (tid >> 3)) * 512 + (tid & 7) * 8;
    const int ntiles = ((4 * cur + 2) >> 6) + 1;
    f32x16 O[2] = {}; float l = 0.f, carry = 0.f;
    for (int m = 0; m < ntiles; ++m) {
        __syncthreads();
        *(LAS u32x4*)(lds + (tid >> 3) * 144 + (tid & 7) * 16) = *(const u32x4*)(Kth + (size_t)m * 64 * 64);
        { const u32x4 v = *(const u32x4*)(Vth + (size_t)m * 64); LAS u32x2* vp = (LAS u32x2*)(lds + 9216 + (tid >> 3) * 136 + (tid & 7) * 16); vp[0] = (u32x2){v.x, v.y}; vp[1] = (u32x2){v.z, v.w}; }
        __syncthreads();
        if (wave < 6) {
            unsigned P[2][8]; float av[8], bq[8];
#pragma unroll
            for (int kh2 = 0; kh2 < 2; ++kh2) {
                f32x16 S = {};
#pragma unroll
                for (int c = 0; c < 4; ++c) { const bf16x8 kf = *(const LAS bf16x8*)(lds + (32 * kh2 + r32) * 144 + (16 * c + 8 * hi) * 2); S = mfma32(kf, qr[c], S); }
                float p[16];
#pragma unroll
                for (int r = 0; r < 16; ++r) { const int n = 64 * m + 32 * kh2 + crow(r, hi); const float e = ex2(S[r]); p[r] = (16 * n + 31 <= tq) ? e : 0.f; }
                float s = 0.f;
#pragma unroll
                for (int r = 0; r < 16; ++r) s += p[r];
                l += s;
#pragma unroll
                for (int j = 0; j < 8; ++j) P[kh2][j] = pk2(p[2 * j], p[2 * j + 1]);
#pragma unroll
                for (int j = 0; j < 4; ++j) { av[4 * kh2 + j] = p[4 * j] + p[4 * j + 1] + p[4 * j + 2] + 0.5f * p[4 * j + 3]; bq[4 * kh2 + j] = 0.5f * p[4 * j + 3]; }
            }
#pragma unroll
            for (int db = 0; db < 2; ++db)
#pragma unroll
                for (int cc = 0; cc < 4; ++cc) {
                    const u32x2 a0 = *(const LAS u32x2*)(lds + 9216 + (32 * db + r32) * 136 + (16 * cc + 4 * hi) * 2);
                    const u32x2 a1 = *(const LAS u32x2*)(lds + 9216 + (32 * db + r32) * 136 + (16 * cc + 8 + 4 * hi) * 2);
                    const bf16x8 vf = as_bf16x8((u32x4){a0.x, a0.y, a1.x, a1.y});
                    const bf16x8 pf = as_bf16x8((u32x4){P[cc >> 1][4 * (cc & 1)], P[cc >> 1][4 * (cc & 1) + 1], P[cc >> 1][4 * (cc & 1) + 2], P[cc >> 1][4 * (cc & 1) + 3]});
                    O[db] = mfma32(vf, pf, O[db]);
                }
            float recv[8];
#pragma unroll
            for (int jj = 0; jj < 8; ++jj) recv[jj] = __shfl_xor(bq[jj], 32);
            LAS float* ip = imp + (rh * 64 + ql) * NC_IMPW + 16 * m + hi;
#pragma unroll
            for (int jj = 0; jj < 8; ++jj) {
                const float add = hi ? recv[jj] : (jj == 0 ? carry : recv[jj > 0 ? jj - 1 : 0]);
                ip[2 * jj] = av[jj] + add;
            }
            carry = recv[7];
        }
    }
    if (wave < 6) {
        const float lt = l + __shfl_xor(l, 32);
        const float li = (tq >= 31 && lt > 0.f) ? 1.0f / lt : 0.f;
        if (hi == 0) linv[rh * 64 + ql] = li;
        const float g0 = sigmoidf_(bf2f(zq[C_NG + 3 * h + 0]));
        bf16_t* mx = (bf16_t*)(ws + WS_MIX) + (size_t)(b * T + tq) * DM + 64 * h;
        const float sc = li * g0;
#pragma unroll
        for (int db = 0; db < 2; ++db)
#pragma unroll
            for (int r = 0; r < 16; ++r) mx[32 * db + crow(r, hi)] = f2bf(O[db][r] * sc);
    }
    __syncthreads();
    for (int qi = 0; qi < 8; ++qi) {
        const int q = 8 * wave + qi;
        unsigned w0 = 0u, w1 = 0u, w2 = 0u, w3 = 0u;
        if (cur <= 15) { w0 = (1u << (cur + 1)) - 1u; }
        else {
            const float i0 = linv[q], i1 = linv[64 + q], i2 = linv[128 + q];
            const int ma = lane, mb = lane + 64;
            float va = 0.f, vb = 0.f;
            if (ma >= 1 && ma <= cur - 2) va = imp[(0 * 64 + q) * NC_IMPW + ma] * i0 + imp[(1 * 64 + q) * NC_IMPW + ma] * i1 + imp[(2 * 64 + q) * NC_IMPW + ma] * i2;
            if (mb <= cur - 2) vb = imp[(0 * 64 + q) * NC_IMPW + mb] * i0 + imp[(1 * 64 + q) * NC_IMPW + mb] * i1 + imp[(2 * 64 + q) * NC_IMPW + mb] * i2;
            unsigned long long mine_a = ((unsigned long long)__float_as_uint(va) << 32) | (unsigned)(255 - ma);
            unsigned long long mine_b = ((unsigned long long)__float_as_uint(vb) << 32) | (unsigned)(255 - mb);
            if (va <= 0.f) mine_a = 0ull;
            if (vb <= 0.f) mine_b = 0ull;
            unsigned long long sa = 0ull, sb = 0ull;
            for (int it = 0; it < 13; ++it) {
                unsigned long long best = mine_a > mine_b ? mine_a : mine_b;
#pragma unroll
                for (int o = 1; o < 64; o <<= 1) {
                    const unsigned oh = __shfl_xor((unsigned)(best >> 32), o), ol = __shfl_xor((unsigned)best, o);
                    const unsigned long long other = ((unsigned long long)oh << 32) | ol;
                    best = other > best ? other : best;
                }
                if (best != 0ull) {
                    const int mw = 255 - (int)(unsigned)(best & 0xffffffffull);
                    if (mw < 64) sa |= 1ull << mw; else sb |= 1ull << (mw - 64);
                    if (mine_a == best) mine_a = 0ull;
                    if (mine_b == best) mine_b = 0ull;
                }
            }
            sa |= 1ull;
            if (cur < 64) sa |= 1ull << cur; else sb |= 1ull << (cur - 64);
            if (cur - 1 < 64) sa |= 1ull << (cur - 1); else sb |= 1ull << (cur - 1 - 64);
            w0 = (unsigned)sa; w1 = (unsigned)(sa >> 32); w2 = (unsigned)sb; w3 = (unsigned)(sb >> 32);
        }
        if (lane == 0) *(u32x4*)((unsigned*)(ws + WS_SELM) + ((size_t)(b * 2 + g) * T + q0 + q) * 4) = (u32x4){w0, w1, w2, w3};
    }
}

struct Args { const float* in[N_IN]; float* out; unsigned char* ws; int ph_lo, ph_hi; };
static_assert(sizeof(Args) == 8 * N_IN + 24, "Args has no padding");
constexpr int PH_PER_LAYER = 11, N_PHASES = DEPTH * PH_PER_LAYER;
#ifndef PH_HI
#define PH_HI N_PHASES
#endif

__global__ void __launch_bounds__(512) mega(Args a) {
    extern __shared__ __attribute__((aligned(16))) unsigned char lds_raw[];
    LAS unsigned char* lds = (LAS unsigned char*)lds_raw;
    LAS int* slot = (LAS int*)(lds + LDS_MISC);
    cg::grid_group grid = cg::this_grid();
    const float* const* in = nullptr;
#ifndef PHM
#define PHM 0x7ff
#endif
#define PHASE_BEGIN(j) { const int ph_ = L * PH_PER_LAYER + (j); if (((PHM >> (j)) & 1) && ph_ >= a.ph_lo && ph_ < a.ph_hi) { int Lx_ = L; asm volatile("" : "+s"(Lx_)); const int L = Lx_; unsigned char* ws = a.ws; asm volatile("" : "+s"(ws)); \
    unsigned* ctl = (unsigned*)(ws + WS_CTL); bf16_t* r1 = (bf16_t*)(ws + WS_R1); bf16_t* mixed = (bf16_t*)(ws + WS_MIX); bf16_t* pb = (bf16_t*)(ws + WS_PB); unsigned char* wb = ws + WS_W; float* rsqp = (float*)(ws + WS_RSQP); \
    float* rsq = (float*)(ws + ((L & 1) ? WS_RSQ1 : WS_RSQ0)); float* rsq_next = (float*)(ws + ((L & 1) ? WS_RSQ0 : WS_RSQ1)); \
    bf16_t* xb = (bf16_t*)(ws + ((L & 1) ? WS_XB1 : WS_XB)); bf16_t* xb_next = (bf16_t*)(ws + ((L & 1) ? WS_XB : WS_XB1)); \
    (void)ctl; (void)r1; (void)mixed; (void)pb; (void)wb; (void)rsqp; (void)rsq; (void)rsq_next; (void)xb; (void)xb_next;
#define PHASE_END() } if (ph_ >= a.ph_lo && ph_ + 1 < a.ph_hi) { asm volatile("s_waitcnt vmcnt(0) lgkmcnt(0)" ::: "memory"); grid.sync(); __builtin_amdgcn_fence(__ATOMIC_ACQUIRE, "agent"); asm volatile("s_waitcnt vmcnt(0)" ::: "memory"); } }
    for (int L = 0; L < DEPTH; ++L) {
        PHASE_BEGIN(0) phase_convert(in, ws, a.out, L, lds); PHASE_END()
        PHASE_BEGIN(1) { EpiSwiGLU E{r1, rsq}; run_gemm(lds, xb, (const bf16_t*)(wb + W_GU1), 2 * FF, DM, E); } PHASE_END()
        PHASE_BEGIN(2) { EpiRes<0> E{a.out, xb, rsq, 0.5f, nullptr, nullptr, nullptr, nullptr, nullptr}; run_gemm(lds, r1, (const bf16_t*)(wb + W_D1), DM, FF, E); } PHASE_END()
        PHASE_BEGIN(3) { EpiZ E{r1, rsq}; run_gemm(lds, xb, (const bf16_t*)(wb + W_IN), ZW, DM, E); } PHASE_END()
        PHASE_BEGIN(4) {
            unsigned* ctr = ctl + (L * 4 + 0) * 64;
            for (;;) { const int t = next_task(ctr, slot); if (t >= 1536) break;
                if (t < 512) task_compress(in, ws, L, t, lds); else if (t < 1024) task_hgrn_local(in, ws, L, t - 512, lds); else task_prep(in, ws, L, t - 1024, lds); }
        } PHASE_END()
        PHASE_BEGIN(5) {
            unsigned* ctr = ctl + (L * 4 + 1) * 64;
            for (;;) { const int t = next_task(ctr, slot); if (t >= 192 + 512 + 1024) break;
                if (t < 192) task_hgrn_scan(ws, t); else if (t < 704) task_diff(in, ws, L, t - 192, lds); else task_nsa_c(in, ws, L, t - 704, lds); }
        } PHASE_END()
        PHASE_BEGIN(6) {
            unsigned* ctr = ctl + (L * 4 + 2) * 64;
            for (;;) { const int t = next_task(ctr, slot); if (t >= 768 + 1024) break;
                if (t < 768) task_nsa_sw(in, ws, L, t, lds); else task_hgrn_out(in, ws, L, t - 768, lds); }
        } PHASE_END()
        PHASE_BEGIN(7) { EpiRes<0> E{a.out, xb, rsq, 1.0f, nullptr, nullptr, nullptr, nullptr, nullptr}; run_gemm(lds, mixed, (const bf16_t*)(wb + W_OUT), DM, DM, E); } PHASE_END()
        PHASE_BEGIN(8) {
            { EpiSwiGLU E{r1, rsq}; run_gemm(lds, xb, (const bf16_t*)(wb + W_GU2), 2 * FF, DM, E); }
            { EpiRes<2> E{nullptr, nullptr, rsqp, 0.f, nullptr, nullptr, nullptr, nullptr, mixed}; run_gemm(lds, pb, (const bf16_t*)(wb + W_PP), DM, PLE, E); }
        } PHASE_END()
        PHASE_BEGIN(9) { EpiRes<0> E{a.out, xb, rsq, 0.5f, nullptr, nullptr, nullptr, nullptr, nullptr}; run_gemm(lds, r1, (const bf16_t*)(wb + W_D2), DM, FF, E); } PHASE_END()
        PHASE_BEGIN(10) { EpiRes<1> E{a.out, xb_next, rsq_next, 0.f, rsq, mixed, rsqp, inp(I_PLPOST) + L * DM, nullptr}; run_gemm(lds, xb, (const bf16_t*)(wb + W_PG), DM, DM, E); } PHASE_END()
    }
}

#ifdef DUMPK
__global__ void __launch_bounds__(512) dump_kernel(float* out, unsigned char* ws) {
    bf16_t* mixed = (bf16_t*)(ws + WS_MIX); (void)mixed;
    for (size_t idx = (size_t)blockIdx.x * 512 + threadIdx.x; idx < (size_t)M * 1024; idx += (size_t)gridDim.x * 512) {
        const size_t m = idx >> 10; const int c = (int)(idx & 1023);
        float v = 0.f;
#if DUMPK == 3 || DUMPK == 40
        { const bf16_t* z = (const bf16_t*)(ws + WS_R1); v = bf2f(z[m * ZW + c]) + bf2f(z[m * ZW + 1024 + c]) + bf2f(z[m * ZW + 2048 + c]) + (c < 402 ? bf2f(z[m * ZW + 3072 + c]) : 0.f); }
#elif DUMPK == 41
        { const bf16_t* vt = (const bf16_t*)(ws + WS_VT); v = bf2f(vt[m * 512 + (c & 511)]); }
#elif DUMPK == 42
        { const float* hs = (const float*)(ws + WS_HS); const float* hd = (const float*)(ws + WS_HD); v = hs[m * 384 + (c % 384)] + hd[m * 6 + (c % 6)]; }
#elif DUMPK == 43
        { const bf16_t* kc = (const bf16_t*)(ws + WS_KC); const bf16_t* vct = (const bf16_t*)(ws + WS_VCT); v = bf2f(kc[m * 8 + (c & 7)]) + bf2f(vct[m * 8 + (c & 7)]); }
#elif DUMPK == 50 || DUMPK == 60
        v = (c < 384) ? bf2f(mixed[m * 1024 + c]) : 0.f;
#elif DUMPK == 51
        v = (c >= 384 && c < 640) ? bf2f(mixed[m * 1024 + c]) : 0.f;
#elif DUMPK == 52
        { const unsigned* selm = (const unsigned*)(ws + WS_SELM); v = (float)(selm[m * 8 + (c & 7)] & 0xffffu) + (float)(selm[m * 8 + (c & 7)] >> 16); }
#elif DUMPK == 53
        { const float* hs = (const float*)(ws + WS_HS); v = hs[m * 384 + (c % 384)]; }
#elif DUMPK == 61
        v = (c >= 640) ? bf2f(mixed[m * 1024 + c]) : 0.f;
#endif
        out[idx] = v;
    }
}
#endif

extern "C" void kernel_launch(void* const* d_in, const int* in_sizes, int n_in, void* d_out, int out_size, void* d_ws, size_t ws_size, hipStream_t stream) {
    static int grid = 0;
    if (grid == 0) {
        if (n_in != N_IN || out_size != M * DM || ws_size < WS_END) { fprintf(stderr, "kernel_launch: unexpected shapes (n_in %d out %d ws %zu)\n", n_in, out_size, ws_size); grid = -1; return; }
        int dev = 0, cus = 0, per_cu = 0;
        hipGetDevice(&dev); hipDeviceGetAttribute(&cus, hipDeviceAttributeMultiprocessorCount, dev);
        if (hipFuncSetAttribute((const void*)mega, hipFuncAttributeMaxDynamicSharedMemorySize, LDS_BYTES) != hipSuccess) { fprintf(stderr, "hipFuncSetAttribute failed\n"); }
        if (hipOccupancyMaxActiveBlocksPerMultiprocessor(&per_cu, (const void*)mega, 512, LDS_BYTES) != hipSuccess || per_cu < 1) { fprintf(stderr, "occupancy query: %d\n", per_cu); per_cu = 1; }
        (void)hipGetLastError();
        grid = cus;
    }
    if (grid < 0) return;
    hipMemsetAsync((char*)d_ws + WS_CTL, 0, 64 * 1024, stream);
    Args a{};
    for (int i = 0; i < N_IN; ++i) a.in[i] = (const float*)d_in[i];
    a.out = (float*)d_out; a.ws = (unsigned char*)d_ws; a.ph_lo = 0; a.ph_hi = PH_HI;
    void* args[] = {&a};
    hipError_t e = hipLaunchCooperativeKernel((const void*)mega, dim3(grid), dim3(512), args, LDS_BYTES, stream);
    if (e != hipSuccess) fprintf(stderr, "cooperative launch failed: %s (grid %d)\n", hipGetErrorString(e), grid);
#ifdef DUMPK
    dump_kernel<<<dim3(1024), dim3(512), 0, stream>>>((float*)d_out, (unsigned char*)d_ws);
#endif
}
```

```cpp
#include <hip/hip_runtime.h>
#include <hip/hip_cooperative_groups.h>
#include <cstdio>
#include <cstdint>
namespace cg = cooperative_groups;
__device__ __forceinline__ int TID() { int t = threadIdx.x; asm volatile("" : "+v"(t)); return t; }
namespace pg8 {
#define PG8_LAS __attribute__((address_space(3)))
typedef unsigned short bf16_t;
typedef short bf16x8 __attribute__((ext_vector_type(8)));
typedef float f32x4 __attribute__((ext_vector_type(4)));
typedef unsigned u32x4 __attribute__((ext_vector_type(4)));
constexpr int BM = 256, BK = 64, HALF = 128, HTB = HALF * BK * 2  , STAGE_BYTES = 8 * HTB, NXCD = 8, WGM = 8;

__host__ __device__ __forceinline__ int lds_byte(int r, int c) { const int st = (r >> 4) * 2 + (c >> 5), rr = r & 15, cc = c & 31, ob = rr * 64 + cc * 2; return st * 1024 + (ob ^ (((ob >> 9) & 1) << 5)); }
__host__ __device__ __forceinline__ void stage_rc(int b, int& R, int& C) { const int st = b / 1024, sb = b % 1024, swz = sb ^ (((sb >> 9) & 1) << 5); R = (st >> 1) * 16 + swz / 64; C = (st & 1) * 32 + (swz % 64) / 2; }
__host__ __device__ __forceinline__ int perm32(int rho) { const int n = rho >> 4, i = rho & 15; return 8 * (i >> 2) + 4 * n + (i & 3); }

struct Unit { int pm, pn; };
struct Gemm { const bf16_t* A; const bf16_t* Bt; int M, N, K; };

struct StaticOrder {
    int nM, nN, nwg, G, c;
    __host__ __device__ void init(int M, int N, int G_, int c_) { nM = M / BM; nN = N / BM; nwg = nM * nN; G = G_; c = c_; }
    __host__ __device__ bool next(int i, Unit& u) const {
        const long L = (long)i * G + c; if (L >= nwg) return false;
        int wgid = (int)L; { const int q = nwg / NXCD, r = nwg % NXCD, xcd = wgid % NXCD, off = wgid / NXCD; wgid = (xcd < r ? xcd * (q + 1) : r * (q + 1) + (xcd - r) * q) + off; }
        const int nig = WGM * nN, gid = wgid / nig, fm = gid * WGM, gsz = (nM - fm) < WGM ? (nM - fm) : WGM;
        u.pm = fm + ((wgid % nig) % gsz); u.pn = (wgid % nig) / gsz; return true;
    }
    __device__ __forceinline__ void a_ready(const Unit&) const {}
    __device__ __forceinline__ void done(const Unit&) const {}
};

template <class Epi, class Sched, bool ALIGN_EPI = false, bool SP2 = false>
__device__ __forceinline__ void gemm_phase(PG8_LAS unsigned char* lds, const Gemm g, const Sched& S, const Epi& E) {
    const int tid = TID(), wid = __builtin_amdgcn_readfirstlane(tid >> 6), lane = tid & 63, wr = wid >> 2, wc = wid & 3, fr = lane & 15, fq = lane >> 4;
    const int K = g.K, nt = K / BK;
    unsigned voffA[2], voffB[2];
#pragma unroll
    for (int i = 0; i < 2; ++i) { int R, C; stage_rc(tid * 16 + i * 8192, R, C); const int Rb = Epi::PERM ? ((R & ~31) + perm32(R & 31)) : R;
        voffA[i] = (unsigned)(R * K + C) * 2u; voffB[i] = (unsigned)(Rb * K + C) * 2u; }
    const size_t kstep = (size_t)(BK * 2);
    const size_t hstep = (size_t)HALF * K * 2;
    const size_t tstep = 2 * hstep;
    const unsigned ldsw = (unsigned)wid * 1024u;
    const int aoff = lds_byte(wr * 64 + fr, fq * 8), boff = lds_byte(wc * 32 + fr, fq * 8);
#define PG8_SA(b, h) (((b) * 2 + (h)) * HTB)
#define PG8_SB(b, h) ((4 + (b) * 2 + (h)) * HTB)
#define PG8_STAGE(bufoff, gbase, voff) do { _Pragma("unroll") for (int _i = 0; _i < 2; ++_i) \
        __builtin_amdgcn_global_load_lds((const unsigned*)((const char*)(gbase) + (voff)[_i]), (PG8_LAS unsigned*)(lds + (bufoff) + ldsw + _i * 8192), 16, 0, 0); } while (0)
#define PG8_LDA(dst, b, h) do { _Pragma("unroll") for (int m = 0; m < 4; ++m) _Pragma("unroll") for (int k = 0; k < 2; ++k) dst[m][k] = *(const PG8_LAS bf16x8*)(lds + PG8_SA(b, h) + aoff + m * 2048 + k * 1024); } while (0)
#define PG8_LDB(dst, b, h) do { _Pragma("unroll") for (int n = 0; n < 2; ++n) _Pragma("unroll") for (int k = 0; k < 2; ++k) dst[n][k] = *(const PG8_LAS bf16x8*)(lds + PG8_SB(b, h) + boff + n * 2048 + k * 1024); } while (0)
#define PG8_MMA(ai, bj, At, Bt) do { __builtin_amdgcn_s_setprio(1); _Pragma("unroll") for (int m = 0; m < 4; ++m) _Pragma("unroll") for (int n = 0; n < 2; ++n) _Pragma("unroll") for (int k = 0; k < 2; ++k) \
        acc[ai][bj][m][n] = __builtin_amdgcn_mfma_f32_16x16x32_bf16(Bt[n][k], At[m][k], acc[ai][bj][m][n], 0, 0, 0); __builtin_amdgcn_s_setprio(0); } while (0)
#define PG8_WAIT_V(n) asm volatile("s_waitcnt vmcnt(" #n ")" ::: "memory")
#define PG8_WAIT_L(n) asm volatile("s_waitcnt lgkmcnt(" #n ")" ::: "memory")
#define PG8_BAR __builtin_amdgcn_s_barrier()
#define PG8_SCHED __builtin_amdgcn_sched_barrier(0)
    Unit cur, nxt; int ui = 0;
    if (!S.next(0, cur)) return;
    f32x4 acc[2][2][4][2];
#pragma unroll
    for (int a = 0; a < 2; ++a)
#pragma unroll
        for (int b = 0; b < 2; ++b)
#pragma unroll
            for (int m = 0; m < 4; ++m)
#pragma unroll
                for (int n = 0; n < 2; ++n) acc[a][b][m][n] = (f32x4){0.f, 0.f, 0.f, 0.f};
    bf16x8 At[4][2], B0[2][2], B1[2][2];
    const char* cA = (const char*)g.A + (size_t)cur.pm * tstep; const char* cB = (const char*)g.Bt + (size_t)cur.pn * tstep;
    S.a_ready(cur);
    if constexpr (SP2) {
        PG8_STAGE(PG8_SB(0, 0), cB, voffB); PG8_STAGE(PG8_SB(0, 1), cB + hstep, voffB); PG8_STAGE(PG8_SA(0, 0), cA, voffA); PG8_STAGE(PG8_SA(0, 1), cA + hstep, voffA);
        if (wr == 1) PG8_BAR;
        PG8_WAIT_V(2); PG8_BAR;
        PG8_STAGE(PG8_SB(1, 0), cB + kstep, voffB); PG8_STAGE(PG8_SA(1, 0), cA + kstep, voffA); PG8_STAGE(PG8_SB(1, 1), cB + hstep + kstep, voffB);
        PG8_WAIT_V(6); PG8_BAR;
    } else {
        PG8_STAGE(PG8_SB(0, 0), cB, voffB); PG8_STAGE(PG8_SA(0, 0), cA, voffA); PG8_STAGE(PG8_SB(0, 1), cB + hstep, voffB); PG8_STAGE(PG8_SA(0, 1), cA + hstep, voffA);
        if (wr == 1) PG8_BAR;
        PG8_WAIT_V(4); PG8_BAR;
        PG8_STAGE(PG8_SB(1, 0), cB + kstep, voffB); PG8_STAGE(PG8_SA(1, 0), cA + kstep, voffA); PG8_STAGE(PG8_SB(1, 1), cB + hstep + kstep, voffB);
        PG8_WAIT_V(6); PG8_BAR;
    }
    for (;;) {
        const bool has_next = S.next(ui + 1, nxt);
        const char* nA = has_next ? (const char*)g.A + (size_t)nxt.pm * tstep : cA; const char* nB = has_next ? (const char*)g.Bt + (size_t)nxt.pn * tstep : cB;
        for (int t = 0; t < nt; t += 2) {
            const bool last = (t == nt - 2);
            const char* a1 = cA + (size_t)(t + 1) * kstep;
            const char* a2 = last ? nA : cA + (size_t)(t + 2) * kstep; const char* b2 = last ? nB : cB + (size_t)(t + 2) * kstep;
            const char* a3 = a2 + kstep; const char* b3 = b2 + kstep;
            if (last && has_next) S.a_ready(nxt);
            if constexpr (SP2) {
            PG8_LDB(B0, 0, 0); PG8_LDB(B1, 0, 1); PG8_SCHED; PG8_LDA(At, 0, 0); PG8_STAGE(PG8_SA(1, 1), a1 + hstep, voffA);
            PG8_WAIT_V(8); PG8_WAIT_L(0); PG8_BAR; PG8_MMA(0, 0, At, B0); PG8_MMA(0, 1, At, B1); PG8_BAR; PG8_SCHED;
            PG8_LDA(At, 0, 1); PG8_STAGE(PG8_SB(0, 0), b2, voffB); PG8_STAGE(PG8_SB(0, 1), b2 + hstep, voffB); PG8_STAGE(PG8_SA(0, 0), a2, voffA);
            PG8_WAIT_V(8); PG8_WAIT_L(0); PG8_BAR; PG8_MMA(1, 0, At, B0); PG8_MMA(1, 1, At, B1); PG8_BAR; PG8_SCHED;
            PG8_LDB(B0, 1, 0); PG8_LDB(B1, 1, 1); PG8_SCHED; PG8_LDA(At, 1, 0); PG8_STAGE(PG8_SA(0, 1), a2 + hstep, voffA);
            PG8_WAIT_V(8); PG8_WAIT_L(0); PG8_BAR; PG8_MMA(0, 0, At, B0); PG8_MMA(0, 1, At, B1); PG8_BAR; PG8_SCHED;
            PG8_LDA(At, 1, 1); PG8_STAGE(PG8_SB(1, 0), b3, voffB); PG8_STAGE(PG8_SB(1, 1), b3 + hstep, voffB); PG8_STAGE(PG8_SA(1, 0), a3, voffA);
            PG8_WAIT_V(8); PG8_WAIT_L(0); PG8_BAR; PG8_MMA(1, 0, At, B0); PG8_MMA(1, 1, At, B1); PG8_BAR; PG8_SCHED;
            } else {
            PG8_LDB(B0, 0, 0); PG8_SCHED; PG8_LDA(At, 0, 0); PG8_STAGE(PG8_SA(1, 1), a1 + hstep, voffA);
            PG8_WAIT_L(8); PG8_BAR; PG8_WAIT_L(0); PG8_MMA(0, 0, At, B0); PG8_BAR; PG8_SCHED;
            PG8_LDB(B1, 0, 1); PG8_STAGE(PG8_SB(0, 0), b2, voffB);
            PG8_BAR; PG8_WAIT_L(0); PG8_MMA(0, 1, At, B1); PG8_BAR;
            PG8_LDA(At, 0, 1); PG8_STAGE(PG8_SA(0, 0), a2, voffA);
            PG8_BAR; PG8_WAIT_L(0); PG8_MMA(1, 0, At, B0); PG8_BAR; PG8_SCHED;
            PG8_STAGE(PG8_SB(0, 1), b2 + hstep, voffB);
            PG8_WAIT_V(6); PG8_BAR; PG8_MMA(1, 1, At, B1); PG8_BAR;
            PG8_LDB(B0, 1, 0); PG8_SCHED; PG8_LDA(At, 1, 0); PG8_STAGE(PG8_SA(0, 1), a2 + hstep, voffA);
            PG8_WAIT_L(8); PG8_BAR; PG8_WAIT_L(0); PG8_MMA(0, 0, At, B0); PG8_BAR; PG8_SCHED;
            PG8_LDB(B1, 1, 1); PG8_STAGE(PG8_SB(1, 0), b3, voffB);
            PG8_BAR; PG8_WAIT_L(0); PG8_MMA(0, 1, At, B1); PG8_BAR;
            PG8_LDA(At, 1, 1); PG8_STAGE(PG8_SA(1, 0), a3, voffA);
            PG8_BAR; PG8_WAIT_L(0); PG8_MMA(1, 0, At, B0); PG8_BAR; PG8_SCHED;
            PG8_STAGE(PG8_SB(1, 1), b3 + hstep, voffB);
            PG8_WAIT_V(6); PG8_BAR; PG8_MMA(1, 1, At, B1); PG8_BAR;
            }
        }
        if constexpr (ALIGN_EPI) { if (wr == 0) PG8_BAR; }
        if constexpr (!Epi::AFTER_DRAIN) { E(acc, cur, wr, wc, fr, fq); S.done(cur); }
        if (!has_next) break;
#pragma unroll
        for (int a = 0; a < 2; ++a)
#pragma unroll
            for (int b = 0; b < 2; ++b)
#pragma unroll
                for (int m = 0; m < 4; ++m)
#pragma unroll
                    for (int n = 0; n < 2; ++n) acc[a][b][m][n] = (f32x4){0.f, 0.f, 0.f, 0.f};
        cur = nxt; cA = nA; cB = nB; ++ui;
        if constexpr (ALIGN_EPI) { if (wr == 1) PG8_BAR; }
    }
    PG8_WAIT_V(0);
    if constexpr (!ALIGN_EPI) { if (wr == 0) PG8_BAR; }
    PG8_BAR;
    if constexpr (Epi::AFTER_DRAIN) { E.fused(acc, cur, wr, wc, fr, fq, lds, wid, lane); S.done(cur); }
#undef PG8_SA
#undef PG8_SB
#undef PG8_STAGE
#undef PG8_LDA
#undef PG8_LDB
#undef PG8_MMA
#undef PG8_WAIT_V
#undef PG8_WAIT_L
#undef PG8_BAR
#undef PG8_SCHED
}
}

#define LAS __attribute__((address_space(3)))
typedef unsigned short bf16_t;
typedef short bf16x8 __attribute__((ext_vector_type(8)));
typedef float f32x4 __attribute__((ext_vector_type(4)));
typedef float f32x16 __attribute__((ext_vector_type(16)));
typedef unsigned u32x4 __attribute__((ext_vector_type(4)));
typedef unsigned u32x2 __attribute__((ext_vector_type(2)));

constexpr int NB = 4, T = 8192, DM = 1024, M = NB * T, DEPTH = 4, PLE = 256, FF = 2816, ZW = 3584, INW = 3474;
constexpr int C_NQ = 0, C_CK = 384, C_CV = 512, C_SK = 640, C_SV = 768, C_WK = 896, C_WV = 1024, C_DQ = 1152, C_DK = 1408, C_DV = 1664,
              C_HQ = 1920, C_HF = 2304, C_HI = 2688, C_HG = 3072, C_NG = 3456;
constexpr float EPS = 1e-6f, LOG2E = 1.4426950408889634f;
enum { I_X = 0, I_P, I_RELB, I_LBLOG, I_F1N, I_F1G, I_F1U, I_F1D, I_MIXN, I_WIN, I_WOUT, I_NQN, I_NKN, I_CPOS, I_CW1, I_CW2,
       I_DQN, I_DKN, I_DLAM, I_DSUB, I_HON, I_F2N, I_F2G, I_F2U, I_F2D, I_PLN, I_PLG, I_PLP, I_PLPOST, N_IN };
constexpr size_t MiB = 1u << 20;
constexpr size_t WS_CTL = 0, WS_W = 1 * MiB, WS_PB = 53 * MiB, WS_XB = 69 * MiB, WS_R1 = 133 * MiB, WS_MIX = 357 * MiB, WS_VT = 421 * MiB,
                 WS_HS = 453 * MiB, WS_KC = 501 * MiB, WS_VCT = WS_KC + 512 * 1024, WS_SELM = 503 * MiB, WS_RSQ0 = 504 * MiB, WS_RSQ1 = 506 * MiB,
                 WS_RSQP = 508 * MiB, WS_HD = 510 * MiB, WS_XB1 = 511 * MiB, WS_OCB = 575 * MiB, WS_END = 599 * MiB;
constexpr size_t W_GU1 = 0, W_D1 = 11 * MiB, W_GU2 = W_D1 + 5 * MiB + 512 * 1024, W_D2 = W_GU2 + 11 * MiB, W_IN = 33 * MiB, W_OUT = 40 * MiB, W_PG = 42 * MiB,
                 W_PP = 44 * MiB, W_1T = W_PP + 512 * 1024, W_2T = W_1T + 2 * MiB, W_POSB = W_2T + 64 * 1024;
static_assert(W_D2 + 5 * MiB + 512 * 1024 == W_IN, "weight map");
constexpr int LDS_BYTES = 132 * 1024, LDS_MISC = 131072;

__device__ __forceinline__ float bf2f(unsigned short u) { return __uint_as_float(((unsigned)u) << 16); }
__device__ __forceinline__ float bflo(unsigned w) { return __uint_as_float(w << 16); }
__device__ __forceinline__ float bfhi(unsigned w) { return __uint_as_float(w & 0xffff0000u); }
typedef float f32x2_t __attribute__((ext_vector_type(2))); typedef __bf16 bf16x2_t __attribute__((ext_vector_type(2)));
__device__ __forceinline__ unsigned pk2(float lo, float hi) { f32x2_t v = {lo, hi}; bf16x2_t b = __builtin_convertvector(v, bf16x2_t); return __builtin_bit_cast(unsigned, b); }
__device__ __forceinline__ bf16_t f2bf(float f) { return (bf16_t)(pk2(f, 0.f) & 0xffffu); }
__device__ __forceinline__ float ex2(float x) { return __builtin_amdgcn_exp2f(x); }
__device__ __forceinline__ float sigmoidf_(float x) { return 1.0f / (1.0f + __expf(-x)); }
__device__ __forceinline__ int crow(int r, int hi) { return (r & 3) + 8 * (r >> 2) + 4 * hi; }
__device__ __forceinline__ f32x16 mfma32(bf16x8 a, bf16x8 b, f32x16 c) { return __builtin_amdgcn_mfma_f32_32x32x16_bf16(a, b, c, 0, 0, 0); }
__device__ __forceinline__ f32x4 mfma16(bf16x8 a, bf16x8 b, f32x4 c) { return __builtin_amdgcn_mfma_f32_16x16x32_bf16(a, b, c, 0, 0, 0); }
__device__ __forceinline__ bf16x8 as_bf16x8(u32x4 v) { return __builtin_bit_cast(bf16x8, v); }
#define LDSW() asm volatile("s_waitcnt lgkmcnt(0)" ::: "memory")
#define CFENCE() asm volatile("" ::: "memory")
#define GAS __attribute__((address_space(1)))
__device__ __forceinline__ const float* inp(int i) { asm volatile("" : "+s"(i)); const unsigned long long v = ((const unsigned long long __attribute__((address_space(4)))*)__builtin_amdgcn_kernarg_segment_ptr())[i]; return (const float*)(const GAS float*)v; }

__device__ __forceinline__ float row_rinv(const float* rsq, int row) {
    const f32x4* p = (const f32x4*)(rsq + (size_t)row * 16);
    const f32x4 a = p[0], b = p[1], c = p[2], d = p[3];
    const float s = ((a.x + a.y) + (a.z + a.w)) + ((b.x + b.y) + (b.z + b.w)) + ((c.x + c.y) + (c.z + c.w)) + ((d.x + d.y) + (d.z + d.w));
    return rsqrtf(s * (1.0f / 1024.0f) + EPS);
}
struct EpiSwiGLU {
    static constexpr bool PERM = true, AFTER_DRAIN = false;
    bf16_t* O; const float* rsq;
    __device__ __forceinline__ void operator()(const f32x4 (&acc)[2][2][4][2], const pg8::Unit& u, int wr, int wc, int fr, int fq) const {
#pragma unroll
        for (int ai = 0; ai < 2; ++ai)
#pragma unroll
            for (int m = 0; m < 4; ++m) {
                const int row = u.pm * 256 + ai * 128 + wr * 64 + m * 16 + fr;
                const float r = row_rinv(rsq, row);
                float o[8];
#pragma unroll
                for (int n = 0; n < 2; ++n)
#pragma unroll
                    for (int e = 0; e < 4; ++e) { const float g = acc[ai][0][m][n][e] * r, up = acc[ai][1][m][n][e] * r; o[n * 4 + e] = g * sigmoidf_(g) * up; }
                u32x4 w; w.x = pk2(o[0], o[1]); w.y = pk2(o[2], o[3]); w.z = pk2(o[4], o[5]); w.w = pk2(o[6], o[7]);
                *(u32x4*)(O + (size_t)row * FF + u.pn * 128 + wc * 32 + 8 * fq) = w;
                CFENCE();
            }
    }
};
struct EpiZ {
    static constexpr bool PERM = true, AFTER_DRAIN = false;
    bf16_t* Z; const float* rsq;
    __device__ __forceinline__ void operator()(const f32x4 (&acc)[2][2][4][2], const pg8::Unit& u, int wr, int wc, int fr, int fq) const {
#pragma unroll
        for (int ai = 0; ai < 2; ++ai)
#pragma unroll
            for (int m = 0; m < 4; ++m) {
                const int row = u.pm * 256 + ai * 128 + wr * 64 + m * 16 + fr;
                const float r = row_rinv(rsq, row);
#pragma unroll
                for (int bj = 0; bj < 2; ++bj) {
                    const f32x4 v0 = acc[ai][bj][m][0] * r, v1 = acc[ai][bj][m][1] * r;
                    u32x4 w; w.x = pk2(v0[0], v0[1]); w.y = pk2(v0[2], v0[3]); w.z = pk2(v1[0], v1[1]); w.w = pk2(v1[2], v1[3]);
                    *(u32x4*)(Z + (size_t)row * ZW + u.pn * 256 + bj * 128 + wc * 32 + 8 * fq) = w;
                }
                CFENCE();
            }
    }
};
template <int MODE> struct EpiRes {
    static constexpr bool PERM = false, AFTER_DRAIN = false;
    float* X; bf16_t* XB; float* rsq_out; float alpha; const float* rsq_in; const bf16_t* P; const float* rsqp; const float* post; bf16_t* Pout;
    __device__ __forceinline__ void operator()(const f32x4 (&acc)[2][2][4][2], const pg8::Unit& u, int wr, int wc, int fr, int fq) const {
#pragma unroll
        for (int ai = 0; ai < 2; ++ai)
#pragma unroll
            for (int m = 0; m < 4; ++m) {
                const int row = u.pm * 256 + ai * 128 + wr * 64 + m * 16 + fr;
                float r = 1.f, rp = 1.f;
                if (MODE == 1) { r = row_rinv(rsq_in, row); rp = row_rinv(rsqp, row); }
                float ss = 0.f;
#pragma unroll
                for (int bj = 0; bj < 2; ++bj)
#pragma unroll
                    for (int n = 0; n < 2; ++n) {
                        const int c0 = u.pn * 256 + bj * 128 + wc * 32 + 16 * n + 4 * fq;
                        const size_t off = (size_t)row * DM + c0;
                        const f32x4 a = acc[ai][bj][m][n];
                        if (MODE == 2) {
                            u32x2 w; w.x = pk2(a[0], a[1]); w.y = pk2(a[2], a[3]);
                            *(u32x2*)(Pout + off) = w;
                            ss += (a[0] * a[0] + a[1] * a[1]) + (a[2] * a[2] + a[3] * a[3]);
                        } else {
                            f32x4 xv = *(const f32x4*)(X + off);
                            if (MODE == 0) xv += a * alpha;
                            else {
                                const u32x2 pw = *(const u32x2*)(P + off); const f32x4 po = *(const f32x4*)(post + c0);
                                xv[0] += sigmoidf_(a[0] * r) * (bflo(pw.x) * rp * po[0]);
                                xv[1] += sigmoidf_(a[1] * r) * (bfhi(pw.x) * rp * po[1]);
                                xv[2] += sigmoidf_(a[2] * r) * (bflo(pw.y) * rp * po[2]);
                                xv[3] += sigmoidf_(a[3] * r) * (bfhi(pw.y) * rp * po[3]);
                            }
                            *(f32x4*)(X + off) = xv;
                            u32x2 w; w.x = pk2(xv[0], xv[1]); w.y = pk2(xv[2], xv[3]);
                            *(u32x2*)(XB + off) = w;
                            ss += (xv[0] * xv[0] + xv[1] * xv[1]) + (xv[2] * xv[2] + xv[3] * xv[3]);
                        }
                    }
                ss += __shfl_xor(ss, 16); ss += __shfl_xor(ss, 32);
                if (fq == 0) rsq_out[(size_t)row * 16 + u.pn * 4 + wc] = ss;
                CFENCE();
            }
    }
};

template <class Epi> __device__ __forceinline__ void run_gemm(LAS unsigned char* lds, const bf16_t* A, const bf16_t* Bt, int N, int K, const Epi& E) {
    pg8::Gemm g{A, Bt, M, N, K}; int bx = blockIdx.x; asm volatile("" : "+s"(bx)); asm volatile("" : "+s"(K)); asm volatile("" : "+s"(N)); pg8::StaticOrder S; S.init(M, N, (int)gridDim.x, bx);
    pg8::gemm_phase<Epi, pg8::StaticOrder, true, true>(lds, g, S, E);
    __syncthreads();
}

__device__ __forceinline__ int next_task(unsigned* ctr, LAS int* slot) {
    __syncthreads();
    if (TID() == 0) *slot = (int)atomicAdd(ctr, 1u);
    __syncthreads();
    return *slot;
}

__device__ __forceinline__ int colmap(int mode, int n) {
    if (mode == 1) return 256 * (n >> 7) + (n & 127);
    if (mode == 2) return 256 * (n >> 7) + 128 + (n & 127);
    if (mode == 3) return n < 1152 ? n : (n < 1170 ? 3456 + (n - 1152) : n - 18);
    return n;
}
__device__ __forceinline__ void conv_item(const float* W, int K, int N, bf16_t* WT, const float* gain, int mode, LAS float* scr, int item, int lane) {
    const int nblk = (N + 31) >> 5, kb = item / nblk, nb = item % nblk, k0 = 64 * kb, n0 = 32 * nb;
#pragma unroll 16
    for (int i = 0; i < 32; ++i) {
        const int kk = 2 * i + (lane >> 5), n = n0 + (lane & 31);
        float v = (n < N) ? W[(size_t)(k0 + kk) * N + n] : 0.f;
        if (gain) v *= gain[k0 + kk];
        scr[kk * 33 + (lane & 31)] = v;
    }
    LDSW();
    const int c = lane & 7;
#pragma unroll
    for (int j = 0; j < 4; ++j) {
        const int nl = (lane >> 3) + 8 * j, n = n0 + nl;
        const LAS float* s = scr + (8 * c) * 33 + nl;
        u32x4 o; o.x = pk2(s[0], s[33]); o.y = pk2(s[2 * 33], s[3 * 33]); o.z = pk2(s[4 * 33], s[5 * 33]); o.w = pk2(s[6 * 33], s[7 * 33]);
        if (n < N) *(u32x4*)(WT + (size_t)colmap(mode, n) * K + k0 + 8 * c) = o;
    }
    LDSW();
}

__device__ __forceinline__ void phase_convert(const float* const* in, unsigned char* ws, float* out, int L, LAS unsigned char* lds) {
    const int tid = TID(), lane = tid & 63, wave = tid >> 6;
    const int gw = blockIdx.x * 8 + wave, NGW = gridDim.x * 8;
    LAS float* scr = (LAS float*)(lds + wave * 8704);
    unsigned char* wb = ws + WS_W;
    const size_t ffo = (size_t)L * DM * FF;
    constexpr int IT_GU = (DM / 64) * (FF / 32), IT_D = (FF / 64) * (DM / 32), IT_IN = (DM / 64) * ((INW + 31) / 32), IT_SQ = (DM / 64) * (DM / 32),
                  IT_PP = (PLE / 64) * (DM / 32), IT_W1 = (2048 / 64) * (256 / 32), IT_W2 = (256 / 64) * (64 / 32);
    constexpr int total = 4 * IT_GU + 2 * IT_D + IT_IN + 2 * IT_SQ + IT_PP + 2 * IT_W1 + 2 * IT_W2;
    for (int it = gw; it < total; it += NGW) {
        const float* W = nullptr; int K = 0, N = 0; bf16_t* WT = nullptr; const float* gain = nullptr; int mode = 0, rr = -1, r = it;
#define JOB(Wp, Kk, Nn, WTp, gp, md, items) { if (rr < 0 && r < (items)) { W = (Wp); K = (Kk); N = (Nn); WT = (bf16_t*)(WTp); gain = (gp); mode = (md); rr = r; } r -= (items); }
        JOB(inp(I_F1G) + ffo, DM, FF, wb + W_GU1, inp(I_F1N) + L * DM, 1, IT_GU)
        JOB(inp(I_F1U) + ffo, DM, FF, wb + W_GU1, inp(I_F1N) + L * DM, 2, IT_GU)
        JOB(inp(I_F1D) + ffo, FF, DM, wb + W_D1, nullptr, 0, IT_D)
        JOB(inp(I_F2G) + ffo, DM, FF, wb + W_GU2, inp(I_F2N) + L * DM, 1, IT_GU)
        JOB(inp(I_F2U) + ffo, DM, FF, wb + W_GU2, inp(I_F2N) + L * DM, 2, IT_GU)
        JOB(inp(I_F2D) + ffo, FF, DM, wb + W_D2, nullptr, 0, IT_D)
        JOB(inp(I_WIN) + (size_t)L * DM * INW, DM, INW, wb + W_IN, inp(I_MIXN) + L * DM, 3, IT_IN)
        JOB(inp(I_WOUT) + (size_t)L * DM * DM, DM, DM, wb + W_OUT, nullptr, 0, IT_SQ)
        JOB(inp(I_PLG) + (size_t)L * DM * DM, DM, DM, wb + W_PG, inp(I_PLN) + L * DM, 0, IT_SQ)
        JOB(inp(I_PLP) + (size_t)L * PLE * DM, PLE, DM, wb + W_PP, nullptr, 0, IT_PP)
        JOB(inp(I_CW1) + (size_t)(L * 2 + 0) * 2048 * 256, 2048, 256, wb + W_1T, nullptr, 0, IT_W1)
        JOB(inp(I_CW1) + (size_t)(L * 2 + 1) * 2048 * 256, 2048, 256, wb + W_1T + 256 * 2048 * 2, nullptr, 0, IT_W1)
        JOB(inp(I_CW2) + (size_t)(L * 2 + 0) * 256 * 64, 256, 64, wb + W_2T, nullptr, 0, IT_W2)
        JOB(inp(I_CW2) + (size_t)(L * 2 + 1) * 256 * 64, 256, 64, wb + W_2T + 64 * 256 * 2, nullptr, 0, IT_W2)
#undef JOB
        conv_item(W, K, N, WT, gain, mode, scr, rr, lane);
    }
    {
        u32x4* z = (u32x4*)((bf16_t*)(wb + W_IN) + (size_t)INW * DM);
        const int n16 = (ZW - INW) * DM / 8;
        for (int i = blockIdx.x * 512 + tid; i < n16; i += gridDim.x * 512) z[i] = (u32x4){0u, 0u, 0u, 0u};
    }
    {
        const f32x4* src = (const f32x4*)(inp(I_P) + (size_t)L * M * PLE); u32x4* dst = (u32x4*)(ws + WS_PB);
        const int n8 = M * PLE / 8;
        for (int i = blockIdx.x * 512 + tid; i < n8; i += gridDim.x * 512) {
            const f32x4 a = src[2 * i], b = src[2 * i + 1];
            u32x4 w; w.x = pk2(a[0], a[1]); w.y = pk2(a[2], a[3]); w.z = pk2(b[0], b[1]); w.w = pk2(b[2], b[3]); dst[i] = w;
        }
    }
    if (gw < 64) {
        const int ty = gw >> 5, ng = (gw >> 3) & 3, ks = gw & 7, n = ng * 64 + lane;
        const float* w1 = inp(I_CW1) + (size_t)(L * 2 + ty) * 2048 * 256; const float* pos = inp(I_CPOS) + (size_t)(L * 2 + ty) * 2048;
        float acc = 0.f;
        for (int k = ks * 256; k < ks * 256 + 256; ++k) acc += pos[k] * w1[(size_t)k * 256 + n];
        ((float*)(wb + W_POSB))[(ty * 8 + ks) * 256 + n] = acc;
    }
    if (L == 0) {
        const float* x = inp(I_X); bf16_t* xb = (bf16_t*)(ws + WS_XB); float* rsq = (float*)(ws + WS_RSQ0);
        for (int m = gw; m < M; m += NGW) {
            const f32x4* xr = (const f32x4*)(x + (size_t)m * DM) + lane; f32x4* orow = (f32x4*)(out + (size_t)m * DM) + lane;
            u32x2* xbr = (u32x2*)(xb + (size_t)m * DM) + lane;
            float s = 0.f;
#pragma unroll
            for (int j = 0; j < 4; ++j) { const f32x4 v = xr[64 * j]; orow[64 * j] = v; u32x2 w; w.x = pk2(v[0], v[1]); w.y = pk2(v[2], v[3]); xbr[64 * j] = w; s += (v[0] * v[0] + v[1] * v[1]) + (v[2] * v[2] + v[3] * v[3]); }
#pragma unroll
            for (int o = 1; o < 64; o <<= 1) s += __shfl_xor(s, o);
            if (lane < 16) rsq[(size_t)m * 16 + lane] = (lane == 0) ? s : 0.f;
        }
    }
}

__device__ __forceinline__ void task_prep(const float* const* in, unsigned char* ws, int L, int tile, LAS unsigned char* lds) {
    const int tid = TID(), lane = tid & 63, wave = tid >> 6;
    bf16_t* z = (bf16_t*)(ws + WS_R1);
    const int row0 = tile * 64;
    for (int tt = wave; tt < 64; tt += 8) {
        bf16_t* zr = z + (size_t)(row0 + tt) * ZW;
#pragma unroll
        for (int pass = 0; pass < 3; ++pass) {
            const int seg = pass * 64 + lane;
            int col = 0, gs = 8; const float* gp = inp(I_NQN); float scale = 1.f;
            if (seg < 48) { col = C_NQ + 8 * seg; gp = inp(I_NQN) + L * 64 + ((8 * seg) & 63); scale = 0.125f * LOG2E; }
            else if (seg < 64) { col = C_SK + 8 * (seg - 48); gp = inp(I_NKN) + (L * 3 + 1) * 64 + ((8 * seg) & 63); }
            else if (seg < 80) { col = C_WK + 8 * (seg - 64); gp = inp(I_NKN) + (L * 3 + 2) * 64 + ((8 * seg) & 63); }
            else if (seg < 112) { col = C_DQ + 8 * (seg - 80); gp = inp(I_DQN) + L * 32 + ((8 * seg) & 31); gs = 4; scale = 0.17677669529663689f * LOG2E; }
            else { col = C_DK + 8 * (seg - 112); gp = inp(I_DKN) + L * 32 + ((8 * seg) & 31); gs = 4; }
            const bool act = seg < 144;
            u32x4 w = (u32x4){0u, 0u, 0u, 0u};
            if (act) w = *(const u32x4*)(zr + col);
            float v[8] = {bflo(w.x), bfhi(w.x), bflo(w.y), bfhi(w.y), bflo(w.z), bfhi(w.z), bflo(w.w), bfhi(w.w)};
            float ss = 0.f;
#pragma unroll
            for (int e = 0; e < 8; ++e) ss += v[e] * v[e];
            ss += __shfl_xor(ss, 1); ss += __shfl_xor(ss, 2);
            const float t4 = __shfl_xor(ss, 4); if (gs == 8) ss += t4;
            const float r = rsqrtf(ss / (float)(gs * 8) + EPS) * scale;
            if (act) {
                const f32x4 g0 = *(const f32x4*)gp, g1 = *(const f32x4*)(gp + 4);
                u32x4 o; o.x = pk2(v[0] * r * g0[0], v[1] * r * g0[1]); o.y = pk2(v[2] * r * g0[2], v[3] * r * g0[3]);
                o.z = pk2(v[4] * r * g1[0], v[5] * r * g1[1]); o.w = pk2(v[6] * r * g1[2], v[7] * r * g1[3]);
                *(u32x4*)(zr + col) = o;
            }
        }
    }
    LAS bf16_t* tl = (LAS bf16_t*)lds;
#pragma unroll
    for (int i = 0; i < 8; ++i) {
        const int id = i * 512 + tid, row = id >> 6, ch = id & 63;
        const int col = ch < 16 ? C_SV + 8 * ch : (ch < 32 ? C_WV + 8 * (ch - 16) : C_DV + 8 * (ch - 32));
        *(LAS u32x4*)(tl + row * 520 + 8 * ch) = *(const u32x4*)(z + (size_t)(row0 + row) * ZW + col);
    }
    __syncthreads();
    const int b = row0 / T, t0 = row0 % T;
    bf16_t* vt = (bf16_t*)(ws + WS_VT);
#pragma unroll
    for (int i = 0; i < 8; ++i) {
        const int orow = tid, tch = i;
        const LAS bf16_t* s = tl + (tch * 8) * 520 + orow;
        u32x4 o;
        o.x = (unsigned)s[0] | ((unsigned)s[520] << 16); o.y = (unsigned)s[2 * 520] | ((unsigned)s[3 * 520] << 16);
        o.z = (unsigned)s[4 * 520] | ((unsigned)s[5 * 520] << 16); o.w = (unsigned)s[6 * 520] | ((unsigned)s[7 * 520] << 16);
        *(u32x4*)(vt + ((size_t)(b * 8) * 64 + orow) * T + t0 + 8 * tch) = o;
    }
}

__device__ __forceinline__ float gelu_tanh(float x) {
    const float y = 0.7978845608028654f * (x + 0.044715f * x * x * x);
    const float th = 1.0f - 2.0f / (1.0f + __expf(2.0f * y));
    return 0.5f * x * (1.0f + th);
}
__device__ __forceinline__ void task_compress(const float* const* in, unsigned char* ws, int L, int task, LAS unsigned char* lds) {
    const int tid = TID(), lane = tid & 63, wave = tid >> 6;
    const int ty = task >> 8, b = (task >> 6) & 3, g = (task >> 5) & 1, i0 = (task & 31) * 16;
    const bf16_t* z = (const bf16_t*)(ws + WS_R1);
    LAS bf16_t* zt = (LAS bf16_t*)lds;
    LAS bf16_t* hid = (LAS bf16_t*)(lds + 39168);
    LAS float* ofp = (LAS float*)(lds + 39168 + 8448);
    const int ccol = (ty ? C_CV : C_CK) + 64 * g;
    for (int id = tid; id < 272 * 8; id += 512) {
        const int row = id >> 3, ch = id & 7, tok = 16 * i0 + row;
        u32x4 v = (u32x4){0u, 0u, 0u, 0u};
        if (tok < T) v = *(const u32x4*)(z + (size_t)(b * T + tok) * ZW + ccol + 8 * ch);
        *(LAS u32x4*)(zt + row * 72 + 8 * ch) = v;
    }
    __syncthreads();
    const bf16_t* w1t = (const bf16_t*)(ws + WS_W + W_1T) + (size_t)ty * 256 * 2048;
    const bf16_t* w2t = (const bf16_t*)(ws + WS_W + W_2T) + (size_t)ty * 64 * 256;
    const float* posb = (const float*)(ws + WS_W + W_POSB) + ty * 8 * 256;
    const int r16 = lane & 15, kq = lane >> 4;
    f32x4 acc[2] = {(f32x4){0.f, 0.f, 0.f, 0.f}, (f32x4){0.f, 0.f, 0.f, 0.f}};
    const bf16_t* b0p = w1t + (size_t)(16 * (2 * wave) + r16) * 2048 + 8 * kq;
    const bf16_t* b1p = b0p + 16 * 2048;
#pragma unroll 4
    for (int kc = 0; kc < 64; ++kc) {
        const bf16x8 a = *(const LAS bf16x8*)(zt + (16 * r16 + (kc >> 1)) * 72 + (kc & 1) * 32 + 8 * kq);
        const bf16x8 w0 = *(const bf16x8*)(b0p + 32 * kc), w1 = *(const bf16x8*)(b1p + 32 * kc);
        acc[0] = mfma16(a, w0, acc[0]); acc[1] = mfma16(a, w1, acc[1]);
    }
#pragma unroll
    for (int j = 0; j < 2; ++j) {
        const int n = 16 * (2 * wave + j) + r16;
        float pbias = 0.f;
#pragma unroll
        for (int ks = 0; ks < 8; ++ks) pbias += posb[ks * 256 + n];
#pragma unroll
        for (int i = 0; i < 4; ++i) hid[(4 * kq + i) * 264 + n] = f2bf(gelu_tanh(acc[j][i] + pbias));
    }
    __syncthreads();
    if (wave < 4) {
        f32x4 a2 = (f32x4){0.f, 0.f, 0.f, 0.f};
        const bf16_t* bp = w2t + (size_t)(16 * wave + r16) * 256 + 8 * kq;
#pragma unroll
        for (int kc = 0; kc < 8; ++kc) {
            const bf16x8 a = *(const LAS bf16x8*)(hid + r16 * 264 + 32 * kc + 8 * kq);
            const bf16x8 w = *(const bf16x8*)(bp + 32 * kc);
            a2 = mfma16(a, w, a2);
        }
#pragma unroll
        for (int i = 0; i < 4; ++i) ofp[(4 * kq + i) * 64 + 16 * wave + r16] = a2[i];
    }
    __syncthreads();
    if (tid < 256) {
        const int row = tid >> 4, c4 = (tid & 15) * 4, i = i0 + row;
        f32x4 o = *(const LAS f32x4*)(ofp + row * 64 + c4);
        float ss = (o[0] * o[0] + o[1] * o[1]) + (o[2] * o[2] + o[3] * o[3]);
        ss += __shfl_xor(ss, 1); ss += __shfl_xor(ss, 2); ss += __shfl_xor(ss, 4); ss += __shfl_xor(ss, 8);
        if (ty == 0) {
            const float r = rsqrtf(ss * (1.0f / 64.0f) + EPS);
            const f32x4 gn = *(const f32x4*)(inp(I_NKN) + (L * 3 + 0) * 64 + c4);
            o = o * r * gn;
        }
        if (i >= 511) o = (f32x4){0.f, 0.f, 0.f, 0.f};
        if (ty == 0) {
            u32x2 w; w.x = pk2(o[0], o[1]); w.y = pk2(o[2], o[3]);
            *(u32x2*)((bf16_t*)(ws + WS_KC) + ((size_t)(b * 2 + g) * 512 + i) * 64 + c4) = w;
        } else {
            bf16_t* vct = (bf16_t*)(ws + WS_VCT) + (size_t)(b * 2 + g) * 64 * 512;
#pragma unroll
            for (int e = 0; e < 4; ++e) vct[(size_t)(c4 + e) * 512 + i] = f2bf(o[e]);
        }
    }
}

__device__ __forceinline__ float hgrn_lb(const float* logits, int L, int j) {
    if (L == 0) return 0.f;
    const float a0 = logits[j], a1 = logits[384 + j], a2 = logits[768 + j], a3 = logits[1152 + j];
    const float mx = fmaxf(fmaxf(a0, a1), fmaxf(a2, a3));
    const float e0 = __expf(a0 - mx), e1 = __expf(a1 - mx), e2 = __expf(a2 - mx), e3 = __expf(a3 - mx);
    const float inv = 1.0f / (e0 + e1 + e2 + e3);
    float s = e1; if (L >= 2) s += e2; if (L >= 3) s += e3;
    return s * inv;
}
__device__ __forceinline__ void task_hgrn_local(const float* const* in, unsigned char* ws, int L, int task, LAS unsigned char* lds) {
    const int tid = TID(), lane = tid & 63, wave = tid >> 6;
    if (wave < 6) {
        const int chunk = task * 6 + wave;
        const int bh = chunk >> 7, c = chunk & 127, b = bh / 6, h = bh % 6;
        const bf16_t* z = (const bf16_t*)(ws + WS_R1) + (size_t)(b * T + c * 64) * ZW;
        LAS bf16_t* klT = (LAS bf16_t*)(lds + wave * 18432);
        LAS bf16_t* vT = klT + 64 * 72;
        const float lb = hgrn_lb(inp(I_LBLOG), L, h * 64 + lane);
        float suffix = 0.f;
#pragma unroll 8
        for (int s = 63; s >= 0; --s) {
            const float fr = bf2f(z[(size_t)s * ZW + C_HF + 64 * h + lane]);
            const float vv = bf2f(z[(size_t)s * ZW + C_HI + 64 * h + lane]);
            const float sg = sigmoidf_(fr);
            const float f = lb + (1.0f - lb) * sg;
            const float ig = (1.0f - lb) * (1.0f - sg);
            klT[lane * 72 + s] = f2bf(ig * __expf(suffix));
            vT[lane * 72 + s] = f2bf(vv);
            suffix += __logf(f);
        }
        ((float*)(ws + WS_HD))[(size_t)chunk * 64 + lane] = __expf(suffix);
        LDSW();
        const int r32 = lane & 31, hi = lane >> 5;
        float* hs = (float*)(ws + WS_HS) + (size_t)chunk * 4096;
#pragma unroll
        for (int kb = 0; kb < 2; ++kb)
#pragma unroll
            for (int vb = 0; vb < 2; ++vb) {
                f32x16 cacc = {};
#pragma unroll
                for (int cc = 0; cc < 4; ++cc) {
                    const bf16x8 a = *(const LAS bf16x8*)(klT + (32 * kb + r32) * 72 + 16 * cc + 8 * hi);
                    const bf16x8 bb = *(const LAS bf16x8*)(vT + (32 * vb + r32) * 72 + 16 * cc + 8 * hi);
                    cacc = mfma32(a, bb, cacc);
                }
#pragma unroll
                for (int r = 0; r < 16; ++r) hs[(32 * kb + crow(r, hi)) * 64 + 32 * vb + r32] = cacc[r];
            }
    }
}
__device__ __forceinline__ void task_hgrn_scan(unsigned char* ws, int task) {
    const int tid = TID();
    const int bh = task >> 3, k = (task & 7) * 8 + (tid >> 6), v = tid & 63;
    float* hs = (float*)(ws + WS_HS) + (size_t)bh * 128 * 4096 + k * 64 + v;
    const float* hd = (const float*)(ws + WS_HD) + (size_t)bh * 128 * 64 + k;
    float S = 0.f;
#pragma unroll 16
    for (int c = 0; c < 128; ++c) {
        const float a = hs[(size_t)c * 4096], d = hd[c * 64];
        hs[(size_t)c * 4096] = S;
        S = d * S + a;
    }
}
__device__ __forceinline__ void task_hgrn_out(const float* const* in, unsigned char* ws, int L, int task, LAS unsigned char* lds) {
    const int tid = TID(), lane = tid & 63, wave = tid >> 6;
    if (wave < 3) {
        const int chunk = task * 3 + wave;
        const int bh = chunk >> 7, c = chunk & 127, b = bh / 6, h = bh % 6;
        const size_t row0 = (size_t)(b * T + c * 64);
        const bf16_t* z = (const bf16_t*)(ws + WS_R1) + row0 * ZW;
        LAS bf16_t* ke = (LAS bf16_t*)(lds + wave * 36864);
        LAS bf16_t* qe = ke + 64 * 72;
        LAS bf16_t* vT = qe + 64 * 72;
        LAS bf16_t* sT = vT + 64 * 72;
        const float lb = hgrn_lb(inp(I_LBLOG), L, h * 64 + lane);
        float ref = 0.f;
#pragma unroll 8
        for (int s = 0; s < 32; ++s) {
            const float fr = bf2f(z[(size_t)s * ZW + C_HF + 64 * h + lane]);
            ref += __logf(lb + (1.0f - lb) * sigmoidf_(fr));
        }
        float cum = 0.f;
#pragma unroll 8
        for (int s = 0; s < 64; ++s) {
            const float fr = bf2f(z[(size_t)s * ZW + C_HF + 64 * h + lane]);
            const float qv = bf2f(z[(size_t)s * ZW + C_HQ + 64 * h + lane]);
            const float vv = bf2f(z[(size_t)s * ZW + C_HI + 64 * h + lane]);
            const float sg = sigmoidf_(fr);
            const float f = lb + (1.0f - lb) * sg;
            const float ig = (1.0f - lb) * (1.0f - sg);
            cum += __logf(f);
            qe[s * 72 + lane] = f2bf(qv * sigmoidf_(qv) * __expf(cum - ref));
            ke[s * 72 + lane] = f2bf(ig * __expf(ref - cum));
            vT[lane * 72 + s] = f2bf(vv);
        }
        const float* hs = (const float*)(ws + WS_HS) + (size_t)chunk * 4096;
        const float eref = __expf(ref);
#pragma unroll 8
        for (int k = 0; k < 64; ++k) {
            const float er = __shfl(eref, k);
            sT[lane * 72 + k] = f2bf(hs[k * 64 + lane] * er);
        }
        LDSW();
        const int r32 = lane & 31, hi = lane >> 5;
        f32x16 O[2][2] = {};
#pragma unroll
        for (int tb = 0; tb < 2; ++tb) {
            bf16x8 qf[4];
#pragma unroll
            for (int cc = 0; cc < 4; ++cc) qf[cc] = *(const LAS bf16x8*)(qe + (32 * tb + r32) * 72 + 16 * cc + 8 * hi);
#pragma unroll
            for (int vb = 0; vb < 2; ++vb)
#pragma unroll
                for (int cc = 0; cc < 4; ++cc) {
                    const bf16x8 a = *(const LAS bf16x8*)(sT + (32 * vb + r32) * 72 + 16 * cc + 8 * hi);
                    O[vb][tb] = mfma32(a, qf[cc], O[vb][tb]);
                }
#pragma unroll
            for (int sb = 0; sb <= tb; ++sb) {
                f32x16 sc = {};
#pragma unroll
                for (int cc = 0; cc < 4; ++cc) {
                    const bf16x8 a = *(const LAS bf16x8*)(ke + (32 * sb + r32) * 72 + 16 * cc + 8 * hi);
                    sc = mfma32(a, qf[cc], sc);
                }
                unsigned P[8];
#pragma unroll
                for (int j = 0; j < 8; ++j) {
                    float p0 = sc[2 * j], p1 = sc[2 * j + 1];
                    if (sb == tb) { if (crow(2 * j, hi) > r32) p0 = 0.f; if (crow(2 * j + 1, hi) > r32) p1 = 0.f; }
                    P[j] = pk2(p0, p1);
                }
#pragma unroll
                for (int vb = 0; vb < 2; ++vb)
#pragma unroll
                    for (int c2 = 0; c2 < 2; ++c2) {
                        const u32x2 a0 = *(const LAS u32x2*)(vT + (32 * vb + r32) * 72 + 32 * sb + 16 * c2 + 4 * hi);
                        const u32x2 a1 = *(const LAS u32x2*)(vT + (32 * vb + r32) * 72 + 32 * sb + 16 * c2 + 8 + 4 * hi);
                        const bf16x8 vf = as_bf16x8((u32x4){a0.x, a0.y, a1.x, a1.y});
                        const bf16x8 pf = as_bf16x8((u32x4){P[4 * c2], P[4 * c2 + 1], P[4 * c2 + 2], P[4 * c2 + 3]});
                        O[vb][tb] = mfma32(vf, pf, O[vb][tb]);
                    }
            }
        }
        LDSW();
        const float* on = inp(I_HON) + L * 64;
#pragma unroll
        for (int tb = 0; tb < 2; ++tb) {
            float ss = 0.f;
#pragma unroll
            for (int vb = 0; vb < 2; ++vb)
#pragma unroll
                for (int r = 0; r < 16; ++r) ss += O[vb][tb][r] * O[vb][tb][r];
            ss += __shfl_xor(ss, 32);
            const float rn = rsqrtf(ss * (1.0f / 64.0f) + EPS);
#pragma unroll
            for (int vb = 0; vb < 2; ++vb)
#pragma unroll
                for (int r = 0; r < 16; ++r) { const int v = 32 * vb + crow(r, hi); ke[(32 * tb + r32) * 72 + v] = f2bf(O[vb][tb][r] * rn * on[v]); }
        }
        LDSW();
        bf16_t* mixed = (bf16_t*)(ws + WS_MIX) + row0 * DM + 640 + 64 * h;
#pragma unroll
        for (int i = 0; i < 8; ++i) {
            const int t = i * 8 + (lane >> 3), ch = lane & 7;
            const u32x4 ov = *(const LAS u32x4*)(ke + t * 72 + 8 * ch);
            const u32x4 gv = *(const u32x4*)(z + (size_t)t * ZW + C_HG + 64 * h + 8 * ch);
            u32x4 w;
            { const float g0 = bflo(gv.x), g1 = bfhi(gv.x); w.x = pk2(bflo(ov.x) * g0 * sigmoidf_(g0), bfhi(ov.x) * g1 * sigmoidf_(g1)); }
            { const float g0 = bflo(gv.y), g1 = bfhi(gv.y); w.y = pk2(bflo(ov.y) * g0 * sigmoidf_(g0), bfhi(ov.y) * g1 * sigmoidf_(g1)); }
            { const float g0 = bflo(gv.z), g1 = bfhi(gv.z); w.z = pk2(bflo(ov.z) * g0 * sigmoidf_(g0), bfhi(ov.z) * g1 * sigmoidf_(g1)); }
            { const float g0 = bflo(gv.w), g1 = bfhi(gv.w); w.w = pk2(bflo(ov.w) * g0 * sigmoidf_(g0), bfhi(ov.w) * g1 * sigmoidf_(g1)); }
            *(u32x4*)(mixed + (size_t)t * DM + 8 * ch) = w;
        }
    }
}

constexpr int ATT_K = 0, ATT_V = 18432, ATT_LUT = 35840, ATT_STAGE = 36864;
__device__ __forceinline__ void build_lut(LAS float* lut, const float* rel_bias, int head) {
    const int d = TID();
    if (d <= 128) {
        int bk = d;
        if (d >= 16) { const int far = 16 + (int)(__logf((float)d * (1.0f / 16.0f)) / 2.0794415416798357f * 16.0f); bk = far < 31 ? far : 31; }
        lut[d] = rel_bias[bk * 10 + head] * LOG2E;
    }
}
template <int NMAP, bool HAS_SEL>
__device__ __forceinline__ void attn_pass(LAS unsigned char* lds, const bf16_t* Kth, size_t kts, const bf16_t* Vth, int m_lo, int m_hi,
                                          const bf16x8 (&qr)[4], int tq, int qw0, int win, const LAS float* lut, u32x4 selw,
                                          f32x16 (&O)[NMAP][2], float (&l)[NMAP]) {
    const int tid = TID(), lane = tid & 63, r32 = lane & 31, hi = lane >> 5;
    const float c31 = lut[128];
    u32x4 kreg = *(const u32x4*)(Kth + (size_t)m_lo * kts), vreg = *(const u32x4*)(Vth + (size_t)m_lo * 64);
    int buf = 0;
    for (int m = m_lo; m <= m_hi; ++m) {
        *(LAS u32x4*)(lds + ATT_K + buf * 9216 + (tid >> 3) * 144 + (tid & 7) * 16) = kreg;
        { LAS u32x2* vp = (LAS u32x2*)(lds + ATT_V + buf * 8704 + (tid >> 3) * 136 + (tid & 7) * 16); vp[0] = (u32x2){vreg.x, vreg.y}; vp[1] = (u32x2){vreg.z, vreg.w}; }
        __syncthreads();
        if (m < m_hi) { kreg = *(const u32x4*)(Kth + (size_t)(m + 1) * kts); vreg = *(const u32x4*)(Vth + (size_t)(m + 1) * 64); }
        const int k0 = 64 * m, dmin = qw0 - (k0 + 63), dmax = qw0 + 31 - k0;
        bool sel = true;
        if (HAS_SEL) { const unsigned w = m < 32 ? selw.x : (m < 64 ? selw.y : (m < 96 ? selw.z : selw.w)); sel = (w >> (m & 31)) & 1u; }
        bool active = dmax >= 0 && dmin < win;
        if (HAS_SEL) active = active && (__any(sel) != 0);
        if (active) {
            const bool fast = dmin >= 128 && dmax < win;
            const LAS unsigned char* Kb = lds + ATT_K + buf * 9216;
            const LAS unsigned char* Vb = lds + ATT_V + buf * 8704;
            unsigned P[NMAP][2][8];
#pragma unroll
            for (int kh2 = 0; kh2 < 2; ++kh2) {
                f32x16 S[NMAP];
#pragma unroll
                for (int mp = 0; mp < NMAP; ++mp) { const float ini = fast ? c31 : 0.f;
#pragma unroll
                    for (int r = 0; r < 16; ++r) S[mp][r] = ini; }
#pragma unroll
                for (int c = 0; c < 4; ++c) {
                    const bf16x8 kf = *(const LAS bf16x8*)(Kb + (32 * kh2 + r32) * 144 + (16 * c + 8 * hi) * 2);
                    const int mp = (NMAP == 2) ? (c >> 1) : 0;
                    S[mp] = mfma32(kf, qr[c], S[mp]);
                }
#pragma unroll
                for (int mp = 0; mp < NMAP; ++mp) {
                    float p[16];
                    if (fast) {
#pragma unroll
                        for (int r = 0; r < 16; ++r) { const float e = ex2(S[mp][r]); p[r] = sel ? e : 0.f; }
                    } else {
#pragma unroll
                        for (int r = 0; r < 16; ++r) {
                            const int d = tq - (k0 + 32 * kh2 + crow(r, hi));
                            const bool valid = sel && d >= 0 && d < win;
                            const int dc = d < 0 ? 0 : (d > 128 ? 128 : d);
                            const float e = ex2(S[mp][r] + lut[dc]);
                            p[r] = valid ? e : 0.f;
                        }
                    }
                    float s = 0.f;
#pragma unroll
                    for (int r = 0; r < 16; ++r) s += p[r];
                    l[mp] += s;
#pragma unroll
                    for (int j = 0; j < 8; ++j) P[mp][kh2][j] = pk2(p[2 * j], p[2 * j + 1]);
                }
            }
#pragma unroll
            for (int db = 0; db < 2; ++db)
#pragma unroll
                for (int cc = 0; cc < 4; ++cc) {
                    const u32x2 a0 = *(const LAS u32x2*)(Vb + (32 * db + r32) * 136 + (16 * cc + 4 * hi) * 2);
                    const u32x2 a1 = *(const LAS u32x2*)(Vb + (32 * db + r32) * 136 + (16 * cc + 8 + 4 * hi) * 2);
                    const bf16x8 vf = as_bf16x8((u32x4){a0.x, a0.y, a1.x, a1.y});
#pragma unroll
                    for (int mp = 0; mp < NMAP; ++mp) {
                        const bf16x8 pf = as_bf16x8((u32x4){P[mp][cc >> 1][4 * (cc & 1)], P[mp][cc >> 1][4 * (cc & 1) + 1], P[mp][cc >> 1][4 * (cc & 1) + 2], P[mp][cc >> 1][4 * (cc & 1) + 3]});
                        O[mp][db] = mfma32(vf, pf, O[mp][db]);
                    }
                }
        }
        buf ^= 1;
    }
    __syncthreads();
}
template <bool ADD>
__device__ __forceinline__ void store_ot(LAS unsigned char* stage, const float (&val)[2][16], bf16_t* dst, int ld, const bf16_t* addsrc = nullptr, int ldadd = 0) {
    const int lane = TID() & 63, r32 = lane & 31, hi = lane >> 5;
    LAS bf16_t* st = (LAS bf16_t*)stage;
#pragma unroll
    for (int db = 0; db < 2; ++db)
#pragma unroll
        for (int r = 0; r < 16; ++r) st[r32 * 72 + 32 * db + crow(r, hi)] = f2bf(val[db][r]);
    LDSW();
#pragma unroll
    for (int i = 0; i < 4; ++i) {
        const int row = i * 8 + (lane >> 3), ch = lane & 7;
        u32x4 v = *(const LAS u32x4*)(st + row * 72 + 8 * ch);
        bf16_t* gp = dst + (size_t)row * ld + 8 * ch;
        if (ADD) {
            const u32x4 o = *(const u32x4*)(addsrc + (size_t)row * ldadd + 8 * ch);
            v.x = pk2(bflo(v.x) + bflo(o.x), bfhi(v.x) + bfhi(o.x)); v.y = pk2(bflo(v.y) + bflo(o.y), bfhi(v.y) + bfhi(o.y));
            v.z = pk2(bflo(v.z) + bflo(o.z), bfhi(v.z) + bfhi(o.z)); v.w = pk2(bflo(v.w) + bflo(o.w), bfhi(v.w) + bfhi(o.w));
        }
        *(u32x4*)gp = v;
    }
    LDSW();
}

__device__ __forceinline__ void task_diff(const float* const* in, unsigned char* ws, int L, int task, LAS unsigned char* lds) {
    const int tid = TID(), lane = tid & 63, wave = tid >> 6, r32 = lane & 31, hi = lane >> 5;
    const int qb = 31 - (task >> 4), b = (task >> 2) & 3, hd = task & 3;
    const bf16_t* z = (const bf16_t*)(ws + WS_R1);
    LAS float* lut = (LAS float*)(lds + ATT_LUT);
    build_lut(lut, inp(I_RELB), 6 + hd);
    __syncthreads();
    const int q0 = 256 * qb, qw0 = q0 + 32 * wave, tq = qw0 + r32;
    bf16x8 qr[4];
#pragma unroll
    for (int c = 0; c < 4; ++c) qr[c] = *(const bf16x8*)(z + (size_t)(b * T + tq) * ZW + C_DQ + 64 * hd + 16 * c + 8 * hi);
    const bf16_t* Kth = z + (size_t)(b * T + (tid >> 3)) * ZW + C_DK + 64 * hd + (tid & 7) * 8;
    const bf16_t* Vth = (const bf16_t*)(ws + WS_VT) + ((size_t)(b * 8 + 4 + hd) * 64 + (tid >> 3)) * T + (tid & 7) * 8;
    f32x16 O[2][2] = {}; float l[2] = {0.f, 0.f};
    attn_pass<2, false>(lds, Kth, (size_t)64 * ZW, Vth, 0, 4 * qb + 3, qr, tq, qw0, 1 << 30, lut, (u32x4){0u, 0u, 0u, 0u}, O, l);
    const float* lp = inp(I_DLAM) + L * 128;
    float s01 = 0.f, s23 = 0.f;
#pragma unroll
    for (int i = 0; i < 32; ++i) { s01 += lp[i] * lp[32 + i]; s23 += lp[64 + i] * lp[96 + i]; }
    const float lam_init = 0.8f - 0.6f * __expf(-0.3f * (float)L);
    const float lam = __expf(s01) - __expf(s23) + lam_init;
    const float l0 = l[0] + __shfl_xor(l[0], 32), l1 = l[1] + __shfl_xor(l[1], 32);
    const float i0 = 1.0f / l0, i1 = lam / l1;
    float val[2][16]; float ss = 0.f;
#pragma unroll
    for (int db = 0; db < 2; ++db)
#pragma unroll
        for (int r = 0; r < 16; ++r) { const float o = O[0][db][r] * i0 - O[1][db][r] * i1; val[db][r] = o; ss += o * o; }
    ss += __shfl_xor(ss, 32);
    const float rn = rsqrtf(ss * (1.0f / 64.0f) + EPS) * (1.0f - lam_init);
    const float* sub = inp(I_DSUB) + L * 64;
#pragma unroll
    for (int db = 0; db < 2; ++db)
#pragma unroll
        for (int r = 0; r < 16; ++r) val[db][r] *= rn * sub[32 * db + crow(r, hi)];
    store_ot<false>(lds + ATT_STAGE + wave * 4608, val, (bf16_t*)(ws + WS_MIX) + (size_t)(b * T + qw0) * DM + 384 + 64 * hd, DM);
}

__device__ __forceinline__ void task_nsa_sw(const float* const* in, unsigned char* ws, int L, int task, LAS unsigned char* lds) {
    const int tid = TID(), lane = tid & 63, wave = tid >> 6, r32 = lane & 31, hi = lane >> 5;
    const int qb = 31 - task / 24, rem = task % 24, b = rem / 6, h = rem % 6, g = h / 3;
    const bf16_t* z = (const bf16_t*)(ws + WS_R1);
    LAS float* lut = (LAS float*)(lds + ATT_LUT);
    build_lut(lut, inp(I_RELB), h);
    __syncthreads();
    const int q0 = 256 * qb, qw0 = q0 + 32 * wave, tq = qw0 + r32;
    const bf16_t* zq = z + (size_t)(b * T + tq) * ZW;
    bf16x8 qr[4];
#pragma unroll
    for (int c = 0; c < 4; ++c) qr[c] = *(const bf16x8*)(zq + C_NQ + 64 * h + 16 * c + 8 * hi);
    const u32x4 selw = *(const u32x4*)((const unsigned*)(ws + WS_SELM) + ((size_t)(b * 2 + g) * T + tq) * 4);
    const float g1 = sigmoidf_(bf2f(zq[C_NG + 3 * h + 1])), g2 = sigmoidf_(bf2f(zq[C_NG + 3 * h + 2]));
    float val[2][16];
    {
        const bf16_t* Kth = z + (size_t)(b * T + (tid >> 3)) * ZW + C_SK + 64 * g + (tid & 7) * 8;
        const bf16_t* Vth = (const bf16_t*)(ws + WS_VT) + ((size_t)(b * 8 + g) * 64 + (tid >> 3)) * T + (tid & 7) * 8;
        f32x16 O[1][2] = {}; float l[1] = {0.f};
        attn_pass<1, true>(lds, Kth, (size_t)64 * ZW, Vth, 0, 4 * qb + 3, qr, tq, qw0, 1 << 30, lut, selw, O, l);
        const float lt = l[0] + __shfl_xor(l[0], 32), sc = g1 / lt;
#pragma unroll
        for (int db = 0; db < 2; ++db)
#pragma unroll
            for (int r = 0; r < 16; ++r) val[db][r] = O[0][db][r] * sc;
    }
    {
        const bf16_t* Kth = z + (size_t)(b * T + (tid >> 3)) * ZW + C_WK + 64 * g + (tid & 7) * 8;
        const bf16_t* Vth = (const bf16_t*)(ws + WS_VT) + ((size_t)(b * 8 + 2 + g) * 64 + (tid >> 3)) * T + (tid & 7) * 8;
        f32x16 O[1][2] = {}; float l[1] = {0.f};
        const int m_lo = q0 >= 512 ? (q0 >> 6) - 8 : 0;
        attn_pass<1, false>(lds, Kth, (size_t)64 * ZW, Vth, m_lo, 4 * qb + 3, qr, tq, qw0, 512, lut, (u32x4){0u, 0u, 0u, 0u}, O, l);
        const float lt = l[0] + __shfl_xor(l[0], 32), sc = g2 / lt;
#pragma unroll
        for (int db = 0; db < 2; ++db)
#pragma unroll
            for (int r = 0; r < 16; ++r) val[db][r] += O[0][db][r] * sc;
    }
    store_ot<true>(lds + ATT_STAGE + wave * 4608, val, (bf16_t*)(ws + WS_MIX) + (size_t)(b * T + qw0) * DM + 64 * h, DM, (const bf16_t*)(ws + WS_OCB) + (size_t)(b * T + qw0) * 384 + 64 * h, 384);
}

constexpr int NC_IMP = 18432, NC_IMPW = 129, NC_LINV = NC_IMP + 3 * 64 * NC_IMPW * 4;
__device__ __forceinline__ void task_nsa_c(const float* const* in, unsigned char* ws, int L, int task, LAS unsigned char* lds) {
    const int tid = TID(), lane = tid & 63, wave = tid >> 6, r32 = lane & 31, hi = lane >> 5;
    const int cur = 127 - (task >> 3), b = (task >> 1) & 3, g = task & 1;
    const bf16_t* z = (const bf16_t*)(ws + WS_R1);
    LAS float* imp = (LAS float*)(lds + NC_IMP);
    LAS float* linv = (LAS float*)(lds + NC_LINV);
    const int q0 = 64 * cur;
    const int rh = wave >> 1, half = wave & 1, h = 3 * g + (rh < 3 ? rh : 0);
    const int ql = 32 * half + r32, tq = q0 + ql;
    const bf16_t* zq = z + (size_t)(b * T + tq) * ZW;
    bf16x8 qr[4];
#pragma unroll
    for (int c = 0; c < 4; ++c) qr[c] = *(const bf16x8*)(zq + C_NQ + 64 * h + 16 * c + 8 * hi);
    const bf16_t* Kth = (const bf16_t*)(ws + WS_KC) + ((size_t)(b * 2 + g) * 512 + (tid >> 3)) * 64 + (tid & 7) * 8;
    const bf16_t* Vth = (const bf16_t*)(ws + WS_VCT) + ((size_t)(b * 2 + g) * 64 + (tid >> 3)) * 512 + (tid & 7) * 8;
    const int ntiles = ((4 * cur + 2) >> 6) + 1;
    f32x16 O[2] = {}; float l = 0.f, carry = 0.f;
    for (int m = 0; m < ntiles; ++m) {
        __syncthreads();
        *(LAS u32x4*)(lds + (tid >> 3) * 144 + (tid & 7) * 16) = *(const u32x4*)(Kth + (size_t)m * 64 * 64);
        { const u32x4 v = *(const u32x4*)(Vth + (size_t)m * 64); LAS u32x2* vp = (LAS u32x2*)(lds + 9216 + (tid >> 3) * 136 + (tid & 7) * 16); vp[0] = (u32x2){v.x, v.y}; vp[1] = (u32x2){v.z, v.w}; }
        __syncthreads();
        if (wave < 6) {
            unsigned P[2][8]; float av[8], bq[8];
#pragma unroll
            for (int kh2 = 0; kh2 < 2; ++kh2) {
                f32x16 S = {};
#pragma unroll
                for (int c = 0; c < 4; ++c) { const bf16x8 kf = *(const LAS bf16x8*)(lds + (32 * kh2 + r32) * 144 + (16 * c + 8 * hi) * 2); S = mfma32(kf, qr[c], S); }
                float p[16];
#pragma unroll
                for (int r = 0; r < 16; ++r) { const int n = 64 * m + 32 * kh2 + crow(r, hi); const float e = ex2(S[r]); p[r] = (16 * n + 31 <= tq) ? e : 0.f; }
                float s = 0.f;
#pragma unroll
                for (int r = 0; r < 16; ++r) s += p[r];
                l += s;
#pragma unroll
                for (int j = 0; j < 8; ++j) P[kh2][j] = pk2(p[2 * j], p[2 * j + 1]);
#pragma unroll
                for (int j = 0; j < 4; ++j) { av[4 * kh2 + j] = p[4 * j] + p[4 * j + 1] + p[4 * j + 2] + 0.5f * p[4 * j + 3]; bq[4 * kh2 + j] = 0.5f * p[4 * j + 3]; }
            }
#pragma unroll
            for (int db = 0; db < 2; ++db)
#pragma unroll
                for (int cc = 0; cc < 4; ++cc) {
                    const u32x2 a0 = *(const LAS u32x2*)(lds + 9216 + (32 * db + r32) * 136 + (16 * cc + 4 * hi) * 2);
                    const u32x2 a1 = *(const LAS u32x2*)(lds + 9216 + (32 * db + r32) * 136 + (16 * cc + 8 + 4 * hi) * 2);
                    const bf16x8 vf = as_bf16x8((u32x4){a0.x, a0.y, a1.x, a1.y});
                    const bf16x8 pf = as_bf16x8((u32x4){P[cc >> 1][4 * (cc & 1)], P[cc >> 1][4 * (cc & 1) + 1], P[cc >> 1][4 * (cc & 1) + 2], P[cc >> 1][4 * (cc & 1) + 3]});
                    O[db] = mfma32(vf, pf, O[db]);
                }
            float recv[8];
#pragma unroll
            for (int jj = 0; jj < 8; ++jj) recv[jj] = __shfl_xor(bq[jj], 32);
            LAS float* ip = imp + (rh * 64 + ql) * NC_IMPW + 16 * m + hi;
#pragma unroll
            for (int jj = 0; jj < 8; ++jj) {
                const float add = hi ? recv[jj] : (jj == 0 ? carry : recv[jj > 0 ? jj - 1 : 0]);
                ip[2 * jj] = av[jj] + add;
            }
            carry = recv[7];
        }
    }
    if (wave < 6) {
        const float lt = l + __shfl_xor(l, 32);
        const float li = (tq >= 31 && lt > 0.f) ? 1.0f / lt : 0.f;
        if (hi == 0) linv[rh * 64 + ql] = li;
        const float g0 = sigmoidf_(bf2f(zq[C_NG + 3 * h + 0]));
        bf16_t* mx = (bf16_t*)(ws + WS_OCB) + (size_t)(b * T + tq) * 384 + 64 * h;
        const float sc = li * g0;
#pragma unroll
        for (int db = 0; db < 2; ++db)
#pragma unroll
            for (int r = 0; r < 16; ++r) mx[32 * db + crow(r, hi)] = f2bf(O[db][r] * sc);
    }
    __syncthreads();
    for (int qi = 0; qi < 8; ++qi) {
        const int q = 8 * wave + qi;
        unsigned w0 = 0u, w1 = 0u, w2 = 0u, w3 = 0u;
        if (cur <= 15) { w0 = (1u << (cur + 1)) - 1u; }
        else {
            const float i0 = linv[q], i1 = linv[64 + q], i2 = linv[128 + q];
            const int ma = lane, mb = lane + 64;
            float va = 0.f, vb = 0.f;
            if (ma >= 1 && ma <= cur - 2) va = imp[(0 * 64 + q) * NC_IMPW + ma] * i0 + imp[(1 * 64 + q) * NC_IMPW + ma] * i1 + imp[(2 * 64 + q) * NC_IMPW + ma] * i2;
            if (mb <= cur - 2) vb = imp[(0 * 64 + q) * NC_IMPW + mb] * i0 + imp[(1 * 64 + q) * NC_IMPW + mb] * i1 + imp[(2 * 64 + q) * NC_IMPW + mb] * i2;
            unsigned long long mine_a = ((unsigned long long)__float_as_uint(va) << 32) | (unsigned)(255 - ma);
            unsigned long long mine_b = ((unsigned long long)__float_as_uint(vb) << 32) | (unsigned)(255 - mb);
            if (va <= 0.f) mine_a = 0ull;
            if (vb <= 0.f) mine_b = 0ull;
            unsigned long long sa = 0ull, sb = 0ull;
            for (int it = 0; it < 13; ++it) {
                unsigned long long best = mine_a > mine_b ? mine_a : mine_b;
#pragma unroll
                for (int o = 1; o < 64; o <<= 1) {
                    const unsigned oh = __shfl_xor((unsigned)(best >> 32), o), ol = __shfl_xor((unsigned)best, o);
                    const unsigned long long other = ((unsigned long long)oh << 32) | ol;
                    best = other > best ? other : best;
                }
                if (best != 0ull) {
                    const int mw = 255 - (int)(unsigned)(best & 0xffffffffull);
                    if (mw < 64) sa |= 1ull << mw; else sb |= 1ull << (mw - 64);
                    if (mine_a == best) mine_a = 0ull;
                    if (mine_b == best) mine_b = 0ull;
                }
            }
            sa |= 1ull;
            if (cur < 64) sa |= 1ull << cur; else sb |= 1ull << (cur - 64);
            if (cur - 1 < 64) sa |= 1ull << (cur - 1); else sb |= 1ull << (cur - 1 - 64);
            w0 = (unsigned)sa; w1 = (unsigned)(sa >> 32); w2 = (unsigned)sb; w3 = (unsigned)(sb >> 32);
        }
        if (lane == 0) *(u32x4*)((unsigned*)(ws + WS_SELM) + ((size_t)(b * 2 + g) * T + q0 + q) * 4) = (u32x4){w0, w1, w2, w3};
    }
}

#define XB_TMO      128
#define XB_XCNT(j)  (256  + 64 * (j))
#define XB_XSUB(j)  (1280 + 64 * (j))
#define XB_XGEN(j)  (2304 + 64 * (j))
#define XB_TOP      3328
#define XB_TOPGEN   3392
#define XCD_BAR_WORDS 3456
#define XB_SPIN_CAP (1u << 18)

__device__ __forceinline__ unsigned xb_ld(unsigned* p)              { return __hip_atomic_load(p, __ATOMIC_RELAXED, __HIP_MEMORY_SCOPE_AGENT); }
__device__ __forceinline__ unsigned xb_add(unsigned* p, unsigned v) { return __hip_atomic_fetch_add(p, v, __ATOMIC_RELAXED, __HIP_MEMORY_SCOPE_AGENT); }
__device__ __forceinline__ unsigned xb_xcc_id() { return (unsigned)__builtin_amdgcn_s_getreg((3 << 11) | 20) & 0xFu; }
#define XB_SPIN(cond, bar) do { unsigned _sp = 0; while (cond) { __builtin_amdgcn_s_sleep(1); \
    if ((++_sp & 255u) == 0u) { if (xb_ld(&(bar)[XB_TMO])) break; if (_sp > XB_SPIN_CAP) { atomicAdd(&(bar)[XB_TMO], 1u); break; } } } } while (0)

struct XcdBarrier {
    unsigned* bar; unsigned x;
    volatile LAS unsigned* st;
};

__device__ __forceinline__ XcdBarrier xcd_barrier_post(unsigned* bar, volatile LAS unsigned* st) {
    XcdBarrier b; b.bar = bar; b.x = xb_xcc_id(); b.st = st;
    if (threadIdx.x == 0) (void)xb_add(&bar[XB_XCNT(b.x)], 1u);
    return b;
}
__device__ __forceinline__ void xcd_barrier_complete(unsigned* bar, unsigned x, unsigned& nloc, unsigned& nx) {
    const unsigned G = gridDim.x * gridDim.y * gridDim.z;
    unsigned sum, cnt, mine, sp = 0u;
    for (;;) {
        sum = 0u; cnt = 0u; mine = 0u;
#pragma unroll
        for (unsigned j = 0; j < 16; ++j) { const unsigned c = xb_ld(&bar[XB_XCNT(j)]); sum += c; cnt += (c > 0u) ? 1u : 0u; mine = (j == x) ? c : mine; }
        if (sum == G) break;
        __builtin_amdgcn_s_sleep(1);
        if ((++sp & 255u) == 0u) { if (xb_ld(&bar[XB_TMO])) break; if (sp > XB_SPIN_CAP) { atomicAdd(&bar[XB_TMO], 1u); break; } }
    }
    nloc = mine > 0u ? mine : 1u; nx = cnt > 0u ? cnt : 1u;
}

__device__ __forceinline__ void xcd_barrier(const XcdBarrier& b) {
    asm volatile("s_waitcnt vmcnt(0)" ::: "memory");
    __syncthreads();
    if (threadIdx.x == 0) {
        unsigned* bar = b.bar;
        __builtin_amdgcn_s_waitcnt(0);
        unsigned nloc = b.st[0], nx = b.st[1];
        if (nloc == 0u) { xcd_barrier_complete(bar, b.x, nloc, nx); b.st[0] = nloc; b.st[1] = nx; }
        const unsigned old = xb_add(&bar[XB_XSUB(b.x)], 1u);
        const unsigned gen = old / nloc;
        if (old + 1u == (gen + 1u) * nloc) {
            __builtin_amdgcn_fence(__ATOMIC_RELEASE, "agent");
            asm volatile("s_waitcnt vmcnt(0)" ::: "memory");
            const unsigned og = xb_add(&bar[XB_TOP], 1u);
            const unsigned tg = og / nx;
            if (og + 1u == (tg + 1u) * nx) xb_add(&bar[XB_TOPGEN], 1u);
            else XB_SPIN(xb_ld(&bar[XB_TOPGEN]) == tg, bar);
            __builtin_amdgcn_fence(__ATOMIC_ACQUIRE, "agent");
            xb_add(&bar[XB_XGEN(b.x)], 1u);
            asm volatile("s_waitcnt vmcnt(0)" ::: "memory");
        } else {
            XB_SPIN(xb_ld(&bar[XB_XGEN(b.x)]) == gen, bar);
            __builtin_amdgcn_fence(__ATOMIC_ACQUIRE, "agent");
            asm volatile("s_waitcnt vmcnt(0)" ::: "memory");
        }
    }
    __syncthreads();
}

struct Args { const float* in[N_IN]; float* out; unsigned char* ws; int ph_lo, ph_hi; };
static_assert(sizeof(Args) == 8 * N_IN + 24, "Args has no padding");
constexpr int PH_PER_LAYER = 11, N_PHASES = DEPTH * PH_PER_LAYER;
#ifndef PH_HI
#define PH_HI N_PHASES
#endif

__global__ void __launch_bounds__(512) mega(Args a) {
    extern __shared__ __attribute__((aligned(16))) unsigned char lds_raw[];
    LAS unsigned char* lds = (LAS unsigned char*)lds_raw;
    LAS int* slot = (LAS int*)(lds + LDS_MISC);
    cg::grid_group grid = cg::this_grid();
    const float* const* in = nullptr;
    volatile LAS unsigned* misc = (volatile LAS unsigned*)(lds + LDS_MISC);
    if (TID() < 16) misc[TID()] = 0u;
    __syncthreads();
    (void)xcd_barrier_post((unsigned*)(a.ws + WS_CTL) + 4096, misc + 8);
#ifndef DUP_GU
#define DUP_GU 0
#endif
#ifndef DUP_IN
#define DUP_IN 0
#endif
#ifndef DUP_DIFF
#define DUP_DIFF 0
#endif
#ifndef DUP_NSAC
#define DUP_NSAC 0
#endif
#ifndef DUP_SW
#define DUP_SW 0
#endif
#ifndef DUP_HOUT
#define DUP_HOUT 0
#endif
#ifndef DUP_M1
#define DUP_M1 0
#endif
#ifndef DUP_SYNC
#define DUP_SYNC 0
#endif
#ifndef DUP_CONV
#define DUP_CONV 0
#endif
#ifndef PHM
#define PHM 0x7ff
#endif
    for (int ph = a.ph_lo; ph < a.ph_hi; ++ph) {
        int L = ph / PH_PER_LAYER; const int j = ph - L * PH_PER_LAYER;
        asm volatile("" : "+s"(L));
        unsigned long long ws_ = (unsigned long long)a.ws; asm volatile("" : "+s"(ws_)); unsigned char* ws = (unsigned char*)(GAS unsigned char*)ws_;
        unsigned long long out_ = (unsigned long long)a.out; asm volatile("" : "+s"(out_)); float* out_g = (float*)(GAS float*)out_;
        unsigned* ctl = (unsigned*)(ws + WS_CTL); bf16_t* r1 = (bf16_t*)(ws + WS_R1); bf16_t* mixed = (bf16_t*)(ws + WS_MIX); bf16_t* pb = (bf16_t*)(ws + WS_PB); unsigned char* wb = ws + WS_W; float* rsqp = (float*)(ws + WS_RSQP);
        float* rsq = (float*)(ws + ((L & 1) ? WS_RSQ1 : WS_RSQ0)); float* rsq_next = (float*)(ws + ((L & 1) ? WS_RSQ0 : WS_RSQ1));
        bf16_t* xb = (bf16_t*)(ws + ((L & 1) ? WS_XB1 : WS_XB)); bf16_t* xb_next = (bf16_t*)(ws + ((L & 1) ? WS_XB : WS_XB1));
        if ((PHM >> j) & 1) switch (j) {
        case 0: phase_convert(in, ws, out_g, L, lds); if (DUP_CONV) { __syncthreads(); phase_convert(in, ws, out_g, L, lds); } break;
        case 1: { EpiSwiGLU E{r1, rsq}; run_gemm(lds, xb, (const bf16_t*)(wb + W_GU1), 2 * FF, DM, E); } break;
        case 2: { EpiRes<0> E{out_g, xb, rsq, 0.5f, nullptr, nullptr, nullptr, nullptr, nullptr}; run_gemm(lds, r1, (const bf16_t*)(wb + W_D1), DM, FF, E); } break;
        case 3: { EpiZ E{r1, rsq}; run_gemm(lds, xb, (const bf16_t*)(wb + W_IN), ZW, DM, E); } break;
        case 4: {
            unsigned* ctr = ctl + (L * 4 + 0) * 64;
            constexpr int NCMP = 512 << DUP_M1, NHL = 512 << DUP_M1;
            for (;;) { const int t = next_task(ctr, slot); if (t >= NCMP + NHL + 512) break;
                if (t < NCMP) task_compress(in, ws, L, t >> DUP_M1, lds); else if (t < NCMP + NHL) task_hgrn_local(in, ws, L, (t - NCMP) >> DUP_M1, lds); else task_prep(in, ws, L, t - NCMP - NHL, lds); }
        } break;
        case 5: {
            unsigned* ctr = ctl + (L * 4 + 1) * 64;
            constexpr int ND = 512 << DUP_DIFF, NC = 1024 << DUP_NSAC;
            for (;;) { const int t = next_task(ctr, slot); if (t >= 192 + ND + NC) break;
                if (t < 192) task_hgrn_scan(ws, t); else if (t < 192 + ND) task_diff(in, ws, L, (t - 192) >> DUP_DIFF, lds); else task_nsa_c(in, ws, L, (t - 192 - ND) >> DUP_NSAC, lds); }
        } break;
        case 6: {
            unsigned* ctr = ctl + (L * 4 + 2) * 64;
            constexpr int NS = 768 << DUP_SW, NH = 1024 << DUP_HOUT;
            for (;;) { const int t = next_task(ctr, slot); if (t >= NS + NH) break;
                if (t < NS) task_nsa_sw(in, ws, L, t >> DUP_SW, lds); else task_hgrn_out(in, ws, L, (t - NS) >> DUP_HOUT, lds); }
        } break;
        case 7: { EpiRes<0> E{out_g, xb, rsq, 1.0f, nullptr, nullptr, nullptr, nullptr, nullptr}; run_gemm(lds, mixed, (const bf16_t*)(wb + W_OUT), DM, DM, E); } break;
        case 8: {
            { EpiSwiGLU E{r1, rsq}; run_gemm(lds, xb, (const bf16_t*)(wb + W_GU2), 2 * FF, DM, E); }
            { EpiRes<2> E{nullptr, nullptr, rsqp, 0.f, nullptr, nullptr, nullptr, nullptr, mixed}; run_gemm(lds, pb, (const bf16_t*)(wb + W_PP), DM, PLE, E); }
        } break;
        case 9: { EpiRes<0> E{out_g, xb, rsq, 0.5f, nullptr, nullptr, nullptr, nullptr, nullptr}; run_gemm(lds, r1, (const bf16_t*)(wb + W_D2), DM, FF, E); } break;
        default: { EpiRes<1> E{out_g, xb_next, rsq_next, 0.f, rsq, mixed, rsqp, inp(I_PLPOST) + L * DM, nullptr}; run_gemm(lds, xb, (const bf16_t*)(wb + W_PG), DM, DM, E); } break;
        }
        if (ph + 1 < a.ph_hi) {
            if (ph == 0) { asm volatile("s_waitcnt vmcnt(0) lgkmcnt(0)" ::: "memory"); grid.sync(); __builtin_amdgcn_fence(__ATOMIC_ACQUIRE, "agent"); asm volatile("s_waitcnt vmcnt(0)" ::: "memory"); __syncthreads(); }
            else { XcdBarrier xb_; xb_.bar = (unsigned*)(ws + WS_CTL) + 4096; xb_.x = xb_xcc_id(); xb_.st = misc + 8; xcd_barrier(xb_); if (DUP_SYNC) xcd_barrier(xb_); }
        }
    }
}

#ifdef DUMPK
__global__ void __launch_bounds__(512) dump_kernel(float* out, unsigned char* ws) {
    bf16_t* mixed = (bf16_t*)(ws + WS_MIX); (void)mixed;
    for (size_t idx = (size_t)blockIdx.x * 512 + threadIdx.x; idx < (size_t)M * 1024; idx += (size_t)gridDim.x * 512) {
        const size_t m = idx >> 10; const int c = (int)(idx & 1023);
        float v = 0.f;
#if DUMPK == 3 || DUMPK == 40
        { const bf16_t* z = (const bf16_t*)(ws + WS_R1); v = bf2f(z[m * ZW + c]) + bf2f(z[m * ZW + 1024 + c]) + bf2f(z[m * ZW + 2048 + c]) + (c < 402 ? bf2f(z[m * ZW + 3072 + c]) : 0.f); }
#elif DUMPK == 41
        { const bf16_t* vt = (const bf16_t*)(ws + WS_VT); v = bf2f(vt[m * 512 + (c & 511)]); }
#elif DUMPK == 42
        { const float* hs = (const float*)(ws + WS_HS); const float* hd = (const float*)(ws + WS_HD); v = hs[m * 384 + (c % 384)] + hd[m * 6 + (c % 6)]; }
#elif DUMPK == 43
        { const bf16_t* kc = (const bf16_t*)(ws + WS_KC); const bf16_t* vct = (const bf16_t*)(ws + WS_VCT); v = bf2f(kc[m * 8 + (c & 7)]) + bf2f(vct[m * 8 + (c & 7)]); }
#elif DUMPK == 50 || DUMPK == 60
        v = (c < 384) ? bf2f(mixed[m * 1024 + c]) : 0.f;
#elif DUMPK == 51
        v = (c >= 384 && c < 640) ? bf2f(mixed[m * 1024 + c]) : 0.f;
#elif DUMPK == 52
        { const unsigned* selm = (const unsigned*)(ws + WS_SELM); v = (float)(selm[m * 8 + (c & 7)] & 0xffffu) + (float)(selm[m * 8 + (c & 7)] >> 16); }
#elif DUMPK == 53
        { const float* hs = (const float*)(ws + WS_HS); v = hs[m * 384 + (c % 384)]; }
#elif DUMPK == 61
        v = (c >= 640) ? bf2f(mixed[m * 1024 + c]) : 0.f;
#endif
        out[idx] = v;
    }
}
#endif

extern "C" void kernel_launch(void* const* d_in, const int* in_sizes, int n_in, void* d_out, int out_size, void* d_ws, size_t ws_size, hipStream_t stream) {
    static int grid = 0;
    if (grid == 0) {
        if (n_in != N_IN || out_size != M * DM || ws_size < WS_END) { fprintf(stderr, "kernel_launch: unexpected shapes (n_in %d out %d ws %zu)\n", n_in, out_size, ws_size); grid = -1; return; }
        int dev = 0, cus = 0, per_cu = 0;
        hipGetDevice(&dev); hipDeviceGetAttribute(&cus, hipDeviceAttributeMultiprocessorCount, dev);
        if (hipFuncSetAttribute((const void*)mega, hipFuncAttributeMaxDynamicSharedMemorySize, LDS_BYTES) != hipSuccess) { fprintf(stderr, "hipFuncSetAttribute failed\n"); }
        if (hipOccupancyMaxActiveBlocksPerMultiprocessor(&per_cu, (const void*)mega, 512, LDS_BYTES) != hipSuccess || per_cu < 1) { fprintf(stderr, "occupancy query: %d\n", per_cu); per_cu = 1; }
        (void)hipGetLastError();
        grid = cus;
    }
    if (grid < 0) return;
    hipMemsetAsync((char*)d_ws + WS_CTL, 0, 64 * 1024, stream);
    Args a{};
    for (int i = 0; i < N_IN; ++i) a.in[i] = (const float*)d_in[i];
    a.out = (float*)d_out; a.ws = (unsigned char*)d_ws; a.ph_lo = 0; a.ph_hi = PH_HI;
    void* args[] = {&a};
    hipError_t e = hipLaunchCooperativeKernel((const void*)mega, dim3(grid), dim3(512), args, LDS_BYTES, stream);
    if (e != hipSuccess) fprintf(stderr, "cooperative launch failed: %s (grid %d)\n", hipGetErrorString(e), grid);
#ifdef DUMPK
    dump_kernel<<<dim3(1024), dim3(512), 0, stream>>>((float*)d_out, (unsigned char*)d_ws);
#endif
}
```

```cpp
#include <hip/hip_runtime.h>
#include <hip/hip_cooperative_groups.h>
#include <cstdio>
#include <cstdint>
namespace cg = cooperative_groups;
__device__ __forceinline__ int TID() { int t = threadIdx.x; asm volatile("" : "+v"(t)); return t; }
namespace pg8 {
#define PG8_LAS __attribute__((address_space(3)))
typedef unsigned short bf16_t;
typedef short bf16x8 __attribute__((ext_vector_type(8)));
typedef float f32x4 __attribute__((ext_vector_type(4)));
typedef unsigned u32x4 __attribute__((ext_vector_type(4)));
constexpr int BM = 256, BK = 64, HALF = 128, HTB = HALF * BK * 2  , STAGE_BYTES = 8 * HTB, NXCD = 8, WGM = 8;

__host__ __device__ __forceinline__ int lds_byte(int r, int c) { const int st = (r >> 4) * 2 + (c >> 5), rr = r & 15, cc = c & 31, ob = rr * 64 + cc * 2; return st * 1024 + (ob ^ (((ob >> 9) & 1) << 5)); }
__host__ __device__ __forceinline__ void stage_rc(int b, int& R, int& C) { const int st = b / 1024, sb = b % 1024, swz = sb ^ (((sb >> 9) & 1) << 5); R = (st >> 1) * 16 + swz / 64; C = (st & 1) * 32 + (swz % 64) / 2; }
__host__ __device__ __forceinline__ int perm32(int rho) { const int n = rho >> 4, i = rho & 15; return 8 * (i >> 2) + 4 * n + (i & 3); }

struct Unit { int pm, pn; };
struct Gemm { const bf16_t* A; const bf16_t* Bt; int M, N, K; };

struct StaticOrder {
    int nM, nN, nwg, G, c;
    __host__ __device__ void init(int M, int N, int G_, int c_) { nM = M / BM; nN = N / BM; nwg = nM * nN; G = G_; c = c_; }
    __host__ __device__ bool next(int i, Unit& u) const {
        const long L = (long)i * G + c; if (L >= nwg) return false;
        int wgid = (int)L; { const int q = nwg / NXCD, r = nwg % NXCD, xcd = wgid % NXCD, off = wgid / NXCD; wgid = (xcd < r ? xcd * (q + 1) : r * (q + 1) + (xcd - r) * q) + off; }
        const int nig = WGM * nN, gid = wgid / nig, fm = gid * WGM, gsz = (nM - fm) < WGM ? (nM - fm) : WGM;
        u.pm = fm + ((wgid % nig) % gsz); u.pn = (wgid % nig) / gsz; return true;
    }
    __device__ __forceinline__ void a_ready(const Unit&) const {}
    __device__ __forceinline__ void done(const Unit&) const {}
};

template <class Epi, class Sched, bool ALIGN_EPI = false, bool SP2 = false>
__device__ __forceinline__ void gemm_phase(PG8_LAS unsigned char* lds, const Gemm g, const Sched& S, const Epi& E) {
    const int tid = TID(), wid = __builtin_amdgcn_readfirstlane(tid >> 6), lane = tid & 63, wr = wid >> 2, wc = wid & 3, fr = lane & 15, fq = lane >> 4;
    const int K = g.K, nt = K / BK;
    unsigned voffA[2], voffB[2];
#pragma unroll
    for (int i = 0; i < 2; ++i) { int R, C; stage_rc(tid * 16 + i * 8192, R, C); const int Rb = Epi::PERM ? ((R & ~31) + perm32(R & 31)) : R;
        voffA[i] = (unsigned)(R * K + C) * 2u; voffB[i] = (unsigned)(Rb * K + C) * 2u; }
    const size_t kstep = (size_t)(BK * 2);
    const size_t hstep = (size_t)HALF * K * 2;
    const size_t tstep = 2 * hstep;
    const unsigned ldsw = (unsigned)wid * 1024u;
    const int aoff = lds_byte(wr * 64 + fr, fq * 8), boff = lds_byte(wc * 32 + fr, fq * 8);
#define PG8_SA(b, h) (((b) * 2 + (h)) * HTB)
#define PG8_SB(b, h) ((4 + (b) * 2 + (h)) * HTB)
#define PG8_STAGE(bufoff, gbase, voff) do { _Pragma("unroll") for (int _i = 0; _i < 2; ++_i) \
        __builtin_amdgcn_global_load_lds((const unsigned*)((const char*)(gbase) + (voff)[_i]), (PG8_LAS unsigned*)(lds + (bufoff) + ldsw + _i * 8192), 16, 0, 0); } while (0)
#define PG8_LDA(dst, b, h) do { _Pragma("unroll") for (int m = 0; m < 4; ++m) _Pragma("unroll") for (int k = 0; k < 2; ++k) dst[m][k] = *(const PG8_LAS bf16x8*)(lds + PG8_SA(b, h) + aoff + m * 2048 + k * 1024); } while (0)
#define PG8_LDB(dst, b, h) do { _Pragma("unroll") for (int n = 0; n < 2; ++n) _Pragma("unroll") for (int k = 0; k < 2; ++k) dst[n][k] = *(const PG8_LAS bf16x8*)(lds + PG8_SB(b, h) + boff + n * 2048 + k * 1024); } while (0)
#define PG8_MMA(ai, bj, At, Bt) do { __builtin_amdgcn_s_setprio(1); _Pragma("unroll") for (int m = 0; m < 4; ++m) _Pragma("unroll") for (int n = 0; n < 2; ++n) _Pragma("unroll") for (int k = 0; k < 2; ++k) \
        acc[ai][bj][m][n] = __builtin_amdgcn_mfma_f32_16x16x32_bf16(Bt[n][k], At[m][k], acc[ai][bj][m][n], 0, 0, 0); __builtin_amdgcn_s_setprio(0); } while (0)
#define PG8_WAIT_V(n) asm volatile("s_waitcnt vmcnt(" #n ")" ::: "memory")
#define PG8_WAIT_L(n) asm volatile("s_waitcnt lgkmcnt(" #n ")" ::: "memory")
#define PG8_BAR __builtin_amdgcn_s_barrier()
#define PG8_SCHED __builtin_amdgcn_sched_barrier(0)
    Unit cur, nxt; int ui = 0;
    if (!S.next(0, cur)) return;
    f32x4 acc[2][2][4][2];
#pragma unroll
    for (int a = 0; a < 2; ++a)
#pragma unroll
        for (int b = 0; b < 2; ++b)
#pragma unroll
            for (int m = 0; m < 4; ++m)
#pragma unroll
                for (int n = 0; n < 2; ++n) acc[a][b][m][n] = (f32x4){0.f, 0.f, 0.f, 0.f};
    bf16x8 At[4][2], B0[2][2], B1[2][2];
    const char* cA = (const char*)g.A + (size_t)cur.pm * tstep; const char* cB = (const char*)g.Bt + (size_t)cur.pn * tstep;
    S.a_ready(cur);
    if constexpr (SP2) {
        PG8_STAGE(PG8_SB(0, 0), cB, voffB); PG8_STAGE(PG8_SB(0, 1), cB + hstep, voffB); PG8_STAGE(PG8_SA(0, 0), cA, voffA); PG8_STAGE(PG8_SA(0, 1), cA + hstep, voffA);
        if (wr == 1) PG8_BAR;
        PG8_WAIT_V(2); PG8_BAR;
        PG8_STAGE(PG8_SB(1, 0), cB + kstep, voffB); PG8_STAGE(PG8_SA(1, 0), cA + kstep, voffA); PG8_STAGE(PG8_SB(1, 1), cB + hstep + kstep, voffB);
        PG8_WAIT_V(6); PG8_BAR;
    } else {
        PG8_STAGE(PG8_SB(0, 0), cB, voffB); PG8_STAGE(PG8_SA(0, 0), cA, voffA); PG8_STAGE(PG8_SB(0, 1), cB + hstep, voffB); PG8_STAGE(PG8_SA(0, 1), cA + hstep, voffA);
        if (wr == 1) PG8_BAR;
        PG8_WAIT_V(4); PG8_BAR;
        PG8_STAGE(PG8_SB(1, 0), cB + kstep, voffB); PG8_STAGE(PG8_SA(1, 0), cA + kstep, voffA); PG8_STAGE(PG8_SB(1, 1), cB + hstep + kstep, voffB);
        PG8_WAIT_V(6); PG8_BAR;
    }
    for (;;) {
        const bool has_next = S.next(ui + 1, nxt);
        const char* nA = has_next ? (const char*)g.A + (size_t)nxt.pm * tstep : cA; const char* nB = has_next ? (const char*)g.Bt + (size_t)nxt.pn * tstep : cB;
        for (int t = 0; t < nt; t += 2) {
            const bool last = (t == nt - 2);
            const char* a1 = cA + (size_t)(t + 1) * kstep;
            const char* a2 = last ? nA : cA + (size_t)(t + 2) * kstep; const char* b2 = last ? nB : cB + (size_t)(t + 2) * kstep;
            const char* a3 = a2 + kstep; const char* b3 = b2 + kstep;
            if (last && has_next) S.a_ready(nxt);
            if constexpr (SP2) {
            PG8_LDB(B0, 0, 0); PG8_LDB(B1, 0, 1); PG8_SCHED; PG8_LDA(At, 0, 0); PG8_STAGE(PG8_SA(1, 1), a1 + hstep, voffA);
            PG8_WAIT_V(8); PG8_WAIT_L(0); PG8_BAR; PG8_MMA(0, 0, At, B0); PG8_MMA(0, 1, At, B1); PG8_BAR; PG8_SCHED;
            PG8_LDA(At, 0, 1); PG8_STAGE(PG8_SB(0, 0), b2, voffB); PG8_STAGE(PG8_SB(0, 1), b2 + hstep, voffB); PG8_STAGE(PG8_SA(0, 0), a2, voffA);
            PG8_WAIT_V(8); PG8_WAIT_L(0); PG8_BAR; PG8_MMA(1, 0, At, B0); PG8_MMA(1, 1, At, B1); PG8_BAR; PG8_SCHED;
            PG8_LDB(B0, 1, 0); PG8_LDB(B1, 1, 1); PG8_SCHED; PG8_LDA(At, 1, 0); PG8_STAGE(PG8_SA(0, 1), a2 + hstep, voffA);
            PG8_WAIT_V(8); PG8_WAIT_L(0); PG8_BAR; PG8_MMA(0, 0, At, B0); PG8_MMA(0, 1, At, B1); PG8_BAR; PG8_SCHED;
            PG8_LDA(At, 1, 1); PG8_STAGE(PG8_SB(1, 0), b3, voffB); PG8_STAGE(PG8_SB(1, 1), b3 + hstep, voffB); PG8_STAGE(PG8_SA(1, 0), a3, voffA);
            PG8_WAIT_V(8); PG8_WAIT_L(0); PG8_BAR; PG8_MMA(1, 0, At, B0); PG8_MMA(1, 1, At, B1); PG8_BAR; PG8_SCHED;
            } else {
            PG8_LDB(B0, 0, 0); PG8_SCHED; PG8_LDA(At, 0, 0); PG8_STAGE(PG8_SA(1, 1), a1 + hstep, voffA);
            PG8_WAIT_L(8); PG8_BAR; PG8_WAIT_L(0); PG8_MMA(0, 0, At, B0); PG8_BAR; PG8_SCHED;
            PG8_LDB(B1, 0, 1); PG8_STAGE(PG8_SB(0, 0), b2, voffB);
            PG8_BAR; PG8_WAIT_L(0); PG8_MMA(0, 1, At, B1); PG8_BAR;
            PG8_LDA(At, 0, 1); PG8_STAGE(PG8_SA(0, 0), a2, voffA);
            PG8_BAR; PG8_WAIT_L(0); PG8_MMA(1, 0, At, B0); PG8_BAR; PG8_SCHED;
            PG8_STAGE(PG8_SB(0, 1), b2 + hstep, voffB);
            PG8_WAIT_V(6); PG8_BAR; PG8_MMA(1, 1, At, B1); PG8_BAR;
            PG8_LDB(B0, 1, 0); PG8_SCHED; PG8_LDA(At, 1, 0); PG8_STAGE(PG8_SA(0, 1), a2 + hstep, voffA);
            PG8_WAIT_L(8); PG8_BAR; PG8_WAIT_L(0); PG8_MMA(0, 0, At, B0); PG8_BAR; PG8_SCHED;
            PG8_LDB(B1, 1, 1); PG8_STAGE(PG8_SB(1, 0), b3, voffB);
            PG8_BAR; PG8_WAIT_L(0); PG8_MMA(0, 1, At, B1); PG8_BAR;
            PG8_LDA(At, 1, 1); PG8_STAGE(PG8_SA(1, 0), a3, voffA);
            PG8_BAR; PG8_WAIT_L(0); PG8_MMA(1, 0, At, B0); PG8_BAR; PG8_SCHED;
            PG8_STAGE(PG8_SB(1, 1), b3 + hstep, voffB);
            PG8_WAIT_V(6); PG8_BAR; PG8_MMA(1, 1, At, B1); PG8_BAR;
            }
        }
        if constexpr (ALIGN_EPI) { if (wr == 0) PG8_BAR; }
        if constexpr (!Epi::AFTER_DRAIN) { E(acc, cur, wr, wc, fr, fq); S.done(cur); }
        if (!has_next) break;
#pragma unroll
        for (int a = 0; a < 2; ++a)
#pragma unroll
            for (int b = 0; b < 2; ++b)
#pragma unroll
                for (int m = 0; m < 4; ++m)
#pragma unroll
                    for (int n = 0; n < 2; ++n) acc[a][b][m][n] = (f32x4){0.f, 0.f, 0.f, 0.f};
        cur = nxt; cA = nA; cB = nB; ++ui;
        if constexpr (ALIGN_EPI) { if (wr == 1) PG8_BAR; }
    }
    PG8_WAIT_V(0);
    if constexpr (!ALIGN_EPI) { if (wr == 0) PG8_BAR; }
    PG8_BAR;
    if constexpr (Epi::AFTER_DRAIN) { E.fused(acc, cur, wr, wc, fr, fq, lds, wid, lane); S.done(cur); }
#undef PG8_SA
#undef PG8_SB
#undef PG8_STAGE
#undef PG8_LDA
#undef PG8_LDB
#undef PG8_MMA
#undef PG8_WAIT_V
#undef PG8_WAIT_L
#undef PG8_BAR
#undef PG8_SCHED
}
}

#define LAS __attribute__((address_space(3)))
typedef unsigned short bf16_t;
typedef short bf16x8 __attribute__((ext_vector_type(8)));
typedef float f32x4 __attribute__((ext_vector_type(4)));
typedef float f32x16 __attribute__((ext_vector_type(16)));
typedef unsigned u32x4 __attribute__((ext_vector_type(4)));
typedef unsigned u32x2 __attribute__((ext_vector_type(2)));

constexpr int NB = 4, T = 8192, DM = 1024, M = NB * T, DEPTH = 4, PLE = 256, FF = 2816, ZW = 3584, INW = 3474;
constexpr int C_NQ = 0, C_CK = 384, C_CV = 512, C_SK = 640, C_SV = 768, C_WK = 896, C_WV = 1024, C_DQ = 1152, C_DK = 1408, C_DV = 1664,
              C_HQ = 1920, C_HF = 2304, C_HI = 2688, C_HG = 3072, C_NG = 3456;
constexpr float EPS = 1e-6f, LOG2E = 1.4426950408889634f;
enum { I_X = 0, I_P, I_RELB, I_LBLOG, I_F1N, I_F1G, I_F1U, I_F1D, I_MIXN, I_WIN, I_WOUT, I_NQN, I_NKN, I_CPOS, I_CW1, I_CW2,
       I_DQN, I_DKN, I_DLAM, I_DSUB, I_HON, I_F2N, I_F2G, I_F2U, I_F2D, I_PLN, I_PLG, I_PLP, I_PLPOST, N_IN };
constexpr size_t MiB = 1u << 20;
constexpr size_t WS_CTL = 0, WS_W = 1 * MiB, WS_PB = 53 * MiB, WS_XB = 69 * MiB, WS_R1 = 133 * MiB, WS_MIX = 357 * MiB, WS_VT = 421 * MiB,
                 WS_HS = 453 * MiB, WS_KC = 501 * MiB, WS_VCT = WS_KC + 512 * 1024, WS_SELM = 503 * MiB, WS_RSQ0 = 504 * MiB, WS_RSQ1 = 506 * MiB,
                 WS_RSQP = 508 * MiB, WS_HD = 510 * MiB, WS_XB1 = 511 * MiB, WS_OCB = 575 * MiB, WS_END = 599 * MiB;
constexpr size_t W_GU1 = 0, W_D1 = 11 * MiB, W_GU2 = W_D1 + 5 * MiB + 512 * 1024, W_D2 = W_GU2 + 11 * MiB, W_IN = 33 * MiB, W_OUT = 40 * MiB, W_PG = 42 * MiB,
                 W_PP = 44 * MiB, W_1T = W_PP + 512 * 1024, W_2T = W_1T + 2 * MiB, W_POSB = W_2T + 64 * 1024;
static_assert(W_D2 + 5 * MiB + 512 * 1024 == W_IN, "weight map");
constexpr int LDS_BYTES = 132 * 1024, LDS_MISC = 131072;

__device__ __forceinline__ float bf2f(unsigned short u) { return __uint_as_float(((unsigned)u) << 16); }
__device__ __forceinline__ float bflo(unsigned w) { return __uint_as_float(w << 16); }
__device__ __forceinline__ float bfhi(unsigned w) { return __uint_as_float(w & 0xffff0000u); }
typedef float f32x2_t __attribute__((ext_vector_type(2))); typedef __bf16 bf16x2_t __attribute__((ext_vector_type(2)));
__device__ __forceinline__ unsigned pk2(float lo, float hi) { f32x2_t v = {lo, hi}; bf16x2_t b = __builtin_convertvector(v, bf16x2_t); return __builtin_bit_cast(unsigned, b); }
__device__ __forceinline__ bf16_t f2bf(float f) { return (bf16_t)(pk2(f, 0.f) & 0xffffu); }
__device__ __forceinline__ float ex2(float x) { return __builtin_amdgcn_exp2f(x); }
__device__ __forceinline__ float sigmoidf_(float x) { return 1.0f / (1.0f + __expf(-x)); }
__device__ __forceinline__ int crow(int r, int hi) { return (r & 3) + 8 * (r >> 2) + 4 * hi; }
__device__ __forceinline__ f32x16 mfma32(bf16x8 a, bf16x8 b, f32x16 c) { return __builtin_amdgcn_mfma_f32_32x32x16_bf16(a, b, c, 0, 0, 0); }
__device__ __forceinline__ f32x4 mfma16(bf16x8 a, bf16x8 b, f32x4 c) { return __builtin_amdgcn_mfma_f32_16x16x32_bf16(a, b, c, 0, 0, 0); }
__device__ __forceinline__ bf16x8 as_bf16x8(u32x4 v) { return __builtin_bit_cast(bf16x8, v); }
#define LDSW() asm volatile("s_waitcnt lgkmcnt(0)" ::: "memory")
#define CFENCE() asm volatile("" ::: "memory")
#define GAS __attribute__((address_space(1)))
__device__ __forceinline__ const float* inp(int i) { asm volatile("" : "+s"(i)); const unsigned long long v = ((const unsigned long long __attribute__((address_space(4)))*)__builtin_amdgcn_kernarg_segment_ptr())[i]; return (const float*)(const GAS float*)v; }

__device__ __forceinline__ float row_rinv(const float* rsq, int row) {
    const f32x4* p = (const f32x4*)(rsq + (size_t)row * 16);
    const f32x4 a = p[0], b = p[1], c = p[2], d = p[3];
    const float s = ((a.x + a.y) + (a.z + a.w)) + ((b.x + b.y) + (b.z + b.w)) + ((c.x + c.y) + (c.z + c.w)) + ((d.x + d.y) + (d.z + d.w));
    return rsqrtf(s * (1.0f / 1024.0f) + EPS);
}
struct EpiSwiGLU {
    static constexpr bool PERM = true, AFTER_DRAIN = false;
    bf16_t* O; const float* rsq;
    __device__ __forceinline__ void operator()(const f32x4 (&acc)[2][2][4][2], const pg8::Unit& u, int wr, int wc, int fr, int fq) const {
#pragma unroll
        for (int ai = 0; ai < 2; ++ai)
#pragma unroll
            for (int m = 0; m < 4; ++m) {
                const int row = u.pm * 256 + ai * 128 + wr * 64 + m * 16 + fr;
                const float r = row_rinv(rsq, row);
                float o[8];
#pragma unroll
                for (int n = 0; n < 2; ++n)
#pragma unroll
                    for (int e = 0; e < 4; ++e) { const float g = acc[ai][0][m][n][e] * r, up = acc[ai][1][m][n][e] * r; o[n * 4 + e] = g * sigmoidf_(g) * up; }
                u32x4 w; w.x = pk2(o[0], o[1]); w.y = pk2(o[2], o[3]); w.z = pk2(o[4], o[5]); w.w = pk2(o[6], o[7]);
                *(u32x4*)(O + (size_t)row * FF + u.pn * 128 + wc * 32 + 8 * fq) = w;
                CFENCE();
            }
    }
};
struct EpiZ {
    static constexpr bool PERM = true, AFTER_DRAIN = false;
    bf16_t* Z; const float* rsq;
    __device__ __forceinline__ void operator()(const f32x4 (&acc)[2][2][4][2], const pg8::Unit& u, int wr, int wc, int fr, int fq) const {
#pragma unroll
        for (int ai = 0; ai < 2; ++ai)
#pragma unroll
            for (int m = 0; m < 4; ++m) {
                const int row = u.pm * 256 + ai * 128 + wr * 64 + m * 16 + fr;
                const float r = row_rinv(rsq, row);
#pragma unroll
                for (int bj = 0; bj < 2; ++bj) {
                    const f32x4 v0 = acc[ai][bj][m][0] * r, v1 = acc[ai][bj][m][1] * r;
                    u32x4 w; w.x = pk2(v0[0], v0[1]); w.y = pk2(v0[2], v0[3]); w.z = pk2(v1[0], v1[1]); w.w = pk2(v1[2], v1[3]);
                    *(u32x4*)(Z + (size_t)row * ZW + u.pn * 256 + bj * 128 + wc * 32 + 8 * fq) = w;
                }
                CFENCE();
            }
    }
};
template <int MODE> struct EpiRes {
    static constexpr bool PERM = false, AFTER_DRAIN = false;
    float* X; bf16_t* XB; float* rsq_out; float alpha; const float* rsq_in; const bf16_t* P; const float* rsqp; const float* post; bf16_t* Pout;
    __device__ __forceinline__ void operator()(const f32x4 (&acc)[2][2][4][2], const pg8::Unit& u, int wr, int wc, int fr, int fq) const {
#pragma unroll
        for (int ai = 0; ai < 2; ++ai)
#pragma unroll
            for (int m = 0; m < 4; ++m) {
                const int row = u.pm * 256 + ai * 128 + wr * 64 + m * 16 + fr;
                float r = 1.f, rp = 1.f;
                if (MODE == 1) { r = row_rinv(rsq_in, row); rp = row_rinv(rsqp, row); }
                float ss = 0.f;
#pragma unroll
                for (int bj = 0; bj < 2; ++bj)
#pragma unroll
                    for (int n = 0; n < 2; ++n) {
                        const int c0 = u.pn * 256 + bj * 128 + wc * 32 + 16 * n + 4 * fq;
                        const size_t off = (size_t)row * DM + c0;
                        const f32x4 a = acc[ai][bj][m][n];
                        if (MODE == 2) {
                            u32x2 w; w.x = pk2(a[0], a[1]); w.y = pk2(a[2], a[3]);
                            *(u32x2*)(Pout + off) = w;
                            ss += (a[0] * a[0] + a[1] * a[1]) + (a[2] * a[2] + a[3] * a[3]);
                        } else {
                            f32x4 xv = *(const f32x4*)(X + off);
                            if (MODE == 0) xv += a * alpha;
                            else {
                                const u32x2 pw = *(const u32x2*)(P + off); const f32x4 po = *(const f32x4*)(post + c0);
                                xv[0] += sigmoidf_(a[0] * r) * (bflo(pw.x) * rp * po[0]);
                                xv[1] += sigmoidf_(a[1] * r) * (bfhi(pw.x) * rp * po[1]);
                                xv[2] += sigmoidf_(a[2] * r) * (bflo(pw.y) * rp * po[2]);
                                xv[3] += sigmoidf_(a[3] * r) * (bfhi(pw.y) * rp * po[3]);
                            }
                            *(f32x4*)(X + off) = xv;
                            u32x2 w; w.x = pk2(xv[0], xv[1]); w.y = pk2(xv[2], xv[3]);
                            *(u32x2*)(XB + off) = w;
                            ss += (xv[0] * xv[0] + xv[1] * xv[1]) + (xv[2] * xv[2] + xv[3] * xv[3]);
                        }
                    }
                ss += __shfl_xor(ss, 16); ss += __shfl_xor(ss, 32);
                if (fq == 0) rsq_out[(size_t)row * 16 + u.pn * 4 + wc] = ss;
                CFENCE();
            }
    }
};

template <class Epi> __device__ __forceinline__ void run_gemm(LAS unsigned char* lds, const bf16_t* A, const bf16_t* Bt, int N, int K, const Epi& E) {
    pg8::Gemm g{A, Bt, M, N, K}; int bx = blockIdx.x; asm volatile("" : "+s"(bx)); asm volatile("" : "+s"(K)); asm volatile("" : "+s"(N)); pg8::StaticOrder S; S.init(M, N, (int)gridDim.x, bx);
    pg8::gemm_phase<Epi, pg8::StaticOrder, true, true>(lds, g, S, E);
    __syncthreads();
}

__device__ __forceinline__ int next_task(unsigned* ctr, LAS int* slot) {
    __syncthreads();
    if (TID() == 0) *slot = (int)atomicAdd(ctr, 1u);
    __syncthreads();
    return *slot;
}

__device__ __forceinline__ int colmap(int mode, int n) {
    if (mode == 1) return 256 * (n >> 7) + (n & 127);
    if (mode == 2) return 256 * (n >> 7) + 128 + (n & 127);
    if (mode == 3) return n < 1152 ? n : (n < 1170 ? 3456 + (n - 1152) : n - 18);
    return n;
}
__device__ __forceinline__ void conv_item(const float* W, int K, int N, bf16_t* WT, const float* gain, int mode, LAS float* scr, int item, int lane) {
    const int nblk = (N + 31) >> 5, kb = item / nblk, nb = item % nblk, k0 = 64 * kb, n0 = 32 * nb;
#pragma unroll 16
    for (int i = 0; i < 32; ++i) {
        const int kk = 2 * i + (lane >> 5), n = n0 + (lane & 31);
        float v = (n < N) ? W[(size_t)(k0 + kk) * N + n] : 0.f;
        if (gain) v *= gain[k0 + kk];
        scr[kk * 33 + (lane & 31)] = v;
    }
    LDSW();
    const int c = lane & 7;
#pragma unroll
    for (int j = 0; j < 4; ++j) {
        const int nl = (lane >> 3) + 8 * j, n = n0 + nl;
        const LAS float* s = scr + (8 * c) * 33 + nl;
        u32x4 o; o.x = pk2(s[0], s[33]); o.y = pk2(s[2 * 33], s[3 * 33]); o.z = pk2(s[4 * 33], s[5 * 33]); o.w = pk2(s[6 * 33], s[7 * 33]);
        if (n < N) *(u32x4*)(WT + (size_t)colmap(mode, n) * K + k0 + 8 * c) = o;
    }
    LDSW();
}

__device__ __forceinline__ void phase_convert(const float* const* in, unsigned char* ws, float* out, int L, LAS unsigned char* lds) {
    const int tid = TID(), lane = tid & 63, wave = tid >> 6;
    const int gw = blockIdx.x * 8 + wave, NGW = gridDim.x * 8;
    LAS float* scr = (LAS float*)(lds + wave * 8704);
    unsigned char* wb = ws + WS_W;
    const size_t ffo = (size_t)L * DM * FF;
    constexpr int IT_GU = (DM / 64) * (FF / 32), IT_D = (FF / 64) * (DM / 32), IT_IN = (DM / 64) * ((INW + 31) / 32), IT_SQ = (DM / 64) * (DM / 32),
                  IT_PP = (PLE / 64) * (DM / 32), IT_W1 = (2048 / 64) * (256 / 32), IT_W2 = (256 / 64) * (64 / 32);
    constexpr int total = 4 * IT_GU + 2 * IT_D + IT_IN + 2 * IT_SQ + IT_PP + 2 * IT_W1 + 2 * IT_W2;
    for (int it = gw; it < total; it += NGW) {
        const float* W = nullptr; int K = 0, N = 0; bf16_t* WT = nullptr; const float* gain = nullptr; int mode = 0, rr = -1, r = it;
#define JOB(Wp, Kk, Nn, WTp, gp, md, items) { if (rr < 0 && r < (items)) { W = (Wp); K = (Kk); N = (Nn); WT = (bf16_t*)(WTp); gain = (gp); mode = (md); rr = r; } r -= (items); }
        JOB(inp(I_F1G) + ffo, DM, FF, wb + W_GU1, inp(I_F1N) + L * DM, 1, IT_GU)
        JOB(inp(I_F1U) + ffo, DM, FF, wb + W_GU1, inp(I_F1N) + L * DM, 2, IT_GU)
        JOB(inp(I_F1D) + ffo, FF, DM, wb + W_D1, nullptr, 0, IT_D)
        JOB(inp(I_F2G) + ffo, DM, FF, wb + W_GU2, inp(I_F2N) + L * DM, 1, IT_GU)
        JOB(inp(I_F2U) + ffo, DM, FF, wb + W_GU2, inp(I_F2N) + L * DM, 2, IT_GU)
        JOB(inp(I_F2D) + ffo, FF, DM, wb + W_D2, nullptr, 0, IT_D)
        JOB(inp(I_WIN) + (size_t)L * DM * INW, DM, INW, wb + W_IN, inp(I_MIXN) + L * DM, 3, IT_IN)
        JOB(inp(I_WOUT) + (size_t)L * DM * DM, DM, DM, wb + W_OUT, nullptr, 0, IT_SQ)
        JOB(inp(I_PLG) + (size_t)L * DM * DM, DM, DM, wb + W_PG, inp(I_PLN) + L * DM, 0, IT_SQ)
        JOB(inp(I_PLP) + (size_t)L * PLE * DM, PLE, DM, wb + W_PP, nullptr, 0, IT_PP)
        JOB(inp(I_CW1) + (size_t)(L * 2 + 0) * 2048 * 256, 2048, 256, wb + W_1T, nullptr, 0, IT_W1)
        JOB(inp(I_CW1) + (size_t)(L * 2 + 1) * 2048 * 256, 2048, 256, wb + W_1T + 256 * 2048 * 2, nullptr, 0, IT_W1)
        JOB(inp(I_CW2) + (size_t)(L * 2 + 0) * 256 * 64, 256, 64, wb + W_2T, nullptr, 0, IT_W2)
        JOB(inp(I_CW2) + (size_t)(L * 2 + 1) * 256 * 64, 256, 64, wb + W_2T + 64 * 256 * 2, nullptr, 0, IT_W2)
#undef JOB
        conv_item(W, K, N, WT, gain, mode, scr, rr, lane);
    }
    {
        u32x4* z = (u32x4*)((bf16_t*)(wb + W_IN) + (size_t)INW * DM);
        const int n16 = (ZW - INW) * DM / 8;
        for (int i = blockIdx.x * 512 + tid; i < n16; i += gridDim.x * 512) z[i] = (u32x4){0u, 0u, 0u, 0u};
    }
    {
        const f32x4* src = (const f32x4*)(inp(I_P) + (size_t)L * M * PLE); u32x4* dst = (u32x4*)(ws + WS_PB);
        const int n8 = M * PLE / 8;
        for (int i = blockIdx.x * 512 + tid; i < n8; i += gridDim.x * 512) {
            const f32x4 a = src[2 * i], b = src[2 * i + 1];
            u32x4 w; w.x = pk2(a[0], a[1]); w.y = pk2(a[2], a[3]); w.z = pk2(b[0], b[1]); w.w = pk2(b[2], b[3]); dst[i] = w;
        }
    }
    if (gw < 64) {
        const int ty = gw >> 5, ng = (gw >> 3) & 3, ks = gw & 7, n = ng * 64 + lane;
        const float* w1 = inp(I_CW1) + (size_t)(L * 2 + ty) * 2048 * 256; const float* pos = inp(I_CPOS) + (size_t)(L * 2 + ty) * 2048;
        float acc = 0.f;
        for (int k = ks * 256; k < ks * 256 + 256; ++k) acc += pos[k] * w1[(size_t)k * 256 + n];
        ((float*)(wb + W_POSB))[(ty * 8 + ks) * 256 + n] = acc;
    }
    if (L == 0) {
        const float* x = inp(I_X); bf16_t* xb = (bf16_t*)(ws + WS_XB); float* rsq = (float*)(ws + WS_RSQ0);
        for (int m = gw; m < M; m += NGW) {
            const f32x4* xr = (const f32x4*)(x + (size_t)m * DM) + lane; f32x4* orow = (f32x4*)(out + (size_t)m * DM) + lane;
            u32x2* xbr = (u32x2*)(xb + (size_t)m * DM) + lane;
            float s = 0.f;
#pragma unroll
            for (int j = 0; j < 4; ++j) { const f32x4 v = xr[64 * j]; orow[64 * j] = v; u32x2 w; w.x = pk2(v[0], v[1]); w.y = pk2(v[2], v[3]); xbr[64 * j] = w; s += (v[0] * v[0] + v[1] * v[1]) + (v[2] * v[2] + v[3] * v[3]); }
#pragma unroll
            for (int o = 1; o < 64; o <<= 1) s += __shfl_xor(s, o);
            if (lane < 16) rsq[(size_t)m * 16 + lane] = (lane == 0) ? s : 0.f;
        }
    }
}

__device__ __forceinline__ void task_prep(const float* const* in, unsigned char* ws, int L, int tile, LAS unsigned char* lds) {
    const int tid = TID(), lane = tid & 63, wave = tid >> 6;
    bf16_t* z = (bf16_t*)(ws + WS_R1);
    const int row0 = tile * 64;
    for (int tt = wave; tt < 64; tt += 8) {
        bf16_t* zr = z + (size_t)(row0 + tt) * ZW;
#pragma unroll
        for (int pass = 0; pass < 3; ++pass) {
            const int seg = pass * 64 + lane;
            int col = 0, gs = 8; const float* gp = inp(I_NQN); float scale = 1.f;
            if (seg < 48) { col = C_NQ + 8 * seg; gp = inp(I_NQN) + L * 64 + ((8 * seg) & 63); scale = 0.125f * LOG2E; }
            else if (seg < 64) { col = C_SK + 8 * (seg - 48); gp = inp(I_NKN) + (L * 3 + 1) * 64 + ((8 * seg) & 63); }
            else if (seg < 80) { col = C_WK + 8 * (seg - 64); gp = inp(I_NKN) + (L * 3 + 2) * 64 + ((8 * seg) & 63); }
            else if (seg < 112) { col = C_DQ + 8 * (seg - 80); gp = inp(I_DQN) + L * 32 + ((8 * seg) & 31); gs = 4; scale = 0.17677669529663689f * LOG2E; }
            else { col = C_DK + 8 * (seg - 112); gp = inp(I_DKN) + L * 32 + ((8 * seg) & 31); gs = 4; }
            const bool act = seg < 144;
            u32x4 w = (u32x4){0u, 0u, 0u, 0u};
            if (act) w = *(const u32x4*)(zr + col);
            float v[8] = {bflo(w.x), bfhi(w.x), bflo(w.y), bfhi(w.y), bflo(w.z), bfhi(w.z), bflo(w.w), bfhi(w.w)};
            float ss = 0.f;
#pragma unroll
            for (int e = 0; e < 8; ++e) ss += v[e] * v[e];
            ss += __shfl_xor(ss, 1); ss += __shfl_xor(ss, 2);
            const float t4 = __shfl_xor(ss, 4); if (gs == 8) ss += t4;
            const float r = rsqrtf(ss / (float)(gs * 8) + EPS) * scale;
            if (act) {
                const f32x4 g0 = *(const f32x4*)gp, g1 = *(const f32x4*)(gp + 4);
                u32x4 o; o.x = pk2(v[0] * r * g0[0], v[1] * r * g0[1]); o.y = pk2(v[2] * r * g0[2], v[3] * r * g0[3]);
                o.z = pk2(v[4] * r * g1[0], v[5] * r * g1[1]); o.w = pk2(v[6] * r * g1[2], v[7] * r * g1[3]);
                *(u32x4*)(zr + col) = o;
            }
        }
    }
    LAS bf16_t* tl = (LAS bf16_t*)lds;
#pragma unroll
    for (int i = 0; i < 8; ++i) {
        const int id = i * 512 + tid, row = id >> 6, ch = id & 63;
        const int col = ch < 16 ? C_SV + 8 * ch : (ch < 32 ? C_WV + 8 * (ch - 16) : C_DV + 8 * (ch - 32));
        *(LAS u32x4*)(tl + row * 520 + 8 * ch) = *(const u32x4*)(z + (size_t)(row0 + row) * ZW + col);
    }
    __syncthreads();
    const int b = row0 / T, t0 = row0 % T;
    bf16_t* vt = (bf16_t*)(ws + WS_VT);
#pragma unroll
    for (int i = 0; i < 8; ++i) {
        const int orow = tid, tch = i;
        const LAS bf16_t* s = tl + (tch * 8) * 520 + orow;
        u32x4 o;
        o.x = (unsigned)s[0] | ((unsigned)s[520] << 16); o.y = (unsigned)s[2 * 520] | ((unsigned)s[3 * 520] << 16);
        o.z = (unsigned)s[4 * 520] | ((unsigned)s[5 * 520] << 16); o.w = (unsigned)s[6 * 520] | ((unsigned)s[7 * 520] << 16);
        *(u32x4*)(vt + ((size_t)(b * 8) * 64 + orow) * T + t0 + 8 * tch) = o;
    }
}

__device__ __forceinline__ float gelu_tanh(float x) {
    const float y = 0.7978845608028654f * (x + 0.044715f * x * x * x);
    const float th = 1.0f - 2.0f / (1.0f + __expf(2.0f * y));
    return 0.5f * x * (1.0f + th);
}
__device__ __forceinline__ void task_compress(const float* const* in, unsigned char* ws, int L, int task, LAS unsigned char* lds) {
    const int tid = TID(), lane = tid & 63, wave = tid >> 6;
    const int ty = task >> 8, b = (task >> 6) & 3, g = (task >> 5) & 1, i0 = (task & 31) * 16;
    const bf16_t* z = (const bf16_t*)(ws + WS_R1);
    LAS bf16_t* zt = (LAS bf16_t*)lds;
    LAS bf16_t* hid = (LAS bf16_t*)(lds + 39168);
    LAS float* ofp = (LAS float*)(lds + 39168 + 8448);
    const int ccol = (ty ? C_CV : C_CK) + 64 * g;
    for (int id = tid; id < 272 * 8; id += 512) {
        const int row = id >> 3, ch = id & 7, tok = 16 * i0 + row;
        u32x4 v = (u32x4){0u, 0u, 0u, 0u};
        if (tok < T) v = *(const u32x4*)(z + (size_t)(b * T + tok) * ZW + ccol + 8 * ch);
        *(LAS u32x4*)(zt + row * 72 + 8 * ch) = v;
    }
    __syncthreads();
    const bf16_t* w1t = (const bf16_t*)(ws + WS_W + W_1T) + (size_t)ty * 256 * 2048;
    const bf16_t* w2t = (const bf16_t*)(ws + WS_W + W_2T) + (size_t)ty * 64 * 256;
    const float* posb = (const float*)(ws + WS_W + W_POSB) + ty * 8 * 256;
    const int r16 = lane & 15, kq = lane >> 4;
    f32x4 acc[2] = {(f32x4){0.f, 0.f, 0.f, 0.f}, (f32x4){0.f, 0.f, 0.f, 0.f}};
    const bf16_t* b0p = w1t + (size_t)(16 * (2 * wave) + r16) * 2048 + 8 * kq;
    const bf16_t* b1p = b0p + 16 * 2048;
#pragma unroll 4
    for (int kc = 0; kc < 64; ++kc) {
        const bf16x8 a = *(const LAS bf16x8*)(zt + (16 * r16 + (kc >> 1)) * 72 + (kc & 1) * 32 + 8 * kq);
        const bf16x8 w0 = *(const bf16x8*)(b0p + 32 * kc), w1 = *(const bf16x8*)(b1p + 32 * kc);
        acc[0] = mfma16(a, w0, acc[0]); acc[1] = mfma16(a, w1, acc[1]);
    }
#pragma unroll
    for (int j = 0; j < 2; ++j) {
        const int n = 16 * (2 * wave + j) + r16;
        float pbias = 0.f;
#pragma unroll
        for (int ks = 0; ks < 8; ++ks) pbias += posb[ks * 256 + n];
#pragma unroll
        for (int i = 0; i < 4; ++i) hid[(4 * kq + i) * 264 + n] = f2bf(gelu_tanh(acc[j][i] + pbias));
    }
    __syncthreads();
    if (wave < 4) {
        f32x4 a2 = (f32x4){0.f, 0.f, 0.f, 0.f};
        const bf16_t* bp = w2t + (size_t)(16 * wave + r16) * 256 + 8 * kq;
#pragma unroll
        for (int kc = 0; kc < 8; ++kc) {
            const bf16x8 a = *(const LAS bf16x8*)(hid + r16 * 264 + 32 * kc + 8 * kq);
            const bf16x8 w = *(const bf16x8*)(bp + 32 * kc);
            a2 = mfma16(a, w, a2);
        }
#pragma unroll
        for (int i = 0; i < 4; ++i) ofp[(4 * kq + i) * 64 + 16 * wave + r16] = a2[i];
    }
    __syncthreads();
    if (tid < 256) {
        const int row = tid >> 4, c4 = (tid & 15) * 4, i = i0 + row;
        f32x4 o = *(const LAS f32x4*)(ofp + row * 64 + c4);
        float ss = (o[0] * o[0] + o[1] * o[1]) + (o[2] * o[2] + o[3] * o[3]);
        ss += __shfl_xor(ss, 1); ss += __shfl_xor(ss, 2); ss += __shfl_xor(ss, 4); ss += __shfl_xor(ss, 8);
        if (ty == 0) {
            const float r = rsqrtf(ss * (1.0f / 64.0f) + EPS);
            const f32x4 gn = *(const f32x4*)(inp(I_NKN) + (L * 3 + 0) * 64 + c4);
            o = o * r * gn;
        }
        if (i >= 511) o = (f32x4){0.f, 0.f, 0.f, 0.f};
        if (ty == 0) {
            u32x2 w; w.x = pk2(o[0], o[1]); w.y = pk2(o[2], o[3]);
            *(u32x2*)((bf16_t*)(ws + WS_KC) + ((size_t)(b * 2 + g) * 512 + i) * 64 + c4) = w;
        } else {
            bf16_t* vct = (bf16_t*)(ws + WS_VCT) + (size_t)(b * 2 + g) * 64 * 512;
#pragma unroll
            for (int e = 0; e < 4; ++e) vct[(size_t)(c4 + e) * 512 + i] = f2bf(o[e]);
        }
    }
}

__device__ __forceinline__ float hgrn_lb(const float* logits, int L, int j) {
    if (L == 0) return 0.f;
    const float a0 = logits[j], a1 = logits[384 + j], a2 = logits[768 + j], a3 = logits[1152 + j];
    const float mx = fmaxf(fmaxf(a0, a1), fmaxf(a2, a3));
    const float e0 = __expf(a0 - mx), e1 = __expf(a1 - mx), e2 = __expf(a2 - mx), e3 = __expf(a3 - mx);
    const float inv = 1.0f / (e0 + e1 + e2 + e3);
    float s = e1; if (L >= 2) s += e2; if (L >= 3) s += e3;
    return s * inv;
}
__device__ __forceinline__ void task_hgrn_local(const float* const* in, unsigned char* ws, int L, int task, LAS unsigned char* lds) {
    const int tid = TID(), lane = tid & 63, wave = tid >> 6;
    if (wave < 6) {
        const int chunk = task * 6 + wave;
        const int bh = chunk >> 7, c = chunk & 127, b = bh / 6, h = bh % 6;
        const bf16_t* z = (const bf16_t*)(ws + WS_R1) + (size_t)(b * T + c * 64) * ZW;
        LAS bf16_t* klT = (LAS bf16_t*)(lds + wave * 18432);
        LAS bf16_t* vT = klT + 64 * 72;
        const float lb = hgrn_lb(inp(I_LBLOG), L, h * 64 + lane);
        LAS bf16_t* rawf = klT;
        (void)rawf;
        u32x4 rf[8], ri[8];
#pragma unroll
        for (int i = 0; i < 8; ++i) {
            const int row = (lane >> 3) + 8 * i, ch = lane & 7;
            rf[i] = *(const u32x4*)(z + (size_t)row * ZW + C_HF + 64 * h + 8 * ch);
            ri[i] = *(const u32x4*)(z + (size_t)row * ZW + C_HI + 64 * h + 8 * ch);
        }
#pragma unroll
        for (int i = 0; i < 8; ++i) {
            const int row = (lane >> 3) + 8 * i, ch = lane & 7;
            *(LAS u32x4*)(klT + row * 72 + 8 * ch) = rf[i];
            *(LAS u32x4*)(vT + row * 72 + 8 * ch) = ri[i];
        }
        LDSW();
        float suffix = 0.f;
        bf16_t colf[64], colv[64];
#pragma unroll
        for (int s2 = 0; s2 < 64; ++s2) { colf[s2] = klT[s2 * 72 + lane]; colv[s2] = vT[s2 * 72 + lane]; }
        LDSW();
#pragma unroll
        for (int s = 63; s >= 0; --s) {
            const float fr = bf2f(colf[s]);
            const float sg = sigmoidf_(fr);
            const float f = lb + (1.0f - lb) * sg;
            const float ig = (1.0f - lb) * (1.0f - sg);
            klT[lane * 72 + s] = f2bf(ig * __expf(suffix));
            vT[lane * 72 + s] = colv[s];
            suffix += __logf(f);
        }
        ((float*)(ws + WS_HD))[(size_t)chunk * 64 + lane] = __expf(suffix);
        LDSW();
        const int r32 = lane & 31, hi = lane >> 5;
        float* hs = (float*)(ws + WS_HS) + (size_t)chunk * 4096;
#pragma unroll
        for (int kb = 0; kb < 2; ++kb)
#pragma unroll
            for (int vb = 0; vb < 2; ++vb) {
                f32x16 cacc = {};
#pragma unroll
                for (int cc = 0; cc < 4; ++cc) {
                    const bf16x8 a = *(const LAS bf16x8*)(klT + (32 * kb + r32) * 72 + 16 * cc + 8 * hi);
                    const bf16x8 bb = *(const LAS bf16x8*)(vT + (32 * vb + r32) * 72 + 16 * cc + 8 * hi);
                    cacc = mfma32(a, bb, cacc);
                }
#pragma unroll
                for (int r = 0; r < 16; ++r) hs[(32 * kb + crow(r, hi)) * 64 + 32 * vb + r32] = cacc[r];
            }
    }
}
__device__ __forceinline__ void task_hgrn_scan(unsigned char* ws, int task) {
    const int tid = TID();
    const int bh = task >> 3, k = (task & 7) * 8 + (tid >> 6), v = tid & 63;
    float* hs = (float*)(ws + WS_HS) + (size_t)bh * 128 * 4096 + k * 64 + v;
    const float* hd = (const float*)(ws + WS_HD) + (size_t)bh * 128 * 64 + k;
    float S = 0.f;
#pragma unroll 16
    for (int c = 0; c < 128; ++c) {
        const float a = hs[(size_t)c * 4096], d = hd[c * 64];
        hs[(size_t)c * 4096] = S;
        S = d * S + a;
    }
}
__device__ __forceinline__ void task_hgrn_out(const float* const* in, unsigned char* ws, int L, int task, LAS unsigned char* lds) {
    const int tid = TID(), lane = tid & 63, wave = tid >> 6;
    if (wave < 3) {
        const int chunk = task * 3 + wave;
        const int bh = chunk >> 7, c = chunk & 127, b = bh / 6, h = bh % 6;
        const size_t row0 = (size_t)(b * T + c * 64);
        const bf16_t* z = (const bf16_t*)(ws + WS_R1) + row0 * ZW;
        LAS bf16_t* ke = (LAS bf16_t*)(lds + wave * 36864);
        LAS bf16_t* qe = ke + 64 * 72;
        LAS bf16_t* vT = qe + 64 * 72;
        LAS bf16_t* sT = vT + 64 * 72;
        const float lb = hgrn_lb(inp(I_LBLOG), L, h * 64 + lane);
        {
            u32x4 rq[8], rf[8], ri[8];
#pragma unroll
            for (int i = 0; i < 8; ++i) {
                const int row = (lane >> 3) + 8 * i, ch = lane & 7;
                rq[i] = *(const u32x4*)(z + (size_t)row * ZW + C_HQ + 64 * h + 8 * ch);
                rf[i] = *(const u32x4*)(z + (size_t)row * ZW + C_HF + 64 * h + 8 * ch);
                ri[i] = *(const u32x4*)(z + (size_t)row * ZW + C_HI + 64 * h + 8 * ch);
            }
#pragma unroll
            for (int i = 0; i < 8; ++i) {
                const int row = (lane >> 3) + 8 * i, ch = lane & 7;
                *(LAS u32x4*)(qe + row * 72 + 8 * ch) = rq[i];
                *(LAS u32x4*)(ke + row * 72 + 8 * ch) = rf[i];
                *(LAS u32x4*)(sT + row * 72 + 8 * ch) = ri[i];
            }
        }
        LDSW();
        float ref = 0.f;
#pragma unroll 8
        for (int s = 0; s < 32; ++s) {
            const float fr = bf2f(ke[s * 72 + lane]);
            ref += __logf(lb + (1.0f - lb) * sigmoidf_(fr));
        }
        float cum = 0.f;
#pragma unroll 8
        for (int s = 0; s < 64; ++s) {
            const float fr = bf2f(ke[s * 72 + lane]);
            const float qv = bf2f(qe[s * 72 + lane]);
            const bf16_t vraw = sT[s * 72 + lane];
            const float sg = sigmoidf_(fr);
            const float f = lb + (1.0f - lb) * sg;
            const float ig = (1.0f - lb) * (1.0f - sg);
            cum += __logf(f);
            qe[s * 72 + lane] = f2bf(qv * sigmoidf_(qv) * __expf(cum - ref));
            ke[s * 72 + lane] = f2bf(ig * __expf(ref - cum));
            vT[lane * 72 + s] = vraw;
        }
        LDSW();
        const float* hs = (const float*)(ws + WS_HS) + (size_t)chunk * 4096;
        const float eref = __expf(ref);
        {
            f32x4 hv[16];
#pragma unroll
            for (int i = 0; i < 16; ++i) hv[i] = *(const f32x4*)(hs + ((lane >> 4) + 4 * i) * 64 + (lane & 15) * 4);
#pragma unroll
            for (int i = 0; i < 16; ++i) {
                const int k = (lane >> 4) + 4 * i, v4 = (lane & 15) * 4;
                const float er = __shfl(eref, k);
                sT[(v4 + 0) * 72 + k] = f2bf(hv[i][0] * er); sT[(v4 + 1) * 72 + k] = f2bf(hv[i][1] * er);
                sT[(v4 + 2) * 72 + k] = f2bf(hv[i][2] * er); sT[(v4 + 3) * 72 + k] = f2bf(hv[i][3] * er);
            }
        }
        LDSW();
        const int r32 = lane & 31, hi = lane >> 5;
        f32x16 O[2][2] = {};
#pragma unroll
        for (int tb = 0; tb < 2; ++tb) {
            bf16x8 qf[4];
#pragma unroll
            for (int cc = 0; cc < 4; ++cc) qf[cc] = *(const LAS bf16x8*)(qe + (32 * tb + r32) * 72 + 16 * cc + 8 * hi);
#pragma unroll
            for (int vb = 0; vb < 2; ++vb)
#pragma unroll
                for (int cc = 0; cc < 4; ++cc) {
                    const bf16x8 a = *(const LAS bf16x8*)(sT + (32 * vb + r32) * 72 + 16 * cc + 8 * hi);
                    O[vb][tb] = mfma32(a, qf[cc], O[vb][tb]);
                }
#pragma unroll
            for (int sb = 0; sb <= tb; ++sb) {
                f32x16 sc = {};
#pragma unroll
                for (int cc = 0; cc < 4; ++cc) {
                    const bf16x8 a = *(const LAS bf16x8*)(ke + (32 * sb + r32) * 72 + 16 * cc + 8 * hi);
                    sc = mfma32(a, qf[cc], sc);
                }
                unsigned P[8];
#pragma unroll
                for (int j = 0; j < 8; ++j) {
                    float p0 = sc[2 * j], p1 = sc[2 * j + 1];
                    if (sb == tb) { if (crow(2 * j, hi) > r32) p0 = 0.f; if (crow(2 * j + 1, hi) > r32) p1 = 0.f; }
                    P[j] = pk2(p0, p1);
                }
#pragma unroll
                for (int vb = 0; vb < 2; ++vb)
#pragma unroll
                    for (int c2 = 0; c2 < 2; ++c2) {
                        const u32x2 a0 = *(const LAS u32x2*)(vT + (32 * vb + r32) * 72 + 32 * sb + 16 * c2 + 4 * hi);
                        const u32x2 a1 = *(const LAS u32x2*)(vT + (32 * vb + r32) * 72 + 32 * sb + 16 * c2 + 8 + 4 * hi);
                        const bf16x8 vf = as_bf16x8((u32x4){a0.x, a0.y, a1.x, a1.y});
                        const bf16x8 pf = as_bf16x8((u32x4){P[4 * c2], P[4 * c2 + 1], P[4 * c2 + 2], P[4 * c2 + 3]});
                        O[vb][tb] = mfma32(vf, pf, O[vb][tb]);
                    }
            }
        }
        LDSW();
        const float* on = inp(I_HON) + L * 64;
#pragma unroll
        for (int tb = 0; tb < 2; ++tb) {
            float ss = 0.f;
#pragma unroll
            for (int vb = 0; vb < 2; ++vb)
#pragma unroll
                for (int r = 0; r < 16; ++r) ss += O[vb][tb][r] * O[vb][tb][r];
            ss += __shfl_xor(ss, 32);
            const float rn = rsqrtf(ss * (1.0f / 64.0f) + EPS);
#pragma unroll
            for (int vb = 0; vb < 2; ++vb)
#pragma unroll
                for (int r = 0; r < 16; ++r) { const int v = 32 * vb + crow(r, hi); ke[(32 * tb + r32) * 72 + v] = f2bf(O[vb][tb][r] * rn * on[v]); }
        }
        LDSW();
        bf16_t* mixed = (bf16_t*)(ws + WS_MIX) + row0 * DM + 640 + 64 * h;
#pragma unroll
        for (int i = 0; i < 8; ++i) {
            const int t = i * 8 + (lane >> 3), ch = lane & 7;
            const u32x4 ov = *(const LAS u32x4*)(ke + t * 72 + 8 * ch);
            const u32x4 gv = *(const u32x4*)(z + (size_t)t * ZW + C_HG + 64 * h + 8 * ch);
            u32x4 w;
            { const float g0 = bflo(gv.x), g1 = bfhi(gv.x); w.x = pk2(bflo(ov.x) * g0 * sigmoidf_(g0), bfhi(ov.x) * g1 * sigmoidf_(g1)); }
            { const float g0 = bflo(gv.y), g1 = bfhi(gv.y); w.y = pk2(bflo(ov.y) * g0 * sigmoidf_(g0), bfhi(ov.y) * g1 * sigmoidf_(g1)); }
            { const float g0 = bflo(gv.z), g1 = bfhi(gv.z); w.z = pk2(bflo(ov.z) * g0 * sigmoidf_(g0), bfhi(ov.z) * g1 * sigmoidf_(g1)); }
            { const float g0 = bflo(gv.w), g1 = bfhi(gv.w); w.w = pk2(bflo(ov.w) * g0 * sigmoidf_(g0), bfhi(ov.w) * g1 * sigmoidf_(g1)); }
            *(u32x4*)(mixed + (size_t)t * DM + 8 * ch) = w;
        }
    }
}

constexpr int ATT_K = 0, ATT_V = 18432, ATT_LUT = 35840, ATT_STAGE = 36864;
__device__ __forceinline__ void build_lut(LAS float* lut, const float* rel_bias, int head) {
    const int d = TID();
    if (d <= 128) {
        int bk = d;
        if (d >= 16) { const int far = 16 + (int)(__logf((float)d * (1.0f / 16.0f)) / 2.0794415416798357f * 16.0f); bk = far < 31 ? far : 31; }
        lut[d] = rel_bias[bk * 10 + head] * LOG2E;
    }
}
template <int NMAP, bool HAS_SEL>
__device__ __forceinline__ void attn_pass(LAS unsigned char* lds, const bf16_t* Kth, size_t kts, const bf16_t* Vth, int m_lo, int m_hi,
                                          const bf16x8 (&qr)[4], int tq, int qw0, int win, const LAS float* lut, u32x4 selw,
                                          f32x16 (&O)[NMAP][2], float (&l)[NMAP]) {
    const int tid = TID(), lane = tid & 63, r32 = lane & 31, hi = lane >> 5;
    const float c31 = lut[128];
    u32x4 kreg = *(const u32x4*)(Kth + (size_t)m_lo * kts), vreg = *(const u32x4*)(Vth + (size_t)m_lo * 64);
    int buf = 0;
    for (int m = m_lo; m <= m_hi; ++m) {
        *(LAS u32x4*)(lds + ATT_K + buf * 9216 + (tid >> 3) * 144 + (tid & 7) * 16) = kreg;
        { LAS u32x2* vp = (LAS u32x2*)(lds + ATT_V + buf * 8704 + (tid >> 3) * 136 + (tid & 7) * 16); vp[0] = (u32x2){vreg.x, vreg.y}; vp[1] = (u32x2){vreg.z, vreg.w}; }
        __syncthreads();
        if (m < m_hi) { kreg = *(const u32x4*)(Kth + (size_t)(m + 1) * kts); vreg = *(const u32x4*)(Vth + (size_t)(m + 1) * 64); }
        const int k0 = 64 * m, dmin = qw0 - (k0 + 63), dmax = qw0 + 31 - k0;
        bool sel = true;
        if (HAS_SEL) { const unsigned w = m < 32 ? selw.x : (m < 64 ? selw.y : (m < 96 ? selw.z : selw.w)); sel = (w >> (m & 31)) & 1u; }
        bool active = dmax >= 0 && dmin < win;
        if (HAS_SEL) active = active && (__any(sel) != 0);
        if (active) {
            const bool fast = dmin >= 128 && dmax < win;
            const LAS unsigned char* Kb = lds + ATT_K + buf * 9216;
            const LAS unsigned char* Vb = lds + ATT_V + buf * 8704;
            unsigned P[NMAP][2][8];
#pragma unroll
            for (int kh2 = 0; kh2 < 2; ++kh2) {
                f32x16 S[NMAP];
#pragma unroll
                for (int mp = 0; mp < NMAP; ++mp) { const float ini = fast ? c31 : 0.f;
#pragma unroll
                    for (int r = 0; r < 16; ++r) S[mp][r] = ini; }
#pragma unroll
                for (int c = 0; c < 4; ++c) {
                    const bf16x8 kf = *(const LAS bf16x8*)(Kb + (32 * kh2 + r32) * 144 + (16 * c + 8 * hi) * 2);
                    const int mp = (NMAP == 2) ? (c >> 1) : 0;
                    S[mp] = mfma32(kf, qr[c], S[mp]);
                }
#pragma unroll
                for (int mp = 0; mp < NMAP; ++mp) {
                    float p[16];
                    if (fast) {
#pragma unroll
                        for (int r = 0; r < 16; ++r) { const float e = ex2(S[mp][r]); p[r] = sel ? e : 0.f; }
                    } else {
#pragma unroll
                        for (int r = 0; r < 16; ++r) {
                            const int d = tq - (k0 + 32 * kh2 + crow(r, hi));
                            const bool valid = sel && d >= 0 && d < win;
                            const int dc = d < 0 ? 0 : (d > 128 ? 128 : d);
                            const float e = ex2(S[mp][r] + lut[dc]);
                            p[r] = valid ? e : 0.f;
                        }
                    }
                    float s = 0.f;
#pragma unroll
                    for (int r = 0; r < 16; ++r) s += p[r];
                    l[mp] += s;
#pragma unroll
                    for (int j = 0; j < 8; ++j) P[mp][kh2][j] = pk2(p[2 * j], p[2 * j + 1]);
                }
            }
#pragma unroll
            for (int db = 0; db < 2; ++db)
#pragma unroll
                for (int cc = 0; cc < 4; ++cc) {
                    const u32x2 a0 = *(const LAS u32x2*)(Vb + (32 * db + r32) * 136 + (16 * cc + 4 * hi) * 2);
                    const u32x2 a1 = *(const LAS u32x2*)(Vb + (32 * db + r32) * 136 + (16 * cc + 8 + 4 * hi) * 2);
                    const bf16x8 vf = as_bf16x8((u32x4){a0.x, a0.y, a1.x, a1.y});
#pragma unroll
                    for (int mp = 0; mp < NMAP; ++mp) {
                        const bf16x8 pf = as_bf16x8((u32x4){P[mp][cc >> 1][4 * (cc & 1)], P[mp][cc >> 1][4 * (cc & 1) + 1], P[mp][cc >> 1][4 * (cc & 1) + 2], P[mp][cc >> 1][4 * (cc & 1) + 3]});
                        O[mp][db] = mfma32(vf, pf, O[mp][db]);
                    }
                }
        }
        buf ^= 1;
    }
    __syncthreads();
}
template <bool ADD>
__device__ __forceinline__ void store_ot(LAS unsigned char* stage, const float (&val)[2][16], bf16_t* dst, int ld, const bf16_t* addsrc = nullptr, int ldadd = 0) {
    const int lane = TID() & 63, r32 = lane & 31, hi = lane >> 5;
    LAS bf16_t* st = (LAS bf16_t*)stage;
#pragma unroll
    for (int db = 0; db < 2; ++db)
#pragma unroll
        for (int r = 0; r < 16; ++r) st[r32 * 72 + 32 * db + crow(r, hi)] = f2bf(val[db][r]);
    LDSW();
#pragma unroll
    for (int i = 0; i < 4; ++i) {
        const int row = i * 8 + (lane >> 3), ch = lane & 7;
        u32x4 v = *(const LAS u32x4*)(st + row * 72 + 8 * ch);
        bf16_t* gp = dst + (size_t)row * ld + 8 * ch;
        if (ADD) {
            const u32x4 o = *(const u32x4*)(addsrc + (size_t)row * ldadd + 8 * ch);
            v.x = pk2(bflo(v.x) + bflo(o.x), bfhi(v.x) + bfhi(o.x)); v.y = pk2(bflo(v.y) + bflo(o.y), bfhi(v.y) + bfhi(o.y));
            v.z = pk2(bflo(v.z) + bflo(o.z), bfhi(v.z) + bfhi(o.z)); v.w = pk2(bflo(v.w) + bflo(o.w), bfhi(v.w) + bfhi(o.w));
        }
        *(u32x4*)gp = v;
    }
    LDSW();
}

__device__ __forceinline__ void task_diff(const float* const* in, unsigned char* ws, int L, int task, LAS unsigned char* lds) {
    const int tid = TID(), lane = tid & 63, wave = tid >> 6, r32 = lane & 31, hi = lane >> 5;
    const int qb = 31 - (task >> 4), b = (task >> 2) & 3, hd = task & 3;
    const bf16_t* z = (const bf16_t*)(ws + WS_R1);
    LAS float* lut = (LAS float*)(lds + ATT_LUT);
    build_lut(lut, inp(I_RELB), 6 + hd);
    __syncthreads();
    const int q0 = 256 * qb, qw0 = q0 + 32 * wave, tq = qw0 + r32;
    bf16x8 qr[4];
#pragma unroll
    for (int c = 0; c < 4; ++c) qr[c] = *(const bf16x8*)(z + (size_t)(b * T + tq) * ZW + C_DQ + 64 * hd + 16 * c + 8 * hi);
    const bf16_t* Kth = z + (size_t)(b * T + (tid >> 3)) * ZW + C_DK + 64 * hd + (tid & 7) * 8;
    const bf16_t* Vth = (const bf16_t*)(ws + WS_VT) + ((size_t)(b * 8 + 4 + hd) * 64 + (tid >> 3)) * T + (tid & 7) * 8;
    f32x16 O[2][2] = {}; float l[2] = {0.f, 0.f};
    attn_pass<2, false>(lds, Kth, (size_t)64 * ZW, Vth, 0, 4 * qb + 3, qr, tq, qw0, 1 << 30, lut, (u32x4){0u, 0u, 0u, 0u}, O, l);
    const float* lp = inp(I_DLAM) + L * 128;
    float s01 = 0.f, s23 = 0.f;
#pragma unroll
    for (int i = 0; i < 32; ++i) { s01 += lp[i] * lp[32 + i]; s23 += lp[64 + i] * lp[96 + i]; }
    const float lam_init = 0.8f - 0.6f * __expf(-0.3f * (float)L);
    const float lam = __expf(s01) - __expf(s23) + lam_init;
    const float l0 = l[0] + __shfl_xor(l[0], 32), l1 = l[1] + __shfl_xor(l[1], 32);
    const float i0 = 1.0f / l0, i1 = lam / l1;
    float val[2][16]; float ss = 0.f;
#pragma unroll
    for (int db = 0; db < 2; ++db)
#pragma unroll
        for (int r = 0; r < 16; ++r) { const float o = O[0][db][r] * i0 - O[1][db][r] * i1; val[db][r] = o; ss += o * o; }
    ss += __shfl_xor(ss, 32);
    const float rn = rsqrtf(ss * (1.0f / 64.0f) + EPS) * (1.0f - lam_init);
    const float* sub = inp(I_DSUB) + L * 64;
#pragma unroll
    for (int db = 0; db < 2; ++db)
#pragma unroll
        for (int r = 0; r < 16; ++r) val[db][r] *= rn * sub[32 * db + crow(r, hi)];
    store_ot<false>(lds + ATT_STAGE + wave * 4608, val, (bf16_t*)(ws + WS_MIX) + (size_t)(b * T + qw0) * DM + 384 + 64 * hd, DM);
}

__device__ __forceinline__ void task_nsa_sw(const float* const* in, unsigned char* ws, int L, int task, LAS unsigned char* lds) {
    const int tid = TID(), lane = tid & 63, wave = tid >> 6, r32 = lane & 31, hi = lane >> 5;
    const int qb = 31 - task / 24, rem = task % 24, b = rem / 6, h = rem % 6, g = h / 3;
    const bf16_t* z = (const bf16_t*)(ws + WS_R1);
    LAS float* lut = (LAS float*)(lds + ATT_LUT);
    build_lut(lut, inp(I_RELB), h);
    __syncthreads();
    const int q0 = 256 * qb, qw0 = q0 + 32 * wave, tq = qw0 + r32;
    const bf16_t* zq = z + (size_t)(b * T + tq) * ZW;
    bf16x8 qr[4];
#pragma unroll
    for (int c = 0; c < 4; ++c) qr[c] = *(const bf16x8*)(zq + C_NQ + 64 * h + 16 * c + 8 * hi);
    const u32x4 selw = *(const u32x4*)((const unsigned*)(ws + WS_SELM) + ((size_t)(b * 2 + g) * T + tq) * 4);
    const float g1 = sigmoidf_(bf2f(zq[C_NG + 3 * h + 1])), g2 = sigmoidf_(bf2f(zq[C_NG + 3 * h + 2]));
    float val[2][16];
    {
        const bf16_t* Kth = z + (size_t)(b * T + (tid >> 3)) * ZW + C_SK + 64 * g + (tid & 7) * 8;
        const bf16_t* Vth = (const bf16_t*)(ws + WS_VT) + ((size_t)(b * 8 + g) * 64 + (tid >> 3)) * T + (tid & 7) * 8;
        f32x16 O[1][2] = {}; float l[1] = {0.f};
        attn_pass<1, true>(lds, Kth, (size_t)64 * ZW, Vth, 0, 4 * qb + 3, qr, tq, qw0, 1 << 30, lut, selw, O, l);
        const float lt = l[0] + __shfl_xor(l[0], 32), sc = g1 / lt;
#pragma unroll
        for (int db = 0; db < 2; ++db)
#pragma unroll
            for (int r = 0; r < 16; ++r) val[db][r] = O[0][db][r] * sc;
    }
    {
        const bf16_t* Kth = z + (size_t)(b * T + (tid >> 3)) * ZW + C_WK + 64 * g + (tid & 7) * 8;
        const bf16_t* Vth = (const bf16_t*)(ws + WS_VT) + ((size_t)(b * 8 + 2 + g) * 64 + (tid >> 3)) * T + (tid & 7) * 8;
        f32x16 O[1][2] = {}; float l[1] = {0.f};
        const int m_lo = q0 >= 512 ? (q0 >> 6) - 8 : 0;
        attn_pass<1, false>(lds, Kth, (size_t)64 * ZW, Vth, m_lo, 4 * qb + 3, qr, tq, qw0, 512, lut, (u32x4){0u, 0u, 0u, 0u}, O, l);
        const float lt = l[0] + __shfl_xor(l[0], 32), sc = g2 / lt;
#pragma unroll
        for (int db = 0; db < 2; ++db)
#pragma unroll
            for (int r = 0; r < 16; ++r) val[db][r] += O[0][db][r] * sc;
    }
    store_ot<true>(lds + ATT_STAGE + wave * 4608, val, (bf16_t*)(ws + WS_MIX) + (size_t)(b * T + qw0) * DM + 64 * h, DM, (const bf16_t*)(ws + WS_OCB) + (size_t)(b * T + qw0) * 384 + 64 * h, 384);
}

constexpr int NC_IMP = 18432, NC_IMPW = 129, NC_LINV = NC_IMP + 3 * 64 * NC_IMPW * 4;
__device__ __forceinline__ void task_nsa_c(const float* const* in, unsigned char* ws, int L, int task, LAS unsigned char* lds) {
    const int tid = TID(), lane = tid & 63, wave = tid >> 6, r32 = lane & 31, hi = lane >> 5;
    const int cur = 127 - (task >> 3), b = (task >> 1) & 3, g = task & 1;
    const bf16_t* z = (const bf16_t*)(ws + WS_R1);
    LAS float* imp = (LAS float*)(lds + NC_IMP);
    LAS float* linv = (LAS float*)(lds + NC_LINV);
    const int q0 = 64 * cur;
    const int rh = wave >> 1, half = wave & 1, h = 3 * g + (rh < 3 ? rh : 0);
    const int ql = 32 * half + r32, tq = q0 + ql;
    const bf16_t* zq = z + (size_t)(b * T + tq) * ZW;
    bf16x8 qr[4];
#pragma unroll
    for (int c = 0; c < 4; ++c) qr[c] = *(const bf16x8*)(zq + C_NQ + 64 * h + 16 * c + 8 * hi);
    const bf16_t* Kth = (const bf16_t*)(ws + WS_KC) + ((size_t)(b * 2 + g) * 512 + (tid >> 3)) * 64 + (tid & 7) * 8;
    const bf16_t* Vth = (const bf16_t*)(ws + WS_VCT) + ((size_t)(b * 2 + g) * 64 + (tid >> 3)) * 512 + (tid & 7) * 8;
    const int ntiles = ((4 * cur + 2) >> 6) + 1;
    f32x16 O[2] = {}; float l = 0.f, carry = 0.f;
    for (int m = 0; m < ntiles; ++m) {
        __syncthreads();
        *(LAS u32x4*)(lds + (tid >> 3) * 144 + (tid & 7) * 16) = *(const u32x4*)(Kth + (size_t)m * 64 * 64);
        { const u32x4 v = *(const u32x4*)(Vth + (size_t)m * 64); LAS u32x2* vp = (LAS u32x2*)(lds + 9216 + (tid >> 3) * 136 + (tid & 7) * 16); vp[0] = (u32x2){v.x, v.y}; vp[1] = (u32x2){v.z, v.w}; }
        __syncthreads();
        if (wave < 6) {
            unsigned P[2][8]; float av[8], bq[8];
#pragma unroll
            for (int kh2 = 0; kh2 < 2; ++kh2) {
                f32x16 S = {};
#pragma unroll
                for (int c = 0; c < 4; ++c) { const bf16x8 kf = *(const LAS bf16x8*)(lds + (32 * kh2 + r32) * 144 + (16 * c + 8 * hi) * 2); S = mfma32(kf, qr[c], S); }
                float p[16];
#pragma unroll
                for (int r = 0; r < 16; ++r) { const int n = 64 * m + 32 * kh2 + crow(r, hi); const float e = ex2(S[r]); p[r] = (16 * n + 31 <= tq) ? e : 0.f; }
                float s = 0.f;
#pragma unroll
                for (int r = 0; r < 16; ++r) s += p[r];
                l += s;
#pragma unroll
                for (int j = 0; j < 8; ++j) P[kh2][j] = pk2(p[2 * j], p[2 * j + 1]);
#pragma unroll
                for (int j = 0; j < 4; ++j) { av[4 * kh2 + j] = p[4 * j] + p[4 * j + 1] + p[4 * j + 2] + 0.5f * p[4 * j + 3]; bq[4 * kh2 + j] = 0.5f * p[4 * j + 3]; }
            }
#pragma unroll
            for (int db = 0; db < 2; ++db)
#pragma unroll
                for (int cc = 0; cc < 4; ++cc) {
                    const u32x2 a0 = *(const LAS u32x2*)(lds + 9216 + (32 * db + r32) * 136 + (16 * cc + 4 * hi) * 2);
                    const u32x2 a1 = *(const LAS u32x2*)(lds + 9216 + (32 * db + r32) * 136 + (16 * cc + 8 + 4 * hi) * 2);
                    const bf16x8 vf = as_bf16x8((u32x4){a0.x, a0.y, a1.x, a1.y});
                    const bf16x8 pf = as_bf16x8((u32x4){P[cc >> 1][4 * (cc & 1)], P[cc >> 1][4 * (cc & 1) + 1], P[cc >> 1][4 * (cc & 1) + 2], P[cc >> 1][4 * (cc & 1) + 3]});
                    O[db] = mfma32(vf, pf, O[db]);
                }
            float recv[8];
#pragma unroll
            for (int jj = 0; jj < 8; ++jj) recv[jj] = __shfl_xor(bq[jj], 32);
            LAS float* ip = imp + (rh * 64 + ql) * NC_IMPW + 16 * m + hi;
#pragma unroll
            for (int jj = 0; jj < 8; ++jj) {
                const float add = hi ? recv[jj] : (jj == 0 ? carry : recv[jj > 0 ? jj - 1 : 0]);
                ip[2 * jj] = av[jj] + add;
            }
            carry = recv[7];
        }
    }
    if (wave < 6) {
        const float lt = l + __shfl_xor(l, 32);
        const float li = (tq >= 31 && lt > 0.f) ? 1.0f / lt : 0.f;
        if (hi == 0) linv[rh * 64 + ql] = li;
        const float g0 = sigmoidf_(bf2f(zq[C_NG + 3 * h + 0]));
        bf16_t* mx = (bf16_t*)(ws + WS_OCB) + (size_t)(b * T + tq) * 384 + 64 * h;
        const float sc = li * g0;
#pragma unroll
        for (int db = 0; db < 2; ++db)
#pragma unroll
            for (int r = 0; r < 16; ++r) mx[32 * db + crow(r, hi)] = f2bf(O[db][r] * sc);
    }
    __syncthreads();
    for (int qi = 0; qi < 8; ++qi) {
        const int q = 8 * wave + qi;
        unsigned w0 = 0u, w1 = 0u, w2 = 0u, w3 = 0u;
        if (cur <= 15) { w0 = (1u << (cur + 1)) - 1u; }
        else {
            const float i0 = linv[q], i1 = linv[64 + q], i2 = linv[128 + q];
            const int ma = lane, mb = lane + 64;
            float va = 0.f, vb = 0.f;
            if (ma >= 1 && ma <= cur - 2) va = imp[(0 * 64 + q) * NC_IMPW + ma] * i0 + imp[(1 * 64 + q) * NC_IMPW + ma] * i1 + imp[(2 * 64 + q) * NC_IMPW + ma] * i2;
            if (mb <= cur - 2) vb = imp[(0 * 64 + q) * NC_IMPW + mb] * i0 + imp[(1 * 64 + q) * NC_IMPW + mb] * i1 + imp[(2 * 64 + q) * NC_IMPW + mb] * i2;
            unsigned long long mine_a = ((unsigned long long)__float_as_uint(va) << 32) | (unsigned)(255 - ma);
            unsigned long long mine_b = ((unsigned long long)__float_as_uint(vb) << 32) | (unsigned)(255 - mb);
            if (va <= 0.f) mine_a = 0ull;
            if (vb <= 0.f) mine_b = 0ull;
            unsigned long long sa = 0ull, sb = 0ull;
            for (int it = 0; it < 13; ++it) {
                unsigned long long best = mine_a > mine_b ? mine_a : mine_b;
#pragma unroll
                for (int o = 1; o < 64; o <<= 1) {
                    const unsigned oh = __shfl_xor((unsigned)(best >> 32), o), ol = __shfl_xor((unsigned)best, o);
                    const unsigned long long other = ((unsigned long long)oh << 32) | ol;
                    best = other > best ? other : best;
                }
                if (best != 0ull) {
                    const int mw = 255 - (int)(unsigned)(best & 0xffffffffull);
                    if (mw < 64) sa |= 1ull << mw; else sb |= 1ull << (mw - 64);
                    if (mine_a == best) mine_a = 0ull;
                    if (mine_b == best) mine_b = 0ull;
                }
            }
            sa |= 1ull;
            if (cur < 64) sa |= 1ull << cur; else sb |= 1ull << (cur - 64);
            if (cur - 1 < 64) sa |= 1ull << (cur - 1); else sb |= 1ull << (cur - 1 - 64);
            w0 = (unsigned)sa; w1 = (unsigned)(sa >> 32); w2 = (unsigned)sb; w3 = (unsigned)(sb >> 32);
        }
        if (lane == 0) *(u32x4*)((unsigned*)(ws + WS_SELM) + ((size_t)(b * 2 + g) * T + q0 + q) * 4) = (u32x4){w0, w1, w2, w3};
    }
}

#define XB_TMO      128
#define XB_XCNT(j)  (256  + 64 * (j))
#define XB_XSUB(j)  (1280 + 64 * (j))
#define XB_XGEN(j)  (2304 + 64 * (j))
#define XB_TOP      3328
#define XB_TOPGEN   3392
#define XCD_BAR_WORDS 3456
#define XB_SPIN_CAP (1u << 18)

__device__ __forceinline__ unsigned xb_ld(unsigned* p)              { return __hip_atomic_load(p, __ATOMIC_RELAXED, __HIP_MEMORY_SCOPE_AGENT); }
__device__ __forceinline__ unsigned xb_add(unsigned* p, unsigned v) { return __hip_atomic_fetch_add(p, v, __ATOMIC_RELAXED, __HIP_MEMORY_SCOPE_AGENT); }
__device__ __forceinline__ unsigned xb_xcc_id() { return (unsigned)__builtin_amdgcn_s_getreg((3 << 11) | 20) & 0xFu; }
#define XB_SPIN(cond, bar) do { unsigned _sp = 0; while (cond) { __builtin_amdgcn_s_sleep(1); \
    if ((++_sp & 255u) == 0u) { if (xb_ld(&(bar)[XB_TMO])) break; if (_sp > XB_SPIN_CAP) { atomicAdd(&(bar)[XB_TMO], 1u); break; } } } } while (0)

struct XcdBarrier {
    unsigned* bar; unsigned x;
    volatile LAS unsigned* st;
};

__device__ __forceinline__ XcdBarrier xcd_barrier_post(unsigned* bar, volatile LAS unsigned* st) {
    XcdBarrier b; b.bar = bar; b.x = xb_xcc_id(); b.st = st;
    if (threadIdx.x == 0) (void)xb_add(&bar[XB_XCNT(b.x)], 1u);
    return b;
}
__device__ __forceinline__ void xcd_barrier_complete(unsigned* bar, unsigned x, unsigned& nloc, unsigned& nx) {
    const unsigned G = gridDim.x * gridDim.y * gridDim.z;
    unsigned sum, cnt, mine, sp = 0u;
    for (;;) {
        sum = 0u; cnt = 0u; mine = 0u;
#pragma unroll
        for (unsigned j = 0; j < 16; ++j) { const unsigned c = xb_ld(&bar[XB_XCNT(j)]); sum += c; cnt += (c > 0u) ? 1u : 0u; mine = (j == x) ? c : mine; }
        if (sum == G) break;
        __builtin_amdgcn_s_sleep(1);
        if ((++sp & 255u) == 0u) { if (xb_ld(&bar[XB_TMO])) break; if (sp > XB_SPIN_CAP) { atomicAdd(&bar[XB_TMO], 1u); break; } }
    }
    nloc = mine > 0u ? mine : 1u; nx = cnt > 0u ? cnt : 1u;
}

__device__ __forceinline__ void xcd_barrier(const XcdBarrier& b) {
    asm volatile("s_waitcnt vmcnt(0)" ::: "memory");
    __syncthreads();
    if (threadIdx.x == 0) {
        unsigned* bar = b.bar;
        __builtin_amdgcn_s_waitcnt(0);
        unsigned nloc = b.st[0], nx = b.st[1];
        if (nloc == 0u) { xcd_barrier_complete(bar, b.x, nloc, nx); b.st[0] = nloc; b.st[1] = nx; }
        const unsigned old = xb_add(&bar[XB_XSUB(b.x)], 1u);
        const unsigned gen = old / nloc;
        if (old + 1u == (gen + 1u) * nloc) {
            __builtin_amdgcn_fence(__ATOMIC_RELEASE, "agent");
            asm volatile("s_waitcnt vmcnt(0)" ::: "memory");
            const unsigned og = xb_add(&bar[XB_TOP], 1u);
            const unsigned tg = og / nx;
            if (og + 1u == (tg + 1u) * nx) xb_add(&bar[XB_TOPGEN], 1u);
            else XB_SPIN(xb_ld(&bar[XB_TOPGEN]) == tg, bar);
            __builtin_amdgcn_fence(__ATOMIC_ACQUIRE, "agent");
            xb_add(&bar[XB_XGEN(b.x)], 1u);
            asm volatile("s_waitcnt vmcnt(0)" ::: "memory");
        } else {
            XB_SPIN(xb_ld(&bar[XB_XGEN(b.x)]) == gen, bar);
            __builtin_amdgcn_fence(__ATOMIC_ACQUIRE, "agent");
            asm volatile("s_waitcnt vmcnt(0)" ::: "memory");
        }
    }
    __syncthreads();
}

struct Args { const float* in[N_IN]; float* out; unsigned char* ws; int ph_lo, ph_hi; };
static_assert(sizeof(Args) == 8 * N_IN + 24, "Args has no padding");
constexpr int PH_PER_LAYER = 12, N_PHASES = DEPTH * PH_PER_LAYER;
#ifndef PH_HI
#define PH_HI N_PHASES
#endif

__global__ void __launch_bounds__(512) mega(Args a) {
    extern __shared__ __attribute__((aligned(16))) unsigned char lds_raw[];
    LAS unsigned char* lds = (LAS unsigned char*)lds_raw;
    LAS int* slot = (LAS int*)(lds + LDS_MISC);
    cg::grid_group grid = cg::this_grid();
    const float* const* in = nullptr;
    volatile LAS unsigned* misc = (volatile LAS unsigned*)(lds + LDS_MISC);
    if (TID() < 16) misc[TID()] = 0u;
    __syncthreads();
    (void)xcd_barrier_post((unsigned*)(a.ws + WS_CTL) + 4096, misc + 8);
#ifndef DUP_GU
#define DUP_GU 0
#endif
#ifndef DUP_IN
#define DUP_IN 0
#endif
#ifndef DUP_DIFF
#define DUP_DIFF 0
#endif
#ifndef DUP_NSAC
#define DUP_NSAC 0
#endif
#ifndef DUP_SW
#define DUP_SW 0
#endif
#ifndef DUP_HOUT
#define DUP_HOUT 0
#endif
#ifndef DUP_M1
#define DUP_M1 0
#endif
#ifndef DUP_SYNC
#define DUP_SYNC 0
#endif
#ifndef DUP_CONV
#define DUP_CONV 0
#endif
#ifndef PHM
#define PHM 0xfff
#endif
    for (int ph = a.ph_lo; ph < a.ph_hi; ++ph) {
        int L = ph / PH_PER_LAYER; const int j = ph - L * PH_PER_LAYER;
        asm volatile("" : "+s"(L));
        unsigned long long ws_ = (unsigned long long)a.ws; asm volatile("" : "+s"(ws_)); unsigned char* ws = (unsigned char*)(GAS unsigned char*)ws_;
        unsigned long long out_ = (unsigned long long)a.out; asm volatile("" : "+s"(out_)); float* out_g = (float*)(GAS float*)out_;
        unsigned* ctl = (unsigned*)(ws + WS_CTL); bf16_t* r1 = (bf16_t*)(ws + WS_R1); bf16_t* mixed = (bf16_t*)(ws + WS_MIX); bf16_t* pb = (bf16_t*)(ws + WS_PB); unsigned char* wb = ws + WS_W; float* rsqp = (float*)(ws + WS_RSQP);
        float* rsq = (float*)(ws + ((L & 1) ? WS_RSQ1 : WS_RSQ0)); float* rsq_next = (float*)(ws + ((L & 1) ? WS_RSQ0 : WS_RSQ1));
        bf16_t* xb = (bf16_t*)(ws + ((L & 1) ? WS_XB1 : WS_XB)); bf16_t* xb_next = (bf16_t*)(ws + ((L & 1) ? WS_XB : WS_XB1));
        if ((PHM >> j) & 1) switch (j) {
        case 0: phase_convert(in, ws, out_g, L, lds); if (DUP_CONV) { __syncthreads(); phase_convert(in, ws, out_g, L, lds); } break;
        case 1: { EpiSwiGLU E{r1, rsq}; run_gemm(lds, xb, (const bf16_t*)(wb + W_GU1), 2 * FF, DM, E); } break;
        case 2: { EpiRes<0> E{out_g, xb, rsq, 0.5f, nullptr, nullptr, nullptr, nullptr, nullptr}; run_gemm(lds, r1, (const bf16_t*)(wb + W_D1), DM, FF, E); } break;
        case 3: { EpiZ E{r1, rsq}; run_gemm(lds, xb, (const bf16_t*)(wb + W_IN), ZW, DM, E); } break;
        case 4: {
            unsigned* ctr = ctl + (L * 4 + 0) * 64;
            constexpr int NCMP = 512 << DUP_M1, NHL = 512 << DUP_M1;
            for (;;) { const int t = next_task(ctr, slot); if (t >= NCMP + NHL + 512) break;
                if (t < NCMP) task_compress(in, ws, L, t >> DUP_M1, lds); else if (t < NCMP + NHL) task_hgrn_local(in, ws, L, (t - NCMP) >> DUP_M1, lds); else task_prep(in, ws, L, t - NCMP - NHL, lds); }
        } break;
        case 5: {
            unsigned* ctr = ctl + (L * 4 + 1) * 64;
            constexpr int ND = 512 << DUP_DIFF, NC = 1024 << DUP_NSAC;
            for (;;) { const int t = next_task(ctr, slot); if (t >= 192 + ND + NC) break;
                if (t < 192) task_hgrn_scan(ws, t); else if (t < 192 + ND) task_diff(in, ws, L, (t - 192) >> DUP_DIFF, lds); else task_nsa_c(in, ws, L, (t - 192 - ND) >> DUP_NSAC, lds); }
        } break;
        case 6: {
            unsigned* ctr = ctl + (L * 4 + 2) * 64;
            constexpr int NS = 768 << DUP_SW, NH = 1024 << DUP_HOUT;
            for (;;) { const int t = next_task(ctr, slot); if (t >= NS + NH) break;
                if (t < NS) task_nsa_sw(in, ws, L, t >> DUP_SW, lds); else task_hgrn_out(in, ws, L, (t - NS) >> DUP_HOUT, lds); }
        } break;
        case 7: { EpiRes<0> E{out_g, xb, rsq, 1.0f, nullptr, nullptr, nullptr, nullptr, nullptr}; run_gemm(lds, mixed, (const bf16_t*)(wb + W_OUT), DM, DM, E); } break;
        case 8: { EpiSwiGLU E{r1, rsq}; run_gemm(lds, xb, (const bf16_t*)(wb + W_GU2), 2 * FF, DM, E); } break;
        case 9: { EpiRes<2> E{nullptr, nullptr, rsqp, 0.f, nullptr, nullptr, nullptr, nullptr, mixed}; run_gemm(lds, pb, (const bf16_t*)(wb + W_PP), DM, PLE, E); } break;
        case 10: { EpiRes<0> E{out_g, xb, rsq, 0.5f, nullptr, nullptr, nullptr, nullptr, nullptr}; run_gemm(lds, r1, (const bf16_t*)(wb + W_D2), DM, FF, E); } break;
        default: { EpiRes<1> E{out_g, xb_next, rsq_next, 0.f, rsq, mixed, rsqp, inp(I_PLPOST) + L * DM, nullptr}; run_gemm(lds, xb, (const bf16_t*)(wb + W_PG), DM, DM, E); } break;
        }
        if (ph + 1 < a.ph_hi) {
            if (ph == 0) { asm volatile("s_waitcnt vmcnt(0) lgkmcnt(0)" ::: "memory"); grid.sync(); __builtin_amdgcn_fence(__ATOMIC_ACQUIRE, "agent"); asm volatile("s_waitcnt vmcnt(0)" ::: "memory"); __syncthreads(); }
            else { XcdBarrier xb_; xb_.bar = (unsigned*)(ws + WS_CTL) + 4096; xb_.x = xb_xcc_id(); xb_.st = misc + 8; xcd_barrier(xb_); if (DUP_SYNC) xcd_barrier(xb_); }
        }
    }
}

#ifdef DUMPK
__global__ void __launch_bounds__(512) dump_kernel(float* out, unsigned char* ws) {
    bf16_t* mixed = (bf16_t*)(ws + WS_MIX); (void)mixed;
    for (size_t idx = (size_t)blockIdx.x * 512 + threadIdx.x; idx < (size_t)M * 1024; idx += (size_t)gridDim.x * 512) {
        const size_t m = idx >> 10; const int c = (int)(idx & 1023);
        float v = 0.f;
#if DUMPK == 3 || DUMPK == 40
        { const bf16_t* z = (const bf16_t*)(ws + WS_R1); v = bf2f(z[m * ZW + c]) + bf2f(z[m * ZW + 1024 + c]) + bf2f(z[m * ZW + 2048 + c]) + (c < 402 ? bf2f(z[m * ZW + 3072 + c]) : 0.f); }
#elif DUMPK == 41
        { const bf16_t* vt = (const bf16_t*)(ws + WS_VT); v = bf2f(vt[m * 512 + (c & 511)]); }
#elif DUMPK == 42
        { const float* hs = (const float*)(ws + WS_HS); const float* hd = (const float*)(ws + WS_HD); v = hs[m * 384 + (c % 384)] + hd[m * 6 + (c % 6)]; }
#elif DUMPK == 43
        { const bf16_t* kc = (const bf16_t*)(ws + WS_KC); const bf16_t* vct = (const bf16_t*)(ws + WS_VCT); v = bf2f(kc[m * 8 + (c & 7)]) + bf2f(vct[m * 8 + (c & 7)]); }
#elif DUMPK == 50 || DUMPK == 60
        v = (c < 384) ? bf2f(mixed[m * 1024 + c]) : 0.f;
#elif DUMPK == 51
        v = (c >= 384 && c < 640) ? bf2f(mixed[m * 1024 + c]) : 0.f;
#elif DUMPK == 52
        { const unsigned* selm = (const unsigned*)(ws + WS_SELM); v = (float)(selm[m * 8 + (c & 7)] & 0xffffu) + (float)(selm[m * 8 + (c & 7)] >> 16); }
#elif DUMPK == 53
        { const float* hs = (const float*)(ws + WS_HS); v = hs[m * 384 + (c % 384)]; }
#elif DUMPK == 61
        v = (c >= 640) ? bf2f(mixed[m * 1024 + c]) : 0.f;
#endif
        out[idx] = v;
    }
}
#endif

extern "C" void kernel_launch(void* const* d_in, const int* in_sizes, int n_in, void* d_out, int out_size, void* d_ws, size_t ws_size, hipStream_t stream) {
    static int grid = 0;
    if (grid == 0) {
        if (n_in != N_IN || out_size != M * DM || ws_size < WS_END) { fprintf(stderr, "kernel_launch: unexpected shapes (n_in %d out %d ws %zu)\n", n_in, out_size, ws_size); grid = -1; return; }
        int dev = 0, cus = 0, per_cu = 0;
        hipGetDevice(&dev); hipDeviceGetAttribute(&cus, hipDeviceAttributeMultiprocessorCount, dev);
        if (hipFuncSetAttribute((const void*)mega, hipFuncAttributeMaxDynamicSharedMemorySize, LDS_BYTES) != hipSuccess) { fprintf(stderr, "hipFuncSetAttribute failed\n"); }
        if (hipOccupancyMaxActiveBlocksPerMultiprocessor(&per_cu, (const void*)mega, 512, LDS_BYTES) != hipSuccess || per_cu < 1) { fprintf(stderr, "occupancy query: %d\n", per_cu); per_cu = 1; }
        (void)hipGetLastError();
        grid = cus;
    }
    if (grid < 0) return;
    hipMemsetAsync((char*)d_ws + WS_CTL, 0, 64 * 1024, stream);
    Args a{};
    for (int i = 0; i < N_IN; ++i) a.in[i] = (const float*)d_in[i];
    a.out = (float*)d_out; a.ws = (unsigned char*)d_ws; a.ph_lo = 0; a.ph_hi = PH_HI;
    void* args[] = {&a};
    hipError_t e = hipLaunchCooperativeKernel((const void*)mega, dim3(grid), dim3(512), args, LDS_BYTES, stream);
    if (e != hipSuccess) fprintf(stderr, "cooperative launch failed: %s (grid %d)\n", hipGetErrorString(e), grid);
#ifdef DUMPK
    dump_kernel<<<dim3(1024), dim3(512), 0, stream>>>((float*)d_out, (unsigned char*)d_ws);
#endif
}
```

```cpp
#include <hip/hip_runtime.h>
#include <hip/hip_cooperative_groups.h>
#include <cstdio>
#include <cstdint>
namespace cg = cooperative_groups;
__device__ __forceinline__ int TID() { int t = threadIdx.x; asm volatile("" : "+v"(t)); return t; }
namespace pg8 {
#define PG8_LAS __attribute__((address_space(3)))
typedef unsigned short bf16_t;
typedef short bf16x8 __attribute__((ext_vector_type(8)));
typedef float f32x4 __attribute__((ext_vector_type(4)));
typedef unsigned u32x4 __attribute__((ext_vector_type(4)));
constexpr int BM = 256, BK = 64, HALF = 128, HTB = HALF * BK * 2  , STAGE_BYTES = 8 * HTB, NXCD = 8, WGM = 8;

__host__ __device__ __forceinline__ int lds_byte(int r, int c) { const int st = (r >> 4) * 2 + (c >> 5), rr = r & 15, cc = c & 31, ob = rr * 64 + cc * 2; return st * 1024 + (ob ^ (((ob >> 9) & 1) << 5)); }
__host__ __device__ __forceinline__ void stage_rc(int b, int& R, int& C) { const int st = b / 1024, sb = b % 1024, swz = sb ^ (((sb >> 9) & 1) << 5); R = (st >> 1) * 16 + swz / 64; C = (st & 1) * 32 + (swz % 64) / 2; }
__host__ __device__ __forceinline__ int perm32(int rho) { const int n = rho >> 4, i = rho & 15; return 8 * (i >> 2) + 4 * n + (i & 3); }

struct Unit { int pm, pn; };
struct Gemm { const bf16_t* A; const bf16_t* Bt; int M, N, K; };

struct StaticOrder {
    int nM, nN, nwg, G, c;
    __host__ __device__ void init(int M, int N, int G_, int c_) { nM = M / BM; nN = N / BM; nwg = nM * nN; G = G_; c = c_; }
    __host__ __device__ bool next(int i, Unit& u) const {
        const long L = (long)i * G + c; if (L >= nwg) return false;
        int wgid = (int)L; { const int q = nwg / NXCD, r = nwg % NXCD, xcd = wgid % NXCD, off = wgid / NXCD; wgid = (xcd < r ? xcd * (q + 1) : r * (q + 1) + (xcd - r) * q) + off; }
        const int nig = WGM * nN, gid = wgid / nig, fm = gid * WGM, gsz = (nM - fm) < WGM ? (nM - fm) : WGM;
        u.pm = fm + ((wgid % nig) % gsz); u.pn = (wgid % nig) / gsz; return true;
    }
    __device__ __forceinline__ void a_ready(const Unit&) const {}
    __device__ __forceinline__ void done(const Unit&) const {}
};

template <class Epi, class Sched, bool ALIGN_EPI = false, bool SP2 = false>
__device__ __forceinline__ void gemm_phase(PG8_LAS unsigned char* lds, const Gemm g, const Sched& S, const Epi& E) {
    const int tid = TID(), wid = __builtin_amdgcn_readfirstlane(tid >> 6), lane = tid & 63, wr = wid >> 2, wc = wid & 3, fr = lane & 15, fq = lane >> 4;
    const int K = g.K, nt = K / BK;
    unsigned voffA[2], voffB[2];
#pragma unroll
    for (int i = 0; i < 2; ++i) { int R, C; stage_rc(tid * 16 + i * 8192, R, C); const int Rb = Epi::PERM ? ((R & ~31) + perm32(R & 31)) : R;
        voffA[i] = (unsigned)(R * K + C) * 2u; voffB[i] = (unsigned)(Rb * K + C) * 2u; }
    const size_t kstep = (size_t)(BK * 2);
    const size_t hstep = (size_t)HALF * K * 2;
    const size_t tstep = 2 * hstep;
    const unsigned ldsw = (unsigned)wid * 1024u;
    const int aoff = lds_byte(wr * 64 + fr, fq * 8), boff = lds_byte(wc * 32 + fr, fq * 8);
#define PG8_SA(b, h) (((b) * 2 + (h)) * HTB)
#define PG8_SB(b, h) ((4 + (b) * 2 + (h)) * HTB)
#define PG8_STAGE(bufoff, gbase, voff) do { _Pragma("unroll") for (int _i = 0; _i < 2; ++_i) \
        __builtin_amdgcn_global_load_lds((const unsigned*)((const char*)(gbase) + (voff)[_i]), (PG8_LAS unsigned*)(lds + (bufoff) + ldsw + _i * 8192), 16, 0, 0); } while (0)
#define PG8_LDA(dst, b, h) do { _Pragma("unroll") for (int m = 0; m < 4; ++m) _Pragma("unroll") for (int k = 0; k < 2; ++k) dst[m][k] = *(const PG8_LAS bf16x8*)(lds + PG8_SA(b, h) + aoff + m * 2048 + k * 1024); } while (0)
#define PG8_LDB(dst, b, h) do { _Pragma("unroll") for (int n = 0; n < 2; ++n) _Pragma("unroll") for (int k = 0; k < 2; ++k) dst[n][k] = *(const PG8_LAS bf16x8*)(lds + PG8_SB(b, h) + boff + n * 2048 + k * 1024); } while (0)
#define PG8_MMA(ai, bj, At, Bt) do { __builtin_amdgcn_s_setprio(1); _Pragma("unroll") for (int m = 0; m < 4; ++m) _Pragma("unroll") for (int n = 0; n < 2; ++n) _Pragma("unroll") for (int k = 0; k < 2; ++k) \
        acc[ai][bj][m][n] = __builtin_amdgcn_mfma_f32_16x16x32_bf16(Bt[n][k], At[m][k], acc[ai][bj][m][n], 0, 0, 0); __builtin_amdgcn_s_setprio(0); } while (0)
#define PG8_WAIT_V(n) asm volatile("s_waitcnt vmcnt(" #n ")" ::: "memory")
#define PG8_WAIT_L(n) asm volatile("s_waitcnt lgkmcnt(" #n ")" ::: "memory")
#define PG8_BAR __builtin_amdgcn_s_barrier()
#define PG8_SCHED __builtin_amdgcn_sched_barrier(0)
    Unit cur, nxt; int ui = 0;
    if (!S.next(0, cur)) return;
    f32x4 acc[2][2][4][2];
#pragma unroll
    for (int a = 0; a < 2; ++a)
#pragma unroll
        for (int b = 0; b < 2; ++b)
#pragma unroll
            for (int m = 0; m < 4; ++m)
#pragma unroll
                for (int n = 0; n < 2; ++n) acc[a][b][m][n] = (f32x4){0.f, 0.f, 0.f, 0.f};
    bf16x8 At[4][2], B0[2][2], B1[2][2];
    const char* cA = (const char*)g.A + (size_t)cur.pm * tstep; const char* cB = (const char*)g.Bt + (size_t)cur.pn * tstep;
    S.a_ready(cur);
    if constexpr (SP2) {
        PG8_STAGE(PG8_SB(0, 0), cB, voffB); PG8_STAGE(PG8_SB(0, 1), cB + hstep, voffB); PG8_STAGE(PG8_SA(0, 0), cA, voffA); PG8_STAGE(PG8_SA(0, 1), cA + hstep, voffA);
        if (wr == 1) PG8_BAR;
        PG8_WAIT_V(2); PG8_BAR;
        PG8_STAGE(PG8_SB(1, 0), cB + kstep, voffB); PG8_STAGE(PG8_SA(1, 0), cA + kstep, voffA); PG8_STAGE(PG8_SB(1, 1), cB + hstep + kstep, voffB);
        PG8_WAIT_V(6); PG8_BAR;
    } else {
        PG8_STAGE(PG8_SB(0, 0), cB, voffB); PG8_STAGE(PG8_SA(0, 0), cA, voffA); PG8_STAGE(PG8_SB(0, 1), cB + hstep, voffB); PG8_STAGE(PG8_SA(0, 1), cA + hstep, voffA);
        if (wr == 1) PG8_BAR;
        PG8_WAIT_V(4); PG8_BAR;
        PG8_STAGE(PG8_SB(1, 0), cB + kstep, voffB); PG8_STAGE(PG8_SA(1, 0), cA + kstep, voffA); PG8_STAGE(PG8_SB(1, 1), cB + hstep + kstep, voffB);
        PG8_WAIT_V(6); PG8_BAR;
    }
    for (;;) {
        const bool has_next = S.next(ui + 1, nxt);
        const char* nA = has_next ? (const char*)g.A + (size_t)nxt.pm * tstep : cA; const char* nB = has_next ? (const char*)g.Bt + (size_t)nxt.pn * tstep : cB;
        for (int t = 0; t < nt; t += 2) {
            const bool last = (t == nt - 2);
            const char* a1 = cA + (size_t)(t + 1) * kstep;
            const char* a2 = last ? nA : cA + (size_t)(t + 2) * kstep; const char* b2 = last ? nB : cB + (size_t)(t + 2) * kstep;
            const char* a3 = a2 + kstep; const char* b3 = b2 + kstep;
            if (last && has_next) S.a_ready(nxt);
            if constexpr (SP2) {
            PG8_LDB(B0, 0, 0); PG8_LDB(B1, 0, 1); PG8_SCHED; PG8_LDA(At, 0, 0); PG8_STAGE(PG8_SA(1, 1), a1 + hstep, voffA);
            PG8_WAIT_V(8); PG8_WAIT_L(0); PG8_BAR; PG8_MMA(0, 0, At, B0); PG8_MMA(0, 1, At, B1); PG8_BAR; PG8_SCHED;
            PG8_LDA(At, 0, 1); PG8_STAGE(PG8_SB(0, 0), b2, voffB); PG8_STAGE(PG8_SB(0, 1), b2 + hstep, voffB); PG8_STAGE(PG8_SA(0, 0), a2, voffA);
            PG8_WAIT_V(8); PG8_WAIT_L(0); PG8_BAR; PG8_MMA(1, 0, At, B0); PG8_MMA(1, 1, At, B1); PG8_BAR; PG8_SCHED;
            PG8_LDB(B0, 1, 0); PG8_LDB(B1, 1, 1); PG8_SCHED; PG8_LDA(At, 1, 0); PG8_STAGE(PG8_SA(0, 1), a2 + hstep, voffA);
            PG8_WAIT_V(8); PG8_WAIT_L(0); PG8_BAR; PG8_MMA(0, 0, At, B0); PG8_MMA(0, 1, At, B1); PG8_BAR; PG8_SCHED;
            PG8_LDA(At, 1, 1); PG8_STAGE(PG8_SB(1, 0), b3, voffB); PG8_STAGE(PG8_SB(1, 1), b3 + hstep, voffB); PG8_STAGE(PG8_SA(1, 0), a3, voffA);
            PG8_WAIT_V(8); PG8_WAIT_L(0); PG8_BAR; PG8_MMA(1, 0, At, B0); PG8_MMA(1, 1, At, B1); PG8_BAR; PG8_SCHED;
            } else {
            PG8_LDB(B0, 0, 0); PG8_SCHED; PG8_LDA(At, 0, 0); PG8_STAGE(PG8_SA(1, 1), a1 + hstep, voffA);
            PG8_WAIT_L(8); PG8_BAR; PG8_WAIT_L(0); PG8_MMA(0, 0, At, B0); PG8_BAR; PG8_SCHED;
            PG8_LDB(B1, 0, 1); PG8_STAGE(PG8_SB(0, 0), b2, voffB);
            PG8_BAR; PG8_WAIT_L(0); PG8_MMA(0, 1, At, B1); PG8_BAR;
            PG8_LDA(At, 0, 1); PG8_STAGE(PG8_SA(0, 0), a2, voffA);
            PG8_BAR; PG8_WAIT_L(0); PG8_MMA(1, 0, At, B0); PG8_BAR; PG8_SCHED;
            PG8_STAGE(PG8_SB(0, 1), b2 + hstep, voffB);
            PG8_WAIT_V(6); PG8_BAR; PG8_MMA(1, 1, At, B1); PG8_BAR;
            PG8_LDB(B0, 1, 0); PG8_SCHED; PG8_LDA(At, 1, 0); PG8_STAGE(PG8_SA(0, 1), a2 + hstep, voffA);
            PG8_WAIT_L(8); PG8_BAR; PG8_WAIT_L(0); PG8_MMA(0, 0, At, B0); PG8_BAR; PG8_SCHED;
            PG8_LDB(B1, 1, 1); PG8_STAGE(PG8_SB(1, 0), b3, voffB);
            PG8_BAR; PG8_WAIT_L(0); PG8_MMA(0, 1, At, B1); PG8_BAR;
            PG8_LDA(At, 1, 1); PG8_STAGE(PG8_SA(1, 0), a3, voffA);
            PG8_BAR; PG8_WAIT_L(0); PG8_MMA(1, 0, At, B0); PG8_BAR; PG8_SCHED;
            PG8_STAGE(PG8_SB(1, 1), b3 + hstep, voffB);
            PG8_WAIT_V(6); PG8_BAR; PG8_MMA(1, 1, At, B1); PG8_BAR;
            }
        }
        if constexpr (ALIGN_EPI) { if (wr == 0) PG8_BAR; }
        if constexpr (!Epi::AFTER_DRAIN) { E(acc, cur, wr, wc, fr, fq); S.done(cur); }
        if (!has_next) break;
#pragma unroll
        for (int a = 0; a < 2; ++a)
#pragma unroll
            for (int b = 0; b < 2; ++b)
#pragma unroll
                for (int m = 0; m < 4; ++m)
#pragma unroll
                    for (int n = 0; n < 2; ++n) acc[a][b][m][n] = (f32x4){0.f, 0.f, 0.f, 0.f};
        cur = nxt; cA = nA; cB = nB; ++ui;
        if constexpr (ALIGN_EPI) { if (wr == 1) PG8_BAR; }
    }
    PG8_WAIT_V(0);
    if constexpr (!ALIGN_EPI) { if (wr == 0) PG8_BAR; }
    PG8_BAR;
    if constexpr (Epi::AFTER_DRAIN) { E.fused(acc, cur, wr, wc, fr, fq, lds, wid, lane); S.done(cur); }
#undef PG8_SA
#undef PG8_SB
#undef PG8_STAGE
#undef PG8_LDA
#undef PG8_LDB
#undef PG8_MMA
#undef PG8_WAIT_V
#undef PG8_WAIT_L
#undef PG8_BAR
#undef PG8_SCHED
}
}

#define LAS __attribute__((address_space(3)))
typedef unsigned short bf16_t;
typedef short bf16x8 __attribute__((ext_vector_type(8)));
typedef float f32x4 __attribute__((ext_vector_type(4)));
typedef float f32x16 __attribute__((ext_vector_type(16)));
typedef unsigned u32x4 __attribute__((ext_vector_type(4)));
typedef unsigned u32x2 __attribute__((ext_vector_type(2)));

constexpr int NB = 4, T = 8192, DM = 1024, M = NB * T, DEPTH = 4, PLE = 256, FF = 2816, ZW = 3584, INW = 3474;
constexpr int C_NQ = 0, C_CK = 384, C_CV = 512, C_SK = 640, C_SV = 768, C_WK = 896, C_WV = 1024, C_DQ = 1152, C_DK = 1408, C_DV = 1664,
              C_HQ = 1920, C_HF = 2304, C_HI = 2688, C_HG = 3072, C_NG = 3456;
constexpr float EPS = 1e-6f, LOG2E = 1.4426950408889634f;
enum { I_X = 0, I_P, I_RELB, I_LBLOG, I_F1N, I_F1G, I_F1U, I_F1D, I_MIXN, I_WIN, I_WOUT, I_NQN, I_NKN, I_CPOS, I_CW1, I_CW2,
       I_DQN, I_DKN, I_DLAM, I_DSUB, I_HON, I_F2N, I_F2G, I_F2U, I_F2D, I_PLN, I_PLG, I_PLP, I_PLPOST, N_IN };
constexpr size_t MiB = 1u << 20;
constexpr size_t WS_CTL = 0, WS_W = 1 * MiB, WS_PB = 53 * MiB, WS_XB = 69 * MiB, WS_R1 = 133 * MiB, WS_MIX = 357 * MiB, WS_VT = 421 * MiB,
                 WS_HS = 453 * MiB, WS_KC = 501 * MiB, WS_VCT = WS_KC + 512 * 1024, WS_SELM = 503 * MiB, WS_RSQ0 = 504 * MiB, WS_RSQ1 = 506 * MiB,
                 WS_RSQP = 508 * MiB, WS_HD = 510 * MiB, WS_XB1 = 511 * MiB, WS_OCB = 575 * MiB, WS_ONES = 599 * MiB, WS_END = 601 * MiB;
constexpr size_t W_GU1 = 0, W_D1 = 11 * MiB, W_GU2 = W_D1 + 5 * MiB + 512 * 1024, W_D2 = W_GU2 + 11 * MiB, W_IN = 33 * MiB, W_OUT = 40 * MiB, W_PG = 42 * MiB,
                 W_PP = 44 * MiB, W_1T = W_PP + 512 * 1024, W_2T = W_1T + 2 * MiB, W_POSB = W_2T + 64 * 1024;
static_assert(W_D2 + 5 * MiB + 512 * 1024 == W_IN, "weight map");
constexpr int LDS_BYTES = 132 * 1024, LDS_MISC = 131072;

__device__ __forceinline__ float bf2f(unsigned short u) { return __uint_as_float(((unsigned)u) << 16); }
__device__ __forceinline__ float bflo(unsigned w) { return __uint_as_float(w << 16); }
__device__ __forceinline__ float bfhi(unsigned w) { return __uint_as_float(w & 0xffff0000u); }
typedef float f32x2_t __attribute__((ext_vector_type(2))); typedef __bf16 bf16x2_t __attribute__((ext_vector_type(2)));
__device__ __forceinline__ unsigned pk2(float lo, float hi) { f32x2_t v = {lo, hi}; bf16x2_t b = __builtin_convertvector(v, bf16x2_t); return __builtin_bit_cast(unsigned, b); }
__device__ __forceinline__ bf16_t f2bf(float f) { return (bf16_t)(pk2(f, 0.f) & 0xffffu); }
__device__ __forceinline__ float ex2(float x) { return __builtin_amdgcn_exp2f(x); }
__device__ __forceinline__ float sigmoidf_(float x) { return 1.0f / (1.0f + __expf(-x)); }
__device__ __forceinline__ int crow(int r, int hi) { return (r & 3) + 8 * (r >> 2) + 4 * hi; }
__device__ __forceinline__ f32x16 mfma32(bf16x8 a, bf16x8 b, f32x16 c) { return __builtin_amdgcn_mfma_f32_32x32x16_bf16(a, b, c, 0, 0, 0); }
__device__ __forceinline__ f32x4 mfma16(bf16x8 a, bf16x8 b, f32x4 c) { return __builtin_amdgcn_mfma_f32_16x16x32_bf16(a, b, c, 0, 0, 0); }
__device__ __forceinline__ bf16x8 as_bf16x8(u32x4 v) { return __builtin_bit_cast(bf16x8, v); }
#define LDSW() asm volatile("s_waitcnt lgkmcnt(0)" ::: "memory")
#define CFENCE() asm volatile("" ::: "memory")
#define GAS __attribute__((address_space(1)))
__device__ __forceinline__ const float* inp(int i) { asm volatile("" : "+s"(i)); const unsigned long long v = ((const unsigned long long __attribute__((address_space(4)))*)__builtin_amdgcn_kernarg_segment_ptr())[i]; return (const float*)(const GAS float*)v; }

__device__ __forceinline__ float row_rinv(const float* rsq, int row) {
    const f32x4* p = (const f32x4*)(rsq + (size_t)row * 16);
    const f32x4 a = p[0], b = p[1], c = p[2], d = p[3];
    const float s = ((a.x + a.y) + (a.z + a.w)) + ((b.x + b.y) + (b.z + b.w)) + ((c.x + c.y) + (c.z + c.w)) + ((d.x + d.y) + (d.z + d.w));
    return rsqrtf(s * (1.0f / 1024.0f) + EPS);
}
struct EpiSwiGLU {
    static constexpr bool PERM = true, AFTER_DRAIN = false;
    bf16_t* O; const float* rsq;
    __device__ __forceinline__ void operator()(const f32x4 (&acc)[2][2][4][2], const pg8::Unit& u, int wr, int wc, int fr, int fq) const {
#pragma unroll
        for (int ai = 0; ai < 2; ++ai)
#pragma unroll
            for (int m = 0; m < 4; ++m) {
                const int row = u.pm * 256 + ai * 128 + wr * 64 + m * 16 + fr;
                const float r = row_rinv(rsq, row);
                float o[8];
#pragma unroll
                for (int n = 0; n < 2; ++n)
#pragma unroll
                    for (int e = 0; e < 4; ++e) { const float g = acc[ai][0][m][n][e] * r, up = acc[ai][1][m][n][e] * r; o[n * 4 + e] = g * sigmoidf_(g) * up; }
                u32x4 w; w.x = pk2(o[0], o[1]); w.y = pk2(o[2], o[3]); w.z = pk2(o[4], o[5]); w.w = pk2(o[6], o[7]);
                *(u32x4*)(O + (size_t)row * FF + u.pn * 128 + wc * 32 + 8 * fq) = w;
                CFENCE();
            }
    }
};
template <int LD> struct EpiZT {
    static constexpr bool PERM = true, AFTER_DRAIN = false;
    bf16_t* Z; const float* rsq;
    __device__ __forceinline__ void operator()(const f32x4 (&acc)[2][2][4][2], const pg8::Unit& u, int wr, int wc, int fr, int fq) const {
#pragma unroll
        for (int ai = 0; ai < 2; ++ai)
#pragma unroll
            for (int m = 0; m < 4; ++m) {
                const int row = u.pm * 256 + ai * 128 + wr * 64 + m * 16 + fr;
                const float r = row_rinv(rsq, row);
#pragma unroll
                for (int bj = 0; bj < 2; ++bj) {
                    const f32x4 v0 = acc[ai][bj][m][0] * r, v1 = acc[ai][bj][m][1] * r;
                    u32x4 w; w.x = pk2(v0[0], v0[1]); w.y = pk2(v0[2], v0[3]); w.z = pk2(v1[0], v1[1]); w.w = pk2(v1[2], v1[3]);
                    *(u32x4*)(Z + (size_t)row * LD + u.pn * 256 + bj * 128 + wc * 32 + 8 * fq) = w;
                }
                CFENCE();
            }
    }
};
typedef EpiZT<ZW> EpiZ;
template <int MODE> struct EpiRes {
    static constexpr bool PERM = false, AFTER_DRAIN = false;
    float* X; bf16_t* XB; float* rsq_out; float alpha; const float* rsq_in; const bf16_t* P; const float* rsqp; const float* post; bf16_t* Pout;
    __device__ __forceinline__ void operator()(const f32x4 (&acc)[2][2][4][2], const pg8::Unit& u, int wr, int wc, int fr, int fq) const {
#pragma unroll
        for (int ai = 0; ai < 2; ++ai)
#pragma unroll
            for (int m = 0; m < 4; ++m) {
                const int row = u.pm * 256 + ai * 128 + wr * 64 + m * 16 + fr;
                float r = 1.f, rp = 1.f;
                if (MODE == 1) { r = row_rinv(rsq_in, row); rp = row_rinv(rsqp, row); }
                float ss = 0.f;
#pragma unroll
                for (int bj = 0; bj < 2; ++bj)
#pragma unroll
                    for (int n = 0; n < 2; ++n) {
                        const int c0 = u.pn * 256 + bj * 128 + wc * 32 + 16 * n + 4 * fq;
                        const size_t off = (size_t)row * DM + c0;
                        const f32x4 a = acc[ai][bj][m][n];
                        if (MODE == 2) {
                            u32x2 w; w.x = pk2(a[0], a[1]); w.y = pk2(a[2], a[3]);
                            *(u32x2*)(Pout + off) = w;
                            ss += (a[0] * a[0] + a[1] * a[1]) + (a[2] * a[2] + a[3] * a[3]);
                        } else {
                            f32x4 xv = *(const f32x4*)(X + off);
                            if (MODE == 0) xv += a * alpha;
                            else {
                                const u32x2 pw = *(const u32x2*)(P + off); const f32x4 po = *(const f32x4*)(post + c0);
                                xv[0] += sigmoidf_(a[0] * r) * (bflo(pw.x) * rp * po[0]);
                                xv[1] += sigmoidf_(a[1] * r) * (bfhi(pw.x) * rp * po[1]);
                                xv[2] += sigmoidf_(a[2] * r) * (bflo(pw.y) * rp * po[2]);
                                xv[3] += sigmoidf_(a[3] * r) * (bfhi(pw.y) * rp * po[3]);
                            }
                            *(f32x4*)(X + off) = xv;
                            u32x2 w; w.x = pk2(xv[0], xv[1]); w.y = pk2(xv[2], xv[3]);
                            *(u32x2*)(XB + off) = w;
                            ss += (xv[0] * xv[0] + xv[1] * xv[1]) + (xv[2] * xv[2] + xv[3] * xv[3]);
                        }
                    }
                ss += __shfl_xor(ss, 16); ss += __shfl_xor(ss, 32);
                if (fq == 0) rsq_out[(size_t)row * 16 + u.pn * 4 + wc] = ss;
                CFENCE();
            }
    }
};

template <class Epi, bool SP2 = true> __device__ __forceinline__ void run_gemm(LAS unsigned char* lds, const bf16_t* A, const bf16_t* Bt, int N, int K, const Epi& E) {
    pg8::Gemm g{A, Bt, M, N, K}; int bx = blockIdx.x; asm volatile("" : "+s"(bx)); asm volatile("" : "+s"(K)); asm volatile("" : "+s"(N)); pg8::StaticOrder S; S.init(M, N, (int)gridDim.x, bx);
    pg8::gemm_phase<Epi, pg8::StaticOrder, true, SP2>(lds, g, S, E);
    __syncthreads();
}

__device__ __forceinline__ void rowsq_pass(const bf16_t* P, float* rsq_out) {
    const int tid = TID(), lane = tid & 63, wave = tid >> 6;
    for (int base = (blockIdx.x * 8 + wave) * 4; base < M; base += gridDim.x * 8 * 4) {
        u32x4 v[4][2];
#pragma unroll
        for (int i = 0; i < 4; ++i) { const u32x4* pr = (const u32x4*)(P + (size_t)(base + i) * DM) + lane; v[i][0] = pr[0]; v[i][1] = pr[64]; }
#pragma unroll
        for (int i = 0; i < 4; ++i) {
            float s = 0.f;
#pragma unroll
            for (int h2 = 0; h2 < 2; ++h2) { const u32x4 w = v[i][h2];
                s += (bflo(w.x) * bflo(w.x) + bfhi(w.x) * bfhi(w.x)) + (bflo(w.y) * bflo(w.y) + bfhi(w.y) * bfhi(w.y)) + (bflo(w.z) * bflo(w.z) + bfhi(w.z) * bfhi(w.z)) + (bflo(w.w) * bflo(w.w) + bfhi(w.w) * bfhi(w.w)); }
#pragma unroll
            for (int o = 1; o < 64; o <<= 1) s += __shfl_xor(s, o);
            if (lane < 16) rsq_out[(size_t)(base + i) * 16 + lane] = (lane == 0) ? s : 0.f;
        }
    }
}

__device__ __forceinline__ int next_task(unsigned* ctr, LAS int* slot) {
    __syncthreads();
    if (TID() == 0) *slot = (int)atomicAdd(ctr, 1u);
    __syncthreads();
    return *slot;
}

__device__ __forceinline__ int colmap(int mode, int n) {
    if (mode == 1) return 256 * (n >> 7) + (n & 127);
    if (mode == 2) return 256 * (n >> 7) + 128 + (n & 127);
    if (mode == 3) return n < 1152 ? n : (n < 1170 ? 3456 + (n - 1152) : n - 18);
    return n;
}
__device__ __forceinline__ void conv_item(const float* W, int K, int N, bf16_t* WT, const float* gain, int mode, LAS float* scr, int item, int lane) {
    const int nblk = (N + 31) >> 5, kb = item / nblk, nb = item % nblk, k0 = 64 * kb, n0 = 32 * nb;
#pragma unroll 16
    for (int i = 0; i < 32; ++i) {
        const int kk = 2 * i + (lane >> 5), n = n0 + (lane & 31);
        float v = (n < N) ? W[(size_t)(k0 + kk) * N + n] : 0.f;
        if (gain) v *= gain[k0 + kk];
        scr[kk * 33 + (lane & 31)] = v;
    }
    LDSW();
    const int c = lane & 7;
#pragma unroll
    for (int j = 0; j < 4; ++j) {
        const int nl = (lane >> 3) + 8 * j, n = n0 + nl;
        const LAS float* s = scr + (8 * c) * 33 + nl;
        u32x4 o; o.x = pk2(s[0], s[33]); o.y = pk2(s[2 * 33], s[3 * 33]); o.z = pk2(s[4 * 33], s[5 * 33]); o.w = pk2(s[6 * 33], s[7 * 33]);
        if (n < N) *(u32x4*)(WT + (size_t)colmap(mode, n) * K + k0 + 8 * c) = o;
    }
    LDSW();
}

__device__ __forceinline__ void phase_convert(const float* const* in, unsigned char* ws, float* out, int L, LAS unsigned char* lds) {
    const int tid = TID(), lane = tid & 63, wave = tid >> 6;
    const int gw = blockIdx.x * 8 + wave, NGW = gridDim.x * 8;
    LAS float* scr = (LAS float*)(lds + wave * 8704);
    unsigned char* wb = ws + WS_W;
    const size_t ffo = (size_t)L * DM * FF;
    constexpr int IT_GU = (DM / 64) * (FF / 32), IT_D = (FF / 64) * (DM / 32), IT_IN = (DM / 64) * ((INW + 31) / 32), IT_SQ = (DM / 64) * (DM / 32),
                  IT_PP = (PLE / 64) * (DM / 32), IT_W1 = (2048 / 64) * (256 / 32), IT_W2 = (256 / 64) * (64 / 32);
    constexpr int total = 4 * IT_GU + 2 * IT_D + IT_IN + 2 * IT_SQ + IT_PP + 2 * IT_W1 + 2 * IT_W2;
    for (int it = gw; it < total; it += NGW) {
        const float* W = nullptr; int K = 0, N = 0; bf16_t* WT = nullptr; const float* gain = nullptr; int mode = 0, rr = -1, r = it;
#define JOB(Wp, Kk, Nn, WTp, gp, md, items) { if (rr < 0 && r < (items)) { W = (Wp); K = (Kk); N = (Nn); WT = (bf16_t*)(WTp); gain = (gp); mode = (md); rr = r; } r -= (items); }
        JOB(inp(I_F1G) + ffo, DM, FF, wb + W_GU1, inp(I_F1N) + L * DM, 1, IT_GU)
        JOB(inp(I_F1U) + ffo, DM, FF, wb + W_GU1, inp(I_F1N) + L * DM, 2, IT_GU)
        JOB(inp(I_F1D) + ffo, FF, DM, wb + W_D1, nullptr, 0, IT_D)
        JOB(inp(I_F2G) + ffo, DM, FF, wb + W_GU2, inp(I_F2N) + L * DM, 1, IT_GU)
        JOB(inp(I_F2U) + ffo, DM, FF, wb + W_GU2, inp(I_F2N) + L * DM, 2, IT_GU)
        JOB(inp(I_F2D) + ffo, FF, DM, wb + W_D2, nullptr, 0, IT_D)
        JOB(inp(I_WIN) + (size_t)L * DM * INW, DM, INW, wb + W_IN, inp(I_MIXN) + L * DM, 3, IT_IN)
        JOB(inp(I_WOUT) + (size_t)L * DM * DM, DM, DM, wb + W_OUT, nullptr, 0, IT_SQ)
        JOB(inp(I_PLG) + (size_t)L * DM * DM, DM, DM, wb + W_PG, inp(I_PLN) + L * DM, 0, IT_SQ)
        JOB(inp(I_PLP) + (size_t)L * PLE * DM, PLE, DM, wb + W_PP, nullptr, 0, IT_PP)
        JOB(inp(I_CW1) + (size_t)(L * 2 + 0) * 2048 * 256, 2048, 256, wb + W_1T, nullptr, 0, IT_W1)
        JOB(inp(I_CW1) + (size_t)(L * 2 + 1) * 2048 * 256, 2048, 256, wb + W_1T + 256 * 2048 * 2, nullptr, 0, IT_W1)
        JOB(inp(I_CW2) + (size_t)(L * 2 + 0) * 256 * 64, 256, 64, wb + W_2T, nullptr, 0, IT_W2)
        JOB(inp(I_CW2) + (size_t)(L * 2 + 1) * 256 * 64, 256, 64, wb + W_2T + 64 * 256 * 2, nullptr, 0, IT_W2)
#undef JOB
        conv_item(W, K, N, WT, gain, mode, scr, rr, lane);
    }
    {
        u32x4* z = (u32x4*)((bf16_t*)(wb + W_IN) + (size_t)INW * DM);
        const int n16 = (ZW - INW) * DM / 8;
        for (int i = blockIdx.x * 512 + tid; i < n16; i += gridDim.x * 512) z[i] = (u32x4){0u, 0u, 0u, 0u};
    }
    {
        const f32x4* src = (const f32x4*)(inp(I_P) + (size_t)L * M * PLE); u32x4* dst = (u32x4*)(ws + WS_PB);
        const int n8 = M * PLE / 8;
        for (int i = blockIdx.x * 512 + tid; i < n8; i += gridDim.x * 512) {
            const f32x4 a = src[2 * i], b = src[2 * i + 1];
            u32x4 w; w.x = pk2(a[0], a[1]); w.y = pk2(a[2], a[3]); w.z = pk2(b[0], b[1]); w.w = pk2(b[2], b[3]); dst[i] = w;
        }
    }
    if (gw < 64) {
        const int ty = gw >> 5, ng = (gw >> 3) & 3, ks = gw & 7, n = ng * 64 + lane;
        const float* w1 = inp(I_CW1) + (size_t)(L * 2 + ty) * 2048 * 256; const float* pos = inp(I_CPOS) + (size_t)(L * 2 + ty) * 2048;
        float acc = 0.f;
#pragma unroll 16
        for (int k = ks * 256; k < ks * 256 + 256; ++k) acc += pos[k] * w1[(size_t)k * 256 + n];
        ((float*)(wb + W_POSB))[(ty * 8 + ks) * 256 + n] = acc;
    }
    if (L == 0) {
        const float* x = inp(I_X); bf16_t* xb = (bf16_t*)(ws + WS_XB); float* rsq = (float*)(ws + WS_RSQ0);
        for (int m = gw; m < M; m += NGW) {
            const f32x4* xr = (const f32x4*)(x + (size_t)m * DM) + lane; f32x4* orow = (f32x4*)(out + (size_t)m * DM) + lane;
            u32x2* xbr = (u32x2*)(xb + (size_t)m * DM) + lane;
            float s = 0.f;
#pragma unroll
            for (int j = 0; j < 4; ++j) { const f32x4 v = xr[64 * j]; orow[64 * j] = v; u32x2 w; w.x = pk2(v[0], v[1]); w.y = pk2(v[2], v[3]); xbr[64 * j] = w; s += (v[0] * v[0] + v[1] * v[1]) + (v[2] * v[2] + v[3] * v[3]); }
#pragma unroll
            for (int o = 1; o < 64; o <<= 1) s += __shfl_xor(s, o);
            if (lane < 16) rsq[(size_t)m * 16 + lane] = (lane == 0) ? s : 0.f;
        }
    }
}

__device__ __forceinline__ void task_prep(const float* const* in, unsigned char* ws, int L, int tile, LAS unsigned char* lds) {
    const int tid = TID(), lane = tid & 63, wave = tid >> 6;
    bf16_t* z = (bf16_t*)(ws + WS_R1);
    const int row0 = tile * 64;
#pragma unroll
    for (int pass = 0; pass < 3; ++pass) {
        const int seg = pass * 64 + lane;
        int col = 0, gs = 8; const float* gp = inp(I_NQN); float scale = 1.f;
        if (seg < 48) { col = C_NQ + 8 * seg; gp = inp(I_NQN) + L * 64 + ((8 * seg) & 63); scale = 0.125f * LOG2E; }
        else if (seg < 64) { col = C_SK + 8 * (seg - 48); gp = inp(I_NKN) + (L * 3 + 1) * 64 + ((8 * seg) & 63); }
        else if (seg < 80) { col = C_WK + 8 * (seg - 64); gp = inp(I_NKN) + (L * 3 + 2) * 64 + ((8 * seg) & 63); }
        else if (seg < 112) { col = C_DQ + 8 * (seg - 80); gp = inp(I_DQN) + L * 32 + ((8 * seg) & 31); gs = 4; scale = 0.17677669529663689f * LOG2E; }
        else { col = C_DK + 8 * (seg - 112); gp = inp(I_DKN) + L * 32 + ((8 * seg) & 31); gs = 4; }
        const bool act = seg < 144;
        if (!act) { col = 0; }
        const f32x4 g0 = *(const f32x4*)gp, g1 = *(const f32x4*)(gp + 4);
        u32x4 w[8];
#pragma unroll
        for (int i = 0; i < 8; ++i) w[i] = *(const u32x4*)(z + (size_t)(row0 + wave + 8 * i) * ZW + col);
#pragma unroll
        for (int i = 0; i < 8; ++i) {
            float v[8] = {bflo(w[i].x), bfhi(w[i].x), bflo(w[i].y), bfhi(w[i].y), bflo(w[i].z), bfhi(w[i].z), bflo(w[i].w), bfhi(w[i].w)};
            float ss = 0.f;
#pragma unroll
            for (int e2 = 0; e2 < 8; ++e2) ss += v[e2] * v[e2];
            ss += __shfl_xor(ss, 1); ss += __shfl_xor(ss, 2);
            const float t4 = __shfl_xor(ss, 4); if (gs == 8) ss += t4;
            const float r = rsqrtf(ss / (float)(gs * 8) + EPS) * scale;
            u32x4 o; o.x = pk2(v[0] * r * g0[0], v[1] * r * g0[1]); o.y = pk2(v[2] * r * g0[2], v[3] * r * g0[3]);
            o.z = pk2(v[4] * r * g1[0], v[5] * r * g1[1]); o.w = pk2(v[6] * r * g1[2], v[7] * r * g1[3]);
            if (act) *(u32x4*)(z + (size_t)(row0 + wave + 8 * i) * ZW + col) = o;
        }
    }
    LAS bf16_t* tl = (LAS bf16_t*)lds;
#pragma unroll
    for (int i = 0; i < 8; ++i) {
        const int id = i * 512 + tid, row = id >> 6, ch = id & 63;
        const int col = ch < 16 ? C_SV + 8 * ch : (ch < 32 ? C_WV + 8 * (ch - 16) : C_DV + 8 * (ch - 32));
        *(LAS u32x4*)(tl + row * 520 + 8 * ch) = *(const u32x4*)(z + (size_t)(row0 + row) * ZW + col);
    }
    __syncthreads();
    const int b = row0 / T, t0 = row0 % T;
    bf16_t* vt = (bf16_t*)(ws + WS_VT);
#pragma unroll
    for (int i = 0; i < 8; ++i) {
        const int orow = tid, tch = i;
        const LAS bf16_t* s = tl + (tch * 8) * 520 + orow;
        u32x4 o;
        o.x = (unsigned)s[0] | ((unsigned)s[520] << 16); o.y = (unsigned)s[2 * 520] | ((unsigned)s[3 * 520] << 16);
        o.z = (unsigned)s[4 * 520] | ((unsigned)s[5 * 520] << 16); o.w = (unsigned)s[6 * 520] | ((unsigned)s[7 * 520] << 16);
        *(u32x4*)(vt + ((size_t)(b * 8) * 64 + orow) * T + t0 + 8 * tch) = o;
    }
}

__device__ __forceinline__ float gelu_tanh(float x) {
    const float y = 0.7978845608028654f * (x + 0.044715f * x * x * x);
    const float th = 1.0f - 2.0f / (1.0f + __expf(2.0f * y));
    return 0.5f * x * (1.0f + th);
}
__device__ __forceinline__ void task_compress(const float* const* in, unsigned char* ws, int L, int task, LAS unsigned char* lds) {
    const int tid = TID(), lane = tid & 63, wave = tid >> 6;
    const int ty = task >> 8, b = (task >> 6) & 3, g = (task >> 5) & 1, i0 = (task & 31) * 16;
    const bf16_t* z = (const bf16_t*)(ws + WS_R1);
    LAS bf16_t* zt = (LAS bf16_t*)lds;
    LAS bf16_t* hid = (LAS bf16_t*)(lds + 39168);
    LAS float* ofp = (LAS float*)(lds + 39168 + 8448);
    const int ccol = (ty ? C_CV : C_CK) + 64 * g;
    for (int id = tid; id < 272 * 8; id += 512) {
        const int row = id >> 3, ch = id & 7, tok = 16 * i0 + row;
        u32x4 v = (u32x4){0u, 0u, 0u, 0u};
        if (tok < T) v = *(const u32x4*)(z + (size_t)(b * T + tok) * ZW + ccol + 8 * ch);
        *(LAS u32x4*)(zt + row * 72 + 8 * ch) = v;
    }
    __syncthreads();
    const bf16_t* w1t = (const bf16_t*)(ws + WS_W + W_1T) + (size_t)ty * 256 * 2048;
    const bf16_t* w2t = (const bf16_t*)(ws + WS_W + W_2T) + (size_t)ty * 64 * 256;
    const float* posb = (const float*)(ws + WS_W + W_POSB) + ty * 8 * 256;
    const int r16 = lane & 15, kq = lane >> 4;
    f32x4 acc[2] = {(f32x4){0.f, 0.f, 0.f, 0.f}, (f32x4){0.f, 0.f, 0.f, 0.f}};
    const bf16_t* b0p = w1t + (size_t)(16 * (2 * wave) + r16) * 2048 + 8 * kq;
    const bf16_t* b1p = b0p + 16 * 2048;
#pragma unroll 8
    for (int kc = 0; kc < 64; ++kc) {
        const bf16x8 a = *(const LAS bf16x8*)(zt + (16 * r16 + (kc >> 1)) * 72 + (kc & 1) * 32 + 8 * kq);
        const bf16x8 w0 = *(const bf16x8*)(b0p + 32 * kc), w1 = *(const bf16x8*)(b1p + 32 * kc);
        acc[0] = mfma16(a, w0, acc[0]); acc[1] = mfma16(a, w1, acc[1]);
    }
#pragma unroll
    for (int j = 0; j < 2; ++j) {
        const int n = 16 * (2 * wave + j) + r16;
        float pbias = 0.f;
#pragma unroll
        for (int ks = 0; ks < 8; ++ks) pbias += posb[ks * 256 + n];
#pragma unroll
        for (int i = 0; i < 4; ++i) hid[(4 * kq + i) * 264 + n] = f2bf(gelu_tanh(acc[j][i] + pbias));
    }
    __syncthreads();
    if (wave < 4) {
        f32x4 a2 = (f32x4){0.f, 0.f, 0.f, 0.f};
        const bf16_t* bp = w2t + (size_t)(16 * wave + r16) * 256 + 8 * kq;
#pragma unroll
        for (int kc = 0; kc < 8; ++kc) {
            const bf16x8 a = *(const LAS bf16x8*)(hid + r16 * 264 + 32 * kc + 8 * kq);
            const bf16x8 w = *(const bf16x8*)(bp + 32 * kc);
            a2 = mfma16(a, w, a2);
        }
#pragma unroll
        for (int i = 0; i < 4; ++i) ofp[(4 * kq + i) * 64 + 16 * wave + r16] = a2[i];
    }
    __syncthreads();
    if (tid < 256) {
        const int row = tid >> 4, c4 = (tid & 15) * 4, i = i0 + row;
        f32x4 o = *(const LAS f32x4*)(ofp + row * 64 + c4);
        float ss = (o[0] * o[0] + o[1] * o[1]) + (o[2] * o[2] + o[3] * o[3]);
        ss += __shfl_xor(ss, 1); ss += __shfl_xor(ss, 2); ss += __shfl_xor(ss, 4); ss += __shfl_xor(ss, 8);
        if (ty == 0) {
            const float r = rsqrtf(ss * (1.0f / 64.0f) + EPS);
            const f32x4 gn = *(const f32x4*)(inp(I_NKN) + (L * 3 + 0) * 64 + c4);
            o = o * r * gn;
        }
        if (i >= 511) o = (f32x4){0.f, 0.f, 0.f, 0.f};
        if (ty == 0) {
            u32x2 w; w.x = pk2(o[0], o[1]); w.y = pk2(o[2], o[3]);
            *(u32x2*)((bf16_t*)(ws + WS_KC) + ((size_t)(b * 2 + g) * 512 + i) * 64 + c4) = w;
        } else {
            bf16_t* vct = (bf16_t*)(ws + WS_VCT) + (size_t)(b * 2 + g) * 64 * 512;
#pragma unroll
            for (int e = 0; e < 4; ++e) vct[(size_t)(c4 + e) * 512 + i] = f2bf(o[e]);
        }
    }
}

__device__ __forceinline__ float hgrn_lb(const float* logits, int L, int j) {
    if (L == 0) return 0.f;
    const float a0 = logits[j], a1 = logits[384 + j], a2 = logits[768 + j], a3 = logits[1152 + j];
    const float mx = fmaxf(fmaxf(a0, a1), fmaxf(a2, a3));
    const float e0 = __expf(a0 - mx), e1 = __expf(a1 - mx), e2 = __expf(a2 - mx), e3 = __expf(a3 - mx);
    const float inv = 1.0f / (e0 + e1 + e2 + e3);
    float s = e1; if (L >= 2) s += e2; if (L >= 3) s += e3;
    return s * inv;
}
__device__ __forceinline__ void task_hgrn_local(const float* const* in, unsigned char* ws, int L, int task, LAS unsigned char* lds) {
    const int tid = TID(), lane = tid & 63, wave = tid >> 6;
    if (wave < 6) {
        const int chunk = task * 6 + wave;
        const int bh = chunk >> 7, c = chunk & 127, b = bh / 6, h = bh % 6;
        const bf16_t* z = (const bf16_t*)(ws + WS_R1) + (size_t)(b * T + c * 64) * ZW;
        LAS bf16_t* klT = (LAS bf16_t*)(lds + wave * 18432);
        LAS bf16_t* vT = klT + 64 * 72;
        const float lb = hgrn_lb(inp(I_LBLOG), L, h * 64 + lane);
        LAS bf16_t* rawf = klT;
        (void)rawf;
        u32x4 rf[8], ri[8];
#pragma unroll
        for (int i = 0; i < 8; ++i) {
            const int row = (lane >> 3) + 8 * i, ch = lane & 7;
            rf[i] = *(const u32x4*)(z + (size_t)row * ZW + C_HF + 64 * h + 8 * ch);
            ri[i] = *(const u32x4*)(z + (size_t)row * ZW + C_HI + 64 * h + 8 * ch);
        }
#pragma unroll
        for (int i = 0; i < 8; ++i) {
            const int row = (lane >> 3) + 8 * i, ch = lane & 7;
            *(LAS u32x4*)(klT + row * 72 + 8 * ch) = rf[i];
            *(LAS u32x4*)(vT + row * 72 + 8 * ch) = ri[i];
        }
        LDSW();
        float suffix = 0.f;
        bf16_t colf[64], colv[64];
#pragma unroll
        for (int s2 = 0; s2 < 64; ++s2) { colf[s2] = klT[s2 * 72 + lane]; colv[s2] = vT[s2 * 72 + lane]; }
        LDSW();
#pragma unroll
        for (int s = 63; s >= 0; --s) {
            const float fr = bf2f(colf[s]);
            const float sg = sigmoidf_(fr);
            const float f = lb + (1.0f - lb) * sg;
            const float ig = (1.0f - lb) * (1.0f - sg);
            klT[lane * 72 + s] = f2bf(ig * __expf(suffix));
            vT[lane * 72 + s] = colv[s];
            suffix += __logf(f);
        }
        ((float*)(ws + WS_HD))[(size_t)chunk * 64 + lane] = __expf(suffix);
        LDSW();
        const int r32 = lane & 31, hi = lane >> 5;
        float* hs = (float*)(ws + WS_HS) + (size_t)chunk * 4096;
#pragma unroll
        for (int kb = 0; kb < 2; ++kb)
#pragma unroll
            for (int vb = 0; vb < 2; ++vb) {
                f32x16 cacc = {};
#pragma unroll
                for (int cc = 0; cc < 4; ++cc) {
                    const bf16x8 a = *(const LAS bf16x8*)(klT + (32 * kb + r32) * 72 + 16 * cc + 8 * hi);
                    const bf16x8 bb = *(const LAS bf16x8*)(vT + (32 * vb + r32) * 72 + 16 * cc + 8 * hi);
                    cacc = mfma32(a, bb, cacc);
                }
#pragma unroll
                for (int r = 0; r < 16; ++r) hs[(32 * kb + crow(r, hi)) * 64 + 32 * vb + r32] = cacc[r];
            }
    }
}
__device__ __forceinline__ void task_hgrn_scan(unsigned char* ws, int task) {
    const int tid = TID();
    const int bh = task >> 3, k = (task & 7) * 8 + (tid >> 6), v = tid & 63;
    float* hs = (float*)(ws + WS_HS) + (size_t)bh * 128 * 4096 + k * 64 + v;
    const float* hd = (const float*)(ws + WS_HD) + (size_t)bh * 128 * 64 + k;
    float S = 0.f;
#pragma unroll 16
    for (int c = 0; c < 128; ++c) {
        const float a = hs[(size_t)c * 4096], d = hd[c * 64];
        hs[(size_t)c * 4096] = S;
        S = d * S + a;
    }
}
__device__ __forceinline__ void task_hgrn_out(const float* const* in, unsigned char* ws, int L, int task, LAS unsigned char* lds) {
    const int tid = TID(), lane = tid & 63, wave = tid >> 6;
    if (wave < 3) {
        const int chunk = task * 3 + wave;
        const int bh = chunk >> 7, c = chunk & 127, b = bh / 6, h = bh % 6;
        const size_t row0 = (size_t)(b * T + c * 64);
        const bf16_t* z = (const bf16_t*)(ws + WS_R1) + row0 * ZW;
        LAS bf16_t* ke = (LAS bf16_t*)(lds + wave * 36864);
        LAS bf16_t* qe = ke + 64 * 72;
        LAS bf16_t* vT = qe + 64 * 72;
        LAS bf16_t* sT = vT + 64 * 72;
        const float lb = hgrn_lb(inp(I_LBLOG), L, h * 64 + lane);
        {
            u32x4 rq[8], rf[8], ri[8];
#pragma unroll
            for (int i = 0; i < 8; ++i) {
                const int row = (lane >> 3) + 8 * i, ch = lane & 7;
                rq[i] = *(const u32x4*)(z + (size_t)row * ZW + C_HQ + 64 * h + 8 * ch);
                rf[i] = *(const u32x4*)(z + (size_t)row * ZW + C_HF + 64 * h + 8 * ch);
                ri[i] = *(const u32x4*)(z + (size_t)row * ZW + C_HI + 64 * h + 8 * ch);
            }
#pragma unroll
            for (int i = 0; i < 8; ++i) {
                const int row = (lane >> 3) + 8 * i, ch = lane & 7;
                *(LAS u32x4*)(qe + row * 72 + 8 * ch) = rq[i];
                *(LAS u32x4*)(ke + row * 72 + 8 * ch) = rf[i];
                *(LAS u32x4*)(sT + row * 72 + 8 * ch) = ri[i];
            }
        }
        LDSW();
        float ref = 0.f;
#pragma unroll 8
        for (int s = 0; s < 32; ++s) {
            const float fr = bf2f(ke[s * 72 + lane]);
            ref += __logf(lb + (1.0f - lb) * sigmoidf_(fr));
        }
        float cum = 0.f;
#pragma unroll 8
        for (int s = 0; s < 64; ++s) {
            const float fr = bf2f(ke[s * 72 + lane]);
            const float qv = bf2f(qe[s * 72 + lane]);
            const bf16_t vraw = sT[s * 72 + lane];
            const float sg = sigmoidf_(fr);
            const float f = lb + (1.0f - lb) * sg;
            const float ig = (1.0f - lb) * (1.0f - sg);
            cum += __logf(f);
            qe[s * 72 + lane] = f2bf(qv * sigmoidf_(qv) * __expf(cum - ref));
            ke[s * 72 + lane] = f2bf(ig * __expf(ref - cum));
            vT[lane * 72 + s] = vraw;
        }
        LDSW();
        const float* hs = (const float*)(ws + WS_HS) + (size_t)chunk * 4096;
        const float eref = __expf(ref);
        {
            f32x4 hv[16];
#pragma unroll
            for (int i = 0; i < 16; ++i) hv[i] = *(const f32x4*)(hs + ((lane >> 4) + 4 * i) * 64 + (lane & 15) * 4);
#pragma unroll
            for (int i = 0; i < 16; ++i) {
                const int k = (lane >> 4) + 4 * i, v4 = (lane & 15) * 4;
                const float er = __shfl(eref, k);
                sT[(v4 + 0) * 72 + k] = f2bf(hv[i][0] * er); sT[(v4 + 1) * 72 + k] = f2bf(hv[i][1] * er);
                sT[(v4 + 2) * 72 + k] = f2bf(hv[i][2] * er); sT[(v4 + 3) * 72 + k] = f2bf(hv[i][3] * er);
            }
        }
        LDSW();
        const int r32 = lane & 31, hi = lane >> 5;
        f32x16 O[2][2] = {};
#pragma unroll
        for (int tb = 0; tb < 2; ++tb) {
            bf16x8 qf[4];
#pragma unroll
            for (int cc = 0; cc < 4; ++cc) qf[cc] = *(const LAS bf16x8*)(qe + (32 * tb + r32) * 72 + 16 * cc + 8 * hi);
#pragma unroll
            for (int vb = 0; vb < 2; ++vb)
#pragma unroll
                for (int cc = 0; cc < 4; ++cc) {
                    const bf16x8 a = *(const LAS bf16x8*)(sT + (32 * vb + r32) * 72 + 16 * cc + 8 * hi);
                    O[vb][tb] = mfma32(a, qf[cc], O[vb][tb]);
                }
#pragma unroll
            for (int sb = 0; sb <= tb; ++sb) {
                f32x16 sc = {};
#pragma unroll
                for (int cc = 0; cc < 4; ++cc) {
                    const bf16x8 a = *(const LAS bf16x8*)(ke + (32 * sb + r32) * 72 + 16 * cc + 8 * hi);
                    sc = mfma32(a, qf[cc], sc);
                }
                unsigned P[8];
#pragma unroll
                for (int j = 0; j < 8; ++j) {
                    float p0 = sc[2 * j], p1 = sc[2 * j + 1];
                    if (sb == tb) { if (crow(2 * j, hi) > r32) p0 = 0.f; if (crow(2 * j + 1, hi) > r32) p1 = 0.f; }
                    P[j] = pk2(p0, p1);
                }
#pragma unroll
                for (int vb = 0; vb < 2; ++vb)
#pragma unroll
                    for (int c2 = 0; c2 < 2; ++c2) {
                        const u32x2 a0 = *(const LAS u32x2*)(vT + (32 * vb + r32) * 72 + 32 * sb + 16 * c2 + 4 * hi);
                        const u32x2 a1 = *(const LAS u32x2*)(vT + (32 * vb + r32) * 72 + 32 * sb + 16 * c2 + 8 + 4 * hi);
                        const bf16x8 vf = as_bf16x8((u32x4){a0.x, a0.y, a1.x, a1.y});
                        const bf16x8 pf = as_bf16x8((u32x4){P[4 * c2], P[4 * c2 + 1], P[4 * c2 + 2], P[4 * c2 + 3]});
                        O[vb][tb] = mfma32(vf, pf, O[vb][tb]);
                    }
            }
        }
        LDSW();
        const float* on = inp(I_HON) + L * 64;
#pragma unroll
        for (int tb = 0; tb < 2; ++tb) {
            float ss = 0.f;
#pragma unroll
            for (int vb = 0; vb < 2; ++vb)
#pragma unroll
                for (int r = 0; r < 16; ++r) ss += O[vb][tb][r] * O[vb][tb][r];
            ss += __shfl_xor(ss, 32);
            const float rn = rsqrtf(ss * (1.0f / 64.0f) + EPS);
#pragma unroll
            for (int vb = 0; vb < 2; ++vb)
#pragma unroll
                for (int r = 0; r < 16; ++r) { const int v = 32 * vb + crow(r, hi); ke[(32 * tb + r32) * 72 + v] = f2bf(O[vb][tb][r] * rn * on[v]); }
        }
        LDSW();
        bf16_t* mixed = (bf16_t*)(ws + WS_MIX) + row0 * DM + 640 + 64 * h;
#pragma unroll
        for (int i = 0; i < 8; ++i) {
            const int t = i * 8 + (lane >> 3), ch = lane & 7;
            const u32x4 ov = *(const LAS u32x4*)(ke + t * 72 + 8 * ch);
            const u32x4 gv = *(const u32x4*)(z + (size_t)t * ZW + C_HG + 64 * h + 8 * ch);
            u32x4 w;
            { const float g0 = bflo(gv.x), g1 = bfhi(gv.x); w.x = pk2(bflo(ov.x) * g0 * sigmoidf_(g0), bfhi(ov.x) * g1 * sigmoidf_(g1)); }
            { const float g0 = bflo(gv.y), g1 = bfhi(gv.y); w.y = pk2(bflo(ov.y) * g0 * sigmoidf_(g0), bfhi(ov.y) * g1 * sigmoidf_(g1)); }
            { const float g0 = bflo(gv.z), g1 = bfhi(gv.z); w.z = pk2(bflo(ov.z) * g0 * sigmoidf_(g0), bfhi(ov.z) * g1 * sigmoidf_(g1)); }
            { const float g0 = bflo(gv.w), g1 = bfhi(gv.w); w.w = pk2(bflo(ov.w) * g0 * sigmoidf_(g0), bfhi(ov.w) * g1 * sigmoidf_(g1)); }
            *(u32x4*)(mixed + (size_t)t * DM + 8 * ch) = w;
        }
    }
}

constexpr int ATT_K = 0, ATT_V = 18432, ATT_LUT = 35840, ATT_STAGE = 36864;
__device__ __forceinline__ void build_lut(LAS float* lut, const float* rel_bias, int head) {
    const int d = TID();
    if (d <= 128) {
        int bk = d;
        if (d >= 16) { const int far = 16 + (int)(__logf((float)d * (1.0f / 16.0f)) / 2.0794415416798357f * 16.0f); bk = far < 31 ? far : 31; }
        lut[d] = rel_bias[bk * 10 + head] * LOG2E;
    }
}
template <int NMAP, bool HAS_SEL>
__device__ __forceinline__ void attn_pass(LAS unsigned char* lds, const bf16_t* Kth, size_t kts, const bf16_t* Vth, int m_lo, int m_hi,
                                          const bf16x8 (&qr)[4], int tq, int qw0, int win, const LAS float* lut, u32x4 selw,
                                          f32x16 (&O)[NMAP][2], float (&l)[NMAP]) {
    const int tid = TID(), lane = tid & 63, r32 = lane & 31, hi = lane >> 5;
    const float c31 = lut[128];
    u32x4 kreg = *(const u32x4*)(Kth + (size_t)m_lo * kts), vreg = *(const u32x4*)(Vth + (size_t)m_lo * 64);
    int buf = 0;
    for (int m = m_lo; m <= m_hi; ++m) {
        *(LAS u32x4*)(lds + ATT_K + buf * 9216 + (tid >> 3) * 144 + (tid & 7) * 16) = kreg;
        { LAS u32x2* vp = (LAS u32x2*)(lds + ATT_V + buf * 8704 + (tid >> 3) * 136 + (tid & 7) * 16); vp[0] = (u32x2){vreg.x, vreg.y}; vp[1] = (u32x2){vreg.z, vreg.w}; }
        __syncthreads();
        if (m < m_hi) { kreg = *(const u32x4*)(Kth + (size_t)(m + 1) * kts); vreg = *(const u32x4*)(Vth + (size_t)(m + 1) * 64); }
        const int k0 = 64 * m, dmin = qw0 - (k0 + 63), dmax = qw0 + 31 - k0;
        bool sel = true;
        if (HAS_SEL) { const unsigned w = m < 32 ? selw.x : (m < 64 ? selw.y : (m < 96 ? selw.z : selw.w)); sel = (w >> (m & 31)) & 1u; }
        bool active = dmax >= 0 && dmin < win;
        if (HAS_SEL) active = active && (__any(sel) != 0);
        if (active) {
            const bool fast = dmin >= 128 && dmax < win;
            const LAS unsigned char* Kb = lds + ATT_K + buf * 9216;
            const LAS unsigned char* Vb = lds + ATT_V + buf * 8704;
            unsigned P[NMAP][2][8];
#pragma unroll
            for (int kh2 = 0; kh2 < 2; ++kh2) {
                f32x16 S[NMAP];
#pragma unroll
                for (int mp = 0; mp < NMAP; ++mp) { const float ini = fast ? c31 : 0.f;
#pragma unroll
                    for (int r = 0; r < 16; ++r) S[mp][r] = ini; }
#pragma unroll
                for (int c = 0; c < 4; ++c) {
                    const bf16x8 kf = *(const LAS bf16x8*)(Kb + (32 * kh2 + r32) * 144 + (16 * c + 8 * hi) * 2);
                    const int mp = (NMAP == 2) ? (c >> 1) : 0;
                    S[mp] = mfma32(kf, qr[c], S[mp]);
                }
#pragma unroll
                for (int mp = 0; mp < NMAP; ++mp) {
                    float p[16];
                    if (fast) {
#pragma unroll
                        for (int r = 0; r < 16; ++r) { const float e = ex2(S[mp][r]); p[r] = sel ? e : 0.f; }
                    } else {
#pragma unroll
                        for (int r = 0; r < 16; ++r) {
                            const int d = tq - (k0 + 32 * kh2 + crow(r, hi));
                            const bool valid = sel && d >= 0 && d < win;
                            const int dc = d < 0 ? 0 : (d > 128 ? 128 : d);
                            const float e = ex2(S[mp][r] + lut[dc]);
                            p[r] = valid ? e : 0.f;
                        }
                    }
                    float s = 0.f;
#pragma unroll
                    for (int r = 0; r < 16; ++r) s += p[r];
                    l[mp] += s;
#pragma unroll
                    for (int j = 0; j < 8; ++j) P[mp][kh2][j] = pk2(p[2 * j], p[2 * j + 1]);
                }
            }
#pragma unroll
            for (int db = 0; db < 2; ++db)
#pragma unroll
                for (int cc = 0; cc < 4; ++cc) {
                    const u32x2 a0 = *(const LAS u32x2*)(Vb + (32 * db + r32) * 136 + (16 * cc + 4 * hi) * 2);
                    const u32x2 a1 = *(const LAS u32x2*)(Vb + (32 * db + r32) * 136 + (16 * cc + 8 + 4 * hi) * 2);
                    const bf16x8 vf = as_bf16x8((u32x4){a0.x, a0.y, a1.x, a1.y});
#pragma unroll
                    for (int mp = 0; mp < NMAP; ++mp) {
                        const bf16x8 pf = as_bf16x8((u32x4){P[mp][cc >> 1][4 * (cc & 1)], P[mp][cc >> 1][4 * (cc & 1) + 1], P[mp][cc >> 1][4 * (cc & 1) + 2], P[mp][cc >> 1][4 * (cc & 1) + 3]});
                        O[mp][db] = mfma32(vf, pf, O[mp][db]);
                    }
                }
        }
        buf ^= 1;
    }
    __syncthreads();
}
template <bool ADD>
__device__ __forceinline__ void store_ot(LAS unsigned char* stage, const float (&val)[2][16], bf16_t* dst, int ld, const bf16_t* addsrc = nullptr, int ldadd = 0) {
    const int lane = TID() & 63, r32 = lane & 31, hi = lane >> 5;
    LAS bf16_t* st = (LAS bf16_t*)stage;
#pragma unroll
    for (int db = 0; db < 2; ++db)
#pragma unroll
        for (int r = 0; r < 16; ++r) st[r32 * 72 + 32 * db + crow(r, hi)] = f2bf(val[db][r]);
    LDSW();
#pragma unroll
    for (int i = 0; i < 4; ++i) {
        const int row = i * 8 + (lane >> 3), ch = lane & 7;
        u32x4 v = *(const LAS u32x4*)(st + row * 72 + 8 * ch);
        bf16_t* gp = dst + (size_t)row * ld + 8 * ch;
        if (ADD) {
            const u32x4 o = *(const u32x4*)(addsrc + (size_t)row * ldadd + 8 * ch);
            v.x = pk2(bflo(v.x) + bflo(o.x), bfhi(v.x) + bfhi(o.x)); v.y = pk2(bflo(v.y) + bflo(o.y), bfhi(v.y) + bfhi(o.y));
            v.z = pk2(bflo(v.z) + bflo(o.z), bfhi(v.z) + bfhi(o.z)); v.w = pk2(bflo(v.w) + bflo(o.w), bfhi(v.w) + bfhi(o.w));
        }
        *(u32x4*)gp = v;
    }
    LDSW();
}

__device__ __forceinline__ void task_diff(const float* const* in, unsigned char* ws, int L, int task, LAS unsigned char* lds) {
    const int tid = TID(), lane = tid & 63, wave = tid >> 6, r32 = lane & 31, hi = lane >> 5;
    const int qb = 31 - (task >> 4), b = (task >> 2) & 3, hd = task & 3;
    const bf16_t* z = (const bf16_t*)(ws + WS_R1);
    LAS float* lut = (LAS float*)(lds + ATT_LUT);
    build_lut(lut, inp(I_RELB), 6 + hd);
    __syncthreads();
    const int q0 = 256 * qb, qw0 = q0 + 32 * wave, tq = qw0 + r32;
    bf16x8 qr[4];
#pragma unroll
    for (int c = 0; c < 4; ++c) qr[c] = *(const bf16x8*)(z + (size_t)(b * T + tq) * ZW + C_DQ + 64 * hd + 16 * c + 8 * hi);
    const bf16_t* Kth = z + (size_t)(b * T + (tid >> 3)) * ZW + C_DK + 64 * hd + (tid & 7) * 8;
    const bf16_t* Vth = (const bf16_t*)(ws + WS_VT) + ((size_t)(b * 8 + 4 + hd) * 64 + (tid >> 3)) * T + (tid & 7) * 8;
    f32x16 O[2][2] = {}; float l[2] = {0.f, 0.f};
    attn_pass<2, false>(lds, Kth, (size_t)64 * ZW, Vth, 0, 4 * qb + 3, qr, tq, qw0, 1 << 30, lut, (u32x4){0u, 0u, 0u, 0u}, O, l);
    const float* lp = inp(I_DLAM) + L * 128;
    float s01 = 0.f, s23 = 0.f;
#pragma unroll
    for (int i = 0; i < 32; ++i) { s01 += lp[i] * lp[32 + i]; s23 += lp[64 + i] * lp[96 + i]; }
    const float lam_init = 0.8f - 0.6f * __expf(-0.3f * (float)L);
    const float lam = __expf(s01) - __expf(s23) + lam_init;
    const float l0 = l[0] + __shfl_xor(l[0], 32), l1 = l[1] + __shfl_xor(l[1], 32);
    const float i0 = 1.0f / l0, i1 = lam / l1;
    float val[2][16]; float ss = 0.f;
#pragma unroll
    for (int db = 0; db < 2; ++db)
#pragma unroll
        for (int r = 0; r < 16; ++r) { const float o = O[0][db][r] * i0 - O[1][db][r] * i1; val[db][r] = o; ss += o * o; }
    ss += __shfl_xor(ss, 32);
    const float rn = rsqrtf(ss * (1.0f / 64.0f) + EPS) * (1.0f - lam_init);
    const float* sub = inp(I_DSUB) + L * 64;
#pragma unroll
    for (int db = 0; db < 2; ++db)
#pragma unroll
        for (int r = 0; r < 16; ++r) val[db][r] *= rn * sub[32 * db + crow(r, hi)];
    store_ot<false>(lds + ATT_STAGE + wave * 4608, val, (bf16_t*)(ws + WS_MIX) + (size_t)(b * T + qw0) * DM + 384 + 64 * hd, DM);
}

__device__ __forceinline__ void task_nsa_sw(const float* const* in, unsigned char* ws, int L, int task, LAS unsigned char* lds) {
    const int tid = TID(), lane = tid & 63, wave = tid >> 6, r32 = lane & 31, hi = lane >> 5;
    const int qb = 31 - task / 24, rem = task % 24, b = rem / 6, h = rem % 6, g = h / 3;
    const bf16_t* z = (const bf16_t*)(ws + WS_R1);
    LAS float* lut = (LAS float*)(lds + ATT_LUT);
    build_lut(lut, inp(I_RELB), h);
    __syncthreads();
    const int q0 = 256 * qb, qw0 = q0 + 32 * wave, tq = qw0 + r32;
    const bf16_t* zq = z + (size_t)(b * T + tq) * ZW;
    bf16x8 qr[4];
#pragma unroll
    for (int c = 0; c < 4; ++c) qr[c] = *(const bf16x8*)(zq + C_NQ + 64 * h + 16 * c + 8 * hi);
    const u32x4 selw = *(const u32x4*)((const unsigned*)(ws + WS_SELM) + ((size_t)(b * 2 + g) * T + tq) * 4);
    const float g1 = sigmoidf_(bf2f(zq[C_NG + 3 * h + 1])), g2 = sigmoidf_(bf2f(zq[C_NG + 3 * h + 2]));
    float val[2][16];
    {
        const bf16_t* Kth = z + (size_t)(b * T + (tid >> 3)) * ZW + C_SK + 64 * g + (tid & 7) * 8;
        const bf16_t* Vth = (const bf16_t*)(ws + WS_VT) + ((size_t)(b * 8 + g) * 64 + (tid >> 3)) * T + (tid & 7) * 8;
        f32x16 O[1][2] = {}; float l[1] = {0.f};
        attn_pass<1, true>(lds, Kth, (size_t)64 * ZW, Vth, 0, 4 * qb + 3, qr, tq, qw0, 1 << 30, lut, selw, O, l);
        const float lt = l[0] + __shfl_xor(l[0], 32), sc = g1 / lt;
#pragma unroll
        for (int db = 0; db < 2; ++db)
#pragma unroll
            for (int r = 0; r < 16; ++r) val[db][r] = O[0][db][r] * sc;
    }
    {
        const bf16_t* Kth = z + (size_t)(b * T + (tid >> 3)) * ZW + C_WK + 64 * g + (tid & 7) * 8;
        const bf16_t* Vth = (const bf16_t*)(ws + WS_VT) + ((size_t)(b * 8 + 2 + g) * 64 + (tid >> 3)) * T + (tid & 7) * 8;
        f32x16 O[1][2] = {}; float l[1] = {0.f};
        const int m_lo = q0 >= 512 ? (q0 >> 6) - 8 : 0;
        attn_pass<1, false>(lds, Kth, (size_t)64 * ZW, Vth, m_lo, 4 * qb + 3, qr, tq, qw0, 512, lut, (u32x4){0u, 0u, 0u, 0u}, O, l);
        const float lt = l[0] + __shfl_xor(l[0], 32), sc = g2 / lt;
#pragma unroll
        for (int db = 0; db < 2; ++db)
#pragma unroll
            for (int r = 0; r < 16; ++r) val[db][r] += O[0][db][r] * sc;
    }
    store_ot<true>(lds + ATT_STAGE + wave * 4608, val, (bf16_t*)(ws + WS_MIX) + (size_t)(b * T + qw0) * DM + 64 * h, DM, (const bf16_t*)(ws + WS_OCB) + (size_t)(b * T + qw0) * 384 + 64 * h, 384);
}

constexpr int NC_IMP = 18432, NC_IMPW = 129, NC_LINV = NC_IMP + 3 * 64 * NC_IMPW * 4;
__device__ __forceinline__ void task_nsa_c(const float* const* in, unsigned char* ws, int L, int task, LAS unsigned char* lds) {
    const int tid = TID(), lane = tid & 63, wave = tid >> 6, r32 = lane & 31, hi = lane >> 5;
    const int cur = 127 - (task >> 3), b = (task >> 1) & 3, g = task & 1;
    const bf16_t* z = (const bf16_t*)(ws + WS_R1);
    LAS float* imp = (LAS float*)(lds + NC_IMP);
    LAS float* linv = (LAS float*)(lds + NC_LINV);
    const int q0 = 64 * cur;
    const int rh = wave >> 1, half = wave & 1, h = 3 * g + (rh < 3 ? rh : 0);
    const int ql = 32 * half + r32, tq = q0 + ql;
    const bf16_t* zq = z + (size_t)(b * T + tq) * ZW;
    bf16x8 qr[4];
#pragma unroll
    for (int c = 0; c < 4; ++c) qr[c] = *(const bf16x8*)(zq + C_NQ + 64 * h + 16 * c + 8 * hi);
    const bf16_t* Kth = (const bf16_t*)(ws + WS_KC) + ((size_t)(b * 2 + g) * 512 + (tid >> 3)) * 64 + (tid & 7) * 8;
    const bf16_t* Vth = (const bf16_t*)(ws + WS_VCT) + ((size_t)(b * 2 + g) * 64 + (tid >> 3)) * 512 + (tid & 7) * 8;
    const int ntiles = ((4 * cur + 2) >> 6) + 1;
    f32x16 O[2] = {}; float l = 0.f, carry = 0.f;
    for (int m = 0; m < ntiles; ++m) {
        __syncthreads();
        *(LAS u32x4*)(lds + (tid >> 3) * 144 + (tid & 7) * 16) = *(const u32x4*)(Kth + (size_t)m * 64 * 64);
        { const u32x4 v = *(const u32x4*)(Vth + (size_t)m * 64); LAS u32x2* vp = (LAS u32x2*)(lds + 9216 + (tid >> 3) * 136 + (tid & 7) * 16); vp[0] = (u32x2){v.x, v.y}; vp[1] = (u32x2){v.z, v.w}; }
        __syncthreads();
        if (wave < 6) {
            unsigned P[2][8]; float av[8], bq[8];
#pragma unroll
            for (int kh2 = 0; kh2 < 2; ++kh2) {
                f32x16 S = {};
#pragma unroll
                for (int c = 0; c < 4; ++c) { const bf16x8 kf = *(const LAS bf16x8*)(lds + (32 * kh2 + r32) * 144 + (16 * c + 8 * hi) * 2); S = mfma32(kf, qr[c], S); }
                float p[16];
#pragma unroll
                for (int r = 0; r < 16; ++r) { const int n = 64 * m + 32 * kh2 + crow(r, hi); const float e = ex2(S[r]); p[r] = (16 * n + 31 <= tq) ? e : 0.f; }
                float s = 0.f;
#pragma unroll
                for (int r = 0; r < 16; ++r) s += p[r];
                l += s;
#pragma unroll
                for (int j = 0; j < 8; ++j) P[kh2][j] = pk2(p[2 * j], p[2 * j + 1]);
#pragma unroll
                for (int j = 0; j < 4; ++j) { av[4 * kh2 + j] = p[4 * j] + p[4 * j + 1] + p[4 * j + 2] + 0.5f * p[4 * j + 3]; bq[4 * kh2 + j] = 0.5f * p[4 * j + 3]; }
            }
#pragma unroll
            for (int db = 0; db < 2; ++db)
#pragma unroll
                for (int cc = 0; cc < 4; ++cc) {
                    const u32x2 a0 = *(const LAS u32x2*)(lds + 9216 + (32 * db + r32) * 136 + (16 * cc + 4 * hi) * 2);
                    const u32x2 a1 = *(const LAS u32x2*)(lds + 9216 + (32 * db + r32) * 136 + (16 * cc + 8 + 4 * hi) * 2);
                    const bf16x8 vf = as_bf16x8((u32x4){a0.x, a0.y, a1.x, a1.y});
                    const bf16x8 pf = as_bf16x8((u32x4){P[cc >> 1][4 * (cc & 1)], P[cc >> 1][4 * (cc & 1) + 1], P[cc >> 1][4 * (cc & 1) + 2], P[cc >> 1][4 * (cc & 1) + 3]});
                    O[db] = mfma32(vf, pf, O[db]);
                }
            float recv[8];
#pragma unroll
            for (int jj = 0; jj < 8; ++jj) recv[jj] = __shfl_xor(bq[jj], 32);
            LAS float* ip = imp + (rh * 64 + ql) * NC_IMPW + 16 * m + hi;
#pragma unroll
            for (int jj = 0; jj < 8; ++jj) {
                const float add = hi ? recv[jj] : (jj == 0 ? carry : recv[jj > 0 ? jj - 1 : 0]);
                ip[2 * jj] = av[jj] + add;
            }
            carry = recv[7];
        }
    }
    if (wave < 6) {
        const float lt = l + __shfl_xor(l, 32);
        const float li = (tq >= 31 && lt > 0.f) ? 1.0f / lt : 0.f;
        if (hi == 0) linv[rh * 64 + ql] = li;
        const float g0 = sigmoidf_(bf2f(zq[C_NG + 3 * h + 0]));
        bf16_t* mx = (bf16_t*)(ws + WS_OCB) + (size_t)(b * T + tq) * 384 + 64 * h;
        const float sc = li * g0;
#pragma unroll
        for (int db = 0; db < 2; ++db)
#pragma unroll
            for (int r = 0; r < 16; ++r) mx[32 * db + crow(r, hi)] = f2bf(O[db][r] * sc);
    }
    __syncthreads();
    for (int qi = 0; qi < 8; ++qi) {
        const int q = 8 * wave + qi;
        unsigned w0 = 0u, w1 = 0u, w2 = 0u, w3 = 0u;
        if (cur <= 15) { w0 = (1u << (cur + 1)) - 1u; }
        else {
            const float i0 = linv[q], i1 = linv[64 + q], i2 = linv[128 + q];
            const int ma = lane, mb = lane + 64;
            float va = 0.f, vb = 0.f;
            if (ma >= 1 && ma <= cur - 2) va = imp[(0 * 64 + q) * NC_IMPW + ma] * i0 + imp[(1 * 64 + q) * NC_IMPW + ma] * i1 + imp[(2 * 64 + q) * NC_IMPW + ma] * i2;
            if (mb <= cur - 2) vb = imp[(0 * 64 + q) * NC_IMPW + mb] * i0 + imp[(1 * 64 + q) * NC_IMPW + mb] * i1 + imp[(2 * 64 + q) * NC_IMPW + mb] * i2;
            unsigned long long mine_a = ((unsigned long long)__float_as_uint(va) << 32) | (unsigned)(255 - ma);
            unsigned long long mine_b = ((unsigned long long)__float_as_uint(vb) << 32) | (unsigned)(255 - mb);
            if (va <= 0.f) mine_a = 0ull;
            if (vb <= 0.f) mine_b = 0ull;
            unsigned long long sa = 0ull, sb = 0ull;
            for (int it = 0; it < 13; ++it) {
                unsigned long long best = mine_a > mine_b ? mine_a : mine_b;
#pragma unroll
                for (int o = 1; o < 64; o <<= 1) {
                    const unsigned oh = __shfl_xor((unsigned)(best >> 32), o), ol = __shfl_xor((unsigned)best, o);
                    const unsigned long long other = ((unsigned long long)oh << 32) | ol;
                    best = other > best ? other : best;
                }
                if (best != 0ull) {
                    const int mw = 255 - (int)(unsigned)(best & 0xffffffffull);
                    if (mw < 64) sa |= 1ull << mw; else sb |= 1ull << (mw - 64);
                    if (mine_a == best) mine_a = 0ull;
                    if (mine_b == best) mine_b = 0ull;
                }
            }
            sa |= 1ull;
            if (cur < 64) sa |= 1ull << cur; else sb |= 1ull << (cur - 64);
            if (cur - 1 < 64) sa |= 1ull << (cur - 1); else sb |= 1ull << (cur - 1 - 64);
            w0 = (unsigned)sa; w1 = (unsigned)(sa >> 32); w2 = (unsigned)sb; w3 = (unsigned)(sb >> 32);
        }
        if (lane == 0) *(u32x4*)((unsigned*)(ws + WS_SELM) + ((size_t)(b * 2 + g) * T + q0 + q) * 4) = (u32x4){w0, w1, w2, w3};
    }
}

#define XB_TMO      128
#define XB_XCNT(j)  (256  + 64 * (j))
#define XB_XSUB(j)  (1280 + 64 * (j))
#define XB_XGEN(j)  (2304 + 64 * (j))
#define XB_TOP      3328
#define XB_TOPGEN   3392
#define XCD_BAR_WORDS 3456
#define XB_SPIN_CAP (1u << 18)

__device__ __forceinline__ unsigned xb_ld(unsigned* p)              { return __hip_atomic_load(p, __ATOMIC_RELAXED, __HIP_MEMORY_SCOPE_AGENT); }
__device__ __forceinline__ unsigned xb_add(unsigned* p, unsigned v) { return __hip_atomic_fetch_add(p, v, __ATOMIC_RELAXED, __HIP_MEMORY_SCOPE_AGENT); }
__device__ __forceinline__ unsigned xb_xcc_id() { return (unsigned)__builtin_amdgcn_s_getreg((3 << 11) | 20) & 0xFu; }
#define XB_SPIN(cond, bar) do { unsigned _sp = 0; while (cond) { __builtin_amdgcn_s_sleep(1); \
    if ((++_sp & 255u) == 0u) { if (xb_ld(&(bar)[XB_TMO])) break; if (_sp > XB_SPIN_CAP) { atomicAdd(&(bar)[XB_TMO], 1u); break; } } } } while (0)

struct XcdBarrier {
    unsigned* bar; unsigned x;
    volatile LAS unsigned* st;
};

__device__ __forceinline__ XcdBarrier xcd_barrier_post(unsigned* bar, volatile LAS unsigned* st) {
    XcdBarrier b; b.bar = bar; b.x = xb_xcc_id(); b.st = st;
    if (threadIdx.x == 0) (void)xb_add(&bar[XB_XCNT(b.x)], 1u);
    return b;
}
__device__ __forceinline__ void xcd_barrier_complete(unsigned* bar, unsigned x, unsigned& nloc, unsigned& nx) {
    const unsigned G = gridDim.x * gridDim.y * gridDim.z;
    unsigned sum, cnt, mine, sp = 0u;
    for (;;) {
        sum = 0u; cnt = 0u; mine = 0u;
#pragma unroll
        for (unsigned j = 0; j < 16; ++j) { const unsigned c = xb_ld(&bar[XB_XCNT(j)]); sum += c; cnt += (c > 0u) ? 1u : 0u; mine = (j == x) ? c : mine; }
        if (sum == G) break;
        __builtin_amdgcn_s_sleep(1);
        if ((++sp & 255u) == 0u) { if (xb_ld(&bar[XB_TMO])) break; if (sp > XB_SPIN_CAP) { atomicAdd(&bar[XB_TMO], 1u); break; } }
    }
    nloc = mine > 0u ? mine : 1u; nx = cnt > 0u ? cnt : 1u;
}

__device__ __forceinline__ void xcd_barrier(const XcdBarrier& b) {
    asm volatile("s_waitcnt vmcnt(0)" ::: "memory");
    __syncthreads();
    if (threadIdx.x == 0) {
        unsigned* bar = b.bar;
        __builtin_amdgcn_s_waitcnt(0);
        unsigned nloc = b.st[0], nx = b.st[1];
        if (nloc == 0u) { xcd_barrier_complete(bar, b.x, nloc, nx); b.st[0] = nloc; b.st[1] = nx; }
        const unsigned old = xb_add(&bar[XB_XSUB(b.x)], 1u);
        const unsigned gen = old / nloc;
        if (old + 1u == (gen + 1u) * nloc) {
            __builtin_amdgcn_fence(__ATOMIC_RELEASE, "agent");
            asm volatile("s_waitcnt vmcnt(0)" ::: "memory");
            const unsigned og = xb_add(&bar[XB_TOP], 1u);
            const unsigned tg = og / nx;
            if (og + 1u == (tg + 1u) * nx) xb_add(&bar[XB_TOPGEN], 1u);
            else XB_SPIN(xb_ld(&bar[XB_TOPGEN]) == tg, bar);
            __builtin_amdgcn_fence(__ATOMIC_ACQUIRE, "agent");
            xb_add(&bar[XB_XGEN(b.x)], 1u);
            asm volatile("s_waitcnt vmcnt(0)" ::: "memory");
        } else {
            XB_SPIN(xb_ld(&bar[XB_XGEN(b.x)]) == gen, bar);
            __builtin_amdgcn_fence(__ATOMIC_ACQUIRE, "agent");
            asm volatile("s_waitcnt vmcnt(0)" ::: "memory");
        }
    }
    __syncthreads();
}

struct Args { const float* in[N_IN]; float* out; unsigned char* ws; int ph_lo, ph_hi; };
static_assert(sizeof(Args) == 8 * N_IN + 24, "Args has no padding");
constexpr int PH_PER_LAYER = 12, N_PHASES = DEPTH * PH_PER_LAYER;
#ifndef PH_HI
#define PH_HI N_PHASES
#endif

__global__ void __launch_bounds__(512) mega(Args a) {
    extern __shared__ __attribute__((aligned(16))) unsigned char lds_raw[];
    LAS unsigned char* lds = (LAS unsigned char*)lds_raw;
    LAS int* slot = (LAS int*)(lds + LDS_MISC);
    cg::grid_group grid = cg::this_grid();
    const float* const* in = nullptr;
    volatile LAS unsigned* misc = (volatile LAS unsigned*)(lds + LDS_MISC);
    if (TID() < 16) misc[TID()] = 0u;
    __syncthreads();
    (void)xcd_barrier_post((unsigned*)(a.ws + WS_CTL) + 4096, misc + 8);
#ifndef DUP_GU
#define DUP_GU 0
#endif
#ifndef DUP_IN
#define DUP_IN 0
#endif
#ifndef DUP_DIFF
#define DUP_DIFF 0
#endif
#ifndef DUP_NSAC
#define DUP_NSAC 0
#endif
#ifndef DUP_SW
#define DUP_SW 0
#endif
#ifndef DUP_HOUT
#define DUP_HOUT 0
#endif
#ifndef DUP_M1
#define DUP_M1 0
#endif
#ifndef DUP_SYNC
#define DUP_SYNC 0
#endif
#ifndef DUP_CONV
#define DUP_CONV 0
#endif
#ifndef PHM
#define PHM 0xfff
#endif
    for (int ph = a.ph_lo; ph < a.ph_hi; ++ph) {
        int L = ph / PH_PER_LAYER; const int j = ph - L * PH_PER_LAYER;
        asm volatile("" : "+s"(L));
        unsigned long long ws_ = (unsigned long long)a.ws; asm volatile("" : "+s"(ws_)); unsigned char* ws = (unsigned char*)(GAS unsigned char*)ws_;
        unsigned long long out_ = (unsigned long long)a.out; asm volatile("" : "+s"(out_)); float* out_g = (float*)(GAS float*)out_;
        unsigned* ctl = (unsigned*)(ws + WS_CTL); bf16_t* r1 = (bf16_t*)(ws + WS_R1); bf16_t* mixed = (bf16_t*)(ws + WS_MIX); bf16_t* pb = (bf16_t*)(ws + WS_PB); unsigned char* wb = ws + WS_W; float* rsqp = (float*)(ws + WS_RSQP);
        float* rsq = (float*)(ws + ((L & 1) ? WS_RSQ1 : WS_RSQ0)); float* rsq_next = (float*)(ws + ((L & 1) ? WS_RSQ0 : WS_RSQ1));
        bf16_t* xb = (bf16_t*)(ws + ((L & 1) ? WS_XB1 : WS_XB)); bf16_t* xb_next = (bf16_t*)(ws + ((L & 1) ? WS_XB : WS_XB1));
        if ((PHM >> j) & 1) switch (j) {
        case 0: phase_convert(in, ws, out_g, L, lds); if (DUP_CONV) { __syncthreads(); phase_convert(in, ws, out_g, L, lds); } break;
        case 1: { EpiSwiGLU E{r1, rsq}; run_gemm(lds, xb, (const bf16_t*)(wb + W_GU1), 2 * FF, DM, E); } break;
        case 2: { EpiRes<0> E{out_g, xb, rsq, 0.5f, nullptr, nullptr, nullptr, nullptr, nullptr}; run_gemm(lds, r1, (const bf16_t*)(wb + W_D1), DM, FF, E); } break;
        case 3: { EpiZ E{r1, rsq}; run_gemm(lds, xb, (const bf16_t*)(wb + W_IN), ZW, DM, E); } break;
        case 4: {
            unsigned* ctr = ctl + (L * 4 + 0) * 64;
            constexpr int NCMP = 512 << DUP_M1, NHL = 512 << DUP_M1;
            for (;;) { const int t = next_task(ctr, slot); if (t >= NCMP + NHL + 512) break;
                if (t < NCMP) task_compress(in, ws, L, t >> DUP_M1, lds); else if (t < NCMP + NHL) task_hgrn_local(in, ws, L, (t - NCMP) >> DUP_M1, lds); else task_prep(in, ws, L, t - NCMP - NHL, lds); }
        } break;
        case 5: {
            unsigned* ctr = ctl + (L * 4 + 1) * 64;
            constexpr int ND = 512 << DUP_DIFF, NC = 1024 << DUP_NSAC;
            for (;;) { const int t = next_task(ctr, slot); if (t >= 192 + ND + NC) break;
                if (t < 192) task_hgrn_scan(ws, t); else if (t < 192 + ND) task_diff(in, ws, L, (t - 192) >> DUP_DIFF, lds); else task_nsa_c(in, ws, L, (t - 192 - ND) >> DUP_NSAC, lds); }
        } break;
        case 6: {
            unsigned* ctr = ctl + (L * 4 + 2) * 64;
            constexpr int NS = 768 << DUP_SW, NH = 1024 << DUP_HOUT;
            for (;;) { const int t = next_task(ctr, slot); if (t >= NS + NH) break;
                if (t < NS) task_nsa_sw(in, ws, L, t >> DUP_SW, lds); else task_hgrn_out(in, ws, L, (t - NS) >> DUP_HOUT, lds); }
        } break;
        case 7: { EpiRes<0> E{out_g, xb, rsq, 1.0f, nullptr, nullptr, nullptr, nullptr, nullptr}; run_gemm(lds, mixed, (const bf16_t*)(wb + W_OUT), DM, DM, E); } break;
        case 8: { EpiSwiGLU E{r1, rsq}; run_gemm(lds, xb, (const bf16_t*)(wb + W_GU2), 2 * FF, DM, E); } break;
        case 9: { EpiRes<2> E{nullptr, nullptr, rsqp, 0.f, nullptr, nullptr, nullptr, nullptr, mixed}; run_gemm(lds, pb, (const bf16_t*)(wb + W_PP), DM, PLE, E); } break;
        case 10: { EpiRes<0> E{out_g, xb, rsq, 0.5f, nullptr, nullptr, nullptr, nullptr, nullptr}; run_gemm(lds, r1, (const bf16_t*)(wb + W_D2), DM, FF, E); } break;
        default: { EpiRes<1> E{out_g, xb_next, rsq_next, 0.f, rsq, mixed, rsqp, inp(I_PLPOST) + L * DM, nullptr}; run_gemm(lds, xb, (const bf16_t*)(wb + W_PG), DM, DM, E); } break;
        }
        if (ph + 1 < a.ph_hi) {
            if (ph == 0) { asm volatile("s_waitcnt vmcnt(0) lgkmcnt(0)" ::: "memory"); grid.sync(); __builtin_amdgcn_fence(__ATOMIC_ACQUIRE, "agent"); asm volatile("s_waitcnt vmcnt(0)" ::: "memory"); __syncthreads(); }
            else { XcdBarrier xb_; xb_.bar = (unsigned*)(ws + WS_CTL) + 4096; xb_.x = xb_xcc_id(); xb_.st = misc + 8; xcd_barrier(xb_); if (DUP_SYNC) xcd_barrier(xb_); }
        }
    }
}

#ifdef DUMPK
__global__ void __launch_bounds__(512) dump_kernel(float* out, unsigned char* ws) {
    bf16_t* mixed = (bf16_t*)(ws + WS_MIX); (void)mixed;
    for (size_t idx = (size_t)blockIdx.x * 512 + threadIdx.x; idx < (size_t)M * 1024; idx += (size_t)gridDim.x * 512) {
        const size_t m = idx >> 10; const int c = (int)(idx & 1023);
        float v = 0.f;
#if DUMPK == 3 || DUMPK == 40
        { const bf16_t* z = (const bf16_t*)(ws + WS_R1); v = bf2f(z[m * ZW + c]) + bf2f(z[m * ZW + 1024 + c]) + bf2f(z[m * ZW + 2048 + c]) + (c < 402 ? bf2f(z[m * ZW + 3072 + c]) : 0.f); }
#elif DUMPK == 41
        { const bf16_t* vt = (const bf16_t*)(ws + WS_VT); v = bf2f(vt[m * 512 + (c & 511)]); }
#elif DUMPK == 42
        { const float* hs = (const float*)(ws + WS_HS); const float* hd = (const float*)(ws + WS_HD); v = hs[m * 384 + (c % 384)] + hd[m * 6 + (c % 6)]; }
#elif DUMPK == 43
        { const bf16_t* kc = (const bf16_t*)(ws + WS_KC); const bf16_t* vct = (const bf16_t*)(ws + WS_VCT); v = bf2f(kc[m * 8 + (c & 7)]) + bf2f(vct[m * 8 + (c & 7)]); }
#elif DUMPK == 50 || DUMPK == 60
        v = (c < 384) ? bf2f(mixed[m * 1024 + c]) : 0.f;
#elif DUMPK == 51
        v = (c >= 384 && c < 640) ? bf2f(mixed[m * 1024 + c]) : 0.f;
#elif DUMPK == 52
        { const unsigned* selm = (const unsigned*)(ws + WS_SELM); v = (float)(selm[m * 8 + (c & 7)] & 0xffffu) + (float)(selm[m * 8 + (c & 7)] >> 16); }
#elif DUMPK == 53
        { const float* hs = (const float*)(ws + WS_HS); v = hs[m * 384 + (c % 384)]; }
#elif DUMPK == 61
        v = (c >= 640) ? bf2f(mixed[m * 1024 + c]) : 0.f;
#endif
        out[idx] = v;
    }
}
#endif

extern "C" void kernel_launch(void* const* d_in, const int* in_sizes, int n_in, void* d_out, int out_size, void* d_ws, size_t ws_size, hipStream_t stream) {
    static int grid = 0;
    if (grid == 0) {
        if (n_in != N_IN || out_size != M * DM || ws_size < WS_END) { fprintf(stderr, "kernel_launch: unexpected shapes (n_in %d out %d ws %zu)\n", n_in, out_size, ws_size); grid = -1; return; }
        int dev = 0, cus = 0, per_cu = 0;
        hipGetDevice(&dev); hipDeviceGetAttribute(&cus, hipDeviceAttributeMultiprocessorCount, dev);
        if (hipFuncSetAttribute((const void*)mega, hipFuncAttributeMaxDynamicSharedMemorySize, LDS_BYTES) != hipSuccess) { fprintf(stderr, "hipFuncSetAttribute failed\n"); }
        if (hipOccupancyMaxActiveBlocksPerMultiprocessor(&per_cu, (const void*)mega, 512, LDS_BYTES) != hipSuccess || per_cu < 1) { fprintf(stderr, "occupancy query: %d\n", per_cu); per_cu = 1; }
        (void)hipGetLastError();
        grid = cus;
    }
    if (grid < 0) return;
    hipMemsetAsync((char*)d_ws + WS_CTL, 0, 64 * 1024, stream);
    Args a{};
    for (int i = 0; i < N_IN; ++i) a.in[i] = (const float*)d_in[i];
    a.out = (float*)d_out; a.ws = (unsigned char*)d_ws; a.ph_lo = 0; a.ph_hi = PH_HI;
    void* args[] = {&a};
    hipError_t e = hipLaunchCooperativeKernel((const void*)mega, dim3(grid), dim3(512), args, LDS_BYTES, stream);
    if (e != hipSuccess) fprintf(stderr, "cooperative launch failed: %s (grid %d)\n", hipGetErrorString(e), grid);
#ifdef DUMPK
    dump_kernel<<<dim3(1024), dim3(512), 0, stream>>>((float*)d_out, (unsigned char*)d_ws);
#endif
}
```

```cpp
#include <hip/hip_runtime.h>
#include <hip/hip_cooperative_groups.h>
#include <cstdio>
#include <cstdint>
namespace cg = cooperative_groups;
__device__ __forceinline__ int TID() { int t = threadIdx.x; asm volatile("" : "+v"(t)); return t; }
namespace pg8 {
#define PG8_LAS __attribute__((address_space(3)))
typedef unsigned short bf16_t;
typedef short bf16x8 __attribute__((ext_vector_type(8)));
typedef float f32x4 __attribute__((ext_vector_type(4)));
typedef unsigned u32x4 __attribute__((ext_vector_type(4)));
constexpr int BM = 256, BK = 64, HALF = 128, HTB = HALF * BK * 2  , STAGE_BYTES = 8 * HTB, NXCD = 8, WGM = 8;

__host__ __device__ __forceinline__ int lds_byte(int r, int c) { const int st = (r >> 4) * 2 + (c >> 5), rr = r & 15, cc = c & 31, ob = rr * 64 + cc * 2; return st * 1024 + (ob ^ (((ob >> 9) & 1) << 5)); }
__host__ __device__ __forceinline__ void stage_rc(int b, int& R, int& C) { const int st = b / 1024, sb = b % 1024, swz = sb ^ (((sb >> 9) & 1) << 5); R = (st >> 1) * 16 + swz / 64; C = (st & 1) * 32 + (swz % 64) / 2; }
__host__ __device__ __forceinline__ int perm32(int rho) { const int n = rho >> 4, i = rho & 15; return 8 * (i >> 2) + 4 * n + (i & 3); }

struct Unit { int pm, pn; };
struct Gemm { const bf16_t* A; const bf16_t* Bt; int M, N, K; };

struct StaticOrder {
    int nM, nN, nwg, G, c;
    __host__ __device__ void init(int M, int N, int G_, int c_) { nM = M / BM; nN = N / BM; nwg = nM * nN; G = G_; c = c_; }
    __host__ __device__ bool next(int i, Unit& u) const {
        const long L = (long)i * G + c; if (L >= nwg) return false;
        int wgid = (int)L; { const int q = nwg / NXCD, r = nwg % NXCD, xcd = wgid % NXCD, off = wgid / NXCD; wgid = (xcd < r ? xcd * (q + 1) : r * (q + 1) + (xcd - r) * q) + off; }
        const int nig = WGM * nN, gid = wgid / nig, fm = gid * WGM, gsz = (nM - fm) < WGM ? (nM - fm) : WGM;
        u.pm = fm + ((wgid % nig) % gsz); u.pn = (wgid % nig) / gsz; return true;
    }
    __device__ __forceinline__ void a_ready(const Unit&) const {}
    __device__ __forceinline__ void done(const Unit&) const {}
};

template <class Epi, class Sched, bool ALIGN_EPI = false, bool SP2 = false>
__device__ __forceinline__ void gemm_phase(PG8_LAS unsigned char* lds, const Gemm g, const Sched& S, const Epi& E) {
    const int tid = TID(), wid = __builtin_amdgcn_readfirstlane(tid >> 6), lane = tid & 63, wr = wid >> 2, wc = wid & 3, fr = lane & 15, fq = lane >> 4;
    const int K = g.K, nt = K / BK;
    unsigned voffA[2], voffB[2];
#pragma unroll
    for (int i = 0; i < 2; ++i) { int R, C; stage_rc(tid * 16 + i * 8192, R, C); const int Rb = Epi::PERM ? ((R & ~31) + perm32(R & 31)) : R;
        voffA[i] = (unsigned)(R * K + C) * 2u; voffB[i] = (unsigned)(Rb * K + C) * 2u; }
    const size_t kstep = (size_t)(BK * 2);
    const size_t hstep = (size_t)HALF * K * 2;
    const size_t tstep = 2 * hstep;
    const unsigned ldsw = (unsigned)wid * 1024u;
    const int aoff = lds_byte(wr * 64 + fr, fq * 8), boff = lds_byte(wc * 32 + fr, fq * 8);
#define PG8_SA(b, h) (((b) * 2 + (h)) * HTB)
#define PG8_SB(b, h) ((4 + (b) * 2 + (h)) * HTB)
#define PG8_STAGE(bufoff, gbase, voff) do { _Pragma("unroll") for (int _i = 0; _i < 2; ++_i) \
        __builtin_amdgcn_global_load_lds((const unsigned*)((const char*)(gbase) + (voff)[_i]), (PG8_LAS unsigned*)(lds + (bufoff) + ldsw + _i * 8192), 16, 0, 0); } while (0)
#define PG8_LDA(dst, b, h) do { _Pragma("unroll") for (int m = 0; m < 4; ++m) _Pragma("unroll") for (int k = 0; k < 2; ++k) dst[m][k] = *(const PG8_LAS bf16x8*)(lds + PG8_SA(b, h) + aoff + m * 2048 + k * 1024); } while (0)
#define PG8_LDB(dst, b, h) do { _Pragma("unroll") for (int n = 0; n < 2; ++n) _Pragma("unroll") for (int k = 0; k < 2; ++k) dst[n][k] = *(const PG8_LAS bf16x8*)(lds + PG8_SB(b, h) + boff + n * 2048 + k * 1024); } while (0)
#define PG8_MMA(ai, bj, At, Bt) do { __builtin_amdgcn_s_setprio(1); _Pragma("unroll") for (int m = 0; m < 4; ++m) _Pragma("unroll") for (int n = 0; n < 2; ++n) _Pragma("unroll") for (int k = 0; k < 2; ++k) \
        acc[ai][bj][m][n] = __builtin_amdgcn_mfma_f32_16x16x32_bf16(Bt[n][k], At[m][k], acc[ai][bj][m][n], 0, 0, 0); __builtin_amdgcn_s_setprio(0); } while (0)
#define PG8_WAIT_V(n) asm volatile("s_waitcnt vmcnt(" #n ")" ::: "memory")
#define PG8_WAIT_L(n) asm volatile("s_waitcnt lgkmcnt(" #n ")" ::: "memory")
#define PG8_BAR __builtin_amdgcn_s_barrier()
#define PG8_SCHED __builtin_amdgcn_sched_barrier(0)
    Unit cur, nxt; int ui = 0;
    if (!S.next(0, cur)) return;
    f32x4 acc[2][2][4][2];
#pragma unroll
    for (int a = 0; a < 2; ++a)
#pragma unroll
        for (int b = 0; b < 2; ++b)
#pragma unroll
            for (int m = 0; m < 4; ++m)
#pragma unroll
                for (int n = 0; n < 2; ++n) acc[a][b][m][n] = (f32x4){0.f, 0.f, 0.f, 0.f};
    bf16x8 At[4][2], B0[2][2], B1[2][2];
    const char* cA = (const char*)g.A + (size_t)cur.pm * tstep; const char* cB = (const char*)g.Bt + (size_t)cur.pn * tstep;
    S.a_ready(cur);
    if constexpr (SP2) {
        PG8_STAGE(PG8_SB(0, 0), cB, voffB); PG8_STAGE(PG8_SB(0, 1), cB + hstep, voffB); PG8_STAGE(PG8_SA(0, 0), cA, voffA); PG8_STAGE(PG8_SA(0, 1), cA + hstep, voffA);
        if (wr == 1) PG8_BAR;
        PG8_WAIT_V(2); PG8_BAR;
        PG8_STAGE(PG8_SB(1, 0), cB + kstep, voffB); PG8_STAGE(PG8_SA(1, 0), cA + kstep, voffA); PG8_STAGE(PG8_SB(1, 1), cB + hstep + kstep, voffB);
        PG8_WAIT_V(6); PG8_BAR;
    } else {
        PG8_STAGE(PG8_SB(0, 0), cB, voffB); PG8_STAGE(PG8_SA(0, 0), cA, voffA); PG8_STAGE(PG8_SB(0, 1), cB + hstep, voffB); PG8_STAGE(PG8_SA(0, 1), cA + hstep, voffA);
        if (wr == 1) PG8_BAR;
        PG8_WAIT_V(4); PG8_BAR;
        PG8_STAGE(PG8_SB(1, 0), cB + kstep, voffB); PG8_STAGE(PG8_SA(1, 0), cA + kstep, voffA); PG8_STAGE(PG8_SB(1, 1), cB + hstep + kstep, voffB);
        PG8_WAIT_V(6); PG8_BAR;
    }
    for (;;) {
        const bool has_next = S.next(ui + 1, nxt);
        const char* nA = has_next ? (const char*)g.A + (size_t)nxt.pm * tstep : cA; const char* nB = has_next ? (const char*)g.Bt + (size_t)nxt.pn * tstep : cB;
        for (int t = 0; t < nt; t += 2) {
            const bool last = (t == nt - 2);
            const char* a1 = cA + (size_t)(t + 1) * kstep;
            const char* a2 = last ? nA : cA + (size_t)(t + 2) * kstep; const char* b2 = last ? nB : cB + (size_t)(t + 2) * kstep;
            const char* a3 = a2 + kstep; const char* b3 = b2 + kstep;
            if (last && has_next) S.a_ready(nxt);
            if constexpr (SP2) {
            PG8_LDB(B0, 0, 0); PG8_LDB(B1, 0, 1); PG8_SCHED; PG8_LDA(At, 0, 0); PG8_STAGE(PG8_SA(1, 1), a1 + hstep, voffA);
            PG8_WAIT_V(8); PG8_WAIT_L(0); PG8_BAR; PG8_MMA(0, 0, At, B0); PG8_MMA(0, 1, At, B1); PG8_BAR; PG8_SCHED;
            PG8_LDA(At, 0, 1); PG8_STAGE(PG8_SB(0, 0), b2, voffB); PG8_STAGE(PG8_SB(0, 1), b2 + hstep, voffB); PG8_STAGE(PG8_SA(0, 0), a2, voffA);
            PG8_WAIT_V(8); PG8_WAIT_L(0); PG8_BAR; PG8_MMA(1, 0, At, B0); PG8_MMA(1, 1, At, B1); PG8_BAR; PG8_SCHED;
            PG8_LDB(B0, 1, 0); PG8_LDB(B1, 1, 1); PG8_SCHED; PG8_LDA(At, 1, 0); PG8_STAGE(PG8_SA(0, 1), a2 + hstep, voffA);
            PG8_WAIT_V(8); PG8_WAIT_L(0); PG8_BAR; PG8_MMA(0, 0, At, B0); PG8_MMA(0, 1, At, B1); PG8_BAR; PG8_SCHED;
            PG8_LDA(At, 1, 1); PG8_STAGE(PG8_SB(1, 0), b3, voffB); PG8_STAGE(PG8_SB(1, 1), b3 + hstep, voffB); PG8_STAGE(PG8_SA(1, 0), a3, voffA);
            PG8_WAIT_V(8); PG8_WAIT_L(0); PG8_BAR; PG8_MMA(1, 0, At, B0); PG8_MMA(1, 1, At, B1); PG8_BAR; PG8_SCHED;
            } else {
            PG8_LDB(B0, 0, 0); PG8_SCHED; PG8_LDA(At, 0, 0); PG8_STAGE(PG8_SA(1, 1), a1 + hstep, voffA);
            PG8_WAIT_L(8); PG8_BAR; PG8_WAIT_L(0); PG8_MMA(0, 0, At, B0); PG8_BAR; PG8_SCHED;
            PG8_LDB(B1, 0, 1); PG8_STAGE(PG8_SB(0, 0), b2, voffB);
            PG8_BAR; PG8_WAIT_L(0); PG8_MMA(0, 1, At, B1); PG8_BAR;
            PG8_LDA(At, 0, 1); PG8_STAGE(PG8_SA(0, 0), a2, voffA);
            PG8_BAR; PG8_WAIT_L(0); PG8_MMA(1, 0, At, B0); PG8_BAR; PG8_SCHED;
            PG8_STAGE(PG8_SB(0, 1), b2 + hstep, voffB);
            PG8_WAIT_V(6); PG8_BAR; PG8_MMA(1, 1, At, B1); PG8_BAR;
            PG8_LDB(B0, 1, 0); PG8_SCHED; PG8_LDA(At, 1, 0); PG8_STAGE(PG8_SA(0, 1), a2 + hstep, voffA);
            PG8_WAIT_L(8); PG8_BAR; PG8_WAIT_L(0); PG8_MMA(0, 0, At, B0); PG8_BAR; PG8_SCHED;
            PG8_LDB(B1, 1, 1); PG8_STAGE(PG8_SB(1, 0), b3, voffB);
            PG8_BAR; PG8_WAIT_L(0); PG8_MMA(0, 1, At, B1); PG8_BAR;
            PG8_LDA(At, 1, 1); PG8_STAGE(PG8_SA(1, 0), a3, voffA);
            PG8_BAR; PG8_WAIT_L(0); PG8_MMA(1, 0, At, B0); PG8_BAR; PG8_SCHED;
            PG8_STAGE(PG8_SB(1, 1), b3 + hstep, voffB);
            PG8_WAIT_V(6); PG8_BAR; PG8_MMA(1, 1, At, B1); PG8_BAR;
            }
        }
        if constexpr (ALIGN_EPI) { if (wr == 0) PG8_BAR; }
        if constexpr (!Epi::AFTER_DRAIN) { E(acc, cur, wr, wc, fr, fq); S.done(cur); }
        if (!has_next) break;
#pragma unroll
        for (int a = 0; a < 2; ++a)
#pragma unroll
            for (int b = 0; b < 2; ++b)
#pragma unroll
                for (int m = 0; m < 4; ++m)
#pragma unroll
                    for (int n = 0; n < 2; ++n) acc[a][b][m][n] = (f32x4){0.f, 0.f, 0.f, 0.f};
        cur = nxt; cA = nA; cB = nB; ++ui;
        if constexpr (ALIGN_EPI) { if (wr == 1) PG8_BAR; }
    }
    PG8_WAIT_V(0);
    if constexpr (!ALIGN_EPI) { if (wr == 0) PG8_BAR; }
    PG8_BAR;
    if constexpr (Epi::AFTER_DRAIN) { E.fused(acc, cur, wr, wc, fr, fq, lds, wid, lane); S.done(cur); }
#undef PG8_SA
#undef PG8_SB
#undef PG8_STAGE
#undef PG8_LDA
#undef PG8_LDB
#undef PG8_MMA
#undef PG8_WAIT_V
#undef PG8_WAIT_L
#undef PG8_BAR
#undef PG8_SCHED
}
}

#define LAS __attribute__((address_space(3)))
typedef unsigned short bf16_t;
typedef short bf16x8 __attribute__((ext_vector_type(8)));
typedef float f32x4 __attribute__((ext_vector_type(4)));
typedef float f32x16 __attribute__((ext_vector_type(16)));
typedef unsigned u32x4 __attribute__((ext_vector_type(4)));
typedef unsigned u32x2 __attribute__((ext_vector_type(2)));

constexpr int NB = 4, T = 8192, DM = 1024, M = NB * T, DEPTH = 4, PLE = 256, FF = 2816, ZW = 3584, INW = 3474;
constexpr int C_NQ = 0, C_CK = 384, C_CV = 512, C_SK = 640, C_SV = 768, C_WK = 896, C_WV = 1024, C_DQ = 1152, C_DK = 1408, C_DV = 1664,
              C_HQ = 1920, C_HF = 2304, C_HI = 2688, C_HG = 3072, C_NG = 3456;
constexpr float EPS = 1e-6f, LOG2E = 1.4426950408889634f;
enum { I_X = 0, I_P, I_RELB, I_LBLOG, I_F1N, I_F1G, I_F1U, I_F1D, I_MIXN, I_WIN, I_WOUT, I_NQN, I_NKN, I_CPOS, I_CW1, I_CW2,
       I_DQN, I_DKN, I_DLAM, I_DSUB, I_HON, I_F2N, I_F2G, I_F2U, I_F2D, I_PLN, I_PLG, I_PLP, I_PLPOST, N_IN };
constexpr size_t MiB = 1u << 20;
constexpr size_t WS_CTL = 0, WS_W = 1 * MiB, WS_PB = 53 * MiB, WS_XB = 69 * MiB, WS_R1 = 133 * MiB, WS_MIX = 357 * MiB, WS_VT = 421 * MiB,
                 WS_HS = 453 * MiB, WS_KC = 501 * MiB, WS_VCT = WS_KC + 512 * 1024, WS_SELM = 503 * MiB, WS_RSQ0 = 504 * MiB, WS_RSQ1 = 506 * MiB,
                 WS_RSQP = 508 * MiB, WS_HD = 510 * MiB, WS_XB1 = 511 * MiB, WS_OCB = 575 * MiB, WS_ONES = 599 * MiB, WS_END = 601 * MiB;
constexpr size_t W_GU1 = 0, W_D1 = 11 * MiB, W_GU2 = W_D1 + 5 * MiB + 512 * 1024, W_D2 = W_GU2 + 11 * MiB, W_IN = 33 * MiB, W_OUT = 40 * MiB, W_PG = 42 * MiB,
                 W_PP = 44 * MiB, W_1T = W_PP + 512 * 1024, W_2T = W_1T + 2 * MiB, W_POSB = W_2T + 64 * 1024;
static_assert(W_D2 + 5 * MiB + 512 * 1024 == W_IN, "weight map");
constexpr int LDS_BYTES = 138 * 1024, LDS_MISC = 131072, LDS_RTAB = LDS_MISC + 1024;

__device__ __forceinline__ float bf2f(unsigned short u) { return __uint_as_float(((unsigned)u) << 16); }
__device__ __forceinline__ float bflo(unsigned w) { return __uint_as_float(w << 16); }
__device__ __forceinline__ float bfhi(unsigned w) { return __uint_as_float(w & 0xffff0000u); }
typedef float f32x2_t __attribute__((ext_vector_type(2))); typedef __bf16 bf16x2_t __attribute__((ext_vector_type(2)));
__device__ __forceinline__ unsigned pk2(float lo, float hi) { f32x2_t v = {lo, hi}; bf16x2_t b = __builtin_convertvector(v, bf16x2_t); return __builtin_bit_cast(unsigned, b); }
__device__ __forceinline__ bf16_t f2bf(float f) { return (bf16_t)(pk2(f, 0.f) & 0xffffu); }
__device__ __forceinline__ float ex2(float x) { return __builtin_amdgcn_exp2f(x); }
__device__ __forceinline__ float sigmoidf_(float x) { return 1.0f / (1.0f + __expf(-x)); }
__device__ __forceinline__ int crow(int r, int hi) { return (r & 3) + 8 * (r >> 2) + 4 * hi; }
__device__ __forceinline__ f32x16 mfma32(bf16x8 a, bf16x8 b, f32x16 c) { return __builtin_amdgcn_mfma_f32_32x32x16_bf16(a, b, c, 0, 0, 0); }
__device__ __forceinline__ f32x4 mfma16(bf16x8 a, bf16x8 b, f32x4 c) { return __builtin_amdgcn_mfma_f32_16x16x32_bf16(a, b, c, 0, 0, 0); }
__device__ __forceinline__ bf16x8 as_bf16x8(u32x4 v) { return __builtin_bit_cast(bf16x8, v); }
#define LDSW() asm volatile("s_waitcnt lgkmcnt(0)" ::: "memory")
#define CFENCE() asm volatile("" ::: "memory")
#define GAS __attribute__((address_space(1)))
__device__ __forceinline__ const float* inp(int i) { asm volatile("" : "+s"(i)); const unsigned long long v = ((const unsigned long long __attribute__((address_space(4)))*)__builtin_amdgcn_kernarg_segment_ptr())[i]; return (const float*)(const GAS float*)v; }

__device__ __forceinline__ float row_rinv(const float* rsq, int row) {
    const f32x4* p = (const f32x4*)(rsq + (size_t)row * 16);
    const f32x4 a = p[0], b = p[1], c = p[2], d = p[3];
    const float s = ((a.x + a.y) + (a.z + a.w)) + ((b.x + b.y) + (b.z + b.w)) + ((c.x + c.y) + (c.z + c.w)) + ((d.x + d.y) + (d.z + d.w));
    return rsqrtf(s * (1.0f / 1024.0f) + EPS);
}
struct RowTab {
    int p0, p1, p2, p3;
    __device__ __forceinline__ int slot(int pm) const { return pm == p0 ? 0 : (pm == p1 ? 1 : (pm == p2 ? 2 : 3)); }
    __device__ __forceinline__ float get(int t, int pm, int r256) const { return ((const LAS float*)(LAS unsigned char*)(size_t)LDS_RTAB)[(t * 4 + slot(pm)) * 256 + r256]; }
};
struct EpiSwiGLU {
    static constexpr bool PERM = true, AFTER_DRAIN = false;
    bf16_t* O; RowTab rt;
    __device__ __forceinline__ void operator()(const f32x4 (&acc)[2][2][4][2], const pg8::Unit& u, int wr, int wc, int fr, int fq) const {
#pragma unroll
        for (int ai = 0; ai < 2; ++ai)
#pragma unroll
            for (int m = 0; m < 4; ++m) {
                const int row = u.pm * 256 + ai * 128 + wr * 64 + m * 16 + fr;
                const float r = rt.get(0, u.pm, row & 255);
                float o[8];
#pragma unroll
                for (int n = 0; n < 2; ++n)
#pragma unroll
                    for (int e = 0; e < 4; ++e) { const float g = acc[ai][0][m][n][e] * r, up = acc[ai][1][m][n][e] * r; o[n * 4 + e] = g * sigmoidf_(g) * up; }
                u32x4 w; w.x = pk2(o[0], o[1]); w.y = pk2(o[2], o[3]); w.z = pk2(o[4], o[5]); w.w = pk2(o[6], o[7]);
                *(u32x4*)(O + (size_t)row * FF + u.pn * 128 + wc * 32 + 8 * fq) = w;
                CFENCE();
            }
    }
};
template <int LD> struct EpiZT {
    static constexpr bool PERM = true, AFTER_DRAIN = false;
    bf16_t* Z; RowTab rt;
    __device__ __forceinline__ void operator()(const f32x4 (&acc)[2][2][4][2], const pg8::Unit& u, int wr, int wc, int fr, int fq) const {
#pragma unroll
        for (int ai = 0; ai < 2; ++ai)
#pragma unroll
            for (int m = 0; m < 4; ++m) {
                const int row = u.pm * 256 + ai * 128 + wr * 64 + m * 16 + fr;
                const float r = rt.get(0, u.pm, row & 255);
#pragma unroll
                for (int bj = 0; bj < 2; ++bj) {
                    const f32x4 v0 = acc[ai][bj][m][0] * r, v1 = acc[ai][bj][m][1] * r;
                    u32x4 w; w.x = pk2(v0[0], v0[1]); w.y = pk2(v0[2], v0[3]); w.z = pk2(v1[0], v1[1]); w.w = pk2(v1[2], v1[3]);
                    *(u32x4*)(Z + (size_t)row * LD + u.pn * 256 + bj * 128 + wc * 32 + 8 * fq) = w;
                }
                CFENCE();
            }
    }
};
typedef EpiZT<ZW> EpiZ;
template <int MODE> struct EpiRes {
    static constexpr bool PERM = true, AFTER_DRAIN = false;
    float* X; bf16_t* XB; float* rsq_out; float alpha; const float* rsq_in; const bf16_t* P; const float* rsqp; const float* post; bf16_t* Pout; RowTab rt;
    __device__ __forceinline__ void operator()(const f32x4 (&acc)[2][2][4][2], const pg8::Unit& u, int wr, int wc, int fr, int fq) const {
        const int rowb = u.pm * 256 + wr * 64 + fr, colb = u.pn * 256 + wc * 32 + 8 * fq;
        f32x4 xn[2][2]; u32x2 pn_[2][2];
        if (MODE != 2) {
#pragma unroll
            for (int bj = 0; bj < 2; ++bj)
#pragma unroll
                for (int n = 0; n < 2; ++n) { const size_t off = (size_t)rowb * DM + colb + bj * 128 + 4 * n; xn[bj][n] = *(const f32x4*)(X + off); if (MODE == 1) pn_[bj][n] = *(const u32x2*)(P + off); }
        }
#pragma unroll
        for (int gI = 0; gI < 8; ++gI) {
            const int ai = gI >> 2, m = gI & 3;
            const int row = rowb + ai * 128 + m * 16;
            f32x4 xc[2][2]; u32x2 pc[2][2];
#pragma unroll
            for (int bj = 0; bj < 2; ++bj)
#pragma unroll
                for (int n = 0; n < 2; ++n) { xc[bj][n] = xn[bj][n]; pc[bj][n] = pn_[bj][n]; }
            if (MODE != 2 && gI < 7) {
                const int row2 = rowb + ((gI + 1) >> 2) * 128 + ((gI + 1) & 3) * 16;
#pragma unroll
                for (int bj = 0; bj < 2; ++bj)
#pragma unroll
                    for (int n = 0; n < 2; ++n) { const size_t off = (size_t)row2 * DM + colb + bj * 128 + 4 * n; xn[bj][n] = *(const f32x4*)(X + off); if (MODE == 1) pn_[bj][n] = *(const u32x2*)(P + off); }
            }
            CFENCE();
            float r = 1.f, rp = 1.f;
            if (MODE == 1) { r = rt.get(0, u.pm, row & 255); rp = rt.get(1, u.pm, row & 255); }
            float ss = 0.f;
#pragma unroll
            for (int bj = 0; bj < 2; ++bj)
#pragma unroll
                for (int n = 0; n < 2; ++n) {
                    const int c0 = colb + bj * 128 + 4 * n;
                    const size_t off = (size_t)row * DM + c0;
                    const f32x4 a = acc[ai][bj][m][n];
                    if (MODE == 2) {
                        u32x2 w; w.x = pk2(a[0], a[1]); w.y = pk2(a[2], a[3]);
                        *(u32x2*)(Pout + off) = w;
                        ss += (a[0] * a[0] + a[1] * a[1]) + (a[2] * a[2] + a[3] * a[3]);
                    } else {
                        f32x4 xv = xc[bj][n];
                        if (MODE == 0) xv += a * alpha;
                        else {
                            const u32x2 pw = pc[bj][n]; const f32x4 po = *(const f32x4*)(post + c0);
                            xv[0] += sigmoidf_(a[0] * r) * (bflo(pw.x) * rp * po[0]);
                            xv[1] += sigmoidf_(a[1] * r) * (bfhi(pw.x) * rp * po[1]);
                            xv[2] += sigmoidf_(a[2] * r) * (bflo(pw.y) * rp * po[2]);
                            xv[3] += sigmoidf_(a[3] * r) * (bfhi(pw.y) * rp * po[3]);
                        }
                        *(f32x4*)(X + off) = xv;
                        u32x2 w; w.x = pk2(xv[0], xv[1]); w.y = pk2(xv[2], xv[3]);
                        *(u32x2*)(XB + off) = w;
                        ss += (xv[0] * xv[0] + xv[1] * xv[1]) + (xv[2] * xv[2] + xv[3] * xv[3]);
                    }
                }
            ss += __shfl_xor(ss, 16); ss += __shfl_xor(ss, 32);
            if (fq == 0) rsq_out[(size_t)row * 16 + u.pn * 4 + wc] = ss;
        }
    }
};

template <class Epi> __device__ __forceinline__ void run_gemm(LAS unsigned char* lds, const bf16_t* A, const bf16_t* Bt, int N, int K, Epi& E, const float* rsqA = nullptr, const float* rsqB = nullptr) {
    int bx = blockIdx.x; asm volatile("" : "+s"(bx)); asm volatile("" : "+s"(K)); asm volatile("" : "+s"(N));
    pg8::Gemm g{A, Bt, M, N, K}; pg8::StaticOrder S; S.init(M, N, (int)gridDim.x, bx);
    if (rsqA) {
        int p0 = -1, p1 = -1, p2 = -1, p3 = -1; pg8::Unit u;
        for (int i = 0; S.next(i, u); ++i) { const int pm = u.pm; if (pm != p0 && pm != p1 && pm != p2 && pm != p3) { if (p0 < 0) p0 = pm; else if (p1 < 0) p1 = pm; else if (p2 < 0) p2 = pm; else p3 = pm; } }
        E.rt.p0 = p0; E.rt.p1 = p1; E.rt.p2 = p2; E.rt.p3 = p3;
        const int tid = TID();
        LAS float* tab = (LAS float*)(lds + LDS_RTAB);
        if (tid < 256) {
#pragma unroll
            for (int s = 0; s < 4; ++s) { const int pm = s == 0 ? p0 : (s == 1 ? p1 : (s == 2 ? p2 : p3));
                if (pm >= 0) { tab[s * 256 + tid] = row_rinv(rsqA, pm * 256 + tid); if (rsqB) tab[(4 + s) * 256 + tid] = row_rinv(rsqB, pm * 256 + tid); } }
        }
        __syncthreads();
    }
    pg8::gemm_phase<Epi, pg8::StaticOrder, true, true>(lds, g, S, E);
    __syncthreads();
}

__device__ __forceinline__ void rowsq_pass(const bf16_t* P, float* rsq_out) {
    const int tid = TID(), lane = tid & 63, wave = tid >> 6;
    for (int base = (blockIdx.x * 8 + wave) * 4; base < M; base += gridDim.x * 8 * 4) {
        u32x4 v[4][2];
#pragma unroll
        for (int i = 0; i < 4; ++i) { const u32x4* pr = (const u32x4*)(P + (size_t)(base + i) * DM) + lane; v[i][0] = pr[0]; v[i][1] = pr[64]; }
#pragma unroll
        for (int i = 0; i < 4; ++i) {
            float s = 0.f;
#pragma unroll
            for (int h2 = 0; h2 < 2; ++h2) { const u32x4 w = v[i][h2];
                s += (bflo(w.x) * bflo(w.x) + bfhi(w.x) * bfhi(w.x)) + (bflo(w.y) * bflo(w.y) + bfhi(w.y) * bfhi(w.y)) + (bflo(w.z) * bflo(w.z) + bfhi(w.z) * bfhi(w.z)) + (bflo(w.w) * bflo(w.w) + bfhi(w.w) * bfhi(w.w)); }
#pragma unroll
            for (int o = 1; o < 64; o <<= 1) s += __shfl_xor(s, o);
            if (lane < 16) rsq_out[(size_t)(base + i) * 16 + lane] = (lane == 0) ? s : 0.f;
        }
    }
}

__device__ __forceinline__ int next_task(unsigned* ctr, LAS int* slot) {
    __syncthreads();
    if (TID() == 0) *slot = (int)atomicAdd(ctr, 1u);
    __syncthreads();
    return *slot;
}

__device__ __forceinline__ int colmap(int mode, int n) {
    if (mode == 1) return 256 * (n >> 7) + (n & 127);
    if (mode == 2) return 256 * (n >> 7) + 128 + (n & 127);
    if (mode == 3) return n < 1152 ? n : (n < 1170 ? 3456 + (n - 1152) : n - 18);
    return n;
}
__device__ __forceinline__ void conv_item(const float* W, int K, int N, bf16_t* WT, const float* gain, int mode, LAS float* scr, int item, int lane) {
    const int nblk = (N + 31) >> 5, kb = item / nblk, nb = item % nblk, k0 = 64 * kb, n0 = 32 * nb;
#pragma unroll 16
    for (int i = 0; i < 32; ++i) {
        const int kk = 2 * i + (lane >> 5), n = n0 + (lane & 31);
        float v = (n < N) ? W[(size_t)(k0 + kk) * N + n] : 0.f;
        if (gain) v *= gain[k0 + kk];
        scr[kk * 33 + (lane & 31)] = v;
    }
    LDSW();
    const int c = lane & 7;
#pragma unroll
    for (int j = 0; j < 4; ++j) {
        const int nl = (lane >> 3) + 8 * j, n = n0 + nl;
        const LAS float* s = scr + (8 * c) * 33 + nl;
        u32x4 o; o.x = pk2(s[0], s[33]); o.y = pk2(s[2 * 33], s[3 * 33]); o.z = pk2(s[4 * 33], s[5 * 33]); o.w = pk2(s[6 * 33], s[7 * 33]);
        if (n < N) *(u32x4*)(WT + (size_t)colmap(mode, n) * K + k0 + 8 * c) = o;
    }
    LDSW();
}

__device__ __forceinline__ void phase_convert(const float* const* in, unsigned char* ws, float* out, int L, LAS unsigned char* lds) {
    const int tid = TID(), lane = tid & 63, wave = tid >> 6;
    const int gw = blockIdx.x * 8 + wave, NGW = gridDim.x * 8;
    LAS float* scr = (LAS float*)(lds + wave * 8704);
    unsigned char* wb = ws + WS_W;
    if (gw < 256) {
        const int ty = gw >> 7, ng = (gw >> 5) & 3, ks = gw & 31, n = ng * 64 + lane;
        const float* w1 = inp(I_CW1) + (size_t)(L * 2 + ty) * 2048 * 256; const float* pos = inp(I_CPOS) + (size_t)(L * 2 + ty) * 2048;
        float acc = 0.f;
#pragma unroll 16
        for (int k = ks * 64; k < ks * 64 + 64; ++k) acc += pos[k] * w1[(size_t)k * 256 + n];
        ((float*)(wb + W_POSB))[(ty * 32 + ks) * 256 + n] = acc;
    }
    const size_t ffo = (size_t)L * DM * FF;
    constexpr int IT_GU = (DM / 64) * (FF / 32), IT_D = (FF / 64) * (DM / 32), IT_IN = (DM / 64) * ((INW + 31) / 32), IT_SQ = (DM / 64) * (DM / 32),
                  IT_PP = (PLE / 64) * (DM / 32), IT_W1 = (2048 / 64) * (256 / 32), IT_W2 = (256 / 64) * (64 / 32);
    constexpr int total = 4 * IT_GU + 2 * IT_D + IT_IN + 2 * IT_SQ + IT_PP + 2 * IT_W1 + 2 * IT_W2;
    for (int it = gw; it < total; it += NGW) {
        const float* W = nullptr; int K = 0, N = 0; bf16_t* WT = nullptr; const float* gain = nullptr; int mode = 0, rr = -1, r = it;
#define JOB(Wp, Kk, Nn, WTp, gp, md, items) { if (rr < 0 && r < (items)) { W = (Wp); K = (Kk); N = (Nn); WT = (bf16_t*)(WTp); gain = (gp); mode = (md); rr = r; } r -= (items); }
        JOB(inp(I_F1G) + ffo, DM, FF, wb + W_GU1, inp(I_F1N) + L * DM, 1, IT_GU)
        JOB(inp(I_F1U) + ffo, DM, FF, wb + W_GU1, inp(I_F1N) + L * DM, 2, IT_GU)
        JOB(inp(I_F1D) + ffo, FF, DM, wb + W_D1, nullptr, 0, IT_D)
        JOB(inp(I_F2G) + ffo, DM, FF, wb + W_GU2, inp(I_F2N) + L * DM, 1, IT_GU)
        JOB(inp(I_F2U) + ffo, DM, FF, wb + W_GU2, inp(I_F2N) + L * DM, 2, IT_GU)
        JOB(inp(I_F2D) + ffo, FF, DM, wb + W_D2, nullptr, 0, IT_D)
        JOB(inp(I_WIN) + (size_t)L * DM * INW, DM, INW, wb + W_IN, inp(I_MIXN) + L * DM, 3, IT_IN)
        JOB(inp(I_WOUT) + (size_t)L * DM * DM, DM, DM, wb + W_OUT, nullptr, 0, IT_SQ)
        JOB(inp(I_PLG) + (size_t)L * DM * DM, DM, DM, wb + W_PG, inp(I_PLN) + L * DM, 0, IT_SQ)
        JOB(inp(I_PLP) + (size_t)L * PLE * DM, PLE, DM, wb + W_PP, nullptr, 0, IT_PP)
        JOB(inp(I_CW1) + (size_t)(L * 2 + 0) * 2048 * 256, 2048, 256, wb + W_1T, nullptr, 0, IT_W1)
        JOB(inp(I_CW1) + (size_t)(L * 2 + 1) * 2048 * 256, 2048, 256, wb + W_1T + 256 * 2048 * 2, nullptr, 0, IT_W1)
        JOB(inp(I_CW2) + (size_t)(L * 2 + 0) * 256 * 64, 256, 64, wb + W_2T, nullptr, 0, IT_W2)
        JOB(inp(I_CW2) + (size_t)(L * 2 + 1) * 256 * 64, 256, 64, wb + W_2T + 64 * 256 * 2, nullptr, 0, IT_W2)
#undef JOB
        conv_item(W, K, N, WT, gain, mode, scr, rr, lane);
    }
    {
        u32x4* z = (u32x4*)((bf16_t*)(wb + W_IN) + (size_t)INW * DM);
        const int n16 = (ZW - INW) * DM / 8;
        for (int i = blockIdx.x * 512 + tid; i < n16; i += gridDim.x * 512) z[i] = (u32x4){0u, 0u, 0u, 0u};
    }
    {
        const f32x4* src = (const f32x4*)(inp(I_P) + (size_t)L * M * PLE); u32x4* dst = (u32x4*)(ws + WS_PB);
        const int n8 = M * PLE / 8;
        for (int i = blockIdx.x * 512 + tid; i < n8; i += gridDim.x * 512) {
            const f32x4 a = src[2 * i], b = src[2 * i + 1];
            u32x4 w; w.x = pk2(a[0], a[1]); w.y = pk2(a[2], a[3]); w.z = pk2(b[0], b[1]); w.w = pk2(b[2], b[3]); dst[i] = w;
        }
    }
    if (L == 0) {
        const float* x = inp(I_X); bf16_t* xb = (bf16_t*)(ws + WS_XB); float* rsq = (float*)(ws + WS_RSQ0);
        for (int m = gw; m < M; m += NGW) {
            const f32x4* xr = (const f32x4*)(x + (size_t)m * DM) + lane; f32x4* orow = (f32x4*)(out + (size_t)m * DM) + lane;
            u32x2* xbr = (u32x2*)(xb + (size_t)m * DM) + lane;
            float s = 0.f;
#pragma unroll
            for (int j = 0; j < 4; ++j) { const f32x4 v = xr[64 * j]; orow[64 * j] = v; u32x2 w; w.x = pk2(v[0], v[1]); w.y = pk2(v[2], v[3]); xbr[64 * j] = w; s += (v[0] * v[0] + v[1] * v[1]) + (v[2] * v[2] + v[3] * v[3]); }
#pragma unroll
            for (int o = 1; o < 64; o <<= 1) s += __shfl_xor(s, o);
            if (lane < 16) rsq[(size_t)m * 16 + lane] = (lane == 0) ? s : 0.f;
        }
    }
}

__device__ __forceinline__ void task_prep(const float* const* in, unsigned char* ws, int L, int tile, LAS unsigned char* lds) {
    const int tid = TID(), lane = tid & 63, wave = tid >> 6;
    bf16_t* z = (bf16_t*)(ws + WS_R1);
    const int row0 = tile * 64;
#pragma unroll
    for (int pass = 0; pass < 3; ++pass) {
        const int seg = pass * 64 + lane;
        int col = 0, gs = 8; const float* gp = inp(I_NQN); float scale = 1.f;
        if (seg < 48) { col = C_NQ + 8 * seg; gp = inp(I_NQN) + L * 64 + ((8 * seg) & 63); scale = 0.125f * LOG2E; }
        else if (seg < 64) { col = C_SK + 8 * (seg - 48); gp = inp(I_NKN) + (L * 3 + 1) * 64 + ((8 * seg) & 63); }
        else if (seg < 80) { col = C_WK + 8 * (seg - 64); gp = inp(I_NKN) + (L * 3 + 2) * 64 + ((8 * seg) & 63); }
        else if (seg < 112) { col = C_DQ + 8 * (seg - 80); gp = inp(I_DQN) + L * 32 + ((8 * seg) & 31); gs = 4; scale = 0.17677669529663689f * LOG2E; }
        else { col = C_DK + 8 * (seg - 112); gp = inp(I_DKN) + L * 32 + ((8 * seg) & 31); gs = 4; }
        const bool act = seg < 144;
        if (!act) { col = 0; }
        const f32x4 g0 = *(const f32x4*)gp, g1 = *(const f32x4*)(gp + 4);
        u32x4 w[8];
#pragma unroll
        for (int i = 0; i < 8; ++i) w[i] = *(const u32x4*)(z + (size_t)(row0 + wave + 8 * i) * ZW + col);
#pragma unroll
        for (int i = 0; i < 8; ++i) {
            float v[8] = {bflo(w[i].x), bfhi(w[i].x), bflo(w[i].y), bfhi(w[i].y), bflo(w[i].z), bfhi(w[i].z), bflo(w[i].w), bfhi(w[i].w)};
            float ss = 0.f;
#pragma unroll
            for (int e2 = 0; e2 < 8; ++e2) ss += v[e2] * v[e2];
            ss += __shfl_xor(ss, 1); ss += __shfl_xor(ss, 2);
            const float t4 = __shfl_xor(ss, 4); if (gs == 8) ss += t4;
            const float r = rsqrtf(ss / (float)(gs * 8) + EPS) * scale;
            u32x4 o; o.x = pk2(v[0] * r * g0[0], v[1] * r * g0[1]); o.y = pk2(v[2] * r * g0[2], v[3] * r * g0[3]);
            o.z = pk2(v[4] * r * g1[0], v[5] * r * g1[1]); o.w = pk2(v[6] * r * g1[2], v[7] * r * g1[3]);
            if (act) *(u32x4*)(z + (size_t)(row0 + wave + 8 * i) * ZW + col) = o;
        }
    }
    LAS bf16_t* tl = (LAS bf16_t*)lds;
#pragma unroll
    for (int i = 0; i < 8; ++i) {
        const int id = i * 512 + tid, row = id >> 6, ch = id & 63;
        const int col = ch < 16 ? C_SV + 8 * ch : (ch < 32 ? C_WV + 8 * (ch - 16) : C_DV + 8 * (ch - 32));
        *(LAS u32x4*)(tl + row * 520 + 8 * ch) = *(const u32x4*)(z + (size_t)(row0 + row) * ZW + col);
    }
    __syncthreads();
    const int b = row0 / T, t0 = row0 % T;
    bf16_t* vt = (bf16_t*)(ws + WS_VT);
#pragma unroll
    for (int i = 0; i < 8; ++i) {
        const int orow = tid, tch = i;
        const LAS bf16_t* s = tl + (tch * 8) * 520 + orow;
        u32x4 o;
        o.x = (unsigned)s[0] | ((unsigned)s[520] << 16); o.y = (unsigned)s[2 * 520] | ((unsigned)s[3 * 520] << 16);
        o.z = (unsigned)s[4 * 520] | ((unsigned)s[5 * 520] << 16); o.w = (unsigned)s[6 * 520] | ((unsigned)s[7 * 520] << 16);
        *(u32x4*)(vt + ((size_t)(b * 8) * 64 + orow) * T + t0 + 8 * tch) = o;
    }
}

__device__ __forceinline__ float gelu_tanh(float x) {
    const float y = 0.7978845608028654f * (x + 0.044715f * x * x * x);
    const float th = 1.0f - 2.0f / (1.0f + __expf(2.0f * y));
    return 0.5f * x * (1.0f + th);
}
__device__ __forceinline__ void task_compress(const float* const* in, unsigned char* ws, int L, int task, LAS unsigned char* lds) {
    const int tid = TID(), lane = tid & 63, wave = tid >> 6;
    const int ty = task >> 8, b = (task >> 6) & 3, g = (task >> 5) & 1, i0 = (task & 31) * 16;
    const bf16_t* z = (const bf16_t*)(ws + WS_R1);
    LAS bf16_t* zt = (LAS bf16_t*)lds;
    LAS bf16_t* hid = (LAS bf16_t*)(lds + 39168);
    LAS float* ofp = (LAS float*)(lds + 39168 + 8448);
    const int ccol = (ty ? C_CV : C_CK) + 64 * g;
    for (int id = tid; id < 272 * 8; id += 512) {
        const int row = id >> 3, ch = id & 7, tok = 16 * i0 + row;
        u32x4 v = (u32x4){0u, 0u, 0u, 0u};
        if (tok < T) v = *(const u32x4*)(z + (size_t)(b * T + tok) * ZW + ccol + 8 * ch);
        *(LAS u32x4*)(zt + row * 72 + 8 * ch) = v;
    }
    __syncthreads();
    const bf16_t* w1t = (const bf16_t*)(ws + WS_W + W_1T) + (size_t)ty * 256 * 2048;
    const bf16_t* w2t = (const bf16_t*)(ws + WS_W + W_2T) + (size_t)ty * 64 * 256;
    const float* posb = (const float*)(ws + WS_W + W_POSB) + ty * 32 * 256;
    const int r16 = lane & 15, kq = lane >> 4;
    f32x4 acc[2] = {(f32x4){0.f, 0.f, 0.f, 0.f}, (f32x4){0.f, 0.f, 0.f, 0.f}};
    const bf16_t* b0p = w1t + (size_t)(16 * (2 * wave) + r16) * 2048 + 8 * kq;
    const bf16_t* b1p = b0p + 16 * 2048;
#pragma unroll 8
    for (int kc = 0; kc < 64; ++kc) {
        const bf16x8 a = *(const LAS bf16x8*)(zt + (16 * r16 + (kc >> 1)) * 72 + (kc & 1) * 32 + 8 * kq);
        const bf16x8 w0 = *(const bf16x8*)(b0p + 32 * kc), w1 = *(const bf16x8*)(b1p + 32 * kc);
        acc[0] = mfma16(a, w0, acc[0]); acc[1] = mfma16(a, w1, acc[1]);
    }
#pragma unroll
    for (int j = 0; j < 2; ++j) {
        const int n = 16 * (2 * wave + j) + r16;
        float pbias = 0.f;
#pragma unroll
        for (int ks = 0; ks < 32; ++ks) pbias += posb[ks * 256 + n];
#pragma unroll
        for (int i = 0; i < 4; ++i) hid[(4 * kq + i) * 264 + n] = f2bf(gelu_tanh(acc[j][i] + pbias));
    }
    __syncthreads();
    if (wave < 4) {
        f32x4 a2 = (f32x4){0.f, 0.f, 0.f, 0.f};
        const bf16_t* bp = w2t + (size_t)(16 * wave + r16) * 256 + 8 * kq;
#pragma unroll
        for (int kc = 0; kc < 8; ++kc) {
            const bf16x8 a = *(const LAS bf16x8*)(hid + r16 * 264 + 32 * kc + 8 * kq);
            const bf16x8 w = *(const bf16x8*)(bp + 32 * kc);
            a2 = mfma16(a, w, a2);
        }
#pragma unroll
        for (int i = 0; i < 4; ++i) ofp[(4 * kq + i) * 64 + 16 * wave + r16] = a2[i];
    }
    __syncthreads();
    if (tid < 256) {
        const int row = tid >> 4, c4 = (tid & 15) * 4, i = i0 + row;
        f32x4 o = *(const LAS f32x4*)(ofp + row * 64 + c4);
        float ss = (o[0] * o[0] + o[1] * o[1]) + (o[2] * o[2] + o[3] * o[3]);
        ss += __shfl_xor(ss, 1); ss += __shfl_xor(ss, 2); ss += __shfl_xor(ss, 4); ss += __shfl_xor(ss, 8);
        if (ty == 0) {
            const float r = rsqrtf(ss * (1.0f / 64.0f) + EPS);
            const f32x4 gn = *(const f32x4*)(inp(I_NKN) + (L * 3 + 0) * 64 + c4);
            o = o * r * gn;
        }
        if (i >= 511) o = (f32x4){0.f, 0.f, 0.f, 0.f};
        if (ty == 0) {
            u32x2 w; w.x = pk2(o[0], o[1]); w.y = pk2(o[2], o[3]);
            *(u32x2*)((bf16_t*)(ws + WS_KC) + ((size_t)(b * 2 + g) * 512 + i) * 64 + c4) = w;
        } else {
            bf16_t* vct = (bf16_t*)(ws + WS_VCT) + (size_t)(b * 2 + g) * 64 * 512;
#pragma unroll
            for (int e = 0; e < 4; ++e) vct[(size_t)(c4 + e) * 512 + i] = f2bf(o[e]);
        }
    }
}

__device__ __forceinline__ float hgrn_lb(const float* logits, int L, int j) {
    if (L == 0) return 0.f;
    const float a0 = logits[j], a1 = logits[384 + j], a2 = logits[768 + j], a3 = logits[1152 + j];
    const float mx = fmaxf(fmaxf(a0, a1), fmaxf(a2, a3));
    const float e0 = __expf(a0 - mx), e1 = __expf(a1 - mx), e2 = __expf(a2 - mx), e3 = __expf(a3 - mx);
    const float inv = 1.0f / (e0 + e1 + e2 + e3);
    float s = e1; if (L >= 2) s += e2; if (L >= 3) s += e3;
    return s * inv;
}
__device__ __forceinline__ void task_hgrn_local(const float* const* in, unsigned char* ws, int L, int task, LAS unsigned char* lds) {
    const int tid = TID(), lane = tid & 63, wave = tid >> 6;
    if (wave < 6) {
        const int chunk = task * 6 + wave;
        const int bh = chunk >> 7, c = chunk & 127, b = bh / 6, h = bh % 6;
        const bf16_t* z = (const bf16_t*)(ws + WS_R1) + (size_t)(b * T + c * 64) * ZW;
        LAS bf16_t* klT = (LAS bf16_t*)(lds + wave * 18432);
        LAS bf16_t* vT = klT + 64 * 72;
        const float lb = hgrn_lb(inp(I_LBLOG), L, h * 64 + lane);
        LAS bf16_t* rawf = klT;
        (void)rawf;
        u32x4 rf[8], ri[8];
#pragma unroll
        for (int i = 0; i < 8; ++i) {
            const int row = (lane >> 3) + 8 * i, ch = lane & 7;
            rf[i] = *(const u32x4*)(z + (size_t)row * ZW + C_HF + 64 * h + 8 * ch);
            ri[i] = *(const u32x4*)(z + (size_t)row * ZW + C_HI + 64 * h + 8 * ch);
        }
#pragma unroll
        for (int i = 0; i < 8; ++i) {
            const int row = (lane >> 3) + 8 * i, ch = lane & 7;
            *(LAS u32x4*)(klT + row * 72 + 8 * ch) = rf[i];
            *(LAS u32x4*)(vT + row * 72 + 8 * ch) = ri[i];
        }
        LDSW();
        float suffix = 0.f;
        bf16_t colf[64], colv[64];
#pragma unroll
        for (int s2 = 0; s2 < 64; ++s2) { colf[s2] = klT[s2 * 72 + lane]; colv[s2] = vT[s2 * 72 + lane]; }
        LDSW();
#pragma unroll
        for (int s = 63; s >= 0; --s) {
            const float fr = bf2f(colf[s]);
            const float sg = sigmoidf_(fr);
            const float f = lb + (1.0f - lb) * sg;
            const float ig = (1.0f - lb) * (1.0f - sg);
            klT[lane * 72 + s] = f2bf(ig * __expf(suffix));
            vT[lane * 72 + s] = colv[s];
            suffix += __logf(f);
        }
        ((float*)(ws + WS_HD))[(size_t)chunk * 64 + lane] = __expf(suffix);
        LDSW();
        const int r32 = lane & 31, hi = lane >> 5;
        float* hs = (float*)(ws + WS_HS) + (size_t)chunk * 4096;
#pragma unroll
        for (int kb = 0; kb < 2; ++kb)
#pragma unroll
            for (int vb = 0; vb < 2; ++vb) {
                f32x16 cacc = {};
#pragma unroll
                for (int cc = 0; cc < 4; ++cc) {
                    const bf16x8 a = *(const LAS bf16x8*)(klT + (32 * kb + r32) * 72 + 16 * cc + 8 * hi);
                    const bf16x8 bb = *(const LAS bf16x8*)(vT + (32 * vb + r32) * 72 + 16 * cc + 8 * hi);
                    cacc = mfma32(a, bb, cacc);
                }
#pragma unroll
                for (int r = 0; r < 16; ++r) hs[(32 * kb + crow(r, hi)) * 64 + 32 * vb + r32] = cacc[r];
            }
    }
}
__device__ __forceinline__ void task_hgrn_scan(unsigned char* ws, int task) {
    const int tid = TID();
    const int bh = task >> 3, k = (task & 7) * 8 + (tid >> 6), v = tid & 63;
    float* hs = (float*)(ws + WS_HS) + (size_t)bh * 128 * 4096 + k * 64 + v;
    const float* hd = (const float*)(ws + WS_HD) + (size_t)bh * 128 * 64 + k;
    float S = 0.f;
#pragma unroll 16
    for (int c = 0; c < 128; ++c) {
        const float a = hs[(size_t)c * 4096], d = hd[c * 64];
        hs[(size_t)c * 4096] = S;
        S = d * S + a;
    }
}
__device__ __forceinline__ void task_hgrn_out(const float* const* in, unsigned char* ws, int L, int task, LAS unsigned char* lds) {
    const int tid = TID(), lane = tid & 63, wave = tid >> 6;
    if (wave < 3) {
        const int chunk = task * 3 + wave;
        const int bh = chunk >> 7, c = chunk & 127, b = bh / 6, h = bh % 6;
        const size_t row0 = (size_t)(b * T + c * 64);
        const bf16_t* z = (const bf16_t*)(ws + WS_R1) + row0 * ZW;
        LAS bf16_t* ke = (LAS bf16_t*)(lds + wave * 36864);
        LAS bf16_t* qe = ke + 64 * 72;
        LAS bf16_t* vT = qe + 64 * 72;
        LAS bf16_t* sT = vT + 64 * 72;
        const float lb = hgrn_lb(inp(I_LBLOG), L, h * 64 + lane);
        {
            u32x4 rq[8], rf[8], ri[8];
#pragma unroll
            for (int i = 0; i < 8; ++i) {
                const int row = (lane >> 3) + 8 * i, ch = lane & 7;
                rq[i] = *(const u32x4*)(z + (size_t)row * ZW + C_HQ + 64 * h + 8 * ch);
                rf[i] = *(const u32x4*)(z + (size_t)row * ZW + C_HF + 64 * h + 8 * ch);
                ri[i] = *(const u32x4*)(z + (size_t)row * ZW + C_HI + 64 * h + 8 * ch);
            }
#pragma unroll
            for (int i = 0; i < 8; ++i) {
                const int row = (lane >> 3) + 8 * i, ch = lane & 7;
                *(LAS u32x4*)(qe + row * 72 + 8 * ch) = rq[i];
                *(LAS u32x4*)(ke + row * 72 + 8 * ch) = rf[i];
                *(LAS u32x4*)(sT + row * 72 + 8 * ch) = ri[i];
            }
        }
        LDSW();
        float ref = 0.f;
#pragma unroll 8
        for (int s = 0; s < 32; ++s) {
            const float fr = bf2f(ke[s * 72 + lane]);
            ref += __logf(lb + (1.0f - lb) * sigmoidf_(fr));
        }
        float cum = 0.f;
#pragma unroll 8
        for (int s = 0; s < 64; ++s) {
            const float fr = bf2f(ke[s * 72 + lane]);
            const float qv = bf2f(qe[s * 72 + lane]);
            const bf16_t vraw = sT[s * 72 + lane];
            const float sg = sigmoidf_(fr);
            const float f = lb + (1.0f - lb) * sg;
            const float ig = (1.0f - lb) * (1.0f - sg);
            cum += __logf(f);
            qe[s * 72 + lane] = f2bf(qv * sigmoidf_(qv) * __expf(cum - ref));
            ke[s * 72 + lane] = f2bf(ig * __expf(ref - cum));
            vT[lane * 72 + s] = vraw;
        }
        LDSW();
        const float* hs = (const float*)(ws + WS_HS) + (size_t)chunk * 4096;
        const float eref = __expf(ref);
        {
            f32x4 hv[16];
#pragma unroll
            for (int i = 0; i < 16; ++i) hv[i] = *(const f32x4*)(hs + ((lane >> 4) + 4 * i) * 64 + (lane & 15) * 4);
#pragma unroll
            for (int i = 0; i < 16; ++i) {
                const int k = (lane >> 4) + 4 * i, v4 = (lane & 15) * 4;
                const float er = __shfl(eref, k);
                sT[(v4 + 0) * 72 + k] = f2bf(hv[i][0] * er); sT[(v4 + 1) * 72 + k] = f2bf(hv[i][1] * er);
                sT[(v4 + 2) * 72 + k] = f2bf(hv[i][2] * er); sT[(v4 + 3) * 72 + k] = f2bf(hv[i][3] * er);
            }
        }
        LDSW();
        const int r32 = lane & 31, hi = lane >> 5;
        f32x16 O[2][2] = {};
#pragma unroll
        for (int tb = 0; tb < 2; ++tb) {
            bf16x8 qf[4];
#pragma unroll
            for (int cc = 0; cc < 4; ++cc) qf[cc] = *(const LAS bf16x8*)(qe + (32 * tb + r32) * 72 + 16 * cc + 8 * hi);
#pragma unroll
            for (int vb = 0; vb < 2; ++vb)
#pragma unroll
                for (int cc = 0; cc < 4; ++cc) {
                    const bf16x8 a = *(const LAS bf16x8*)(sT + (32 * vb + r32) * 72 + 16 * cc + 8 * hi);
                    O[vb][tb] = mfma32(a, qf[cc], O[vb][tb]);
                }
#pragma unroll
            for (int sb = 0; sb <= tb; ++sb) {
                f32x16 sc = {};
#pragma unroll
                for (int cc = 0; cc < 4; ++cc) {
                    const bf16x8 a = *(const LAS bf16x8*)(ke + (32 * sb + r32) * 72 + 16 * cc + 8 * hi);
                    sc = mfma32(a, qf[cc], sc);
                }
                unsigned P[8];
#pragma unroll
                for (int j = 0; j < 8; ++j) {
                    float p0 = sc[2 * j], p1 = sc[2 * j + 1];
                    if (sb == tb) { if (crow(2 * j, hi) > r32) p0 = 0.f; if (crow(2 * j + 1, hi) > r32) p1 = 0.f; }
                    P[j] = pk2(p0, p1);
                }
#pragma unroll
                for (int vb = 0; vb < 2; ++vb)
#pragma unroll
                    for (int c2 = 0; c2 < 2; ++c2) {
                        const u32x2 a0 = *(const LAS u32x2*)(vT + (32 * vb + r32) * 72 + 32 * sb + 16 * c2 + 4 * hi);
                        const u32x2 a1 = *(const LAS u32x2*)(vT + (32 * vb + r32) * 72 + 32 * sb + 16 * c2 + 8 + 4 * hi);
                        const bf16x8 vf = as_bf16x8((u32x4){a0.x, a0.y, a1.x, a1.y});
                        const bf16x8 pf = as_bf16x8((u32x4){P[4 * c2], P[4 * c2 + 1], P[4 * c2 + 2], P[4 * c2 + 3]});
                        O[vb][tb] = mfma32(vf, pf, O[vb][tb]);
                    }
            }
        }
        LDSW();
        const float* on = inp(I_HON) + L * 64;
#pragma unroll
        for (int tb = 0; tb < 2; ++tb) {
            float ss = 0.f;
#pragma unroll
            for (int vb = 0; vb < 2; ++vb)
#pragma unroll
                for (int r = 0; r < 16; ++r) ss += O[vb][tb][r] * O[vb][tb][r];
            ss += __shfl_xor(ss, 32);
            const float rn = rsqrtf(ss * (1.0f / 64.0f) + EPS);
#pragma unroll
            for (int vb = 0; vb < 2; ++vb)
#pragma unroll
                for (int r = 0; r < 16; ++r) { const int v = 32 * vb + crow(r, hi); ke[(32 * tb + r32) * 72 + v] = f2bf(O[vb][tb][r] * rn * on[v]); }
        }
        LDSW();
        bf16_t* mixed = (bf16_t*)(ws + WS_MIX) + row0 * DM + 640 + 64 * h;
#pragma unroll
        for (int i = 0; i < 8; ++i) {
            const int t = i * 8 + (lane >> 3), ch = lane & 7;
            const u32x4 ov = *(const LAS u32x4*)(ke + t * 72 + 8 * ch);
            const u32x4 gv = *(const u32x4*)(z + (size_t)t * ZW + C_HG + 64 * h + 8 * ch);
            u32x4 w;
            { const float g0 = bflo(gv.x), g1 = bfhi(gv.x); w.x = pk2(bflo(ov.x) * g0 * sigmoidf_(g0), bfhi(ov.x) * g1 * sigmoidf_(g1)); }
            { const float g0 = bflo(gv.y), g1 = bfhi(gv.y); w.y = pk2(bflo(ov.y) * g0 * sigmoidf_(g0), bfhi(ov.y) * g1 * sigmoidf_(g1)); }
            { const float g0 = bflo(gv.z), g1 = bfhi(gv.z); w.z = pk2(bflo(ov.z) * g0 * sigmoidf_(g0), bfhi(ov.z) * g1 * sigmoidf_(g1)); }
            { const float g0 = bflo(gv.w), g1 = bfhi(gv.w); w.w = pk2(bflo(ov.w) * g0 * sigmoidf_(g0), bfhi(ov.w) * g1 * sigmoidf_(g1)); }
            *(u32x4*)(mixed + (size_t)t * DM + 8 * ch) = w;
        }
    }
}

constexpr int ATT_K = 0, ATT_V = 18432, ATT_LUT = 35840, ATT_STAGE = 36864;
__device__ __forceinline__ void build_lut(LAS float* lut, const float* rel_bias, int head) {
    const int d = TID();
    if (d <= 128) {
        int bk = d;
        if (d >= 16) { const int far = 16 + (int)(__logf((float)d * (1.0f / 16.0f)) / 2.0794415416798357f * 16.0f); bk = far < 31 ? far : 31; }
        lut[d] = rel_bias[bk * 10 + head] * LOG2E;
    }
}
template <int NMAP, bool HAS_SEL>
__device__ __forceinline__ void attn_pass(LAS unsigned char* lds, const bf16_t* Kth, size_t kts, const bf16_t* Vth, int m_lo, int m_hi,
                                          const bf16x8 (&qr)[4], int tq, int qw0, int win, const LAS float* lut, u32x4 selw,
                                          f32x16 (&O)[NMAP][2], float (&l)[NMAP]) {
    const int tid = TID(), lane = tid & 63, r32 = lane & 31, hi = lane >> 5;
    const float c31 = lut[128];
    u32x4 kreg = *(const u32x4*)(Kth + (size_t)m_lo * kts), vreg = *(const u32x4*)(Vth + (size_t)m_lo * 64);
    int buf = 0;
    for (int m = m_lo; m <= m_hi; ++m) {
        *(LAS u32x4*)(lds + ATT_K + buf * 9216 + (tid >> 3) * 144 + (tid & 7) * 16) = kreg;
        { LAS u32x2* vp = (LAS u32x2*)(lds + ATT_V + buf * 8704 + (tid >> 3) * 136 + (tid & 7) * 16); vp[0] = (u32x2){vreg.x, vreg.y}; vp[1] = (u32x2){vreg.z, vreg.w}; }
        __syncthreads();
        if (m < m_hi) { kreg = *(const u32x4*)(Kth + (size_t)(m + 1) * kts); vreg = *(const u32x4*)(Vth + (size_t)(m + 1) * 64); }
        const int k0 = 64 * m, dmin = qw0 - (k0 + 63), dmax = qw0 + 31 - k0;
        bool sel = true;
        if (HAS_SEL) { const unsigned w = m < 32 ? selw.x : (m < 64 ? selw.y : (m < 96 ? selw.z : selw.w)); sel = (w >> (m & 31)) & 1u; }
        bool active = dmax >= 0 && dmin < win;
        if (HAS_SEL) active = active && (__any(sel) != 0);
        if (active) {
            const bool fast = dmin >= 128 && dmax < win;
            const LAS unsigned char* Kb = lds + ATT_K + buf * 9216;
            const LAS unsigned char* Vb = lds + ATT_V + buf * 8704;
            unsigned P[NMAP][2][8];
#pragma unroll
            for (int kh2 = 0; kh2 < 2; ++kh2) {
                f32x16 S[NMAP];
#pragma unroll
                for (int mp = 0; mp < NMAP; ++mp) { const float ini = fast ? c31 : 0.f;
#pragma unroll
                    for (int r = 0; r < 16; ++r) S[mp][r] = ini; }
#pragma unroll
                for (int c = 0; c < 4; ++c) {
                    const bf16x8 kf = *(const LAS bf16x8*)(Kb + (32 * kh2 + r32) * 144 + (16 * c + 8 * hi) * 2);
                    const int mp = (NMAP == 2) ? (c >> 1) : 0;
                    S[mp] = mfma32(kf, qr[c], S[mp]);
                }
#pragma unroll
                for (int mp = 0; mp < NMAP; ++mp) {
                    float p[16];
                    if (fast) {
#pragma unroll
                        for (int r = 0; r < 16; ++r) { const float e = ex2(S[mp][r]); p[r] = sel ? e : 0.f; }
                    } else {
#pragma unroll
                        for (int r = 0; r < 16; ++r) {
                            const int d = tq - (k0 + 32 * kh2 + crow(r, hi));
                            const bool valid = sel && d >= 0 && d < win;
                            const int dc = d < 0 ? 0 : (d > 128 ? 128 : d);
                            const float e = ex2(S[mp][r] + lut[dc]);
                            p[r] = valid ? e : 0.f;
                        }
                    }
                    float s = 0.f;
#pragma unroll
                    for (int r = 0; r < 16; ++r) s += p[r];
                    l[mp] += s;
#pragma unroll
                    for (int j = 0; j < 8; ++j) P[mp][kh2][j] = pk2(p[2 * j], p[2 * j + 1]);
                }
            }
#pragma unroll
            for (int db = 0; db < 2; ++db)
#pragma unroll
                for (int cc = 0; cc < 4; ++cc) {
                    const u32x2 a0 = *(const LAS u32x2*)(Vb + (32 * db + r32) * 136 + (16 * cc + 4 * hi) * 2);
                    const u32x2 a1 = *(const LAS u32x2*)(Vb + (32 * db + r32) * 136 + (16 * cc + 8 + 4 * hi) * 2);
                    const bf16x8 vf = as_bf16x8((u32x4){a0.x, a0.y, a1.x, a1.y});
#pragma unroll
                    for (int mp = 0; mp < NMAP; ++mp) {
                        const bf16x8 pf = as_bf16x8((u32x4){P[mp][cc >> 1][4 * (cc & 1)], P[mp][cc >> 1][4 * (cc & 1) + 1], P[mp][cc >> 1][4 * (cc & 1) + 2], P[mp][cc >> 1][4 * (cc & 1) + 3]});
                        O[mp][db] = mfma32(vf, pf, O[mp][db]);
                    }
                }
        }
        buf ^= 1;
    }
    __syncthreads();
}
template <bool ADD>
__device__ __forceinline__ void store_ot(LAS unsigned char* stage, const float (&val)[2][16], bf16_t* dst, int ld, const bf16_t* addsrc = nullptr, int ldadd = 0) {
    const int lane = TID() & 63, r32 = lane & 31, hi = lane >> 5;
    LAS bf16_t* st = (LAS bf16_t*)stage;
#pragma unroll
    for (int db = 0; db < 2; ++db)
#pragma unroll
        for (int r = 0; r < 16; ++r) st[r32 * 72 + 32 * db + crow(r, hi)] = f2bf(val[db][r]);
    LDSW();
#pragma unroll
    for (int i = 0; i < 4; ++i) {
        const int row = i * 8 + (lane >> 3), ch = lane & 7;
        u32x4 v = *(const LAS u32x4*)(st + row * 72 + 8 * ch);
        bf16_t* gp = dst + (size_t)row * ld + 8 * ch;
        if (ADD) {
            const u32x4 o = *(const u32x4*)(addsrc + (size_t)row * ldadd + 8 * ch);
            v.x = pk2(bflo(v.x) + bflo(o.x), bfhi(v.x) + bfhi(o.x)); v.y = pk2(bflo(v.y) + bflo(o.y), bfhi(v.y) + bfhi(o.y));
            v.z = pk2(bflo(v.z) + bflo(o.z), bfhi(v.z) + bfhi(o.z)); v.w = pk2(bflo(v.w) + bflo(o.w), bfhi(v.w) + bfhi(o.w));
        }
        *(u32x4*)gp = v;
    }
    LDSW();
}

__device__ __forceinline__ void task_diff(const float* const* in, unsigned char* ws, int L, int task, LAS unsigned char* lds) {
    const int tid = TID(), lane = tid & 63, wave = tid >> 6, r32 = lane & 31, hi = lane >> 5;
    const int qb = 31 - (task >> 4), b = (task >> 2) & 3, hd = task & 3;
    const bf16_t* z = (const bf16_t*)(ws + WS_R1);
    LAS float* lut = (LAS float*)(lds + ATT_LUT);
    build_lut(lut, inp(I_RELB), 6 + hd);
    __syncthreads();
    const int q0 = 256 * qb, qw0 = q0 + 32 * wave, tq = qw0 + r32;
    bf16x8 qr[4];
#pragma unroll
    for (int c = 0; c < 4; ++c) qr[c] = *(const bf16x8*)(z + (size_t)(b * T + tq) * ZW + C_DQ + 64 * hd + 16 * c + 8 * hi);
    const bf16_t* Kth = z + (size_t)(b * T + (tid >> 3)) * ZW + C_DK + 64 * hd + (tid & 7) * 8;
    const bf16_t* Vth = (const bf16_t*)(ws + WS_VT) + ((size_t)(b * 8 + 4 + hd) * 64 + (tid >> 3)) * T + (tid & 7) * 8;
    f32x16 O[2][2] = {}; float l[2] = {0.f, 0.f};
    attn_pass<2, false>(lds, Kth, (size_t)64 * ZW, Vth, 0, 4 * qb + 3, qr, tq, qw0, 1 << 30, lut, (u32x4){0u, 0u, 0u, 0u}, O, l);
    const float* lp = inp(I_DLAM) + L * 128;
    float s01 = 0.f, s23 = 0.f;
#pragma unroll
    for (int i = 0; i < 32; ++i) { s01 += lp[i] * lp[32 + i]; s23 += lp[64 + i] * lp[96 + i]; }
    const float lam_init = 0.8f - 0.6f * __expf(-0.3f * (float)L);
    const float lam = __expf(s01) - __expf(s23) + lam_init;
    const float l0 = l[0] + __shfl_xor(l[0], 32), l1 = l[1] + __shfl_xor(l[1], 32);
    const float i0 = 1.0f / l0, i1 = lam / l1;
    float val[2][16]; float ss = 0.f;
#pragma unroll
    for (int db = 0; db < 2; ++db)
#pragma unroll
        for (int r = 0; r < 16; ++r) { const float o = O[0][db][r] * i0 - O[1][db][r] * i1; val[db][r] = o; ss += o * o; }
    ss += __shfl_xor(ss, 32);
    const float rn = rsqrtf(ss * (1.0f / 64.0f) + EPS) * (1.0f - lam_init);
    const float* sub = inp(I_DSUB) + L * 64;
#pragma unroll
    for (int db = 0; db < 2; ++db)
#pragma unroll
        for (int r = 0; r < 16; ++r) val[db][r] *= rn * sub[32 * db + crow(r, hi)];
    store_ot<false>(lds + ATT_STAGE + wave * 4608, val, (bf16_t*)(ws + WS_MIX) + (size_t)(b * T + qw0) * DM + 384 + 64 * hd, DM);
}

__device__ __forceinline__ void task_nsa_sw(const float* const* in, unsigned char* ws, int L, int task, LAS unsigned char* lds) {
    const int tid = TID(), lane = tid & 63, wave = tid >> 6, r32 = lane & 31, hi = lane >> 5;
    const int qb = 31 - task / 24, rem = task % 24, b = rem / 6, h = rem % 6, g = h / 3;
    const bf16_t* z = (const bf16_t*)(ws + WS_R1);
    LAS float* lut = (LAS float*)(lds + ATT_LUT);
    build_lut(lut, inp(I_RELB), h);
    __syncthreads();
    const int q0 = 256 * qb, qw0 = q0 + 32 * wave, tq = qw0 + r32;
    const bf16_t* zq = z + (size_t)(b * T + tq) * ZW;
    bf16x8 qr[4];
#pragma unroll
    for (int c = 0; c < 4; ++c) qr[c] = *(const bf16x8*)(zq + C_NQ + 64 * h + 16 * c + 8 * hi);
    const u32x4 selw = *(const u32x4*)((const unsigned*)(ws + WS_SELM) + ((size_t)(b * 2 + g) * T + tq) * 4);
    const float g1 = sigmoidf_(bf2f(zq[C_NG + 3 * h + 1])), g2 = sigmoidf_(bf2f(zq[C_NG + 3 * h + 2]));
    float val[2][16];
    {
        const bf16_t* Kth = z + (size_t)(b * T + (tid >> 3)) * ZW + C_SK + 64 * g + (tid & 7) * 8;
        const bf16_t* Vth = (const bf16_t*)(ws + WS_VT) + ((size_t)(b * 8 + g) * 64 + (tid >> 3)) * T + (tid & 7) * 8;
        f32x16 O[1][2] = {}; float l[1] = {0.f};
        attn_pass<1, true>(lds, Kth, (size_t)64 * ZW, Vth, 0, 4 * qb + 3, qr, tq, qw0, 1 << 30, lut, selw, O, l);
        const float lt = l[0] + __shfl_xor(l[0], 32), sc = g1 / lt;
#pragma unroll
        for (int db = 0; db < 2; ++db)
#pragma unroll
            for (int r = 0; r < 16; ++r) val[db][r] = O[0][db][r] * sc;
    }
    {
        const bf16_t* Kth = z + (size_t)(b * T + (tid >> 3)) * ZW + C_WK + 64 * g + (tid & 7) * 8;
        const bf16_t* Vth = (const bf16_t*)(ws + WS_VT) + ((size_t)(b * 8 + 2 + g) * 64 + (tid >> 3)) * T + (tid & 7) * 8;
        f32x16 O[1][2] = {}; float l[1] = {0.f};
        const int m_lo = q0 >= 512 ? (q0 >> 6) - 8 : 0;
        attn_pass<1, false>(lds, Kth, (size_t)64 * ZW, Vth, m_lo, 4 * qb + 3, qr, tq, qw0, 512, lut, (u32x4){0u, 0u, 0u, 0u}, O, l);
        const float lt = l[0] + __shfl_xor(l[0], 32), sc = g2 / lt;
#pragma unroll
        for (int db = 0; db < 2; ++db)
#pragma unroll
            for (int r = 0; r < 16; ++r) val[db][r] += O[0][db][r] * sc;
    }
    store_ot<true>(lds + ATT_STAGE + wave * 4608, val, (bf16_t*)(ws + WS_MIX) + (size_t)(b * T + qw0) * DM + 64 * h, DM, (const bf16_t*)(ws + WS_OCB) + (size_t)(b * T + qw0) * 384 + 64 * h, 384);
}

constexpr int NC_IMP = 18432, NC_IMPW = 129, NC_LINV = NC_IMP + 3 * 64 * NC_IMPW * 4;
__device__ __forceinline__ void task_nsa_c(const float* const* in, unsigned char* ws, int L, int task, LAS unsigned char* lds) {
    const int tid = TID(), lane = tid & 63, wave = tid >> 6, r32 = lane & 31, hi = lane >> 5;
    const int cur = 127 - (task >> 3), b = (task >> 1) & 3, g = task & 1;
    const bf16_t* z = (const bf16_t*)(ws + WS_R1);
    LAS float* imp = (LAS float*)(lds + NC_IMP);
    LAS float* linv = (LAS float*)(lds + NC_LINV);
    const int q0 = 64 * cur;
    const int rh = wave >> 1, half = wave & 1, h = 3 * g + (rh < 3 ? rh : 0);
    const int ql = 32 * half + r32, tq = q0 + ql;
    const bf16_t* zq = z + (size_t)(b * T + tq) * ZW;
    bf16x8 qr[4];
#pragma unroll
    for (int c = 0; c < 4; ++c) qr[c] = *(const bf16x8*)(zq + C_NQ + 64 * h + 16 * c + 8 * hi);
    const bf16_t* Kth = (const bf16_t*)(ws + WS_KC) + ((size_t)(b * 2 + g) * 512 + (tid >> 3)) * 64 + (tid & 7) * 8;
    const bf16_t* Vth = (const bf16_t*)(ws + WS_VCT) + ((size_t)(b * 2 + g) * 64 + (tid >> 3)) * 512 + (tid & 7) * 8;
    const int ntiles = ((4 * cur + 2) >> 6) + 1;
    f32x16 O[2] = {}; float l = 0.f, carry = 0.f;
    u32x4 kreg = *(const u32x4*)(Kth), vreg = *(const u32x4*)(Vth);
    for (int m = 0; m < ntiles; ++m) {
        __syncthreads();
        *(LAS u32x4*)(lds + (tid >> 3) * 144 + (tid & 7) * 16) = kreg;
        { LAS u32x2* vp = (LAS u32x2*)(lds + 9216 + (tid >> 3) * 136 + (tid & 7) * 16); vp[0] = (u32x2){vreg.x, vreg.y}; vp[1] = (u32x2){vreg.z, vreg.w}; }
        __syncthreads();
        if (m + 1 < ntiles) { kreg = *(const u32x4*)(Kth + (size_t)(m + 1) * 64 * 64); vreg = *(const u32x4*)(Vth + (size_t)(m + 1) * 64); }
        if (wave < 6) {
            unsigned P[2][8]; float av[8], bq[8];
#pragma unroll
            for (int kh2 = 0; kh2 < 2; ++kh2) {
                f32x16 S = {};
#pragma unroll
                for (int c = 0; c < 4; ++c) { const bf16x8 kf = *(const LAS bf16x8*)(lds + (32 * kh2 + r32) * 144 + (16 * c + 8 * hi) * 2); S = mfma32(kf, qr[c], S); }
                float p[16];
#pragma unroll
                for (int r = 0; r < 16; ++r) { const int n = 64 * m + 32 * kh2 + crow(r, hi); const float e = ex2(S[r]); p[r] = (16 * n + 31 <= tq) ? e : 0.f; }
                float s = 0.f;
#pragma unroll
                for (int r = 0; r < 16; ++r) s += p[r];
                l += s;
#pragma unroll
                for (int j = 0; j < 8; ++j) P[kh2][j] = pk2(p[2 * j], p[2 * j + 1]);
#pragma unroll
                for (int j = 0; j < 4; ++j) { av[4 * kh2 + j] = p[4 * j] + p[4 * j + 1] + p[4 * j + 2] + 0.5f * p[4 * j + 3]; bq[4 * kh2 + j] = 0.5f * p[4 * j + 3]; }
            }
#pragma unroll
            for (int db = 0; db < 2; ++db)
#pragma unroll
                for (int cc = 0; cc < 4; ++cc) {
                    const u32x2 a0 = *(const LAS u32x2*)(lds + 9216 + (32 * db + r32) * 136 + (16 * cc + 4 * hi) * 2);
                    const u32x2 a1 = *(const LAS u32x2*)(lds + 9216 + (32 * db + r32) * 136 + (16 * cc + 8 + 4 * hi) * 2);
                    const bf16x8 vf = as_bf16x8((u32x4){a0.x, a0.y, a1.x, a1.y});
                    const bf16x8 pf = as_bf16x8((u32x4){P[cc >> 1][4 * (cc & 1)], P[cc >> 1][4 * (cc & 1) + 1], P[cc >> 1][4 * (cc & 1) + 2], P[cc >> 1][4 * (cc & 1) + 3]});
                    O[db] = mfma32(vf, pf, O[db]);
                }
            float recv[8];
#pragma unroll
            for (int jj = 0; jj < 8; ++jj) recv[jj] = __shfl_xor(bq[jj], 32);
            LAS float* ip = imp + (rh * 64 + ql) * NC_IMPW + 16 * m + hi;
#pragma unroll
            for (int jj = 0; jj < 8; ++jj) {
                const float add = hi ? recv[jj] : (jj == 0 ? carry : recv[jj > 0 ? jj - 1 : 0]);
                ip[2 * jj] = av[jj] + add;
            }
            carry = recv[7];
        }
    }
    if (wave < 6) {
        const float lt = l + __shfl_xor(l, 32);
        const float li = (tq >= 31 && lt > 0.f) ? 1.0f / lt : 0.f;
        if (hi == 0) linv[rh * 64 + ql] = li;
        const float g0 = sigmoidf_(bf2f(zq[C_NG + 3 * h + 0]));
        bf16_t* mx = (bf16_t*)(ws + WS_OCB) + (size_t)(b * T + tq) * 384 + 64 * h;
        const float sc = li * g0;
#pragma unroll
        for (int db = 0; db < 2; ++db)
#pragma unroll
            for (int r = 0; r < 16; ++r) mx[32 * db + crow(r, hi)] = f2bf(O[db][r] * sc);
    }
    __syncthreads();
#pragma unroll 1
    for (int qi = 0; qi < 8; ++qi) {
        const int q = 8 * wave + qi;
        unsigned w0 = 0u, w1 = 0u, w2 = 0u, w3 = 0u;
        if (cur <= 15) { w0 = (1u << (cur + 1)) - 1u; }
        else {
            const float i0 = linv[q], i1 = linv[64 + q], i2 = linv[128 + q];
            const int ma = lane, mb = lane + 64;
            float va = 0.f, vb = 0.f;
            if (ma >= 1 && ma <= cur - 2) va = imp[(0 * 64 + q) * NC_IMPW + ma] * i0 + imp[(1 * 64 + q) * NC_IMPW + ma] * i1 + imp[(2 * 64 + q) * NC_IMPW + ma] * i2;
            if (mb <= cur - 2) vb = imp[(0 * 64 + q) * NC_IMPW + mb] * i0 + imp[(1 * 64 + q) * NC_IMPW + mb] * i1 + imp[(2 * 64 + q) * NC_IMPW + mb] * i2;
            unsigned ka = va > 0.f ? ((__float_as_uint(va) & ~127u) | (unsigned)(127 - ma)) : 0u;
            unsigned kb = vb > 0.f ? ((__float_as_uint(vb) & ~127u) | (unsigned)(127 - mb)) : 0u;
            w0 = 1u;
#pragma unroll 1
            for (int it = 0; it < 13; ++it) {
                unsigned best = ka > kb ? ka : kb;
#pragma unroll
                for (int o = 1; o < 64; o <<= 1) { const unsigned ot = __shfl_xor(best, o); best = ot > best ? ot : best; }
                if (best != 0u) {
                    const int mw = 127 - (int)(best & 127u);
                    const unsigned bit = 1u << (mw & 31);
                    if (mw < 32) w0 |= bit; else if (mw < 64) w1 |= bit; else if (mw < 96) w2 |= bit; else w3 |= bit;
                    if (ka == best) ka = 0u;
                    if (kb == best) kb = 0u;
                }
            }
#pragma unroll
            for (int f = 0; f < 2; ++f) {
                const int mw = cur - f; const unsigned bit = 1u << (mw & 31);
                if (mw < 32) w0 |= bit; else if (mw < 64) w1 |= bit; else if (mw < 96) w2 |= bit; else w3 |= bit;
            }
        }
        if (lane == 0) *(u32x4*)((unsigned*)(ws + WS_SELM) + ((size_t)(b * 2 + g) * T + q0 + q) * 4) = (u32x4){w0, w1, w2, w3};
    }
}

#define XB_TMO      128
#define XB_XCNT(j)  (256  + 64 * (j))
#define XB_XSUB(j)  (1280 + 64 * (j))
#define XB_XGEN(j)  (2304 + 64 * (j))
#define XB_TOP      3328
#define XB_TOPGEN   3392
#define XCD_BAR_WORDS 3456
#define XB_SPIN_CAP (1u << 18)

__device__ __forceinline__ unsigned xb_ld(unsigned* p)              { return __hip_atomic_load(p, __ATOMIC_RELAXED, __HIP_MEMORY_SCOPE_AGENT); }
__device__ __forceinline__ unsigned xb_add(unsigned* p, unsigned v) { return __hip_atomic_fetch_add(p, v, __ATOMIC_RELAXED, __HIP_MEMORY_SCOPE_AGENT); }
__device__ __forceinline__ unsigned xb_xcc_id() { return (unsigned)__builtin_amdgcn_s_getreg((3 << 11) | 20) & 0xFu; }
#define XB_SPIN(cond, bar) do { unsigned _sp = 0; while (cond) { __builtin_amdgcn_s_sleep(1); \
    if ((++_sp & 255u) == 0u) { if (xb_ld(&(bar)[XB_TMO])) break; if (_sp > XB_SPIN_CAP) { atomicAdd(&(bar)[XB_TMO], 1u); break; } } } } while (0)

struct XcdBarrier {
    unsigned* bar; unsigned x;
    volatile LAS unsigned* st;
};

__device__ __forceinline__ XcdBarrier xcd_barrier_post(unsigned* bar, volatile LAS unsigned* st) {
    XcdBarrier b; b.bar = bar; b.x = xb_xcc_id(); b.st = st;
    if (threadIdx.x == 0) (void)xb_add(&bar[XB_XCNT(b.x)], 1u);
    return b;
}
__device__ __forceinline__ void xcd_barrier_complete(unsigned* bar, unsigned x, unsigned& nloc, unsigned& nx) {
    const unsigned G = gridDim.x * gridDim.y * gridDim.z;
    unsigned sum, cnt, mine, sp = 0u;
    for (;;) {
        sum = 0u; cnt = 0u; mine = 0u;
#pragma unroll
        for (unsigned j = 0; j < 16; ++j) { const unsigned c = xb_ld(&bar[XB_XCNT(j)]); sum += c; cnt += (c > 0u) ? 1u : 0u; mine = (j == x) ? c : mine; }
        if (sum == G) break;
        __builtin_amdgcn_s_sleep(1);
        if ((++sp & 255u) == 0u) { if (xb_ld(&bar[XB_TMO])) break; if (sp > XB_SPIN_CAP) { atomicAdd(&bar[XB_TMO], 1u); break; } }
    }
    nloc = mine > 0u ? mine : 1u; nx = cnt > 0u ? cnt : 1u;
}

__device__ __forceinline__ void xcd_barrier(const XcdBarrier& b) {
    asm volatile("s_waitcnt vmcnt(0)" ::: "memory");
    __syncthreads();
    if (threadIdx.x == 0) {
        unsigned* bar = b.bar;
        __builtin_amdgcn_s_waitcnt(0);
        unsigned nloc = b.st[0], nx = b.st[1];
        if (nloc == 0u) { xcd_barrier_complete(bar, b.x, nloc, nx); b.st[0] = nloc; b.st[1] = nx; }
        const unsigned old = xb_add(&bar[XB_XSUB(b.x)], 1u);
        const unsigned gen = old / nloc;
        if (old + 1u == (gen + 1u) * nloc) {
            __builtin_amdgcn_fence(__ATOMIC_RELEASE, "agent");
            asm volatile("s_waitcnt vmcnt(0)" ::: "memory");
            const unsigned og = xb_add(&bar[XB_TOP], 1u);
            const unsigned tg = og / nx;
            if (og + 1u == (tg + 1u) * nx) xb_add(&bar[XB_TOPGEN], 1u);
            else XB_SPIN(xb_ld(&bar[XB_TOPGEN]) == tg, bar);
            __builtin_amdgcn_fence(__ATOMIC_ACQUIRE, "agent");
            xb_add(&bar[XB_XGEN(b.x)], 1u);
            asm volatile("s_waitcnt vmcnt(0)" ::: "memory");
        } else {
            XB_SPIN(xb_ld(&bar[XB_XGEN(b.x)]) == gen, bar);
            __builtin_amdgcn_fence(__ATOMIC_ACQUIRE, "agent");
            asm volatile("s_waitcnt vmcnt(0)" ::: "memory");
        }
    }
    __syncthreads();
}

struct Args { const float* in[N_IN]; float* out; unsigned char* ws; int ph_lo, ph_hi; };
static_assert(sizeof(Args) == 8 * N_IN + 24, "Args has no padding");
constexpr int PH_PER_LAYER = 12, N_PHASES = DEPTH * PH_PER_LAYER;
#ifndef PH_HI
#ifdef REPJ
#define PH_HI (N_PHASES + DEPTH)
#else
#define PH_HI N_PHASES
#endif
#endif

__global__ void __launch_bounds__(512) mega(Args a) {
    extern __shared__ __attribute__((aligned(16))) unsigned char lds_raw[];
    LAS unsigned char* lds = (LAS unsigned char*)lds_raw;
    LAS int* slot = (LAS int*)(lds + LDS_MISC);
    cg::grid_group grid = cg::this_grid();
    const float* const* in = nullptr;
    volatile LAS unsigned* misc = (volatile LAS unsigned*)(lds + LDS_MISC);
    if (TID() < 16) misc[TID()] = 0u;
    __syncthreads();
    (void)xcd_barrier_post((unsigned*)(a.ws + WS_CTL) + 4096, misc + 8);
#ifndef DUP_GU
#define DUP_GU 0
#endif
#ifndef DUP_IN
#define DUP_IN 0
#endif
#ifndef DUP_DIFF
#define DUP_DIFF 0
#endif
#ifndef DUP_NSAC
#define DUP_NSAC 0
#endif
#ifndef DUP_SW
#define DUP_SW 0
#endif
#ifndef DUP_HOUT
#define DUP_HOUT 0
#endif
#ifndef DUP_M1
#define DUP_M1 0
#endif
#ifndef DUP_SYNC
#define DUP_SYNC 0
#endif
#ifndef DUP_CONV
#define DUP_CONV 0
#endif
#ifndef PHM
#define PHM 0xfff
#endif
    for (int ph = a.ph_lo; ph < a.ph_hi; ++ph) {
#ifdef REPJ
        int L = ph / (PH_PER_LAYER + 1); const int k_ = ph - L * (PH_PER_LAYER + 1); const int j = k_ <= REPJ ? k_ : k_ - 1; const float amul = (k_ == REPJ) ? 0.f : 1.f;
#else
        int L = ph / PH_PER_LAYER; const int j = ph - L * PH_PER_LAYER; const float amul = 1.f;
#endif
        asm volatile("" : "+s"(L));
        unsigned long long ws_ = (unsigned long long)a.ws; asm volatile("" : "+s"(ws_)); unsigned char* ws = (unsigned char*)(GAS unsigned char*)ws_;
        unsigned long long out_ = (unsigned long long)a.out; asm volatile("" : "+s"(out_)); float* out_g = (float*)(GAS float*)out_;
        unsigned* ctl = (unsigned*)(ws + WS_CTL); bf16_t* r1 = (bf16_t*)(ws + WS_R1); bf16_t* mixed = (bf16_t*)(ws + WS_MIX); bf16_t* pb = (bf16_t*)(ws + WS_PB); unsigned char* wb = ws + WS_W; float* rsqp = (float*)(ws + WS_RSQP);
        float* rsq = (float*)(ws + ((L & 1) ? WS_RSQ1 : WS_RSQ0)); float* rsq_next = (float*)(ws + ((L & 1) ? WS_RSQ0 : WS_RSQ1));
        bf16_t* xb = (bf16_t*)(ws + ((L & 1) ? WS_XB1 : WS_XB)); bf16_t* xb_next = (bf16_t*)(ws + ((L & 1) ? WS_XB : WS_XB1));
        if ((PHM >> j) & 1) switch (j) {
        case 0: phase_convert(in, ws, out_g, L, lds); if (DUP_CONV) { __syncthreads(); phase_convert(in, ws, out_g, L, lds); } break;
        case 1: { EpiSwiGLU E{r1, {}}; run_gemm(lds, xb, (const bf16_t*)(wb + W_GU1), 2 * FF, DM, E, rsq); } break;
        case 2: { EpiRes<0> E{out_g, xb, rsq, 0.5f * amul, nullptr, nullptr, nullptr, nullptr, nullptr, {}}; run_gemm(lds, r1, (const bf16_t*)(wb + W_D1), DM, FF, E); } break;
        case 3: { EpiZ E{r1, {}}; run_gemm(lds, xb, (const bf16_t*)(wb + W_IN), ZW, DM, E, rsq); } break;
        case 4: {
            unsigned* ctr = ctl + (L * 4 + 0) * 64;
            constexpr int NCMP = 512 << DUP_M1, NHL = 512 << DUP_M1;
            for (;;) { const int t = next_task(ctr, slot); if (t >= NCMP + NHL + 512) break;
                if (t < NCMP) task_compress(in, ws, L, t >> DUP_M1, lds); else if (t < NCMP + NHL) task_hgrn_local(in, ws, L, (t - NCMP) >> DUP_M1, lds); else task_prep(in, ws, L, t - NCMP - NHL, lds); }
        } break;
        case 5: {
            unsigned* ctr = ctl + (L * 4 + 1) * 64;
            constexpr int ND = 512 << DUP_DIFF, NC = 1024 << DUP_NSAC;
            for (;;) { const int t = next_task(ctr, slot); if (t >= 192 + ND + NC) break;
                if (t < 192) task_hgrn_scan(ws, t); else if (t < 192 + ND) task_diff(in, ws, L, (t - 192) >> DUP_DIFF, lds); else task_nsa_c(in, ws, L, (t - 192 - ND) >> DUP_NSAC, lds); }
        } break;
        case 6: {
            unsigned* ctr = ctl + (L * 4 + 2) * 64;
            constexpr int NS = 768 << DUP_SW, NH = 1024 << DUP_HOUT;
            for (;;) { const int t = next_task(ctr, slot); if (t >= NS + NH) break;
                if (t < NS) task_nsa_sw(in, ws, L, t >> DUP_SW, lds); else task_hgrn_out(in, ws, L, (t - NS) >> DUP_HOUT, lds); }
        } break;
        case 7: { EpiRes<0> E{out_g, xb, rsq, 1.0f * amul, nullptr, nullptr, nullptr, nullptr, nullptr, {}}; run_gemm(lds, mixed, (const bf16_t*)(wb + W_OUT), DM, DM, E); } break;
        case 8: { EpiSwiGLU E{r1, {}}; run_gemm(lds, xb, (const bf16_t*)(wb + W_GU2), 2 * FF, DM, E, rsq); } break;
        case 9: { EpiRes<2> E{nullptr, nullptr, rsqp, 0.f, nullptr, nullptr, nullptr, nullptr, mixed, {}}; run_gemm(lds, pb, (const bf16_t*)(wb + W_PP), DM, PLE, E); } break;
        case 10: { EpiRes<0> E{out_g, xb, rsq, 0.5f * amul, nullptr, nullptr, nullptr, nullptr, nullptr, {}}; run_gemm(lds, r1, (const bf16_t*)(wb + W_D2), DM, FF, E); } break;
        default: { EpiRes<1> E{out_g, xb_next, rsq_next, 0.f, rsq, mixed, rsqp, inp(I_PLPOST) + L * DM, nullptr, {}}; run_gemm(lds, xb, (const bf16_t*)(wb + W_PG), DM, DM, E, rsq, rsqp); } break;
        }
        if (ph + 1 < a.ph_hi) {
            if (ph == 0) { asm volatile("s_waitcnt vmcnt(0) lgkmcnt(0)" ::: "memory"); grid.sync(); __builtin_amdgcn_fence(__ATOMIC_ACQUIRE, "agent"); asm volatile("s_waitcnt vmcnt(0)" ::: "memory"); __syncthreads(); }
            else { XcdBarrier xb_; xb_.bar = (unsigned*)(ws + WS_CTL) + 4096; xb_.x = xb_xcc_id(); xb_.st = misc + 8; xcd_barrier(xb_); if (DUP_SYNC) xcd_barrier(xb_); }
        }
    }
}

#ifdef DUMPK
__global__ void __launch_bounds__(512) dump_kernel(float* out, unsigned char* ws) {
    bf16_t* mixed = (bf16_t*)(ws + WS_MIX); (void)mixed;
    for (size_t idx = (size_t)blockIdx.x * 512 + threadIdx.x; idx < (size_t)M * 1024; idx += (size_t)gridDim.x * 512) {
        const size_t m = idx >> 10; const int c = (int)(idx & 1023);
        float v = 0.f;
#if DUMPK == 3 || DUMPK == 40
        { const bf16_t* z = (const bf16_t*)(ws + WS_R1); v = bf2f(z[m * ZW + c]) + bf2f(z[m * ZW + 1024 + c]) + bf2f(z[m * ZW + 2048 + c]) + (c < 402 ? bf2f(z[m * ZW + 3072 + c]) : 0.f); }
#elif DUMPK == 41
        { const bf16_t* vt = (const bf16_t*)(ws + WS_VT); v = bf2f(vt[m * 512 + (c & 511)]); }
#elif DUMPK == 42
        { const float* hs = (const float*)(ws + WS_HS); const float* hd = (const float*)(ws + WS_HD); v = hs[m * 384 + (c % 384)] + hd[m * 6 + (c % 6)]; }
#elif DUMPK == 43
        { const bf16_t* kc = (const bf16_t*)(ws + WS_KC); const bf16_t* vct = (const bf16_t*)(ws + WS_VCT); v = bf2f(kc[m * 8 + (c & 7)]) + bf2f(vct[m * 8 + (c & 7)]); }
#elif DUMPK == 50 || DUMPK == 60
        v = (c < 384) ? bf2f(mixed[m * 1024 + c]) : 0.f;
#elif DUMPK == 51
        v = (c >= 384 && c < 640) ? bf2f(mixed[m * 1024 + c]) : 0.f;
#elif DUMPK == 52
        { const unsigned* selm = (const unsigned*)(ws + WS_SELM); v = (float)(selm[m * 8 + (c & 7)] & 0xffffu) + (float)(selm[m * 8 + (c & 7)] >> 16); }
#elif DUMPK == 53
        { const float* hs = (const float*)(ws + WS_HS); v = hs[m * 384 + (c % 384)]; }
#elif DUMPK == 61
        v = (c >= 640) ? bf2f(mixed[m * 1024 + c]) : 0.f;
#endif
        out[idx] = v;
    }
}
#endif

extern "C" void kernel_launch(void* const* d_in, const int* in_sizes, int n_in, void* d_out, int out_size, void* d_ws, size_t ws_size, hipStream_t stream) {
    static int grid = 0;
    if (grid == 0) {
        if (n_in != N_IN || out_size != M * DM || ws_size < WS_END) { fprintf(stderr, "kernel_launch: unexpected shapes (n_in %d out %d ws %zu)\n", n_in, out_size, ws_size); grid = -1; return; }
        int dev = 0, cus = 0, per_cu = 0;
        hipGetDevice(&dev); hipDeviceGetAttribute(&cus, hipDeviceAttributeMultiprocessorCount, dev);
        if (hipFuncSetAttribute((const void*)mega, hipFuncAttributeMaxDynamicSharedMemorySize, LDS_BYTES) != hipSuccess) { fprintf(stderr, "hipFuncSetAttribute failed\n"); }
        if (hipOccupancyMaxActiveBlocksPerMultiprocessor(&per_cu, (const void*)mega, 512, LDS_BYTES) != hipSuccess || per_cu < 1) { fprintf(stderr, "occupancy query: %d\n", per_cu); per_cu = 1; }
        (void)hipGetLastError();
        grid = cus;
    }
    if (grid < 0) return;
    hipMemsetAsync((char*)d_ws + WS_CTL, 0, 64 * 1024, stream);
    Args a{};
    for (int i = 0; i < N_IN; ++i) a.in[i] = (const float*)d_in[i];
    a.out = (float*)d_out; a.ws = (unsigned char*)d_ws; a.ph_lo = 0; a.ph_hi = PH_HI;
    void* args[] = {&a};
    hipError_t e = hipLaunchCooperativeKernel((const void*)mega, dim3(grid), dim3(512), args, LDS_BYTES, stream);
    if (e != hipSuccess) fprintf(stderr, "cooperative launch failed: %s (grid %d)\n", hipGetErrorString(e), grid);
#ifdef DUMPK
    dump_kernel<<<dim3(1024), dim3(512), 0, stream>>>((float*)d_out, (unsigned char*)d_ws);
#endif
}
```

```cpp
#include <hip/hip_runtime.h>
#include <hip/hip_cooperative_groups.h>
#include <cstdio>
#include <cstdint>
namespace cg = cooperative_groups;
__device__ __forceinline__ int TID() { int t = threadIdx.x; asm volatile("" : "+v"(t)); return t; }
namespace pg8 {
#define PG8_LAS __attribute__((address_space(3)))
typedef unsigned short bf16_t;
typedef short bf16x8 __attribute__((ext_vector_type(8)));
typedef float f32x4 __attribute__((ext_vector_type(4)));
typedef unsigned u32x4 __attribute__((ext_vector_type(4)));
constexpr int BM = 256, BK = 64, HALF = 128, HTB = HALF * BK * 2  , STAGE_BYTES = 8 * HTB, NXCD = 8, WGM = 8;

__host__ __device__ __forceinline__ int lds_byte(int r, int c) { const int st = (r >> 4) * 2 + (c >> 5), rr = r & 15, cc = c & 31, ob = rr * 64 + cc * 2; return st * 1024 + (ob ^ (((ob >> 9) & 1) << 5)); }
__host__ __device__ __forceinline__ void stage_rc(int b, int& R, int& C) { const int st = b / 1024, sb = b % 1024, swz = sb ^ (((sb >> 9) & 1) << 5); R = (st >> 1) * 16 + swz / 64; C = (st & 1) * 32 + (swz % 64) / 2; }
__host__ __device__ __forceinline__ int perm32(int rho) { const int n = rho >> 4, i = rho & 15; return 8 * (i >> 2) + 4 * n + (i & 3); }

struct Unit { int pm, pn; };
struct Gemm { const bf16_t* A; const bf16_t* Bt; int M, N, K; };

struct StaticOrder {
    int nM, nN, nwg, G, c;
    __host__ __device__ void init(int M, int N, int G_, int c_) { nM = M / BM; nN = N / BM; nwg = nM * nN; G = G_; c = c_; }
    __host__ __device__ bool next(int i, Unit& u) const {
        const long L = (long)i * G + c; if (L >= nwg) return false;
        int wgid = (int)L; { const int q = nwg / NXCD, r = nwg % NXCD, xcd = wgid % NXCD, off = wgid / NXCD; wgid = (xcd < r ? xcd * (q + 1) : r * (q + 1) + (xcd - r) * q) + off; }
        const int nig = WGM * nN, gid = wgid / nig, fm = gid * WGM, gsz = (nM - fm) < WGM ? (nM - fm) : WGM;
        u.pm = fm + ((wgid % nig) % gsz); u.pn = (wgid % nig) / gsz; return true;
    }
    __device__ __forceinline__ void a_ready(const Unit&) const {}
    __device__ __forceinline__ void done(const Unit&) const {}
};

template <class Epi, class Sched, bool ALIGN_EPI = false, bool SP2 = false>
__device__ __forceinline__ void gemm_phase(PG8_LAS unsigned char* lds, const Gemm g, const Sched& S, const Epi& E) {
    const int tid = TID(), wid = __builtin_amdgcn_readfirstlane(tid >> 6), lane = tid & 63, wr = wid >> 2, wc = wid & 3, fr = lane & 15, fq = lane >> 4;
    const int K = g.K, nt = K / BK;
    unsigned voffA[2], voffB[2];
#pragma unroll
    for (int i = 0; i < 2; ++i) { int R, C; stage_rc(tid * 16 + i * 8192, R, C); const int Rb = Epi::PERM ? ((R & ~31) + perm32(R & 31)) : R;
        voffA[i] = (unsigned)(R * K + C) * 2u; voffB[i] = (unsigned)(Rb * K + C) * 2u; }
    const size_t kstep = (size_t)(BK * 2);
    const size_t hstep = (size_t)HALF * K * 2;
    const size_t tstep = 2 * hstep;
    const unsigned ldsw = (unsigned)wid * 1024u;
    const int aoff = lds_byte(wr * 64 + fr, fq * 8), boff = lds_byte(wc * 32 + fr, fq * 8);
#define PG8_SA(b, h) (((b) * 2 + (h)) * HTB)
#define PG8_SB(b, h) ((4 + (b) * 2 + (h)) * HTB)
#define PG8_STAGE(bufoff, gbase, voff) do { _Pragma("unroll") for (int _i = 0; _i < 2; ++_i) \
        __builtin_amdgcn_global_load_lds((const unsigned*)((const char*)(gbase) + (voff)[_i]), (PG8_LAS unsigned*)(lds + (bufoff) + ldsw + _i * 8192), 16, 0, 0); } while (0)
#define PG8_LDA(dst, b, h) do { _Pragma("unroll") for (int m = 0; m < 4; ++m) _Pragma("unroll") for (int k = 0; k < 2; ++k) dst[m][k] = *(const PG8_LAS bf16x8*)(lds + PG8_SA(b, h) + aoff + m * 2048 + k * 1024); } while (0)
#define PG8_LDB(dst, b, h) do { _Pragma("unroll") for (int n = 0; n < 2; ++n) _Pragma("unroll") for (int k = 0; k < 2; ++k) dst[n][k] = *(const PG8_LAS bf16x8*)(lds + PG8_SB(b, h) + boff + n * 2048 + k * 1024); } while (0)
#define PG8_MMA(ai, bj, At, Bt) do { __builtin_amdgcn_s_setprio(1); _Pragma("unroll") for (int m = 0; m < 4; ++m) _Pragma("unroll") for (int n = 0; n < 2; ++n) _Pragma("unroll") for (int k = 0; k < 2; ++k) \
        acc[ai][bj][m][n] = __builtin_amdgcn_mfma_f32_16x16x32_bf16(Bt[n][k], At[m][k], acc[ai][bj][m][n], 0, 0, 0); __builtin_amdgcn_s_setprio(0); } while (0)
#define PG8_WAIT_V(n) asm volatile("s_waitcnt vmcnt(" #n ")" ::: "memory")
#define PG8_WAIT_L(n) asm volatile("s_waitcnt lgkmcnt(" #n ")" ::: "memory")
#define PG8_BAR __builtin_amdgcn_s_barrier()
#define PG8_SCHED __builtin_amdgcn_sched_barrier(0)
    Unit cur, nxt; int ui = 0;
    if (!S.next(0, cur)) return;
    f32x4 acc[2][2][4][2];
#pragma unroll
    for (int a = 0; a < 2; ++a)
#pragma unroll
        for (int b = 0; b < 2; ++b)
#pragma unroll
            for (int m = 0; m < 4; ++m)
#pragma unroll
                for (int n = 0; n < 2; ++n) acc[a][b][m][n] = (f32x4){0.f, 0.f, 0.f, 0.f};
    bf16x8 At[4][2], B0[2][2], B1[2][2];
    const char* cA = (const char*)g.A + (size_t)cur.pm * tstep; const char* cB = (const char*)g.Bt + (size_t)cur.pn * tstep;
    S.a_ready(cur);
    if constexpr (SP2) {
        PG8_STAGE(PG8_SB(0, 0), cB, voffB); PG8_STAGE(PG8_SB(0, 1), cB + hstep, voffB); PG8_STAGE(PG8_SA(0, 0), cA, voffA); PG8_STAGE(PG8_SA(0, 1), cA + hstep, voffA);
        if (wr == 1) PG8_BAR;
        PG8_WAIT_V(2); PG8_BAR;
        PG8_STAGE(PG8_SB(1, 0), cB + kstep, voffB); PG8_STAGE(PG8_SA(1, 0), cA + kstep, voffA); PG8_STAGE(PG8_SB(1, 1), cB + hstep + kstep, voffB);
        PG8_WAIT_V(6); PG8_BAR;
    } else {
        PG8_STAGE(PG8_SB(0, 0), cB, voffB); PG8_STAGE(PG8_SA(0, 0), cA, voffA); PG8_STAGE(PG8_SB(0, 1), cB + hstep, voffB); PG8_STAGE(PG8_SA(0, 1), cA + hstep, voffA);
        if (wr == 1) PG8_BAR;
        PG8_WAIT_V(4); PG8_BAR;
        PG8_STAGE(PG8_SB(1, 0), cB + kstep, voffB); PG8_STAGE(PG8_SA(1, 0), cA + kstep, voffA); PG8_STAGE(PG8_SB(1, 1), cB + hstep + kstep, voffB);
        PG8_WAIT_V(6); PG8_BAR;
    }
    for (;;) {
        const bool has_next = S.next(ui + 1, nxt);
        const char* nA = has_next ? (const char*)g.A + (size_t)nxt.pm * tstep : cA; const char* nB = has_next ? (const char*)g.Bt + (size_t)nxt.pn * tstep : cB;
        for (int t = 0; t < nt; t += 2) {
            const bool last = (t == nt - 2);
            const char* a1 = cA + (size_t)(t + 1) * kstep;
            const char* a2 = last ? nA : cA + (size_t)(t + 2) * kstep; const char* b2 = last ? nB : cB + (size_t)(t + 2) * kstep;
            const char* a3 = a2 + kstep; const char* b3 = b2 + kstep;
            if (last && has_next) S.a_ready(nxt);
            if constexpr (SP2) {
            PG8_LDB(B0, 0, 0); PG8_LDB(B1, 0, 1); PG8_SCHED; PG8_LDA(At, 0, 0); PG8_STAGE(PG8_SA(1, 1), a1 + hstep, voffA);
            PG8_WAIT_V(8); PG8_WAIT_L(0); PG8_BAR; PG8_MMA(0, 0, At, B0); PG8_MMA(0, 1, At, B1); PG8_BAR; PG8_SCHED;
            PG8_LDA(At, 0, 1); PG8_STAGE(PG8_SB(0, 0), b2, voffB); PG8_STAGE(PG8_SB(0, 1), b2 + hstep, voffB); PG8_STAGE(PG8_SA(0, 0), a2, voffA);
            PG8_WAIT_V(8); PG8_WAIT_L(0); PG8_BAR; PG8_MMA(1, 0, At, B0); PG8_MMA(1, 1, At, B1); PG8_BAR; PG8_SCHED;
            PG8_LDB(B0, 1, 0); PG8_LDB(B1, 1, 1); PG8_SCHED; PG8_LDA(At, 1, 0); PG8_STAGE(PG8_SA(0, 1), a2 + hstep, voffA);
            PG8_WAIT_V(8); PG8_WAIT_L(0); PG8_BAR; PG8_MMA(0, 0, At, B0); PG8_MMA(0, 1, At, B1); PG8_BAR; PG8_SCHED;
            PG8_LDA(At, 1, 1); PG8_STAGE(PG8_SB(1, 0), b3, voffB); PG8_STAGE(PG8_SB(1, 1), b3 + hstep, voffB); PG8_STAGE(PG8_SA(1, 0), a3, voffA);
            PG8_WAIT_V(8); PG8_WAIT_L(0); PG8_BAR; PG8_MMA(1, 0, At, B0); PG8_MMA(1, 1, At, B1); PG8_BAR; PG8_SCHED;
            } else {
            PG8_LDB(B0, 0, 0); PG8_SCHED; PG8_LDA(At, 0, 0); PG8_STAGE(PG8_SA(1, 1), a1 + hstep, voffA);
            PG8_WAIT_L(8); PG8_BAR; PG8_WAIT_L(0); PG8_MMA(0, 0, At, B0); PG8_BAR; PG8_SCHED;
            PG8_LDB(B1, 0, 1); PG8_STAGE(PG8_SB(0, 0), b2, voffB);
            PG8_BAR; PG8_WAIT_L(0); PG8_MMA(0, 1, At, B1); PG8_BAR;
            PG8_LDA(At, 0, 1); PG8_STAGE(PG8_SA(0, 0), a2, voffA);
            PG8_BAR; PG8_WAIT_L(0); PG8_MMA(1, 0, At, B0); PG8_BAR; PG8_SCHED;
            PG8_STAGE(PG8_SB(0, 1), b2 + hstep, voffB);
            PG8_WAIT_V(6); PG8_BAR; PG8_MMA(1, 1, At, B1); PG8_BAR;
            PG8_LDB(B0, 1, 0); PG8_SCHED; PG8_LDA(At, 1, 0); PG8_STAGE(PG8_SA(0, 1), a2 + hstep, voffA);
            PG8_WAIT_L(8); PG8_BAR; PG8_WAIT_L(0); PG8_MMA(0, 0, At, B0); PG8_BAR; PG8_SCHED;
            PG8_LDB(B1, 1, 1); PG8_STAGE(PG8_SB(1, 0), b3, voffB);
            PG8_BAR; PG8_WAIT_L(0); PG8_MMA(0, 1, At, B1); PG8_BAR;
            PG8_LDA(At, 1, 1); PG8_STAGE(PG8_SA(1, 0), a3, voffA);
            PG8_BAR; PG8_WAIT_L(0); PG8_MMA(1, 0, At, B0); PG8_BAR; PG8_SCHED;
            PG8_STAGE(PG8_SB(1, 1), b3 + hstep, voffB);
            PG8_WAIT_V(6); PG8_BAR; PG8_MMA(1, 1, At, B1); PG8_BAR;
            }
        }
        if constexpr (ALIGN_EPI) { if (wr == 0) PG8_BAR; }
        if constexpr (!Epi::AFTER_DRAIN) { E(acc, cur, wr, wc, fr, fq); S.done(cur); }
        if (!has_next) break;
#pragma unroll
        for (int a = 0; a < 2; ++a)
#pragma unroll
            for (int b = 0; b < 2; ++b)
#pragma unroll
                for (int m = 0; m < 4; ++m)
#pragma unroll
                    for (int n = 0; n < 2; ++n) acc[a][b][m][n] = (f32x4){0.f, 0.f, 0.f, 0.f};
        cur = nxt; cA = nA; cB = nB; ++ui;
        if constexpr (ALIGN_EPI) { if (wr == 1) PG8_BAR; }
    }
    PG8_WAIT_V(0);
    if constexpr (!ALIGN_EPI) { if (wr == 0) PG8_BAR; }
    PG8_BAR;
    if constexpr (Epi::AFTER_DRAIN) { E.fused(acc, cur, wr, wc, fr, fq, lds, wid, lane); S.done(cur); }
#undef PG8_SA
#undef PG8_SB
#undef PG8_STAGE
#undef PG8_LDA
#undef PG8_LDB
#undef PG8_MMA
#undef PG8_WAIT_V
#undef PG8_WAIT_L
#undef PG8_BAR
#undef PG8_SCHED
}
}

#define LAS __attribute__((address_space(3)))
typedef unsigned short bf16_t;
typedef short bf16x8 __attribute__((ext_vector_type(8)));
typedef float f32x4 __attribute__((ext_vector_type(4)));
typedef float f32x16 __attribute__((ext_vector_type(16)));
typedef unsigned u32x4 __attribute__((ext_vector_type(4)));
typedef unsigned u32x2 __attribute__((ext_vector_type(2)));

constexpr int NB = 4, T = 8192, DM = 1024, M = NB * T, DEPTH = 4, PLE = 256, FF = 2816, ZW = 3584, INW = 3474;
constexpr int C_NQ = 0, C_CK = 384, C_CV = 512, C_SK = 640, C_SV = 768, C_WK = 896, C_WV = 1024, C_DQ = 1152, C_DK = 1408, C_DV = 1664,
              C_HQ = 1920, C_HF = 2304, C_HI = 2688, C_HG = 3072, C_NG = 3456;
constexpr float EPS = 1e-6f, LOG2E = 1.4426950408889634f;
enum { I_X = 0, I_P, I_RELB, I_LBLOG, I_F1N, I_F1G, I_F1U, I_F1D, I_MIXN, I_WIN, I_WOUT, I_NQN, I_NKN, I_CPOS, I_CW1, I_CW2,
       I_DQN, I_DKN, I_DLAM, I_DSUB, I_HON, I_F2N, I_F2G, I_F2U, I_F2D, I_PLN, I_PLG, I_PLP, I_PLPOST, N_IN };
constexpr size_t MiB = 1u << 20;
constexpr size_t WS_CTL = 0, WS_W = 1 * MiB, WS_PB = 53 * MiB, WS_XB = 69 * MiB, WS_R1 = 133 * MiB, WS_MIX = 357 * MiB, WS_VT = 421 * MiB,
                 WS_HS = 453 * MiB, WS_KC = 501 * MiB, WS_VCT = WS_KC + 512 * 1024, WS_SELM = 503 * MiB, WS_RSQ0 = 504 * MiB, WS_RSQ1 = 506 * MiB,
                 WS_RSQP = 508 * MiB, WS_HD = 510 * MiB, WS_XB1 = 511 * MiB, WS_OCB = 575 * MiB, WS_ONES = 599 * MiB, WS_END = 601 * MiB;
constexpr size_t W_GU1 = 0, W_D1 = 11 * MiB, W_GU2 = W_D1 + 5 * MiB + 512 * 1024, W_D2 = W_GU2 + 11 * MiB, W_IN = 33 * MiB, W_OUT = 40 * MiB, W_PG = 42 * MiB,
                 W_PP = 44 * MiB, W_1T = W_PP + 512 * 1024, W_2T = W_1T + 2 * MiB, W_POSB = W_2T + 64 * 1024;
static_assert(W_D2 + 5 * MiB + 512 * 1024 == W_IN, "weight map");
constexpr int LDS_BYTES = 138 * 1024, LDS_MISC = 131072, LDS_RTAB = LDS_MISC + 1024;

__device__ __forceinline__ float bf2f(unsigned short u) { return __uint_as_float(((unsigned)u) << 16); }
__device__ __forceinline__ float bflo(unsigned w) { return __uint_as_float(w << 16); }
__device__ __forceinline__ float bfhi(unsigned w) { return __uint_as_float(w & 0xffff0000u); }
typedef float f32x2_t __attribute__((ext_vector_type(2))); typedef __bf16 bf16x2_t __attribute__((ext_vector_type(2)));
__device__ __forceinline__ unsigned pk2(float lo, float hi) { f32x2_t v = {lo, hi}; bf16x2_t b = __builtin_convertvector(v, bf16x2_t); return __builtin_bit_cast(unsigned, b); }
__device__ __forceinline__ bf16_t f2bf(float f) { return (bf16_t)(pk2(f, 0.f) & 0xffffu); }
__device__ __forceinline__ float ex2(float x) { return __builtin_amdgcn_exp2f(x); }
__device__ __forceinline__ float sigmoidf_(float x) { return 1.0f / (1.0f + __expf(-x)); }
__device__ __forceinline__ int crow(int r, int hi) { return (r & 3) + 8 * (r >> 2) + 4 * hi; }
__device__ __forceinline__ f32x16 mfma32(bf16x8 a, bf16x8 b, f32x16 c) { return __builtin_amdgcn_mfma_f32_32x32x16_bf16(a, b, c, 0, 0, 0); }
__device__ __forceinline__ f32x4 mfma16(bf16x8 a, bf16x8 b, f32x4 c) { return __builtin_amdgcn_mfma_f32_16x16x32_bf16(a, b, c, 0, 0, 0); }
__device__ __forceinline__ bf16x8 as_bf16x8(u32x4 v) { return __builtin_bit_cast(bf16x8, v); }
#define LDSW() asm volatile("s_waitcnt lgkmcnt(0)" ::: "memory")
#define CFENCE() asm volatile("" ::: "memory")
#define GAS __attribute__((address_space(1)))
__device__ __forceinline__ const float* inp(int i) { asm volatile("" : "+s"(i)); const unsigned long long v = ((const unsigned long long __attribute__((address_space(4)))*)__builtin_amdgcn_kernarg_segment_ptr())[i]; return (const float*)(const GAS float*)v; }

__device__ __forceinline__ float row_rinv(const float* rsq, int row) {
    const f32x4* p = (const f32x4*)(rsq + (size_t)row * 16);
    const f32x4 a = p[0], b = p[1], c = p[2], d = p[3];
    const float s = ((a.x + a.y) + (a.z + a.w)) + ((b.x + b.y) + (b.z + b.w)) + ((c.x + c.y) + (c.z + c.w)) + ((d.x + d.y) + (d.z + d.w));
    return rsqrtf(s * (1.0f / 1024.0f) + EPS);
}
struct RowTab {
    int p0, p1, p2, p3;
    __device__ __forceinline__ int slot(int pm) const { return pm == p0 ? 0 : (pm == p1 ? 1 : (pm == p2 ? 2 : 3)); }
    __device__ __forceinline__ float get(int t, int pm, int r256) const { return ((const LAS float*)(LAS unsigned char*)(size_t)LDS_RTAB)[(t * 4 + slot(pm)) * 256 + r256]; }
};
struct EpiSwiGLU {
    static constexpr bool PERM = true, AFTER_DRAIN = false;
    bf16_t* O; RowTab rt;
    __device__ __forceinline__ void operator()(const f32x4 (&acc)[2][2][4][2], const pg8::Unit& u, int wr, int wc, int fr, int fq) const {
#pragma unroll
        for (int ai = 0; ai < 2; ++ai)
#pragma unroll
            for (int m = 0; m < 4; ++m) {
                const int row = u.pm * 256 + ai * 128 + wr * 64 + m * 16 + fr;
                const float r = rt.get(0, u.pm, row & 255);
                float o[8];
#pragma unroll
                for (int n = 0; n < 2; ++n)
#pragma unroll
                    for (int e = 0; e < 4; ++e) { const float g = acc[ai][0][m][n][e] * r, up = acc[ai][1][m][n][e] * r; o[n * 4 + e] = g * sigmoidf_(g) * up; }
                u32x4 w; w.x = pk2(o[0], o[1]); w.y = pk2(o[2], o[3]); w.z = pk2(o[4], o[5]); w.w = pk2(o[6], o[7]);
                *(u32x4*)(O + (size_t)row * FF + u.pn * 128 + wc * 32 + 8 * fq) = w;
                CFENCE();
            }
    }
};
template <int LD> struct EpiZT {
    static constexpr bool PERM = true, AFTER_DRAIN = false;
    bf16_t* Z; RowTab rt;
    __device__ __forceinline__ void operator()(const f32x4 (&acc)[2][2][4][2], const pg8::Unit& u, int wr, int wc, int fr, int fq) const {
#pragma unroll
        for (int ai = 0; ai < 2; ++ai)
#pragma unroll
            for (int m = 0; m < 4; ++m) {
                const int row = u.pm * 256 + ai * 128 + wr * 64 + m * 16 + fr;
                const float r = rt.get(0, u.pm, row & 255);
#pragma unroll
                for (int bj = 0; bj < 2; ++bj) {
                    const f32x4 v0 = acc[ai][bj][m][0] * r, v1 = acc[ai][bj][m][1] * r;
                    u32x4 w; w.x = pk2(v0[0], v0[1]); w.y = pk2(v0[2], v0[3]); w.z = pk2(v1[0], v1[1]); w.w = pk2(v1[2], v1[3]);
                    *(u32x4*)(Z + (size_t)row * LD + u.pn * 256 + bj * 128 + wc * 32 + 8 * fq) = w;
                }
                CFENCE();
            }
    }
};
typedef EpiZT<ZW> EpiZ;
template <int MODE> struct EpiRes {
    static constexpr bool PERM = true, AFTER_DRAIN = false;
    float* X; bf16_t* XB; float* rsq_out; float alpha; const float* rsq_in; const bf16_t* P; const float* rsqp; const float* post; bf16_t* Pout; RowTab rt;
    __device__ __forceinline__ void operator()(const f32x4 (&acc)[2][2][4][2], const pg8::Unit& u, int wr, int wc, int fr, int fq) const {
        const int rowb = u.pm * 256 + wr * 64 + fr, colb = u.pn * 256 + wc * 32 + 8 * fq;
        f32x4 xn[2][2]; u32x2 pn_[2][2];
        if (MODE != 2) {
#pragma unroll
            for (int bj = 0; bj < 2; ++bj)
#pragma unroll
                for (int n = 0; n < 2; ++n) { const size_t off = (size_t)rowb * DM + colb + bj * 128 + 4 * n; xn[bj][n] = *(const f32x4*)(X + off); if (MODE == 1) pn_[bj][n] = *(const u32x2*)(P + off); }
        }
#pragma unroll
        for (int gI = 0; gI < 8; ++gI) {
            const int ai = gI >> 2, m = gI & 3;
            const int row = rowb + ai * 128 + m * 16;
            f32x4 xc[2][2]; u32x2 pc[2][2];
#pragma unroll
            for (int bj = 0; bj < 2; ++bj)
#pragma unroll
                for (int n = 0; n < 2; ++n) { xc[bj][n] = xn[bj][n]; pc[bj][n] = pn_[bj][n]; }
            if (MODE != 2 && gI < 7) {
                const int row2 = rowb + ((gI + 1) >> 2) * 128 + ((gI + 1) & 3) * 16;
#pragma unroll
                for (int bj = 0; bj < 2; ++bj)
#pragma unroll
                    for (int n = 0; n < 2; ++n) { const size_t off = (size_t)row2 * DM + colb + bj * 128 + 4 * n; xn[bj][n] = *(const f32x4*)(X + off); if (MODE == 1) pn_[bj][n] = *(const u32x2*)(P + off); }
            }
            CFENCE();
            float r = 1.f, rp = 1.f;
            if (MODE == 1) { r = rt.get(0, u.pm, row & 255); rp = rt.get(1, u.pm, row & 255); }
            float ss = 0.f;
#pragma unroll
            for (int bj = 0; bj < 2; ++bj)
#pragma unroll
                for (int n = 0; n < 2; ++n) {
                    const int c0 = colb + bj * 128 + 4 * n;
                    const size_t off = (size_t)row * DM + c0;
                    const f32x4 a = acc[ai][bj][m][n];
                    if (MODE == 2) {
                        u32x2 w; w.x = pk2(a[0], a[1]); w.y = pk2(a[2], a[3]);
                        *(u32x2*)(Pout + off) = w;
                        ss += (a[0] * a[0] + a[1] * a[1]) + (a[2] * a[2] + a[3] * a[3]);
                    } else {
                        f32x4 xv = xc[bj][n];
                        if (MODE == 0) xv += a * alpha;
                        else {
                            const u32x2 pw = pc[bj][n]; const f32x4 po = *(const f32x4*)(post + c0);
                            xv[0] += sigmoidf_(a[0] * r) * (bflo(pw.x) * rp * po[0]);
                            xv[1] += sigmoidf_(a[1] * r) * (bfhi(pw.x) * rp * po[1]);
                            xv[2] += sigmoidf_(a[2] * r) * (bflo(pw.y) * rp * po[2]);
                            xv[3] += sigmoidf_(a[3] * r) * (bfhi(pw.y) * rp * po[3]);
                        }
                        *(f32x4*)(X + off) = xv;
                        u32x2 w; w.x = pk2(xv[0], xv[1]); w.y = pk2(xv[2], xv[3]);
                        *(u32x2*)(XB + off) = w;
                        ss += (xv[0] * xv[0] + xv[1] * xv[1]) + (xv[2] * xv[2] + xv[3] * xv[3]);
                    }
                }
            ss += __shfl_xor(ss, 16); ss += __shfl_xor(ss, 32);
            if (fq == 0) rsq_out[(size_t)row * 16 + u.pn * 4 + wc] = ss;
        }
    }
};

template <class Epi> __device__ __forceinline__ void run_gemm(LAS unsigned char* lds, const bf16_t* A, const bf16_t* Bt, int N, int K, Epi& E, const float* rsqA = nullptr, const float* rsqB = nullptr) {
    int bx = blockIdx.x; asm volatile("" : "+s"(bx)); asm volatile("" : "+s"(K)); asm volatile("" : "+s"(N));
    pg8::Gemm g{A, Bt, M, N, K}; pg8::StaticOrder S; S.init(M, N, (int)gridDim.x, bx);
    if (rsqA) {
        int p0 = -1, p1 = -1, p2 = -1, p3 = -1; pg8::Unit u;
        for (int i = 0; S.next(i, u); ++i) { const int pm = u.pm; if (pm != p0 && pm != p1 && pm != p2 && pm != p3) { if (p0 < 0) p0 = pm; else if (p1 < 0) p1 = pm; else if (p2 < 0) p2 = pm; else p3 = pm; } }
        E.rt.p0 = p0; E.rt.p1 = p1; E.rt.p2 = p2; E.rt.p3 = p3;
        const int tid = TID();
        LAS float* tab = (LAS float*)(lds + LDS_RTAB);
        if (tid < 256) {
#pragma unroll
            for (int s = 0; s < 4; ++s) { const int pm = s == 0 ? p0 : (s == 1 ? p1 : (s == 2 ? p2 : p3));
                if (pm >= 0) { tab[s * 256 + tid] = row_rinv(rsqA, pm * 256 + tid); if (rsqB) tab[(4 + s) * 256 + tid] = row_rinv(rsqB, pm * 256 + tid); } }
        }
        __syncthreads();
    }
    pg8::gemm_phase<Epi, pg8::StaticOrder, true, true>(lds, g, S, E);
    __syncthreads();
}

__device__ __forceinline__ void rowsq_pass(const bf16_t* P, float* rsq_out) {
    const int tid = TID(), lane = tid & 63, wave = tid >> 6;
    for (int base = (blockIdx.x * 8 + wave) * 4; base < M; base += gridDim.x * 8 * 4) {
        u32x4 v[4][2];
#pragma unroll
        for (int i = 0; i < 4; ++i) { const u32x4* pr = (const u32x4*)(P + (size_t)(base + i) * DM) + lane; v[i][0] = pr[0]; v[i][1] = pr[64]; }
#pragma unroll
        for (int i = 0; i < 4; ++i) {
            float s = 0.f;
#pragma unroll
            for (int h2 = 0; h2 < 2; ++h2) { const u32x4 w = v[i][h2];
                s += (bflo(w.x) * bflo(w.x) + bfhi(w.x) * bfhi(w.x)) + (bflo(w.y) * bflo(w.y) + bfhi(w.y) * bfhi(w.y)) + (bflo(w.z) * bflo(w.z) + bfhi(w.z) * bfhi(w.z)) + (bflo(w.w) * bflo(w.w) + bfhi(w.w) * bfhi(w.w)); }
#pragma unroll
            for (int o = 1; o < 64; o <<= 1) s += __shfl_xor(s, o);
            if (lane < 16) rsq_out[(size_t)(base + i) * 16 + lane] = (lane == 0) ? s : 0.f;
        }
    }
}

__device__ __forceinline__ int next_task(unsigned* ctr, LAS int* slot) {
    __syncthreads();
    if (TID() == 0) *slot = (int)atomicAdd(ctr, 1u);
    __syncthreads();
    return *slot;
}

__device__ __forceinline__ int colmap(int mode, int n) {
    if (mode == 1) return 256 * (n >> 7) + (n & 127);
    if (mode == 2) return 256 * (n >> 7) + 128 + (n & 127);
    if (mode == 3) return n < 1152 ? n : (n < 1170 ? 3456 + (n - 1152) : n - 18);
    return n;
}
__device__ __forceinline__ void conv_item(const float* W, int K, int N, bf16_t* WT, const float* gain, int mode, LAS float* scr, int item, int lane) {
    const int nblk = (N + 31) >> 5, kb = item / nblk, nb = item % nblk, k0 = 64 * kb, n0 = 32 * nb;
#pragma unroll 16
    for (int i = 0; i < 32; ++i) {
        const int kk = 2 * i + (lane >> 5), n = n0 + (lane & 31);
        float v = (n < N) ? W[(size_t)(k0 + kk) * N + n] : 0.f;
        if (gain) v *= gain[k0 + kk];
        scr[kk * 33 + (lane & 31)] = v;
    }
    LDSW();
    const int c = lane & 7;
#pragma unroll
    for (int j = 0; j < 4; ++j) {
        const int nl = (lane >> 3) + 8 * j, n = n0 + nl;
        const LAS float* s = scr + (8 * c) * 33 + nl;
        u32x4 o; o.x = pk2(s[0], s[33]); o.y = pk2(s[2 * 33], s[3 * 33]); o.z = pk2(s[4 * 33], s[5 * 33]); o.w = pk2(s[6 * 33], s[7 * 33]);
        if (n < N) *(u32x4*)(WT + (size_t)colmap(mode, n) * K + k0 + 8 * c) = o;
    }
    LDSW();
}

__device__ __forceinline__ void phase_convert(const float* const* in, unsigned char* ws, float* out, int L, LAS unsigned char* lds) {
    const int tid = TID(), lane = tid & 63, wave = tid >> 6;
    const int gw = blockIdx.x * 8 + wave, NGW = gridDim.x * 8;
    LAS float* scr = (LAS float*)(lds + wave * 8704);
    unsigned char* wb = ws + WS_W;
    if (gw < 256) {
        const int ty = gw >> 7, ng = (gw >> 5) & 3, ks = gw & 31, n = ng * 64 + lane;
        const float* w1 = inp(I_CW1) + (size_t)(L * 2 + ty) * 2048 * 256; const float* pos = inp(I_CPOS) + (size_t)(L * 2 + ty) * 2048;
        float acc = 0.f;
#pragma unroll 16
        for (int k = ks * 64; k < ks * 64 + 64; ++k) acc += pos[k] * w1[(size_t)k * 256 + n];
        ((float*)(wb + W_POSB))[(ty * 32 + ks) * 256 + n] = acc;
    }
    const size_t ffo = (size_t)L * DM * FF;
    constexpr int IT_GU = (DM / 64) * (FF / 32), IT_D = (FF / 64) * (DM / 32), IT_IN = (DM / 64) * ((INW + 31) / 32), IT_SQ = (DM / 64) * (DM / 32),
                  IT_PP = (PLE / 64) * (DM / 32), IT_W1 = (2048 / 64) * (256 / 32), IT_W2 = (256 / 64) * (64 / 32);
    constexpr int total = 4 * IT_GU + 2 * IT_D + IT_IN + 2 * IT_SQ + IT_PP + 2 * IT_W1 + 2 * IT_W2;
    for (int it = gw; it < total; it += NGW) {
        const float* W = nullptr; int K = 0, N = 0; bf16_t* WT = nullptr; const float* gain = nullptr; int mode = 0, rr = -1, r = it;
#define JOB(Wp, Kk, Nn, WTp, gp, md, items) { if (rr < 0 && r < (items)) { W = (Wp); K = (Kk); N = (Nn); WT = (bf16_t*)(WTp); gain = (gp); mode = (md); rr = r; } r -= (items); }
        JOB(inp(I_F1G) + ffo, DM, FF, wb + W_GU1, inp(I_F1N) + L * DM, 1, IT_GU)
        JOB(inp(I_F1U) + ffo, DM, FF, wb + W_GU1, inp(I_F1N) + L * DM, 2, IT_GU)
        JOB(inp(I_F1D) + ffo, FF, DM, wb + W_D1, nullptr, 0, IT_D)
        JOB(inp(I_F2G) + ffo, DM, FF, wb + W_GU2, inp(I_F2N) + L * DM, 1, IT_GU)
        JOB(inp(I_F2U) + ffo, DM, FF, wb + W_GU2, inp(I_F2N) + L * DM, 2, IT_GU)
        JOB(inp(I_F2D) + ffo, FF, DM, wb + W_D2, nullptr, 0, IT_D)
        JOB(inp(I_WIN) + (size_t)L * DM * INW, DM, INW, wb + W_IN, inp(I_MIXN) + L * DM, 3, IT_IN)
        JOB(inp(I_WOUT) + (size_t)L * DM * DM, DM, DM, wb + W_OUT, nullptr, 0, IT_SQ)
        JOB(inp(I_PLG) + (size_t)L * DM * DM, DM, DM, wb + W_PG, inp(I_PLN) + L * DM, 0, IT_SQ)
        JOB(inp(I_PLP) + (size_t)L * PLE * DM, PLE, DM, wb + W_PP, nullptr, 0, IT_PP)
        JOB(inp(I_CW1) + (size_t)(L * 2 + 0) * 2048 * 256, 2048, 256, wb + W_1T, nullptr, 0, IT_W1)
        JOB(inp(I_CW1) + (size_t)(L * 2 + 1) * 2048 * 256, 2048, 256, wb + W_1T + 256 * 2048 * 2, nullptr, 0, IT_W1)
        JOB(inp(I_CW2) + (size_t)(L * 2 + 0) * 256 * 64, 256, 64, wb + W_2T, nullptr, 0, IT_W2)
        JOB(inp(I_CW2) + (size_t)(L * 2 + 1) * 256 * 64, 256, 64, wb + W_2T + 64 * 256 * 2, nullptr, 0, IT_W2)
#undef JOB
        conv_item(W, K, N, WT, gain, mode, scr, rr, lane);
    }
    {
        u32x4* z = (u32x4*)((bf16_t*)(wb + W_IN) + (size_t)INW * DM);
        const int n16 = (ZW - INW) * DM / 8;
        for (int i = blockIdx.x * 512 + tid; i < n16; i += gridDim.x * 512) z[i] = (u32x4){0u, 0u, 0u, 0u};
    }
    {
        const f32x4* src = (const f32x4*)(inp(I_P) + (size_t)L * M * PLE); u32x4* dst = (u32x4*)(ws + WS_PB);
        const int n8 = M * PLE / 8;
        for (int i = blockIdx.x * 512 + tid; i < n8; i += gridDim.x * 512) {
            const f32x4 a = src[2 * i], b = src[2 * i + 1];
            u32x4 w; w.x = pk2(a[0], a[1]); w.y = pk2(a[2], a[3]); w.z = pk2(b[0], b[1]); w.w = pk2(b[2], b[3]); dst[i] = w;
        }
    }
    if (L == 0) {
        const float* x = inp(I_X); bf16_t* xb = (bf16_t*)(ws + WS_XB); float* rsq = (float*)(ws + WS_RSQ0);
        for (int m = gw; m < M; m += NGW) {
            const f32x4* xr = (const f32x4*)(x + (size_t)m * DM) + lane; f32x4* orow = (f32x4*)(out + (size_t)m * DM) + lane;
            u32x2* xbr = (u32x2*)(xb + (size_t)m * DM) + lane;
            float s = 0.f;
#pragma unroll
            for (int j = 0; j < 4; ++j) { const f32x4 v = xr[64 * j]; orow[64 * j] = v; u32x2 w; w.x = pk2(v[0], v[1]); w.y = pk2(v[2], v[3]); xbr[64 * j] = w; s += (v[0] * v[0] + v[1] * v[1]) + (v[2] * v[2] + v[3] * v[3]); }
#pragma unroll
            for (int o = 1; o < 64; o <<= 1) s += __shfl_xor(s, o);
            if (lane < 16) rsq[(size_t)m * 16 + lane] = (lane == 0) ? s : 0.f;
        }
    }
}

__device__ __forceinline__ void task_prep(const float* const* in, unsigned char* ws, int L, int tile, LAS unsigned char* lds) {
    const int tid = TID(), lane = tid & 63, wave = tid >> 6;
    bf16_t* z = (bf16_t*)(ws + WS_R1);
    const int row0 = tile * 64;
#pragma unroll
    for (int pass = 0; pass < 3; ++pass) {
        const int seg = pass * 64 + lane;
        int col = 0, gs = 8; const float* gp = inp(I_NQN); float scale = 1.f;
        if (seg < 48) { col = C_NQ + 8 * seg; gp = inp(I_NQN) + L * 64 + ((8 * seg) & 63); scale = 0.125f * LOG2E; }
        else if (seg < 64) { col = C_SK + 8 * (seg - 48); gp = inp(I_NKN) + (L * 3 + 1) * 64 + ((8 * seg) & 63); }
        else if (seg < 80) { col = C_WK + 8 * (seg - 64); gp = inp(I_NKN) + (L * 3 + 2) * 64 + ((8 * seg) & 63); }
        else if (seg < 112) { col = C_DQ + 8 * (seg - 80); gp = inp(I_DQN) + L * 32 + ((8 * seg) & 31); gs = 4; scale = 0.17677669529663689f * LOG2E; }
        else { col = C_DK + 8 * (seg - 112); gp = inp(I_DKN) + L * 32 + ((8 * seg) & 31); gs = 4; }
        const bool act = seg < 144;
        if (!act) { col = 0; }
        const f32x4 g0 = *(const f32x4*)gp, g1 = *(const f32x4*)(gp + 4);
        u32x4 w[8];
#pragma unroll
        for (int i = 0; i < 8; ++i) w[i] = *(const u32x4*)(z + (size_t)(row0 + wave + 8 * i) * ZW + col);
#pragma unroll
        for (int i = 0; i < 8; ++i) {
            float v[8] = {bflo(w[i].x), bfhi(w[i].x), bflo(w[i].y), bfhi(w[i].y), bflo(w[i].z), bfhi(w[i].z), bflo(w[i].w), bfhi(w[i].w)};
            float ss = 0.f;
#pragma unroll
            for (int e2 = 0; e2 < 8; ++e2) ss += v[e2] * v[e2];
            ss += __shfl_xor(ss, 1); ss += __shfl_xor(ss, 2);
            const float t4 = __shfl_xor(ss, 4); if (gs == 8) ss += t4;
            const float r = rsqrtf(ss / (float)(gs * 8) + EPS) * scale;
            u32x4 o; o.x = pk2(v[0] * r * g0[0], v[1] * r * g0[1]); o.y = pk2(v[2] * r * g0[2], v[3] * r * g0[3]);
            o.z = pk2(v[4] * r * g1[0], v[5] * r * g1[1]); o.w = pk2(v[6] * r * g1[2], v[7] * r * g1[3]);
            if (act) *(u32x4*)(z + (size_t)(row0 + wave + 8 * i) * ZW + col) = o;
        }
    }
    LAS bf16_t* tl = (LAS bf16_t*)lds;
#pragma unroll
    for (int i = 0; i < 8; ++i) {
        const int id = i * 512 + tid, row = id >> 6, ch = id & 63;
        const int col = ch < 16 ? C_SV + 8 * ch : (ch < 32 ? C_WV + 8 * (ch - 16) : C_DV + 8 * (ch - 32));
        *(LAS u32x4*)(tl + row * 520 + 8 * ch) = *(const u32x4*)(z + (size_t)(row0 + row) * ZW + col);
    }
    __syncthreads();
    const int b = row0 / T, t0 = row0 % T;
    bf16_t* vt = (bf16_t*)(ws + WS_VT);
#pragma unroll
    for (int i = 0; i < 8; ++i) {
        const int orow = tid, tch = i;
        const LAS bf16_t* s = tl + (tch * 8) * 520 + orow;
        u32x4 o;
        o.x = (unsigned)s[0] | ((unsigned)s[520] << 16); o.y = (unsigned)s[2 * 520] | ((unsigned)s[3 * 520] << 16);
        o.z = (unsigned)s[4 * 520] | ((unsigned)s[5 * 520] << 16); o.w = (unsigned)s[6 * 520] | ((unsigned)s[7 * 520] << 16);
        *(u32x4*)(vt + ((size_t)(b * 8) * 64 + orow) * T + t0 + 8 * tch) = o;
    }
}

__device__ __forceinline__ float gelu_tanh(float x) {
    const float y = 0.7978845608028654f * (x + 0.044715f * x * x * x);
    const float th = 1.0f - 2.0f / (1.0f + __expf(2.0f * y));
    return 0.5f * x * (1.0f + th);
}
__device__ __forceinline__ void task_compress(const float* const* in, unsigned char* ws, int L, int task, LAS unsigned char* lds) {
    const int tid = TID(), lane = tid & 63, wave = tid >> 6;
    const int ty = task >> 8, b = (task >> 6) & 3, g = (task >> 5) & 1, i0 = (task & 31) * 16;
    const bf16_t* z = (const bf16_t*)(ws + WS_R1);
    LAS bf16_t* zt = (LAS bf16_t*)lds;
    LAS bf16_t* hid = (LAS bf16_t*)(lds + 39168);
    LAS float* ofp = (LAS float*)(lds + 39168 + 8448);
    const int ccol = (ty ? C_CV : C_CK) + 64 * g;
    for (int id = tid; id < 272 * 8; id += 512) {
        const int row = id >> 3, ch = id & 7, tok = 16 * i0 + row;
        u32x4 v = (u32x4){0u, 0u, 0u, 0u};
        if (tok < T) v = *(const u32x4*)(z + (size_t)(b * T + tok) * ZW + ccol + 8 * ch);
        *(LAS u32x4*)(zt + row * 72 + 8 * ch) = v;
    }
    __syncthreads();
    const bf16_t* w1t = (const bf16_t*)(ws + WS_W + W_1T) + (size_t)ty * 256 * 2048;
    const bf16_t* w2t = (const bf16_t*)(ws + WS_W + W_2T) + (size_t)ty * 64 * 256;
    const float* posb = (const float*)(ws + WS_W + W_POSB) + ty * 32 * 256;
    const int r16 = lane & 15, kq = lane >> 4;
    f32x4 acc[2] = {(f32x4){0.f, 0.f, 0.f, 0.f}, (f32x4){0.f, 0.f, 0.f, 0.f}};
    const bf16_t* b0p = w1t + (size_t)(16 * (2 * wave) + r16) * 2048 + 8 * kq;
    const bf16_t* b1p = b0p + 16 * 2048;
#pragma unroll 8
    for (int kc = 0; kc < 64; ++kc) {
        const bf16x8 a = *(const LAS bf16x8*)(zt + (16 * r16 + (kc >> 1)) * 72 + (kc & 1) * 32 + 8 * kq);
        const bf16x8 w0 = *(const bf16x8*)(b0p + 32 * kc), w1 = *(const bf16x8*)(b1p + 32 * kc);
        acc[0] = mfma16(a, w0, acc[0]); acc[1] = mfma16(a, w1, acc[1]);
    }
#pragma unroll
    for (int j = 0; j < 2; ++j) {
        const int n = 16 * (2 * wave + j) + r16;
        float pbias = 0.f;
#pragma unroll
        for (int ks = 0; ks < 32; ++ks) pbias += posb[ks * 256 + n];
#pragma unroll
        for (int i = 0; i < 4; ++i) hid[(4 * kq + i) * 264 + n] = f2bf(gelu_tanh(acc[j][i] + pbias));
    }
    __syncthreads();
    if (wave < 4) {
        f32x4 a2 = (f32x4){0.f, 0.f, 0.f, 0.f};
        const bf16_t* bp = w2t + (size_t)(16 * wave + r16) * 256 + 8 * kq;
#pragma unroll
        for (int kc = 0; kc < 8; ++kc) {
            const bf16x8 a = *(const LAS bf16x8*)(hid + r16 * 264 + 32 * kc + 8 * kq);
            const bf16x8 w = *(const bf16x8*)(bp + 32 * kc);
            a2 = mfma16(a, w, a2);
        }
#pragma unroll
        for (int i = 0; i < 4; ++i) ofp[(4 * kq + i) * 64 + 16 * wave + r16] = a2[i];
    }
    __syncthreads();
    if (tid < 256) {
        const int row = tid >> 4, c4 = (tid & 15) * 4, i = i0 + row;
        f32x4 o = *(const LAS f32x4*)(ofp + row * 64 + c4);
        float ss = (o[0] * o[0] + o[1] * o[1]) + (o[2] * o[2] + o[3] * o[3]);
        ss += __shfl_xor(ss, 1); ss += __shfl_xor(ss, 2); ss += __shfl_xor(ss, 4); ss += __shfl_xor(ss, 8);
        if (ty == 0) {
            const float r = rsqrtf(ss * (1.0f / 64.0f) + EPS);
            const f32x4 gn = *(const f32x4*)(inp(I_NKN) + (L * 3 + 0) * 64 + c4);
            o = o * r * gn;
        }
        if (i >= 511) o = (f32x4){0.f, 0.f, 0.f, 0.f};
        if (ty == 0) {
            u32x2 w; w.x = pk2(o[0], o[1]); w.y = pk2(o[2], o[3]);
            *(u32x2*)((bf16_t*)(ws + WS_KC) + ((size_t)(b * 2 + g) * 512 + i) * 64 + c4) = w;
        } else {
            bf16_t* vct = (bf16_t*)(ws + WS_VCT) + (size_t)(b * 2 + g) * 64 * 512;
#pragma unroll
            for (int e = 0; e < 4; ++e) vct[(size_t)(c4 + e) * 512 + i] = f2bf(o[e]);
        }
    }
}

__device__ __forceinline__ float hgrn_lb(const float* logits, int L, int j) {
    if (L == 0) return 0.f;
    const float a0 = logits[j], a1 = logits[384 + j], a2 = logits[768 + j], a3 = logits[1152 + j];
    const float mx = fmaxf(fmaxf(a0, a1), fmaxf(a2, a3));
    const float e0 = __expf(a0 - mx), e1 = __expf(a1 - mx), e2 = __expf(a2 - mx), e3 = __expf(a3 - mx);
    const float inv = 1.0f / (e0 + e1 + e2 + e3);
    float s = e1; if (L >= 2) s += e2; if (L >= 3) s += e3;
    return s * inv;
}
__device__ __forceinline__ void task_hgrn_local(const float* const* in, unsigned char* ws, int L, int task, LAS unsigned char* lds) {
    const int tid = TID(), lane = tid & 63, wave = tid >> 6;
    if (wave < 6) {
        const int chunk = task * 6 + wave;
        const int bh = chunk >> 7, c = chunk & 127, b = bh / 6, h = bh % 6;
        const bf16_t* z = (const bf16_t*)(ws + WS_R1) + (size_t)(b * T + c * 64) * ZW;
        LAS bf16_t* klT = (LAS bf16_t*)(lds + wave * 18432);
        LAS bf16_t* vT = klT + 64 * 72;
        const float lb = hgrn_lb(inp(I_LBLOG), L, h * 64 + lane);
        LAS bf16_t* rawf = klT;
        (void)rawf;
        u32x4 rf[8], ri[8];
#pragma unroll
        for (int i = 0; i < 8; ++i) {
            const int row = (lane >> 3) + 8 * i, ch = lane & 7;
            rf[i] = *(const u32x4*)(z + (size_t)row * ZW + C_HF + 64 * h + 8 * ch);
            ri[i] = *(const u32x4*)(z + (size_t)row * ZW + C_HI + 64 * h + 8 * ch);
        }
#pragma unroll
        for (int i = 0; i < 8; ++i) {
            const int row = (lane >> 3) + 8 * i, ch = lane & 7;
            *(LAS u32x4*)(klT + row * 72 + 8 * ch) = rf[i];
            *(LAS u32x4*)(vT + row * 72 + 8 * ch) = ri[i];
        }
        LDSW();
        float suffix = 0.f;
        bf16_t colf[64], colv[64];
#pragma unroll
        for (int s2 = 0; s2 < 64; ++s2) { colf[s2] = klT[s2 * 72 + lane]; colv[s2] = vT[s2 * 72 + lane]; }
        LDSW();
#pragma unroll
        for (int s = 63; s >= 0; --s) {
            const float fr = bf2f(colf[s]);
            const float sg = sigmoidf_(fr);
            const float f = lb + (1.0f - lb) * sg;
            const float ig = (1.0f - lb) * (1.0f - sg);
            klT[lane * 72 + s] = f2bf(ig * __expf(suffix));
            vT[lane * 72 + s] = colv[s];
            suffix += __logf(f);
        }
        ((float*)(ws + WS_HD))[(size_t)chunk * 64 + lane] = __expf(suffix);
        LDSW();
        const int r32 = lane & 31, hi = lane >> 5;
        float* hs = (float*)(ws + WS_HS) + (size_t)chunk * 4096;
#pragma unroll
        for (int kb = 0; kb < 2; ++kb)
#pragma unroll
            for (int vb = 0; vb < 2; ++vb) {
                f32x16 cacc = {};
#pragma unroll
                for (int cc = 0; cc < 4; ++cc) {
                    const bf16x8 a = *(const LAS bf16x8*)(klT + (32 * kb + r32) * 72 + 16 * cc + 8 * hi);
                    const bf16x8 bb = *(const LAS bf16x8*)(vT + (32 * vb + r32) * 72 + 16 * cc + 8 * hi);
                    cacc = mfma32(a, bb, cacc);
                }
#pragma unroll
                for (int r = 0; r < 16; ++r) hs[(32 * kb + crow(r, hi)) * 64 + 32 * vb + r32] = cacc[r];
            }
    }
}
__device__ __forceinline__ void task_hgrn_scan(unsigned char* ws, int task) {
    const int tid = TID();
    const int bh = task >> 3, k = (task & 7) * 8 + (tid >> 6), v = tid & 63;
    float* hs = (float*)(ws + WS_HS) + (size_t)bh * 128 * 4096 + k * 64 + v;
    const float* hd = (const float*)(ws + WS_HD) + (size_t)bh * 128 * 64 + k;
    float S = 0.f;
#pragma unroll 16
    for (int c = 0; c < 128; ++c) {
        const float a = hs[(size_t)c * 4096], d = hd[c * 64];
        hs[(size_t)c * 4096] = S;
        S = d * S + a;
    }
}
__device__ __forceinline__ void task_hgrn_out(const float* const* in, unsigned char* ws, int L, int task, LAS unsigned char* lds) {
    const int tid = TID(), lane = tid & 63, wave = tid >> 6;
    if (wave < 3) {
        const int chunk = task * 3 + wave;
        const int bh = chunk >> 7, c = chunk & 127, b = bh / 6, h = bh % 6;
        const size_t row0 = (size_t)(b * T + c * 64);
        const bf16_t* z = (const bf16_t*)(ws + WS_R1) + row0 * ZW;
        LAS bf16_t* ke = (LAS bf16_t*)(lds + wave * 36864);
        LAS bf16_t* qe = ke + 64 * 72;
        LAS bf16_t* vT = qe + 64 * 72;
        LAS bf16_t* sT = vT + 64 * 72;
        const float lb = hgrn_lb(inp(I_LBLOG), L, h * 64 + lane);
        {
            u32x4 rq[8], rf[8], ri[8];
#pragma unroll
            for (int i = 0; i < 8; ++i) {
                const int row = (lane >> 3) + 8 * i, ch = lane & 7;
                rq[i] = *(const u32x4*)(z + (size_t)row * ZW + C_HQ + 64 * h + 8 * ch);
                rf[i] = *(const u32x4*)(z + (size_t)row * ZW + C_HF + 64 * h + 8 * ch);
                ri[i] = *(const u32x4*)(z + (size_t)row * ZW + C_HI + 64 * h + 8 * ch);
            }
#pragma unroll
            for (int i = 0; i < 8; ++i) {
                const int row = (lane >> 3) + 8 * i, ch = lane & 7;
                *(LAS u32x4*)(qe + row * 72 + 8 * ch) = rq[i];
                *(LAS u32x4*)(ke + row * 72 + 8 * ch) = rf[i];
                *(LAS u32x4*)(sT + row * 72 + 8 * ch) = ri[i];
            }
        }
        LDSW();
        float ref = 0.f;
#pragma unroll 8
        for (int s = 0; s < 32; ++s) {
            const float fr = bf2f(ke[s * 72 + lane]);
            ref += __logf(lb + (1.0f - lb) * sigmoidf_(fr));
        }
        float cum = 0.f;
#pragma unroll 8
        for (int s = 0; s < 64; ++s) {
            const float fr = bf2f(ke[s * 72 + lane]);
            const float qv = bf2f(qe[s * 72 + lane]);
            const bf16_t vraw = sT[s * 72 + lane];
            const float sg = sigmoidf_(fr);
            const float f = lb + (1.0f - lb) * sg;
            const float ig = (1.0f - lb) * (1.0f - sg);
            cum += __logf(f);
            qe[s * 72 + lane] = f2bf(qv * sigmoidf_(qv) * __expf(cum - ref));
            ke[s * 72 + lane] = f2bf(ig * __expf(ref - cum));
            vT[lane * 72 + s] = vraw;
        }
        LDSW();
        const float* hs = (const float*)(ws + WS_HS) + (size_t)chunk * 4096;
        const float eref = __expf(ref);
        {
            f32x4 hv[16];
#pragma unroll
            for (int i = 0; i < 16; ++i) hv[i] = *(const f32x4*)(hs + ((lane >> 4) + 4 * i) * 64 + (lane & 15) * 4);
#pragma unroll
            for (int i = 0; i < 16; ++i) {
                const int k = (lane >> 4) + 4 * i, v4 = (lane & 15) * 4;
                const float er = __shfl(eref, k);
                sT[(v4 + 0) * 72 + k] = f2bf(hv[i][0] * er); sT[(v4 + 1) * 72 + k] = f2bf(hv[i][1] * er);
                sT[(v4 + 2) * 72 + k] = f2bf(hv[i][2] * er); sT[(v4 + 3) * 72 + k] = f2bf(hv[i][3] * er);
            }
        }
        LDSW();
        const int r32 = lane & 31, hi = lane >> 5;
        f32x16 O[2][2] = {};
#pragma unroll
        for (int tb = 0; tb < 2; ++tb) {
            bf16x8 qf[4];
#pragma unroll
            for (int cc = 0; cc < 4; ++cc) qf[cc] = *(const LAS bf16x8*)(qe + (32 * tb + r32) * 72 + 16 * cc + 8 * hi);
#pragma unroll
            for (int vb = 0; vb < 2; ++vb)
#pragma unroll
                for (int cc = 0; cc < 4; ++cc) {
                    const bf16x8 a = *(const LAS bf16x8*)(sT + (32 * vb + r32) * 72 + 16 * cc + 8 * hi);
                    O[vb][tb] = mfma32(a, qf[cc], O[vb][tb]);
                }
#pragma unroll
            for (int sb = 0; sb <= tb; ++sb) {
                f32x16 sc = {};
#pragma unroll
                for (int cc = 0; cc < 4; ++cc) {
                    const bf16x8 a = *(const LAS bf16x8*)(ke + (32 * sb + r32) * 72 + 16 * cc + 8 * hi);
                    sc = mfma32(a, qf[cc], sc);
                }
                unsigned P[8];
#pragma unroll
                for (int j = 0; j < 8; ++j) {
                    float p0 = sc[2 * j], p1 = sc[2 * j + 1];
                    if (sb == tb) { if (crow(2 * j, hi) > r32) p0 = 0.f; if (crow(2 * j + 1, hi) > r32) p1 = 0.f; }
                    P[j] = pk2(p0, p1);
                }
#pragma unroll
                for (int vb = 0; vb < 2; ++vb)
#pragma unroll
                    for (int c2 = 0; c2 < 2; ++c2) {
                        const u32x2 a0 = *(const LAS u32x2*)(vT + (32 * vb + r32) * 72 + 32 * sb + 16 * c2 + 4 * hi);
                        const u32x2 a1 = *(const LAS u32x2*)(vT + (32 * vb + r32) * 72 + 32 * sb + 16 * c2 + 8 + 4 * hi);
                        const bf16x8 vf = as_bf16x8((u32x4){a0.x, a0.y, a1.x, a1.y});
                        const bf16x8 pf = as_bf16x8((u32x4){P[4 * c2], P[4 * c2 + 1], P[4 * c2 + 2], P[4 * c2 + 3]});
                        O[vb][tb] = mfma32(vf, pf, O[vb][tb]);
                    }
            }
        }
        LDSW();
        const float* on = inp(I_HON) + L * 64;
#pragma unroll
        for (int tb = 0; tb < 2; ++tb) {
            float ss = 0.f;
#pragma unroll
            for (int vb = 0; vb < 2; ++vb)
#pragma unroll
                for (int r = 0; r < 16; ++r) ss += O[vb][tb][r] * O[vb][tb][r];
            ss += __shfl_xor(ss, 32);
            const float rn = rsqrtf(ss * (1.0f / 64.0f) + EPS);
#pragma unroll
            for (int vb = 0; vb < 2; ++vb)
#pragma unroll
                for (int r = 0; r < 16; ++r) { const int v = 32 * vb + crow(r, hi); ke[(32 * tb + r32) * 72 + v] = f2bf(O[vb][tb][r] * rn * on[v]); }
        }
        LDSW();
        bf16_t* mixed = (bf16_t*)(ws + WS_MIX) + row0 * DM + 640 + 64 * h;
#pragma unroll
        for (int i = 0; i < 8; ++i) {
            const int t = i * 8 + (lane >> 3), ch = lane & 7;
            const u32x4 ov = *(const LAS u32x4*)(ke + t * 72 + 8 * ch);
            const u32x4 gv = *(const u32x4*)(z + (size_t)t * ZW + C_HG + 64 * h + 8 * ch);
            u32x4 w;
            { const float g0 = bflo(gv.x), g1 = bfhi(gv.x); w.x = pk2(bflo(ov.x) * g0 * sigmoidf_(g0), bfhi(ov.x) * g1 * sigmoidf_(g1)); }
            { const float g0 = bflo(gv.y), g1 = bfhi(gv.y); w.y = pk2(bflo(ov.y) * g0 * sigmoidf_(g0), bfhi(ov.y) * g1 * sigmoidf_(g1)); }
            { const float g0 = bflo(gv.z), g1 = bfhi(gv.z); w.z = pk2(bflo(ov.z) * g0 * sigmoidf_(g0), bfhi(ov.z) * g1 * sigmoidf_(g1)); }
            { const float g0 = bflo(gv.w), g1 = bfhi(gv.w); w.w = pk2(bflo(ov.w) * g0 * sigmoidf_(g0), bfhi(ov.w) * g1 * sigmoidf_(g1)); }
            *(u32x4*)(mixed + (size_t)t * DM + 8 * ch) = w;
        }
    }
}

constexpr int ATT_K = 0, ATT_V = 18432, ATT_LUT = 35840, ATT_STAGE = 36864;
__device__ __forceinline__ void build_lut(LAS float* lut, const float* rel_bias, int head) {
    const int d = TID();
    if (d <= 128) {
        int bk = d;
        if (d >= 16) { const int far = 16 + (int)(__logf((float)d * (1.0f / 16.0f)) / 2.0794415416798357f * 16.0f); bk = far < 31 ? far : 31; }
        lut[d] = rel_bias[bk * 10 + head] * LOG2E;
    }
}
template <int NMAP, bool HAS_SEL>
__device__ __forceinline__ void attn_pass(LAS unsigned char* lds, const bf16_t* Kth, size_t kts, const bf16_t* Vth, int m_lo, int m_hi,
                                          const bf16x8 (&qr)[4], int tq, int qw0, int win, const LAS float* lut, u32x4 selw,
                                          f32x16 (&O)[NMAP][2], float (&l)[NMAP]) {
    const int tid = TID(), lane = tid & 63, r32 = lane & 31, hi = lane >> 5;
    const float c31 = lut[128];
    u32x4 kreg = *(const u32x4*)(Kth + (size_t)m_lo * kts), vreg = *(const u32x4*)(Vth + (size_t)m_lo * 64);
    int buf = 0;
    for (int m = m_lo; m <= m_hi; ++m) {
        *(LAS u32x4*)(lds + ATT_K + buf * 9216 + (tid >> 3) * 144 + (tid & 7) * 16) = kreg;
        { LAS u32x2* vp = (LAS u32x2*)(lds + ATT_V + buf * 8704 + (tid >> 3) * 136 + (tid & 7) * 16); vp[0] = (u32x2){vreg.x, vreg.y}; vp[1] = (u32x2){vreg.z, vreg.w}; }
        __syncthreads();
        if (m < m_hi) { kreg = *(const u32x4*)(Kth + (size_t)(m + 1) * kts); vreg = *(const u32x4*)(Vth + (size_t)(m + 1) * 64); }
        const int k0 = 64 * m, dmin = qw0 - (k0 + 63), dmax = qw0 + 31 - k0;
        bool sel = true;
        if (HAS_SEL) { const unsigned w = m < 32 ? selw.x : (m < 64 ? selw.y : (m < 96 ? selw.z : selw.w)); sel = (w >> (m & 31)) & 1u; }
        bool active = dmax >= 0 && dmin < win;
        if (HAS_SEL) active = active && (__any(sel) != 0);
        if (active) {
            const bool fast = dmin >= 128 && dmax < win;
            const LAS unsigned char* Kb = lds + ATT_K + buf * 9216;
            const LAS unsigned char* Vb = lds + ATT_V + buf * 8704;
            unsigned P[NMAP][2][8];
#pragma unroll
            for (int kh2 = 0; kh2 < 2; ++kh2) {
                f32x16 S[NMAP];
#pragma unroll
                for (int mp = 0; mp < NMAP; ++mp) { const float ini = fast ? c31 : 0.f;
#pragma unroll
                    for (int r = 0; r < 16; ++r) S[mp][r] = ini; }
#pragma unroll
                for (int c = 0; c < 4; ++c) {
                    const bf16x8 kf = *(const LAS bf16x8*)(Kb + (32 * kh2 + r32) * 144 + (16 * c + 8 * hi) * 2);
                    const int mp = (NMAP == 2) ? (c >> 1) : 0;
                    S[mp] = mfma32(kf, qr[c], S[mp]);
                }
#pragma unroll
                for (int mp = 0; mp < NMAP; ++mp) {
                    float p[16];
                    if (fast) {
#pragma unroll
                        for (int r = 0; r < 16; ++r) { const float e = ex2(S[mp][r]); p[r] = sel ? e : 0.f; }
                    } else {
#pragma unroll
                        for (int r = 0; r < 16; ++r) {
                            const int d = tq - (k0 + 32 * kh2 + crow(r, hi));
                            const bool valid = sel && d >= 0 && d < win;
                            const int dc = d < 0 ? 0 : (d > 128 ? 128 : d);
                            const float e = ex2(S[mp][r] + lut[dc]);
                            p[r] = valid ? e : 0.f;
                        }
                    }
                    float s = 0.f;
#pragma unroll
                    for (int r = 0; r < 16; ++r) s += p[r];
                    l[mp] += s;
#pragma unroll
                    for (int j = 0; j < 8; ++j) P[mp][kh2][j] = pk2(p[2 * j], p[2 * j + 1]);
                }
            }
#pragma unroll
            for (int db = 0; db < 2; ++db)
#pragma unroll
                for (int cc = 0; cc < 4; ++cc) {
                    const u32x2 a0 = *(const LAS u32x2*)(Vb + (32 * db + r32) * 136 + (16 * cc + 4 * hi) * 2);
                    const u32x2 a1 = *(const LAS u32x2*)(Vb + (32 * db + r32) * 136 + (16 * cc + 8 + 4 * hi) * 2);
                    const bf16x8 vf = as_bf16x8((u32x4){a0.x, a0.y, a1.x, a1.y});
#pragma unroll
                    for (int mp = 0; mp < NMAP; ++mp) {
                        const bf16x8 pf = as_bf16x8((u32x4){P[mp][cc >> 1][4 * (cc & 1)], P[mp][cc >> 1][4 * (cc & 1) + 1], P[mp][cc >> 1][4 * (cc & 1) + 2], P[mp][cc >> 1][4 * (cc & 1) + 3]});
                        O[mp][db] = mfma32(vf, pf, O[mp][db]);
                    }
                }
        }
        buf ^= 1;
    }
    __syncthreads();
}
template <bool ADD>
__device__ __forceinline__ void store_ot(LAS unsigned char* stage, const float (&val)[2][16], bf16_t* dst, int ld, const bf16_t* addsrc = nullptr, int ldadd = 0) {
    const int lane = TID() & 63, r32 = lane & 31, hi = lane >> 5;
    LAS bf16_t* st = (LAS bf16_t*)stage;
#pragma unroll
    for (int db = 0; db < 2; ++db)
#pragma unroll
        for (int r = 0; r < 16; ++r) st[r32 * 72 + 32 * db + crow(r, hi)] = f2bf(val[db][r]);
    LDSW();
#pragma unroll
    for (int i = 0; i < 4; ++i) {
        const int row = i * 8 + (lane >> 3), ch = lane & 7;
        u32x4 v = *(const LAS u32x4*)(st + row * 72 + 8 * ch);
        bf16_t* gp = dst + (size_t)row * ld + 8 * ch;
        if (ADD) {
            const u32x4 o = *(const u32x4*)(addsrc + (size_t)row * ldadd + 8 * ch);
            v.x = pk2(bflo(v.x) + bflo(o.x), bfhi(v.x) + bfhi(o.x)); v.y = pk2(bflo(v.y) + bflo(o.y), bfhi(v.y) + bfhi(o.y));
            v.z = pk2(bflo(v.z) + bflo(o.z), bfhi(v.z) + bfhi(o.z)); v.w = pk2(bflo(v.w) + bflo(o.w), bfhi(v.w) + bfhi(o.w));
        }
        *(u32x4*)gp = v;
    }
    LDSW();
}

__device__ __forceinline__ void task_diff(const float* const* in, unsigned char* ws, int L, int task, LAS unsigned char* lds) {
    const int tid = TID(), lane = tid & 63, wave = tid >> 6, r32 = lane & 31, hi = lane >> 5;
    const int qb = 31 - (task >> 4), b = (task >> 2) & 3, hd = task & 3;
    const bf16_t* z = (const bf16_t*)(ws + WS_R1);
    LAS float* lut = (LAS float*)(lds + ATT_LUT);
    build_lut(lut, inp(I_RELB), 6 + hd);
    __syncthreads();
    const int q0 = 256 * qb, qw0 = q0 + 32 * wave, tq = qw0 + r32;
    bf16x8 qr[4];
#pragma unroll
    for (int c = 0; c < 4; ++c) qr[c] = *(const bf16x8*)(z + (size_t)(b * T + tq) * ZW + C_DQ + 64 * hd + 16 * c + 8 * hi);
    const bf16_t* Kth = z + (size_t)(b * T + (tid >> 3)) * ZW + C_DK + 64 * hd + (tid & 7) * 8;
    const bf16_t* Vth = (const bf16_t*)(ws + WS_VT) + ((size_t)(b * 8 + 4 + hd) * 64 + (tid >> 3)) * T + (tid & 7) * 8;
    f32x16 O[2][2] = {}; float l[2] = {0.f, 0.f};
    attn_pass<2, false>(lds, Kth, (size_t)64 * ZW, Vth, 0, 4 * qb + 3, qr, tq, qw0, 1 << 30, lut, (u32x4){0u, 0u, 0u, 0u}, O, l);
    const float* lp = inp(I_DLAM) + L * 128;
    float s01 = 0.f, s23 = 0.f;
#pragma unroll
    for (int i = 0; i < 32; ++i) { s01 += lp[i] * lp[32 + i]; s23 += lp[64 + i] * lp[96 + i]; }
    const float lam_init = 0.8f - 0.6f * __expf(-0.3f * (float)L);
    const float lam = __expf(s01) - __expf(s23) + lam_init;
    const float l0 = l[0] + __shfl_xor(l[0], 32), l1 = l[1] + __shfl_xor(l[1], 32);
    const float i0 = 1.0f / l0, i1 = lam / l1;
    float val[2][16]; float ss = 0.f;
#pragma unroll
    for (int db = 0; db < 2; ++db)
#pragma unroll
        for (int r = 0; r < 16; ++r) { const float o = O[0][db][r] * i0 - O[1][db][r] * i1; val[db][r] = o; ss += o * o; }
    ss += __shfl_xor(ss, 32);
    const float rn = rsqrtf(ss * (1.0f / 64.0f) + EPS) * (1.0f - lam_init);
    const float* sub = inp(I_DSUB) + L * 64;
#pragma unroll
    for (int db = 0; db < 2; ++db)
#pragma unroll
        for (int r = 0; r < 16; ++r) val[db][r] *= rn * sub[32 * db + crow(r, hi)];
    store_ot<false>(lds + ATT_STAGE + wave * 4608, val, (bf16_t*)(ws + WS_MIX) + (size_t)(b * T + qw0) * DM + 384 + 64 * hd, DM);
}

__device__ __forceinline__ void task_nsa_sw(const float* const* in, unsigned char* ws, int L, int task, LAS unsigned char* lds) {
    const int tid = TID(), lane = tid & 63, wave = tid >> 6, r32 = lane & 31, hi = lane >> 5;
    const int qb = 31 - task / 24, rem = task % 24, b = rem / 6, h = rem % 6, g = h / 3;
    const bf16_t* z = (const bf16_t*)(ws + WS_R1);
    LAS float* lut = (LAS float*)(lds + ATT_LUT);
    build_lut(lut, inp(I_RELB), h);
    __syncthreads();
    const int q0 = 256 * qb, qw0 = q0 + 32 * wave, tq = qw0 + r32;
    const bf16_t* zq = z + (size_t)(b * T + tq) * ZW;
    bf16x8 qr[4];
#pragma unroll
    for (int c = 0; c < 4; ++c) qr[c] = *(const bf16x8*)(zq + C_NQ + 64 * h + 16 * c + 8 * hi);
    const u32x4 selw = *(const u32x4*)((const unsigned*)(ws + WS_SELM) + ((size_t)(b * 2 + g) * T + tq) * 4);
    const float g1 = sigmoidf_(bf2f(zq[C_NG + 3 * h + 1])), g2 = sigmoidf_(bf2f(zq[C_NG + 3 * h + 2]));
    float val[2][16];
    {
        const bf16_t* Kth = z + (size_t)(b * T + (tid >> 3)) * ZW + C_SK + 64 * g + (tid & 7) * 8;
        const bf16_t* Vth = (const bf16_t*)(ws + WS_VT) + ((size_t)(b * 8 + g) * 64 + (tid >> 3)) * T + (tid & 7) * 8;
        f32x16 O[1][2] = {}; float l[1] = {0.f};
        attn_pass<1, true>(lds, Kth, (size_t)64 * ZW, Vth, 0, 4 * qb + 3, qr, tq, qw0, 1 << 30, lut, selw, O, l);
        const float lt = l[0] + __shfl_xor(l[0], 32), sc = g1 / lt;
#pragma unroll
        for (int db = 0; db < 2; ++db)
#pragma unroll
            for (int r = 0; r < 16; ++r) val[db][r] = O[0][db][r] * sc;
    }
    {
        const bf16_t* Kth = z + (size_t)(b * T + (tid >> 3)) * ZW + C_WK + 64 * g + (tid & 7) * 8;
        const bf16_t* Vth = (const bf16_t*)(ws + WS_VT) + ((size_t)(b * 8 + 2 + g) * 64 + (tid >> 3)) * T + (tid & 7) * 8;
        f32x16 O[1][2] = {}; float l[1] = {0.f};
        const int m_lo = q0 >= 512 ? (q0 >> 6) - 8 : 0;
        attn_pass<1, false>(lds, Kth, (size_t)64 * ZW, Vth, m_lo, 4 * qb + 3, qr, tq, qw0, 512, lut, (u32x4){0u, 0u, 0u, 0u}, O, l);
        const float lt = l[0] + __shfl_xor(l[0], 32), sc = g2 / lt;
#pragma unroll
        for (int db = 0; db < 2; ++db)
#pragma unroll
            for (int r = 0; r < 16; ++r) val[db][r] += O[0][db][r] * sc;
    }
    store_ot<true>(lds + ATT_STAGE + wave * 4608, val, (bf16_t*)(ws + WS_MIX) + (size_t)(b * T + qw0) * DM + 64 * h, DM, (const bf16_t*)(ws + WS_OCB) + (size_t)(b * T + qw0) * 384 + 64 * h, 384);
}

__device__ __forceinline__ unsigned wave_max_u32(unsigned v) {
    unsigned t;
    t = (unsigned)__builtin_amdgcn_update_dpp(0, (int)v, 0xB1, 0xF, 0xF, false); v = t > v ? t : v;
    t = (unsigned)__builtin_amdgcn_update_dpp(0, (int)v, 0x4E, 0xF, 0xF, false); v = t > v ? t : v;
    t = (unsigned)__builtin_amdgcn_update_dpp(0, (int)v, 0x141, 0xF, 0xF, false); v = t > v ? t : v;
    t = (unsigned)__builtin_amdgcn_update_dpp(0, (int)v, 0x140, 0xF, 0xF, false); v = t > v ? t : v;
    t = (unsigned)__builtin_amdgcn_update_dpp(0, (int)v, 0x142, 0xA, 0xF, false); v = t > v ? t : v;
    t = (unsigned)__builtin_amdgcn_update_dpp(0, (int)v, 0x143, 0xC, 0xF, false); v = t > v ? t : v;
    return (unsigned)__builtin_amdgcn_readlane((int)v, 63);
}
constexpr int NC_IMP = 18432, NC_IMPW = 129, NC_LINV = NC_IMP + 3 * 64 * NC_IMPW * 4;
__device__ __forceinline__ void task_nsa_c(const float* const* in, unsigned char* ws, int L, int task, LAS unsigned char* lds) {
    const int tid = TID(), lane = tid & 63, wave = tid >> 6, r32 = lane & 31, hi = lane >> 5;
    const int cur = 127 - (task >> 3), b = (task >> 1) & 3, g = task & 1;
    const bf16_t* z = (const bf16_t*)(ws + WS_R1);
    LAS float* imp = (LAS float*)(lds + NC_IMP);
    LAS float* linv = (LAS float*)(lds + NC_LINV);
    const int q0 = 64 * cur;
    const int rh = wave >> 1, half = wave & 1, h = 3 * g + (rh < 3 ? rh : 0);
    const int ql = 32 * half + r32, tq = q0 + ql;
    const bf16_t* zq = z + (size_t)(b * T + tq) * ZW;
    bf16x8 qr[4];
#pragma unroll
    for (int c = 0; c < 4; ++c) qr[c] = *(const bf16x8*)(zq + C_NQ + 64 * h + 16 * c + 8 * hi);
    const bf16_t* Kth = (const bf16_t*)(ws + WS_KC) + ((size_t)(b * 2 + g) * 512 + (tid >> 3)) * 64 + (tid & 7) * 8;
    const bf16_t* Vth = (const bf16_t*)(ws + WS_VCT) + ((size_t)(b * 2 + g) * 64 + (tid >> 3)) * 512 + (tid & 7) * 8;
    const int ntiles = ((4 * cur + 2) >> 6) + 1;
    f32x16 O[2] = {}; float l = 0.f, carry = 0.f;
    u32x4 kreg = *(const u32x4*)(Kth), vreg = *(const u32x4*)(Vth);
    for (int m = 0; m < ntiles; ++m) {
        __syncthreads();
        *(LAS u32x4*)(lds + (tid >> 3) * 144 + (tid & 7) * 16) = kreg;
        { LAS u32x2* vp = (LAS u32x2*)(lds + 9216 + (tid >> 3) * 136 + (tid & 7) * 16); vp[0] = (u32x2){vreg.x, vreg.y}; vp[1] = (u32x2){vreg.z, vreg.w}; }
        __syncthreads();
        if (m + 1 < ntiles) { kreg = *(const u32x4*)(Kth + (size_t)(m + 1) * 64 * 64); vreg = *(const u32x4*)(Vth + (size_t)(m + 1) * 64); }
        if (wave < 6) {
            unsigned P[2][8]; float av[8], bq[8];
#pragma unroll
            for (int kh2 = 0; kh2 < 2; ++kh2) {
                f32x16 S = {};
#pragma unroll
                for (int c = 0; c < 4; ++c) { const bf16x8 kf = *(const LAS bf16x8*)(lds + (32 * kh2 + r32) * 144 + (16 * c + 8 * hi) * 2); S = mfma32(kf, qr[c], S); }
                float p[16];
#pragma unroll
                for (int r = 0; r < 16; ++r) { const int n = 64 * m + 32 * kh2 + crow(r, hi); const float e = ex2(S[r]); p[r] = (16 * n + 31 <= tq) ? e : 0.f; }
                float s = 0.f;
#pragma unroll
                for (int r = 0; r < 16; ++r) s += p[r];
                l += s;
#pragma unroll
                for (int j = 0; j < 8; ++j) P[kh2][j] = pk2(p[2 * j], p[2 * j + 1]);
#pragma unroll
                for (int j = 0; j < 4; ++j) { av[4 * kh2 + j] = p[4 * j] + p[4 * j + 1] + p[4 * j + 2] + 0.5f * p[4 * j + 3]; bq[4 * kh2 + j] = 0.5f * p[4 * j + 3]; }
            }
#pragma unroll
            for (int db = 0; db < 2; ++db)
#pragma unroll
                for (int cc = 0; cc < 4; ++cc) {
                    const u32x2 a0 = *(const LAS u32x2*)(lds + 9216 + (32 * db + r32) * 136 + (16 * cc + 4 * hi) * 2);
                    const u32x2 a1 = *(const LAS u32x2*)(lds + 9216 + (32 * db + r32) * 136 + (16 * cc + 8 + 4 * hi) * 2);
                    const bf16x8 vf = as_bf16x8((u32x4){a0.x, a0.y, a1.x, a1.y});
                    const bf16x8 pf = as_bf16x8((u32x4){P[cc >> 1][4 * (cc & 1)], P[cc >> 1][4 * (cc & 1) + 1], P[cc >> 1][4 * (cc & 1) + 2], P[cc >> 1][4 * (cc & 1) + 3]});
                    O[db] = mfma32(vf, pf, O[db]);
                }
            float recv[8];
#pragma unroll
            for (int jj = 0; jj < 8; ++jj) recv[jj] = __shfl_xor(bq[jj], 32);
            LAS float* ip = imp + (rh * 64 + ql) * NC_IMPW + 16 * m + hi;
#pragma unroll
            for (int jj = 0; jj < 8; ++jj) {
                const float add = hi ? recv[jj] : (jj == 0 ? carry : recv[jj > 0 ? jj - 1 : 0]);
                ip[2 * jj] = av[jj] + add;
            }
            carry = recv[7];
        }
    }
    if (wave < 6) {
        const float lt = l + __shfl_xor(l, 32);
        const float li = (tq >= 31 && lt > 0.f) ? 1.0f / lt : 0.f;
        if (hi == 0) linv[rh * 64 + ql] = li;
        const float g0 = sigmoidf_(bf2f(zq[C_NG + 3 * h + 0]));
        bf16_t* mx = (bf16_t*)(ws + WS_OCB) + (size_t)(b * T + tq) * 384 + 64 * h;
        const float sc = li * g0;
#pragma unroll
        for (int db = 0; db < 2; ++db)
#pragma unroll
            for (int r = 0; r < 16; ++r) mx[32 * db + crow(r, hi)] = f2bf(O[db][r] * sc);
    }
    __syncthreads();
#pragma unroll 1
    for (int qi = 0; qi < 8; ++qi) {
        const int q = 8 * wave + qi;
        unsigned w0 = 0u, w1 = 0u, w2 = 0u, w3 = 0u;
        if (cur <= 15) { w0 = (1u << (cur + 1)) - 1u; }
        else {
            const float i0 = linv[q], i1 = linv[64 + q], i2 = linv[128 + q];
            const int ma = lane, mb = lane + 64;
            float va = 0.f, vb = 0.f;
            if (ma >= 1 && ma <= cur - 2) va = imp[(0 * 64 + q) * NC_IMPW + ma] * i0 + imp[(1 * 64 + q) * NC_IMPW + ma] * i1 + imp[(2 * 64 + q) * NC_IMPW + ma] * i2;
            if (mb <= cur - 2) vb = imp[(0 * 64 + q) * NC_IMPW + mb] * i0 + imp[(1 * 64 + q) * NC_IMPW + mb] * i1 + imp[(2 * 64 + q) * NC_IMPW + mb] * i2;
            unsigned ka = va > 0.f ? ((__float_as_uint(va) & ~127u) | (unsigned)(127 - ma)) : 0u;
            unsigned kb = vb > 0.f ? ((__float_as_uint(vb) & ~127u) | (unsigned)(127 - mb)) : 0u;
            w0 = 1u;
#pragma unroll 1
            for (int it = 0; it < 13; ++it) {
                const unsigned best = wave_max_u32(ka > kb ? ka : kb);
                if (best != 0u) {
                    const int mw = 127 - (int)(best & 127u);
                    const unsigned bit = 1u << (mw & 31);
                    if (mw < 32) w0 |= bit; else if (mw < 64) w1 |= bit; else if (mw < 96) w2 |= bit; else w3 |= bit;
                    if (ka == best) ka = 0u;
                    if (kb == best) kb = 0u;
                }
            }
#pragma unroll
            for (int f = 0; f < 2; ++f) {
                const int mw = cur - f; const unsigned bit = 1u << (mw & 31);
                if (mw < 32) w0 |= bit; else if (mw < 64) w1 |= bit; else if (mw < 96) w2 |= bit; else w3 |= bit;
            }
        }
        if (lane == 0) *(u32x4*)((unsigned*)(ws + WS_SELM) + ((size_t)(b * 2 + g) * T + q0 + q) * 4) = (u32x4){w0, w1, w2, w3};
    }
}

#define XB_TMO      128
#define XB_XCNT(j)  (256  + 64 * (j))
#define XB_XSUB(j)  (1280 + 64 * (j))
#define XB_XGEN(j)  (2304 + 64 * (j))
#define XB_TOP      3328
#define XB_TOPGEN   3392
#define XCD_BAR_WORDS 3456
#define XB_SPIN_CAP (1u << 18)

__device__ __forceinline__ unsigned xb_ld(unsigned* p)              { return __hip_atomic_load(p, __ATOMIC_RELAXED, __HIP_MEMORY_SCOPE_AGENT); }
__device__ __forceinline__ unsigned xb_add(unsigned* p, unsigned v) { return __hip_atomic_fetch_add(p, v, __ATOMIC_RELAXED, __HIP_MEMORY_SCOPE_AGENT); }
__device__ __forceinline__ unsigned xb_xcc_id() { return (unsigned)__builtin_amdgcn_s_getreg((3 << 11) | 20) & 0xFu; }
#define XB_SPIN(cond, bar) do { unsigned _sp = 0; while (cond) { __builtin_amdgcn_s_sleep(1); \
    if ((++_sp & 255u) == 0u) { if (xb_ld(&(bar)[XB_TMO])) break; if (_sp > XB_SPIN_CAP) { atomicAdd(&(bar)[XB_TMO], 1u); break; } } } } while (0)

struct XcdBarrier {
    unsigned* bar; unsigned x;
    volatile LAS unsigned* st;
};

__device__ __forceinline__ XcdBarrier xcd_barrier_post(unsigned* bar, volatile LAS unsigned* st) {
    XcdBarrier b; b.bar = bar; b.x = xb_xcc_id(); b.st = st;
    if (threadIdx.x == 0) (void)xb_add(&bar[XB_XCNT(b.x)], 1u);
    return b;
}
__device__ __forceinline__ void xcd_barrier_complete(unsigned* bar, unsigned x, unsigned& nloc, unsigned& nx) {
    const unsigned G = gridDim.x * gridDim.y * gridDim.z;
    unsigned sum, cnt, mine, sp = 0u;
    for (;;) {
        sum = 0u; cnt = 0u; mine = 0u;
#pragma unroll
        for (unsigned j = 0; j < 16; ++j) { const unsigned c = xb_ld(&bar[XB_XCNT(j)]); sum += c; cnt += (c > 0u) ? 1u : 0u; mine = (j == x) ? c : mine; }
        if (sum == G) break;
        __builtin_amdgcn_s_sleep(1);
        if ((++sp & 255u) == 0u) { if (xb_ld(&bar[XB_TMO])) break; if (sp > XB_SPIN_CAP) { atomicAdd(&bar[XB_TMO], 1u); break; } }
    }
    nloc = mine > 0u ? mine : 1u; nx = cnt > 0u ? cnt : 1u;
}

__device__ __forceinline__ void xcd_barrier(const XcdBarrier& b) {
    asm volatile("s_waitcnt vmcnt(0)" ::: "memory");
    __syncthreads();
    if (threadIdx.x == 0) {
        unsigned* bar = b.bar;
        __builtin_amdgcn_s_waitcnt(0);
        unsigned nloc = b.st[0], nx = b.st[1];
        if (nloc == 0u) { xcd_barrier_complete(bar, b.x, nloc, nx); b.st[0] = nloc; b.st[1] = nx; }
        const unsigned old = xb_add(&bar[XB_XSUB(b.x)], 1u);
        const unsigned gen = old / nloc;
        if (old + 1u == (gen + 1u) * nloc) {
            __builtin_amdgcn_fence(__ATOMIC_RELEASE, "agent");
            asm volatile("s_waitcnt vmcnt(0)" ::: "memory");
            const unsigned og = xb_add(&bar[XB_TOP], 1u);
            const unsigned tg = og / nx;
            if (og + 1u == (tg + 1u) * nx) xb_add(&bar[XB_TOPGEN], 1u);
            else XB_SPIN(xb_ld(&bar[XB_TOPGEN]) == tg, bar);
            __builtin_amdgcn_fence(__ATOMIC_ACQUIRE, "agent");
            xb_add(&bar[XB_XGEN(b.x)], 1u);
            asm volatile("s_waitcnt vmcnt(0)" ::: "memory");
        } else {
            XB_SPIN(xb_ld(&bar[XB_XGEN(b.x)]) == gen, bar);
            __builtin_amdgcn_fence(__ATOMIC_ACQUIRE, "agent");
            asm volatile("s_waitcnt vmcnt(0)" ::: "memory");
        }
    }
    __syncthreads();
}

struct Args { const float* in[N_IN]; float* out; unsigned char* ws; int ph_lo, ph_hi; };
static_assert(sizeof(Args) == 8 * N_IN + 24, "Args has no padding");
constexpr int PH_PER_LAYER = 12, N_PHASES = DEPTH * PH_PER_LAYER;
#ifndef PH_HI
#ifdef REPJ
#define PH_HI (N_PHASES + DEPTH)
#else
#define PH_HI N_PHASES
#endif
#endif

__global__ void __launch_bounds__(512) mega(Args a) {
    extern __shared__ __attribute__((aligned(16))) unsigned char lds_raw[];
    LAS unsigned char* lds = (LAS unsigned char*)lds_raw;
    LAS int* slot = (LAS int*)(lds + LDS_MISC);
    cg::grid_group grid = cg::this_grid();
    const float* const* in = nullptr;
    volatile LAS unsigned* misc = (volatile LAS unsigned*)(lds + LDS_MISC);
    if (TID() < 16) misc[TID()] = 0u;
    __syncthreads();
    (void)xcd_barrier_post((unsigned*)(a.ws + WS_CTL) + 4096, misc + 8);
#ifndef DUP_GU
#define DUP_GU 0
#endif
#ifndef DUP_IN
#define DUP_IN 0
#endif
#ifndef DUP_DIFF
#define DUP_DIFF 0
#endif
#ifndef DUP_NSAC
#define DUP_NSAC 0
#endif
#ifndef DUP_SW
#define DUP_SW 0
#endif
#ifndef DUP_HOUT
#define DUP_HOUT 0
#endif
#ifndef DUP_M1
#define DUP_M1 0
#endif
#ifndef DUP_SYNC
#define DUP_SYNC 0
#endif
#ifndef DUP_CONV
#define DUP_CONV 0
#endif
#ifndef PHM
#define PHM 0xfff
#endif
    for (int ph = a.ph_lo; ph < a.ph_hi; ++ph) {
#ifdef REPJ
        int L = ph / (PH_PER_LAYER + 1); const int k_ = ph - L * (PH_PER_LAYER + 1); const int j = k_ <= REPJ ? k_ : k_ - 1; const float amul = (k_ == REPJ) ? 0.f : 1.f;
#else
        int L = ph / PH_PER_LAYER; const int j = ph - L * PH_PER_LAYER; const float amul = 1.f;
#endif
        asm volatile("" : "+s"(L));
        unsigned long long ws_ = (unsigned long long)a.ws; asm volatile("" : "+s"(ws_)); unsigned char* ws = (unsigned char*)(GAS unsigned char*)ws_;
        unsigned long long out_ = (unsigned long long)a.out; asm volatile("" : "+s"(out_)); float* out_g = (float*)(GAS float*)out_;
        unsigned* ctl = (unsigned*)(ws + WS_CTL); bf16_t* r1 = (bf16_t*)(ws + WS_R1); bf16_t* mixed = (bf16_t*)(ws + WS_MIX); bf16_t* pb = (bf16_t*)(ws + WS_PB); unsigned char* wb = ws + WS_W; float* rsqp = (float*)(ws + WS_RSQP);
        float* rsq = (float*)(ws + ((L & 1) ? WS_RSQ1 : WS_RSQ0)); float* rsq_next = (float*)(ws + ((L & 1) ? WS_RSQ0 : WS_RSQ1));
        bf16_t* xb = (bf16_t*)(ws + ((L & 1) ? WS_XB1 : WS_XB)); bf16_t* xb_next = (bf16_t*)(ws + ((L & 1) ? WS_XB : WS_XB1));
        if ((PHM >> j) & 1) switch (j) {
        case 0: phase_convert(in, ws, out_g, L, lds); if (DUP_CONV) { __syncthreads(); phase_convert(in, ws, out_g, L, lds); } break;
        case 1: { EpiSwiGLU E{r1, {}}; run_gemm(lds, xb, (const bf16_t*)(wb + W_GU1), 2 * FF, DM, E, rsq); } break;
        case 2: { EpiRes<0> E{out_g, xb, rsq, 0.5f * amul, nullptr, nullptr, nullptr, nullptr, nullptr, {}}; run_gemm(lds, r1, (const bf16_t*)(wb + W_D1), DM, FF, E); } break;
        case 3: { EpiZ E{r1, {}}; run_gemm(lds, xb, (const bf16_t*)(wb + W_IN), ZW, DM, E, rsq); } break;
        case 4: {
            unsigned* ctr = ctl + (L * 4 + 0) * 64;
            constexpr int NCMP = 512 << DUP_M1, NHL = 512 << DUP_M1;
            for (;;) { const int t = next_task(ctr, slot); if (t >= NCMP + NHL + 512) break;
                if (t < NCMP) task_compress(in, ws, L, t >> DUP_M1, lds); else if (t < NCMP + NHL) task_hgrn_local(in, ws, L, (t - NCMP) >> DUP_M1, lds); else task_prep(in, ws, L, t - NCMP - NHL, lds); }
        } break;
        case 5: {
            unsigned* ctr = ctl + (L * 4 + 1) * 64;
            constexpr int ND = 512 << DUP_DIFF, NC = 1024 << DUP_NSAC;
            for (;;) { const int t = next_task(ctr, slot); if (t >= 192 + ND + NC) break;
                if (t < 192) task_hgrn_scan(ws, t); else if (t < 192 + ND) task_diff(in, ws, L, (t - 192) >> DUP_DIFF, lds); else task_nsa_c(in, ws, L, (t - 192 - ND) >> DUP_NSAC, lds); }
        } break;
        case 6: {
            unsigned* ctr = ctl + (L * 4 + 2) * 64;
            constexpr int NS = 768 << DUP_SW, NH = 1024 << DUP_HOUT;
            for (;;) { const int t = next_task(ctr, slot); if (t >= NS + NH) break;
                if (t < NS) task_nsa_sw(in, ws, L, t >> DUP_SW, lds); else task_hgrn_out(in, ws, L, (t - NS) >> DUP_HOUT, lds); }
        } break;
        case 7: { EpiRes<0> E{out_g, xb, rsq, 1.0f * amul, nullptr, nullptr, nullptr, nullptr, nullptr, {}}; run_gemm(lds, mixed, (const bf16_t*)(wb + W_OUT), DM, DM, E); } break;
        case 8: { EpiSwiGLU E{r1, {}}; run_gemm(lds, xb, (const bf16_t*)(wb + W_GU2), 2 * FF, DM, E, rsq); } break;
        case 9: { EpiRes<2> E{nullptr, nullptr, rsqp, 0.f, nullptr, nullptr, nullptr, nullptr, mixed, {}}; run_gemm(lds, pb, (const bf16_t*)(wb + W_PP), DM, PLE, E); } break;
        case 10: { EpiRes<0> E{out_g, xb, rsq, 0.5f * amul, nullptr, nullptr, nullptr, nullptr, nullptr, {}}; run_gemm(lds, r1, (const bf16_t*)(wb + W_D2), DM, FF, E); } break;
        default: { EpiRes<1> E{out_g, xb_next, rsq_next, 0.f, rsq, mixed, rsqp, inp(I_PLPOST) + L * DM, nullptr, {}}; run_gemm(lds, xb, (const bf16_t*)(wb + W_PG), DM, DM, E, rsq, rsqp); } break;
        }
        if (ph + 1 < a.ph_hi) {
            if (ph == 0) { asm volatile("s_waitcnt vmcnt(0) lgkmcnt(0)" ::: "memory"); grid.sync(); __builtin_amdgcn_fence(__ATOMIC_ACQUIRE, "agent"); asm volatile("s_waitcnt vmcnt(0)" ::: "memory"); __syncthreads(); }
            else { XcdBarrier xb_; xb_.bar = (unsigned*)(ws + WS_CTL) + 4096; xb_.x = xb_xcc_id(); xb_.st = misc + 8; xcd_barrier(xb_); if (DUP_SYNC) xcd_barrier(xb_); }
        }
    }
}

#ifdef DUMPK
__global__ void __launch_bounds__(512) dump_kernel(float* out, unsigned char* ws) {
    bf16_t* mixed = (bf16_t*)(ws + WS_MIX); (void)mixed;
    for (size_t idx = (size_t)blockIdx.x * 512 + threadIdx.x; idx < (size_t)M * 1024; idx += (size_t)gridDim.x * 512) {
        const size_t m = idx >> 10; const int c = (int)(idx & 1023);
        float v = 0.f;
#if DUMPK == 3 || DUMPK == 40
        { const bf16_t* z = (const bf16_t*)(ws + WS_R1); v = bf2f(z[m * ZW + c]) + bf2f(z[m * ZW + 1024 + c]) + bf2f(z[m * ZW + 2048 + c]) + (c < 402 ? bf2f(z[m * ZW + 3072 + c]) : 0.f); }
#elif DUMPK == 41
        { const bf16_t* vt = (const bf16_t*)(ws + WS_VT); v = bf2f(vt[m * 512 + (c & 511)]); }
#elif DUMPK == 42
        { const float* hs = (const float*)(ws + WS_HS); const float* hd = (const float*)(ws + WS_HD); v = hs[m * 384 + (c % 384)] + hd[m * 6 + (c % 6)]; }
#elif DUMPK == 43
        { const bf16_t* kc = (const bf16_t*)(ws + WS_KC); const bf16_t* vct = (const bf16_t*)(ws + WS_VCT); v = bf2f(kc[m * 8 + (c & 7)]) + bf2f(vct[m * 8 + (c & 7)]); }
#elif DUMPK == 50 || DUMPK == 60
        v = (c < 384) ? bf2f(mixed[m * 1024 + c]) : 0.f;
#elif DUMPK == 51
        v = (c >= 384 && c < 640) ? bf2f(mixed[m * 1024 + c]) : 0.f;
#elif DUMPK == 52
        { const unsigned* selm = (const unsigned*)(ws + WS_SELM); v = (float)(selm[m * 8 + (c & 7)] & 0xffffu) + (float)(selm[m * 8 + (c & 7)] >> 16); }
#elif DUMPK == 53
        { const float* hs = (const float*)(ws + WS_HS); v = hs[m * 384 + (c % 384)]; }
#elif DUMPK == 61
        v = (c >= 640) ? bf2f(mixed[m * 1024 + c]) : 0.f;
#endif
        out[idx] = v;
    }
}
#endif

extern "C" void kernel_launch(void* const* d_in, const int* in_sizes, int n_in, void* d_out, int out_size, void* d_ws, size_t ws_size, hipStream_t stream) {
    static int grid = 0;
    if (grid == 0) {
        if (n_in != N_IN || out_size != M * DM || ws_size < WS_END) { fprintf(stderr, "kernel_launch: unexpected shapes (n_in %d out %d ws %zu)\n", n_in, out_size, ws_size); grid = -1; return; }
        int dev = 0, cus = 0, per_cu = 0;
        hipGetDevice(&dev); hipDeviceGetAttribute(&cus, hipDeviceAttributeMultiprocessorCount, dev);
        if (hipFuncSetAttribute((const void*)mega, hipFuncAttributeMaxDynamicSharedMemorySize, LDS_BYTES) != hipSuccess) { fprintf(stderr, "hipFuncSetAttribute failed\n"); }
        if (hipOccupancyMaxActiveBlocksPerMultiprocessor(&per_cu, (const void*)mega, 512, LDS_BYTES) != hipSuccess || per_cu < 1) { fprintf(stderr, "occupancy query: %d\n", per_cu); per_cu = 1; }
        (void)hipGetLastError();
        grid = cus;
    }
    if (grid < 0) return;
    hipMemsetAsync((char*)d_ws + WS_CTL, 0, 64 * 1024, stream);
    Args a{};
    for (int i = 0; i < N_IN; ++i) a.in[i] = (const float*)d_in[i];
    a.out = (float*)d_out; a.ws = (unsigned char*)d_ws; a.ph_lo = 0; a.ph_hi = PH_HI;
    void* args[] = {&a};
    hipError_t e = hipLaunchCooperativeKernel((const void*)mega, dim3(grid), dim3(512), args, LDS_BYTES, stream);
    if (e != hipSuccess) fprintf(stderr, "cooperative launch failed: %s (grid %d)\n", hipGetErrorString(e), grid);
#ifdef DUMPK
    dump_kernel<<<dim3(1024), dim3(512), 0, stream>>>((float*)d_out, (unsigned char*)d_ws);
#endif
}
```

```cpp
#include <hip/hip_runtime.h>
#include <hip/hip_cooperative_groups.h>
#include <cstdio>
#include <cstdint>
namespace cg = cooperative_groups;
__device__ __forceinline__ int TID() { int t = threadIdx.x; asm volatile("" : "+v"(t)); return t; }
typedef float f32x4_z __attribute__((ext_vector_type(4)));
__device__ __forceinline__ f32x4_z zero4_() { float z = 0.f; asm volatile("" : "+v"(z)); return (f32x4_z){z, z, z, z}; }
namespace pg8 {
#define PG8_LAS __attribute__((address_space(3)))
typedef unsigned short bf16_t;
typedef short bf16x8 __attribute__((ext_vector_type(8)));
typedef float f32x4 __attribute__((ext_vector_type(4)));
typedef unsigned u32x4 __attribute__((ext_vector_type(4)));
constexpr int BM = 256, BK = 64, HALF = 128, HTB = HALF * BK * 2  , STAGE_BYTES = 8 * HTB, NXCD = 8, WGM = 8;

__host__ __device__ __forceinline__ int lds_byte(int r, int c) { const int st = (r >> 4) * 2 + (c >> 5), rr = r & 15, cc = c & 31, ob = rr * 64 + cc * 2; return st * 1024 + (ob ^ (((ob >> 9) & 1) << 5)); }
__host__ __device__ __forceinline__ void stage_rc(int b, int& R, int& C) { const int st = b / 1024, sb = b % 1024, swz = sb ^ (((sb >> 9) & 1) << 5); R = (st >> 1) * 16 + swz / 64; C = (st & 1) * 32 + (swz % 64) / 2; }
__host__ __device__ __forceinline__ int perm32(int rho) { const int n = rho >> 4, i = rho & 15; return 8 * (i >> 2) + 4 * n + (i & 3); }

struct Unit { int pm, pn; };
struct Gemm { const bf16_t* A; const bf16_t* Bt; int M, N, K; };

struct StaticOrder {
    int nM, nN, nwg, G, c;
    __host__ __device__ void init(int M, int N, int G_, int c_) { nM = M / BM; nN = N / BM; nwg = nM * nN; G = G_; c = c_; }
    __host__ __device__ bool next(int i, Unit& u) const {
        const long L = (long)i * G + c; if (L >= nwg) return false;
        int wgid = (int)L; { const int q = nwg / NXCD, r = nwg % NXCD, xcd = wgid % NXCD, off = wgid / NXCD; wgid = (xcd < r ? xcd * (q + 1) : r * (q + 1) + (xcd - r) * q) + off; }
        const int nig = WGM * nN, gid = wgid / nig, fm = gid * WGM, gsz = (nM - fm) < WGM ? (nM - fm) : WGM;
        u.pm = fm + ((wgid % nig) % gsz); u.pn = (wgid % nig) / gsz; return true;
    }
    __device__ __forceinline__ void a_ready(const Unit&) const {}
    __device__ __forceinline__ void done(const Unit&) const {}
};

template <class Epi, class Sched, bool ALIGN_EPI = false, bool SP2 = false>
__device__ __forceinline__ void gemm_phase(PG8_LAS unsigned char* lds, const Gemm g, const Sched& S, const Epi& E) {
    const int tid = TID(), wid = __builtin_amdgcn_readfirstlane(tid >> 6), lane = tid & 63, wr = wid >> 2, wc = wid & 3, fr = lane & 15, fq = lane >> 4;
    const int K = g.K, nt = K / BK;
    unsigned voffA[2], voffB[2];
#pragma unroll
    for (int i = 0; i < 2; ++i) { int R, C; stage_rc(tid * 16 + i * 8192, R, C); const int Rb = Epi::PERM ? ((R & ~31) + perm32(R & 31)) : R;
        voffA[i] = (unsigned)(R * K + C) * 2u; voffB[i] = (unsigned)(Rb * K + C) * 2u; }
    const size_t kstep = (size_t)(BK * 2);
    const size_t hstep = (size_t)HALF * K * 2;
    const size_t tstep = 2 * hstep;
    const unsigned ldsw = (unsigned)wid * 1024u;
    const int aoff = lds_byte(wr * 64 + fr, fq * 8), boff = lds_byte(wc * 32 + fr, fq * 8);
#define PG8_SA(b, h) (((b) * 2 + (h)) * HTB)
#define PG8_SB(b, h) ((4 + (b) * 2 + (h)) * HTB)
#define PG8_STAGE(bufoff, gbase, voff) do { _Pragma("unroll") for (int _i = 0; _i < 2; ++_i) \
        __builtin_amdgcn_global_load_lds((const unsigned*)((const char*)(gbase) + (voff)[_i]), (PG8_LAS unsigned*)(lds + (bufoff) + ldsw + _i * 8192), 16, 0, 0); } while (0)
#define PG8_LDA(dst, b, h) do { _Pragma("unroll") for (int m = 0; m < 4; ++m) _Pragma("unroll") for (int k = 0; k < 2; ++k) dst[m][k] = *(const PG8_LAS bf16x8*)(lds + PG8_SA(b, h) + aoff + m * 2048 + k * 1024); } while (0)
#define PG8_LDB(dst, b, h) do { _Pragma("unroll") for (int n = 0; n < 2; ++n) _Pragma("unroll") for (int k = 0; k < 2; ++k) dst[n][k] = *(const PG8_LAS bf16x8*)(lds + PG8_SB(b, h) + boff + n * 2048 + k * 1024); } while (0)
#define PG8_MMA(ai, bj, At, Bt) do { __builtin_amdgcn_s_setprio(1); _Pragma("unroll") for (int m = 0; m < 4; ++m) _Pragma("unroll") for (int n = 0; n < 2; ++n) _Pragma("unroll") for (int k = 0; k < 2; ++k) \
        acc[ai][bj][m][n] = __builtin_amdgcn_mfma_f32_16x16x32_bf16(Bt[n][k], At[m][k], acc[ai][bj][m][n], 0, 0, 0); __builtin_amdgcn_s_setprio(0); } while (0)
#define PG8_WAIT_V(n) asm volatile("s_waitcnt vmcnt(" #n ")" ::: "memory")
#define PG8_WAIT_L(n) asm volatile("s_waitcnt lgkmcnt(" #n ")" ::: "memory")
#define PG8_BAR __builtin_amdgcn_s_barrier()
#define PG8_SCHED __builtin_amdgcn_sched_barrier(0)
    Unit cur, nxt; int ui = 0;
    if (!S.next(0, cur)) return;
    f32x4 acc[2][2][4][2];
#pragma unroll
    for (int a = 0; a < 2; ++a)
#pragma unroll
        for (int b = 0; b < 2; ++b)
#pragma unroll
            for (int m = 0; m < 4; ++m)
#pragma unroll
                for (int n = 0; n < 2; ++n) acc[a][b][m][n] = zero4_();
    bf16x8 At[4][2], B0[2][2], B1[2][2];
    const char* cA = (const char*)g.A + (size_t)cur.pm * tstep; const char* cB = (const char*)g.Bt + (size_t)cur.pn * tstep;
    S.a_ready(cur);
    if constexpr (SP2) {
        PG8_STAGE(PG8_SB(0, 0), cB, voffB); PG8_STAGE(PG8_SB(0, 1), cB + hstep, voffB); PG8_STAGE(PG8_SA(0, 0), cA, voffA); PG8_STAGE(PG8_SA(0, 1), cA + hstep, voffA);
        if (wr == 1) PG8_BAR;
        PG8_WAIT_V(2); PG8_BAR;
        PG8_STAGE(PG8_SB(1, 0), cB + kstep, voffB); PG8_STAGE(PG8_SA(1, 0), cA + kstep, voffA); PG8_STAGE(PG8_SB(1, 1), cB + hstep + kstep, voffB);
        PG8_WAIT_V(6); PG8_BAR;
    } else {
        PG8_STAGE(PG8_SB(0, 0), cB, voffB); PG8_STAGE(PG8_SA(0, 0), cA, voffA); PG8_STAGE(PG8_SB(0, 1), cB + hstep, voffB); PG8_STAGE(PG8_SA(0, 1), cA + hstep, voffA);
        if (wr == 1) PG8_BAR;
        PG8_WAIT_V(4); PG8_BAR;
        PG8_STAGE(PG8_SB(1, 0), cB + kstep, voffB); PG8_STAGE(PG8_SA(1, 0), cA + kstep, voffA); PG8_STAGE(PG8_SB(1, 1), cB + hstep + kstep, voffB);
        PG8_WAIT_V(6); PG8_BAR;
    }
    for (;;) {
        const bool has_next = S.next(ui + 1, nxt);
        const char* nA = has_next ? (const char*)g.A + (size_t)nxt.pm * tstep : cA; const char* nB = has_next ? (const char*)g.Bt + (size_t)nxt.pn * tstep : cB;
        for (int t = 0; t < nt; t += 2) {
            const bool last = (t == nt - 2);
            const char* a1 = cA + (size_t)(t + 1) * kstep;
            const char* a2 = last ? nA : cA + (size_t)(t + 2) * kstep; const char* b2 = last ? nB : cB + (size_t)(t + 2) * kstep;
            const char* a3 = a2 + kstep; const char* b3 = b2 + kstep;
            if (last && has_next) S.a_ready(nxt);
            if constexpr (SP2) {
            PG8_LDB(B0, 0, 0); PG8_LDB(B1, 0, 1); PG8_SCHED; PG8_LDA(At, 0, 0); PG8_STAGE(PG8_SA(1, 1), a1 + hstep, voffA);
            PG8_WAIT_V(8); PG8_WAIT_L(0); PG8_BAR; PG8_MMA(0, 0, At, B0); PG8_MMA(0, 1, At, B1); PG8_BAR; PG8_SCHED;
            PG8_LDA(At, 0, 1); PG8_STAGE(PG8_SB(0, 0), b2, voffB); PG8_STAGE(PG8_SB(0, 1), b2 + hstep, voffB); PG8_STAGE(PG8_SA(0, 0), a2, voffA);
            PG8_WAIT_V(8); PG8_WAIT_L(0); PG8_BAR; PG8_MMA(1, 0, At, B0); PG8_MMA(1, 1, At, B1); PG8_BAR; PG8_SCHED;
            PG8_LDB(B0, 1, 0); PG8_LDB(B1, 1, 1); PG8_SCHED; PG8_LDA(At, 1, 0); PG8_STAGE(PG8_SA(0, 1), a2 + hstep, voffA);
            PG8_WAIT_V(8); PG8_WAIT_L(0); PG8_BAR; PG8_MMA(0, 0, At, B0); PG8_MMA(0, 1, At, B1); PG8_BAR; PG8_SCHED;
            PG8_LDA(At, 1, 1); PG8_STAGE(PG8_SB(1, 0), b3, voffB); PG8_STAGE(PG8_SB(1, 1), b3 + hstep, voffB); PG8_STAGE(PG8_SA(1, 0), a3, voffA);
            PG8_WAIT_V(8); PG8_WAIT_L(0); PG8_BAR; PG8_MMA(1, 0, At, B0); PG8_MMA(1, 1, At, B1); PG8_BAR; PG8_SCHED;
            } else {
            PG8_LDB(B0, 0, 0); PG8_SCHED; PG8_LDA(At, 0, 0); PG8_STAGE(PG8_SA(1, 1), a1 + hstep, voffA);
            PG8_WAIT_L(8); PG8_BAR; PG8_WAIT_L(0); PG8_MMA(0, 0, At, B0); PG8_BAR; PG8_SCHED;
            PG8_LDB(B1, 0, 1); PG8_STAGE(PG8_SB(0, 0), b2, voffB);
            PG8_BAR; PG8_WAIT_L(0); PG8_MMA(0, 1, At, B1); PG8_BAR;
            PG8_LDA(At, 0, 1); PG8_STAGE(PG8_SA(0, 0), a2, voffA);
            PG8_BAR; PG8_WAIT_L(0); PG8_MMA(1, 0, At, B0); PG8_BAR; PG8_SCHED;
            PG8_STAGE(PG8_SB(0, 1), b2 + hstep, voffB);
            PG8_WAIT_V(6); PG8_BAR; PG8_MMA(1, 1, At, B1); PG8_BAR;
            PG8_LDB(B0, 1, 0); PG8_SCHED; PG8_LDA(At, 1, 0); PG8_STAGE(PG8_SA(0, 1), a2 + hstep, voffA);
            PG8_WAIT_L(8); PG8_BAR; PG8_WAIT_L(0); PG8_MMA(0, 0, At, B0); PG8_BAR; PG8_SCHED;
            PG8_LDB(B1, 1, 1); PG8_STAGE(PG8_SB(1, 0), b3, voffB);
            PG8_BAR; PG8_WAIT_L(0); PG8_MMA(0, 1, At, B1); PG8_BAR;
            PG8_LDA(At, 1, 1); PG8_STAGE(PG8_SA(1, 0), a3, voffA);
            PG8_BAR; PG8_WAIT_L(0); PG8_MMA(1, 0, At, B0); PG8_BAR; PG8_SCHED;
            PG8_STAGE(PG8_SB(1, 1), b3 + hstep, voffB);
            PG8_WAIT_V(6); PG8_BAR; PG8_MMA(1, 1, At, B1); PG8_BAR;
            }
        }
        if constexpr (ALIGN_EPI) { if (wr == 0) PG8_BAR; }
        if constexpr (!Epi::AFTER_DRAIN) { E(acc, cur, wr, wc, fr, fq); S.done(cur); }
        if (!has_next) break;
#pragma unroll
        for (int a = 0; a < 2; ++a)
#pragma unroll
            for (int b = 0; b < 2; ++b)
#pragma unroll
                for (int m = 0; m < 4; ++m)
#pragma unroll
                    for (int n = 0; n < 2; ++n) acc[a][b][m][n] = zero4_();
        cur = nxt; cA = nA; cB = nB; ++ui;
        if constexpr (ALIGN_EPI) { if (wr == 1) PG8_BAR; }
    }
    PG8_WAIT_V(0);
    if constexpr (!ALIGN_EPI) { if (wr == 0) PG8_BAR; }
    PG8_BAR;
    if constexpr (Epi::AFTER_DRAIN) { E.fused(acc, cur, wr, wc, fr, fq, lds, wid, lane); S.done(cur); }
#undef PG8_SA
#undef PG8_SB
#undef PG8_STAGE
#undef PG8_LDA
#undef PG8_LDB
#undef PG8_MMA
#undef PG8_WAIT_V
#undef PG8_WAIT_L
#undef PG8_BAR
#undef PG8_SCHED
}
}

#define LAS __attribute__((address_space(3)))
typedef unsigned short bf16_t;
typedef short bf16x8 __attribute__((ext_vector_type(8)));
typedef float f32x4 __attribute__((ext_vector_type(4)));
typedef float f32x16 __attribute__((ext_vector_type(16)));
typedef unsigned u32x4 __attribute__((ext_vector_type(4)));
typedef unsigned u32x2 __attribute__((ext_vector_type(2)));

constexpr int NB = 4, T = 8192, DM = 1024, M = NB * T, DEPTH = 4, PLE = 256, FF = 2816, ZW = 3584, INW = 3474;
constexpr int C_NQ = 0, C_CK = 384, C_CV = 512, C_SK = 640, C_SV = 768, C_WK = 896, C_WV = 1024, C_DQ = 1152, C_DK = 1408, C_DV = 1664,
              C_HQ = 1920, C_HF = 2304, C_HI = 2688, C_HG = 3072, C_NG = 3456;
constexpr float EPS = 1e-6f, LOG2E = 1.4426950408889634f;
enum { I_X = 0, I_P, I_RELB, I_LBLOG, I_F1N, I_F1G, I_F1U, I_F1D, I_MIXN, I_WIN, I_WOUT, I_NQN, I_NKN, I_CPOS, I_CW1, I_CW2,
       I_DQN, I_DKN, I_DLAM, I_DSUB, I_HON, I_F2N, I_F2G, I_F2U, I_F2D, I_PLN, I_PLG, I_PLP, I_PLPOST, N_IN };
constexpr size_t MiB = 1u << 20;
constexpr size_t WS_CTL = 0, WS_W = 1 * MiB, WS_PB = 53 * MiB, WS_XB = 69 * MiB, WS_R1 = 133 * MiB, WS_MIX = 357 * MiB, WS_VT = 421 * MiB,
                 WS_HS = 453 * MiB, WS_KC = 501 * MiB, WS_VCT = WS_KC + 512 * 1024, WS_SELM = 503 * MiB, WS_RSQ0 = 504 * MiB, WS_RSQ1 = 506 * MiB,
                 WS_RSQP = 508 * MiB, WS_HD = 510 * MiB, WS_XB1 = 511 * MiB, WS_OCB = 575 * MiB, WS_ONES = 599 * MiB, WS_END = 601 * MiB;
constexpr size_t W_GU1 = 0, W_D1 = 11 * MiB, W_GU2 = W_D1 + 5 * MiB + 512 * 1024, W_D2 = W_GU2 + 11 * MiB, W_IN = 33 * MiB, W_OUT = 40 * MiB, W_PG = 42 * MiB,
                 W_PP = 44 * MiB, W_1T = W_PP + 512 * 1024, W_2T = W_1T + 2 * MiB, W_POSB = W_2T + 64 * 1024;
static_assert(W_D2 + 5 * MiB + 512 * 1024 == W_IN, "weight map");
constexpr int LDS_BYTES = 138 * 1024, LDS_MISC = 131072, LDS_RTAB = LDS_MISC + 1024;

__device__ __forceinline__ float bf2f(unsigned short u) { return __uint_as_float(((unsigned)u) << 16); }
__device__ __forceinline__ float bflo(unsigned w) { return __uint_as_float(w << 16); }
__device__ __forceinline__ float bfhi(unsigned w) { return __uint_as_float(w & 0xffff0000u); }
typedef float f32x2_t __attribute__((ext_vector_type(2))); typedef __bf16 bf16x2_t __attribute__((ext_vector_type(2)));
__device__ __forceinline__ unsigned pk2(float lo, float hi) { f32x2_t v = {lo, hi}; bf16x2_t b = __builtin_convertvector(v, bf16x2_t); return __builtin_bit_cast(unsigned, b); }
__device__ __forceinline__ bf16_t f2bf(float f) { return (bf16_t)(pk2(f, 0.f) & 0xffffu); }
__device__ __forceinline__ float ex2(float x) { return __builtin_amdgcn_exp2f(x); }
__device__ __forceinline__ float sigmoidf_(float x) { return 1.0f / (1.0f + __expf(-x)); }
__device__ __forceinline__ int crow(int r, int hi) { return (r & 3) + 8 * (r >> 2) + 4 * hi; }
__device__ __forceinline__ f32x16 mfma32(bf16x8 a, bf16x8 b, f32x16 c) { return __builtin_amdgcn_mfma_f32_32x32x16_bf16(a, b, c, 0, 0, 0); }
__device__ __forceinline__ f32x4 mfma16(bf16x8 a, bf16x8 b, f32x4 c) { return __builtin_amdgcn_mfma_f32_16x16x32_bf16(a, b, c, 0, 0, 0); }
__device__ __forceinline__ bf16x8 as_bf16x8(u32x4 v) { return __builtin_bit_cast(bf16x8, v); }
#define LDSW() asm volatile("s_waitcnt lgkmcnt(0)" ::: "memory")
#define CFENCE() asm volatile("" ::: "memory")
#define GAS __attribute__((address_space(1)))
__device__ __forceinline__ const float* inp(int i) { asm volatile("" : "+s"(i)); const unsigned long long v = ((const unsigned long long __attribute__((address_space(4)))*)__builtin_amdgcn_kernarg_segment_ptr())[i]; return (const float*)(const GAS float*)v; }

__device__ __forceinline__ float row_rinv(const float* rsq, int row) {
    const f32x4* p = (const f32x4*)(rsq + (size_t)row * 16);
    const f32x4 a = p[0], b = p[1], c = p[2], d = p[3];
    const float s = ((a.x + a.y) + (a.z + a.w)) + ((b.x + b.y) + (b.z + b.w)) + ((c.x + c.y) + (c.z + c.w)) + ((d.x + d.y) + (d.z + d.w));
    return rsqrtf(s * (1.0f / 1024.0f) + EPS);
}
struct RowTab {
    int p0, p1, p2, p3;
    __device__ __forceinline__ int slot(int pm) const { return pm == p0 ? 0 : (pm == p1 ? 1 : (pm == p2 ? 2 : 3)); }
    __device__ __forceinline__ float get(int t, int pm, int r256) const { return ((const LAS float*)(LAS unsigned char*)(size_t)LDS_RTAB)[(t * 4 + slot(pm)) * 256 + r256]; }
};
struct EpiSwiGLU {
    static constexpr bool PERM = true, AFTER_DRAIN = false;
    bf16_t* O; RowTab rt;
    __device__ __forceinline__ void operator()(const f32x4 (&acc)[2][2][4][2], const pg8::Unit& u, int wr, int wc, int fr, int fq) const {
#pragma unroll
        for (int ai = 0; ai < 2; ++ai)
#pragma unroll
            for (int m = 0; m < 4; ++m) {
                const int row = u.pm * 256 + ai * 128 + wr * 64 + m * 16 + fr;
                const float r = rt.get(0, u.pm, row & 255);
                float o[8];
#pragma unroll
                for (int n = 0; n < 2; ++n)
#pragma unroll
                    for (int e = 0; e < 4; ++e) { const float g = acc[ai][0][m][n][e] * r, up = acc[ai][1][m][n][e] * r; o[n * 4 + e] = g * sigmoidf_(g) * up; }
                u32x4 w; w.x = pk2(o[0], o[1]); w.y = pk2(o[2], o[3]); w.z = pk2(o[4], o[5]); w.w = pk2(o[6], o[7]);
                *(u32x4*)(O + (size_t)row * FF + u.pn * 128 + wc * 32 + 8 * fq) = w;
                CFENCE();
            }
    }
};
template <int LD> struct EpiZT {
    static constexpr bool PERM = true, AFTER_DRAIN = false;
    bf16_t* Z; RowTab rt;
    __device__ __forceinline__ void operator()(const f32x4 (&acc)[2][2][4][2], const pg8::Unit& u, int wr, int wc, int fr, int fq) const {
#pragma unroll
        for (int ai = 0; ai < 2; ++ai)
#pragma unroll
            for (int m = 0; m < 4; ++m) {
                const int row = u.pm * 256 + ai * 128 + wr * 64 + m * 16 + fr;
                const float r = rt.get(0, u.pm, row & 255);
#pragma unroll
                for (int bj = 0; bj < 2; ++bj) {
                    const f32x4 v0 = acc[ai][bj][m][0] * r, v1 = acc[ai][bj][m][1] * r;
                    u32x4 w; w.x = pk2(v0[0], v0[1]); w.y = pk2(v0[2], v0[3]); w.z = pk2(v1[0], v1[1]); w.w = pk2(v1[2], v1[3]);
                    *(u32x4*)(Z + (size_t)row * LD + u.pn * 256 + bj * 128 + wc * 32 + 8 * fq) = w;
                }
                CFENCE();
            }
    }
};
typedef EpiZT<ZW> EpiZ;
template <int MODE> struct EpiRes {
    static constexpr bool PERM = true, AFTER_DRAIN = false;
    float* X; bf16_t* XB; float* rsq_out; float alpha; const float* rsq_in; const bf16_t* P; const float* rsqp; const float* post; bf16_t* Pout; RowTab rt;
    __device__ __forceinline__ void operator()(const f32x4 (&acc)[2][2][4][2], const pg8::Unit& u, int wr, int wc, int fr, int fq) const {
        const int rowb = u.pm * 256 + wr * 64 + fr, colb = u.pn * 256 + wc * 32 + 8 * fq;
        f32x4 xn[2][2]; u32x2 pn_[2][2];
        if (MODE != 2) {
#pragma unroll
            for (int bj = 0; bj < 2; ++bj)
#pragma unroll
                for (int n = 0; n < 2; ++n) { const size_t off = (size_t)rowb * DM + colb + bj * 128 + 4 * n; xn[bj][n] = *(const f32x4*)(X + off); if (MODE == 1) pn_[bj][n] = *(const u32x2*)(P + off); }
        }
#pragma unroll
        for (int gI = 0; gI < 8; ++gI) {
            const int ai = gI >> 2, m = gI & 3;
            const int row = rowb + ai * 128 + m * 16;
            f32x4 xc[2][2]; u32x2 pc[2][2];
#pragma unroll
            for (int bj = 0; bj < 2; ++bj)
#pragma unroll
                for (int n = 0; n < 2; ++n) { xc[bj][n] = xn[bj][n]; pc[bj][n] = pn_[bj][n]; }
            if (MODE != 2 && gI < 7) {
                const int row2 = rowb + ((gI + 1) >> 2) * 128 + ((gI + 1) & 3) * 16;
#pragma unroll
                for (int bj = 0; bj < 2; ++bj)
#pragma unroll
                    for (int n = 0; n < 2; ++n) { const size_t off = (size_t)row2 * DM + colb + bj * 128 + 4 * n; xn[bj][n] = *(const f32x4*)(X + off); if (MODE == 1) pn_[bj][n] = *(const u32x2*)(P + off); }
            }
            CFENCE();
            float r = 1.f, rp = 1.f;
            if (MODE == 1) { r = rt.get(0, u.pm, row & 255); rp = rt.get(1, u.pm, row & 255); }
            float ss = 0.f;
#pragma unroll
            for (int bj = 0; bj < 2; ++bj)
#pragma unroll
                for (int n = 0; n < 2; ++n) {
                    const int c0 = colb + bj * 128 + 4 * n;
                    const size_t off = (size_t)row * DM + c0;
                    const f32x4 a = acc[ai][bj][m][n];
                    if (MODE == 2) {
                        u32x2 w; w.x = pk2(a[0], a[1]); w.y = pk2(a[2], a[3]);
                        *(u32x2*)(Pout + off) = w;
                        ss += (a[0] * a[0] + a[1] * a[1]) + (a[2] * a[2] + a[3] * a[3]);
                    } else {
                        f32x4 xv = xc[bj][n];
                        if (MODE == 0) xv += a * alpha;
                        else {
                            const u32x2 pw = pc[bj][n]; const f32x4 po = *(const f32x4*)(post + c0);
                            xv[0] += sigmoidf_(a[0] * r) * (bflo(pw.x) * rp * po[0]);
                            xv[1] += sigmoidf_(a[1] * r) * (bfhi(pw.x) * rp * po[1]);
                            xv[2] += sigmoidf_(a[2] * r) * (bflo(pw.y) * rp * po[2]);
                            xv[3] += sigmoidf_(a[3] * r) * (bfhi(pw.y) * rp * po[3]);
                        }
                        *(f32x4*)(X + off) = xv;
                        u32x2 w; w.x = pk2(xv[0], xv[1]); w.y = pk2(xv[2], xv[3]);
                        *(u32x2*)(XB + off) = w;
                        ss += (xv[0] * xv[0] + xv[1] * xv[1]) + (xv[2] * xv[2] + xv[3] * xv[3]);
                    }
                }
            ss += __shfl_xor(ss, 16); ss += __shfl_xor(ss, 32);
            if (fq == 0) rsq_out[(size_t)row * 16 + u.pn * 4 + wc] = ss;
        }
    }
};

template <class Epi> __device__ __forceinline__ void run_gemm(LAS unsigned char* lds, const bf16_t* A, const bf16_t* Bt, int N, int K, Epi& E, const float* rsqA = nullptr, const float* rsqB = nullptr) {
    int bx = blockIdx.x; asm volatile("" : "+s"(bx)); asm volatile("" : "+s"(K)); asm volatile("" : "+s"(N));
    pg8::Gemm g{A, Bt, M, N, K}; pg8::StaticOrder S; S.init(M, N, (int)gridDim.x, bx);
    if (rsqA) {
        int p0 = -1, p1 = -1, p2 = -1, p3 = -1; pg8::Unit u;
        for (int i = 0; S.next(i, u); ++i) { const int pm = u.pm; if (pm != p0 && pm != p1 && pm != p2 && pm != p3) { if (p0 < 0) p0 = pm; else if (p1 < 0) p1 = pm; else if (p2 < 0) p2 = pm; else p3 = pm; } }
        E.rt.p0 = p0; E.rt.p1 = p1; E.rt.p2 = p2; E.rt.p3 = p3;
        const int tid = TID();
        LAS float* tab = (LAS float*)(lds + LDS_RTAB);
        if (tid < 256) {
#pragma unroll
            for (int s = 0; s < 4; ++s) { const int pm = s == 0 ? p0 : (s == 1 ? p1 : (s == 2 ? p2 : p3));
                if (pm >= 0) { tab[s * 256 + tid] = row_rinv(rsqA, pm * 256 + tid); if (rsqB) tab[(4 + s) * 256 + tid] = row_rinv(rsqB, pm * 256 + tid); } }
        }
        __syncthreads();
    }
    pg8::gemm_phase<Epi, pg8::StaticOrder, true, true>(lds, g, S, E);
    __syncthreads();
}

__device__ __forceinline__ void rowsq_pass(const bf16_t* P, float* rsq_out) {
    const int tid = TID(), lane = tid & 63, wave = tid >> 6;
    for (int base = (blockIdx.x * 8 + wave) * 4; base < M; base += gridDim.x * 8 * 4) {
        u32x4 v[4][2];
#pragma unroll
        for (int i = 0; i < 4; ++i) { const u32x4* pr = (const u32x4*)(P + (size_t)(base + i) * DM) + lane; v[i][0] = pr[0]; v[i][1] = pr[64]; }
#pragma unroll
        for (int i = 0; i < 4; ++i) {
            float s = 0.f;
#pragma unroll
            for (int h2 = 0; h2 < 2; ++h2) { const u32x4 w = v[i][h2];
                s += (bflo(w.x) * bflo(w.x) + bfhi(w.x) * bfhi(w.x)) + (bflo(w.y) * bflo(w.y) + bfhi(w.y) * bfhi(w.y)) + (bflo(w.z) * bflo(w.z) + bfhi(w.z) * bfhi(w.z)) + (bflo(w.w) * bflo(w.w) + bfhi(w.w) * bfhi(w.w)); }
#pragma unroll
            for (int o = 1; o < 64; o <<= 1) s += __shfl_xor(s, o);
            if (lane < 16) rsq_out[(size_t)(base + i) * 16 + lane] = (lane == 0) ? s : 0.f;
        }
    }
}

__device__ __forceinline__ int next_task(unsigned* ctr, LAS int* slot) {
    __syncthreads();
    if (TID() == 0) *slot = (int)atomicAdd(ctr, 1u);
    __syncthreads();
    return *slot;
}

__device__ __forceinline__ int colmap(int mode, int n) {
    if (mode == 1) return 256 * (n >> 7) + (n & 127);
    if (mode == 2) return 256 * (n >> 7) + 128 + (n & 127);
    if (mode == 3) return n < 1152 ? n : (n < 1170 ? 3456 + (n - 1152) : n - 18);
    return n;
}
__device__ __forceinline__ void conv_item(const float* W, int K, int N, bf16_t* WT, const float* gain, int mode, LAS float* scr, int item, int lane) {
    const int nblk = (N + 31) >> 5, kb = item / nblk, nb = item % nblk, k0 = 64 * kb, n0 = 32 * nb;
#pragma unroll 16
    for (int i = 0; i < 32; ++i) {
        const int kk = 2 * i + (lane >> 5), n = n0 + (lane & 31);
        float v = (n < N) ? W[(size_t)(k0 + kk) * N + n] : 0.f;
        if (gain) v *= gain[k0 + kk];
        scr[kk * 33 + (lane & 31)] = v;
    }
    LDSW();
    const int c = lane & 7;
#pragma unroll
    for (int j = 0; j < 4; ++j) {
        const int nl = (lane >> 3) + 8 * j, n = n0 + nl;
        const LAS float* s = scr + (8 * c) * 33 + nl;
        u32x4 o; o.x = pk2(s[0], s[33]); o.y = pk2(s[2 * 33], s[3 * 33]); o.z = pk2(s[4 * 33], s[5 * 33]); o.w = pk2(s[6 * 33], s[7 * 33]);
        if (n < N) *(u32x4*)(WT + (size_t)colmap(mode, n) * K + k0 + 8 * c) = o;
    }
    LDSW();
}

__device__ __forceinline__ void phase_convert(const float* const* in, unsigned char* ws, float* out, int L, LAS unsigned char* lds) {
    const int tid = TID(), lane = tid & 63, wave = tid >> 6;
    const int gw = blockIdx.x * 8 + wave, NGW = gridDim.x * 8;
    LAS float* scr = (LAS float*)(lds + wave * 8704);
    unsigned char* wb = ws + WS_W;
    if (gw < 256) {
        const int ty = gw >> 7, ng = (gw >> 5) & 3, ks = gw & 31, n = ng * 64 + lane;
        const float* w1 = inp(I_CW1) + (size_t)(L * 2 + ty) * 2048 * 256; const float* pos = inp(I_CPOS) + (size_t)(L * 2 + ty) * 2048;
        float acc = 0.f;
#pragma unroll 16
        for (int k = ks * 64; k < ks * 64 + 64; ++k) acc += pos[k] * w1[(size_t)k * 256 + n];
        ((float*)(wb + W_POSB))[(ty * 32 + ks) * 256 + n] = acc;
    }
    const size_t ffo = (size_t)L * DM * FF;
    constexpr int IT_GU = (DM / 64) * (FF / 32), IT_D = (FF / 64) * (DM / 32), IT_IN = (DM / 64) * ((INW + 31) / 32), IT_SQ = (DM / 64) * (DM / 32),
                  IT_PP = (PLE / 64) * (DM / 32), IT_W1 = (2048 / 64) * (256 / 32), IT_W2 = (256 / 64) * (64 / 32);
    constexpr int total = 4 * IT_GU + 2 * IT_D + IT_IN + 2 * IT_SQ + IT_PP + 2 * IT_W1 + 2 * IT_W2;
    for (int it = gw; it < total; it += NGW) {
        const float* W = nullptr; int K = 0, N = 0; bf16_t* WT = nullptr; const float* gain = nullptr; int mode = 0, rr = -1, r = it;
#define JOB(Wp, Kk, Nn, WTp, gp, md, items) { if (rr < 0 && r < (items)) { W = (Wp); K = (Kk); N = (Nn); WT = (bf16_t*)(WTp); gain = (gp); mode = (md); rr = r; } r -= (items); }
        JOB(inp(I_F1G) + ffo, DM, FF, wb + W_GU1, inp(I_F1N) + L * DM, 1, IT_GU)
        JOB(inp(I_F1U) + ffo, DM, FF, wb + W_GU1, inp(I_F1N) + L * DM, 2, IT_GU)
        JOB(inp(I_F1D) + ffo, FF, DM, wb + W_D1, nullptr, 0, IT_D)
        JOB(inp(I_F2G) + ffo, DM, FF, wb + W_GU2, inp(I_F2N) + L * DM, 1, IT_GU)
        JOB(inp(I_F2U) + ffo, DM, FF, wb + W_GU2, inp(I_F2N) + L * DM, 2, IT_GU)
        JOB(inp(I_F2D) + ffo, FF, DM, wb + W_D2, nullptr, 0, IT_D)
        JOB(inp(I_WIN) + (size_t)L * DM * INW, DM, INW, wb + W_IN, inp(I_MIXN) + L * DM, 3, IT_IN)
        JOB(inp(I_WOUT) + (size_t)L * DM * DM, DM, DM, wb + W_OUT, nullptr, 0, IT_SQ)
        JOB(inp(I_PLG) + (size_t)L * DM * DM, DM, DM, wb + W_PG, inp(I_PLN) + L * DM, 0, IT_SQ)
        JOB(inp(I_PLP) + (size_t)L * PLE * DM, PLE, DM, wb + W_PP, nullptr, 0, IT_PP)
        JOB(inp(I_CW1) + (size_t)(L * 2 + 0) * 2048 * 256, 2048, 256, wb + W_1T, nullptr, 0, IT_W1)
        JOB(inp(I_CW1) + (size_t)(L * 2 + 1) * 2048 * 256, 2048, 256, wb + W_1T + 256 * 2048 * 2, nullptr, 0, IT_W1)
        JOB(inp(I_CW2) + (size_t)(L * 2 + 0) * 256 * 64, 256, 64, wb + W_2T, nullptr, 0, IT_W2)
        JOB(inp(I_CW2) + (size_t)(L * 2 + 1) * 256 * 64, 256, 64, wb + W_2T + 64 * 256 * 2, nullptr, 0, IT_W2)
#undef JOB
        conv_item(W, K, N, WT, gain, mode, scr, rr, lane);
    }
    {
        u32x4* z = (u32x4*)((bf16_t*)(wb + W_IN) + (size_t)INW * DM);
        const int n16 = (ZW - INW) * DM / 8;
        for (int i = blockIdx.x * 512 + tid; i < n16; i += gridDim.x * 512) z[i] = (u32x4){0u, 0u, 0u, 0u};
    }
    {
        const f32x4* src = (const f32x4*)(inp(I_P) + (size_t)L * M * PLE); u32x4* dst = (u32x4*)(ws + WS_PB);
        const int n8 = M * PLE / 8;
        for (int i = blockIdx.x * 512 + tid; i < n8; i += gridDim.x * 512) {
            const f32x4 a = src[2 * i], b = src[2 * i + 1];
            u32x4 w; w.x = pk2(a[0], a[1]); w.y = pk2(a[2], a[3]); w.z = pk2(b[0], b[1]); w.w = pk2(b[2], b[3]); dst[i] = w;
        }
    }
    if (L == 0) {
        const float* x = inp(I_X); bf16_t* xb = (bf16_t*)(ws + WS_XB); float* rsq = (float*)(ws + WS_RSQ0);
        for (int m = gw; m < M; m += NGW) {
            const f32x4* xr = (const f32x4*)(x + (size_t)m * DM) + lane; f32x4* orow = (f32x4*)(out + (size_t)m * DM) + lane;
            u32x2* xbr = (u32x2*)(xb + (size_t)m * DM) + lane;
            float s = 0.f;
#pragma unroll
            for (int j = 0; j < 4; ++j) { const f32x4 v = xr[64 * j]; orow[64 * j] = v; u32x2 w; w.x = pk2(v[0], v[1]); w.y = pk2(v[2], v[3]); xbr[64 * j] = w; s += (v[0] * v[0] + v[1] * v[1]) + (v[2] * v[2] + v[3] * v[3]); }
#pragma unroll
            for (int o = 1; o < 64; o <<= 1) s += __shfl_xor(s, o);
            if (lane < 16) rsq[(size_t)m * 16 + lane] = (lane == 0) ? s : 0.f;
        }
    }
}

__device__ __forceinline__ void task_prep(const float* const* in, unsigned char* ws, int L, int tile, LAS unsigned char* lds) {
    const int tid = TID(), lane = tid & 63, wave = tid >> 6;
    bf16_t* z = (bf16_t*)(ws + WS_R1);
    const int row0 = tile * 64;
#pragma unroll
    for (int pass = 0; pass < 3; ++pass) {
        const int seg = pass * 64 + lane;
        int col = 0, gs = 8; const float* gp = inp(I_NQN); float scale = 1.f;
        if (seg < 48) { col = C_NQ + 8 * seg; gp = inp(I_NQN) + L * 64 + ((8 * seg) & 63); scale = 0.125f * LOG2E; }
        else if (seg < 64) { col = C_SK + 8 * (seg - 48); gp = inp(I_NKN) + (L * 3 + 1) * 64 + ((8 * seg) & 63); }
        else if (seg < 80) { col = C_WK + 8 * (seg - 64); gp = inp(I_NKN) + (L * 3 + 2) * 64 + ((8 * seg) & 63); }
        else if (seg < 112) { col = C_DQ + 8 * (seg - 80); gp = inp(I_DQN) + L * 32 + ((8 * seg) & 31); gs = 4; scale = 0.17677669529663689f * LOG2E; }
        else { col = C_DK + 8 * (seg - 112); gp = inp(I_DKN) + L * 32 + ((8 * seg) & 31); gs = 4; }
        const bool act = seg < 144;
        if (!act) { col = 0; }
        const f32x4 g0 = *(const f32x4*)gp, g1 = *(const f32x4*)(gp + 4);
        u32x4 w[8];
#pragma unroll
        for (int i = 0; i < 8; ++i) w[i] = *(const u32x4*)(z + (size_t)(row0 + wave + 8 * i) * ZW + col);
#pragma unroll
        for (int i = 0; i < 8; ++i) {
            float v[8] = {bflo(w[i].x), bfhi(w[i].x), bflo(w[i].y), bfhi(w[i].y), bflo(w[i].z), bfhi(w[i].z), bflo(w[i].w), bfhi(w[i].w)};
            float ss = 0.f;
#pragma unroll
            for (int e2 = 0; e2 < 8; ++e2) ss += v[e2] * v[e2];
            ss += __shfl_xor(ss, 1); ss += __shfl_xor(ss, 2);
            const float t4 = __shfl_xor(ss, 4); if (gs == 8) ss += t4;
            const float r = rsqrtf(ss / (float)(gs * 8) + EPS) * scale;
            u32x4 o; o.x = pk2(v[0] * r * g0[0], v[1] * r * g0[1]); o.y = pk2(v[2] * r * g0[2], v[3] * r * g0[3]);
            o.z = pk2(v[4] * r * g1[0], v[5] * r * g1[1]); o.w = pk2(v[6] * r * g1[2], v[7] * r * g1[3]);
            if (act) *(u32x4*)(z + (size_t)(row0 + wave + 8 * i) * ZW + col) = o;
        }
    }
    LAS bf16_t* tl = (LAS bf16_t*)lds;
#pragma unroll
    for (int i = 0; i < 8; ++i) {
        const int id = i * 512 + tid, row = id >> 6, ch = id & 63;
        const int col = ch < 16 ? C_SV + 8 * ch : (ch < 32 ? C_WV + 8 * (ch - 16) : C_DV + 8 * (ch - 32));
        *(LAS u32x4*)(tl + row * 520 + 8 * ch) = *(const u32x4*)(z + (size_t)(row0 + row) * ZW + col);
    }
    __syncthreads();
    const int b = row0 / T, t0 = row0 % T;
    bf16_t* vt = (bf16_t*)(ws + WS_VT);
#pragma unroll
    for (int i = 0; i < 8; ++i) {
        const int orow = tid, tch = i;
        const LAS bf16_t* s = tl + (tch * 8) * 520 + orow;
        u32x4 o;
        o.x = (unsigned)s[0] | ((unsigned)s[520] << 16); o.y = (unsigned)s[2 * 520] | ((unsigned)s[3 * 520] << 16);
        o.z = (unsigned)s[4 * 520] | ((unsigned)s[5 * 520] << 16); o.w = (unsigned)s[6 * 520] | ((unsigned)s[7 * 520] << 16);
        *(u32x4*)(vt + ((size_t)(b * 8) * 64 + orow) * T + t0 + 8 * tch) = o;
    }
}

__device__ __forceinline__ float gelu_tanh(float x) {
    const float y = 0.7978845608028654f * (x + 0.044715f * x * x * x);
    const float th = 1.0f - 2.0f / (1.0f + __expf(2.0f * y));
    return 0.5f * x * (1.0f + th);
}
__device__ __forceinline__ void task_compress(const float* const* in, unsigned char* ws, int L, int task, LAS unsigned char* lds) {
    const int tid = TID(), lane = tid & 63, wave = tid >> 6;
    const int ty = task >> 8, b = (task >> 6) & 3, g = (task >> 5) & 1, i0 = (task & 31) * 16;
    const bf16_t* z = (const bf16_t*)(ws + WS_R1);
    LAS bf16_t* zt = (LAS bf16_t*)lds;
    LAS bf16_t* hid = (LAS bf16_t*)(lds + 39168);
    LAS float* ofp = (LAS float*)(lds + 39168 + 8448);
    const int ccol = (ty ? C_CV : C_CK) + 64 * g;
    for (int id = tid; id < 272 * 8; id += 512) {
        const int row = id >> 3, ch = id & 7, tok = 16 * i0 + row;
        u32x4 v = (u32x4){0u, 0u, 0u, 0u};
        if (tok < T) v = *(const u32x4*)(z + (size_t)(b * T + tok) * ZW + ccol + 8 * ch);
        *(LAS u32x4*)(zt + row * 72 + 8 * ch) = v;
    }
    __syncthreads();
    const bf16_t* w1t = (const bf16_t*)(ws + WS_W + W_1T) + (size_t)ty * 256 * 2048;
    const bf16_t* w2t = (const bf16_t*)(ws + WS_W + W_2T) + (size_t)ty * 64 * 256;
    const float* posb = (const float*)(ws + WS_W + W_POSB) + ty * 32 * 256;
    const int r16 = lane & 15, kq = lane >> 4;
    f32x4 acc[2] = {(f32x4){0.f, 0.f, 0.f, 0.f}, (f32x4){0.f, 0.f, 0.f, 0.f}};
    const bf16_t* b0p = w1t + (size_t)(16 * (2 * wave) + r16) * 2048 + 8 * kq;
    const bf16_t* b1p = b0p + 16 * 2048;
#pragma unroll 8
    for (int kc = 0; kc < 64; ++kc) {
        const bf16x8 a = *(const LAS bf16x8*)(zt + (16 * r16 + (kc >> 1)) * 72 + (kc & 1) * 32 + 8 * kq);
        const bf16x8 w0 = *(const bf16x8*)(b0p + 32 * kc), w1 = *(const bf16x8*)(b1p + 32 * kc);
        acc[0] = mfma16(a, w0, acc[0]); acc[1] = mfma16(a, w1, acc[1]);
    }
#pragma unroll
    for (int j = 0; j < 2; ++j) {
        const int n = 16 * (2 * wave + j) + r16;
        float pbias = 0.f;
#pragma unroll
        for (int ks = 0; ks < 32; ++ks) pbias += posb[ks * 256 + n];
#pragma unroll
        for (int i = 0; i < 4; ++i) hid[(4 * kq + i) * 264 + n] = f2bf(gelu_tanh(acc[j][i] + pbias));
    }
    __syncthreads();
    if (wave < 4) {
        f32x4 a2 = (f32x4){0.f, 0.f, 0.f, 0.f};
        const bf16_t* bp = w2t + (size_t)(16 * wave + r16) * 256 + 8 * kq;
#pragma unroll
        for (int kc = 0; kc < 8; ++kc) {
            const bf16x8 a = *(const LAS bf16x8*)(hid + r16 * 264 + 32 * kc + 8 * kq);
            const bf16x8 w = *(const bf16x8*)(bp + 32 * kc);
            a2 = mfma16(a, w, a2);
        }
#pragma unroll
        for (int i = 0; i < 4; ++i) ofp[(4 * kq + i) * 64 + 16 * wave + r16] = a2[i];
    }
    __syncthreads();
    if (tid < 256) {
        const int row = tid >> 4, c4 = (tid & 15) * 4, i = i0 + row;
        f32x4 o = *(const LAS f32x4*)(ofp + row * 64 + c4);
        float ss = (o[0] * o[0] + o[1] * o[1]) + (o[2] * o[2] + o[3] * o[3]);
        ss += __shfl_xor(ss, 1); ss += __shfl_xor(ss, 2); ss += __shfl_xor(ss, 4); ss += __shfl_xor(ss, 8);
        if (ty == 0) {
            const float r = rsqrtf(ss * (1.0f / 64.0f) + EPS);
            const f32x4 gn = *(const f32x4*)(inp(I_NKN) + (L * 3 + 0) * 64 + c4);
            o = o * r * gn;
        }
        if (i >= 511) o = (f32x4){0.f, 0.f, 0.f, 0.f};
        if (ty == 0) {
            u32x2 w; w.x = pk2(o[0], o[1]); w.y = pk2(o[2], o[3]);
            *(u32x2*)((bf16_t*)(ws + WS_KC) + ((size_t)(b * 2 + g) * 512 + i) * 64 + c4) = w;
        } else {
            bf16_t* vct = (bf16_t*)(ws + WS_VCT) + (size_t)(b * 2 + g) * 64 * 512;
#pragma unroll
            for (int e = 0; e < 4; ++e) vct[(size_t)(c4 + e) * 512 + i] = f2bf(o[e]);
        }
    }
}

__device__ __forceinline__ float hgrn_lb(const float* logits, int L, int j) {
    if (L == 0) return 0.f;
    const float a0 = logits[j], a1 = logits[384 + j], a2 = logits[768 + j], a3 = logits[1152 + j];
    const float mx = fmaxf(fmaxf(a0, a1), fmaxf(a2, a3));
    const float e0 = __expf(a0 - mx), e1 = __expf(a1 - mx), e2 = __expf(a2 - mx), e3 = __expf(a3 - mx);
    const float inv = 1.0f / (e0 + e1 + e2 + e3);
    float s = e1; if (L >= 2) s += e2; if (L >= 3) s += e3;
    return s * inv;
}
__device__ __forceinline__ void task_hgrn_local(const float* const* in, unsigned char* ws, int L, int task, LAS unsigned char* lds) {
    const int tid = TID(), lane = tid & 63, wave = tid >> 6;
    if (wave < 6) {
        const int chunk = task * 6 + wave;
        const int bh = chunk >> 7, c = chunk & 127, b = bh / 6, h = bh % 6;
        const bf16_t* z = (const bf16_t*)(ws + WS_R1) + (size_t)(b * T + c * 64) * ZW;
        LAS bf16_t* klT = (LAS bf16_t*)(lds + wave * 18432);
        LAS bf16_t* vT = klT + 64 * 72;
        const float lb = hgrn_lb(inp(I_LBLOG), L, h * 64 + lane);
        LAS bf16_t* rawf = klT;
        (void)rawf;
        u32x4 rf[8], ri[8];
#pragma unroll
        for (int i = 0; i < 8; ++i) {
            const int row = (lane >> 3) + 8 * i, ch = lane & 7;
            rf[i] = *(const u32x4*)(z + (size_t)row * ZW + C_HF + 64 * h + 8 * ch);
            ri[i] = *(const u32x4*)(z + (size_t)row * ZW + C_HI + 64 * h + 8 * ch);
        }
#pragma unroll
        for (int i = 0; i < 8; ++i) {
            const int row = (lane >> 3) + 8 * i, ch = lane & 7;
            *(LAS u32x4*)(klT + row * 72 + 8 * ch) = rf[i];
            *(LAS u32x4*)(vT + row * 72 + 8 * ch) = ri[i];
        }
        LDSW();
        float suffix = 0.f;
        bf16_t colf[64], colv[64];
#pragma unroll
        for (int s2 = 0; s2 < 64; ++s2) { colf[s2] = klT[s2 * 72 + lane]; colv[s2] = vT[s2 * 72 + lane]; }
        LDSW();
#pragma unroll
        for (int s = 63; s >= 0; --s) {
            const float fr = bf2f(colf[s]);
            const float sg = sigmoidf_(fr);
            const float f = lb + (1.0f - lb) * sg;
            const float ig = (1.0f - lb) * (1.0f - sg);
            klT[lane * 72 + s] = f2bf(ig * __expf(suffix));
            vT[lane * 72 + s] = colv[s];
            suffix += __logf(f);
        }
        ((float*)(ws + WS_HD))[(size_t)chunk * 64 + lane] = __expf(suffix);
        LDSW();
        const int r32 = lane & 31, hi = lane >> 5;
        float* hs = (float*)(ws + WS_HS) + (size_t)chunk * 4096;
#pragma unroll
        for (int kb = 0; kb < 2; ++kb)
#pragma unroll
            for (int vb = 0; vb < 2; ++vb) {
                f32x16 cacc = {};
#pragma unroll
                for (int cc = 0; cc < 4; ++cc) {
                    const bf16x8 a = *(const LAS bf16x8*)(klT + (32 * kb + r32) * 72 + 16 * cc + 8 * hi);
                    const bf16x8 bb = *(const LAS bf16x8*)(vT + (32 * vb + r32) * 72 + 16 * cc + 8 * hi);
                    cacc = mfma32(a, bb, cacc);
                }
#pragma unroll
                for (int r = 0; r < 16; ++r) hs[(32 * kb + crow(r, hi)) * 64 + 32 * vb + r32] = cacc[r];
            }
    }
}
__device__ __forceinline__ void task_hgrn_scan(unsigned char* ws, int task) {
    const int tid = TID();
    const int bh = task >> 3, k = (task & 7) * 8 + (tid >> 6), v = tid & 63;
    float* hs = (float*)(ws + WS_HS) + (size_t)bh * 128 * 4096 + k * 64 + v;
    const float* hd = (const float*)(ws + WS_HD) + (size_t)bh * 128 * 64 + k;
    float S = 0.f;
#pragma unroll 16
    for (int c = 0; c < 128; ++c) {
        const float a = hs[(size_t)c * 4096], d = hd[c * 64];
        hs[(size_t)c * 4096] = S;
        S = d * S + a;
    }
}
__device__ __forceinline__ void task_hgrn_out(const float* const* in, unsigned char* ws, int L, int task, LAS unsigned char* lds) {
    const int tid = TID(), lane = tid & 63, wave = tid >> 6;
    if (wave < 3) {
        const int chunk = task * 3 + wave;
        const int bh = chunk >> 7, c = chunk & 127, b = bh / 6, h = bh % 6;
        const size_t row0 = (size_t)(b * T + c * 64);
        const bf16_t* z = (const bf16_t*)(ws + WS_R1) + row0 * ZW;
        LAS bf16_t* ke = (LAS bf16_t*)(lds + wave * 36864);
        LAS bf16_t* qe = ke + 64 * 72;
        LAS bf16_t* vT = qe + 64 * 72;
        LAS bf16_t* sT = vT + 64 * 72;
        const float lb = hgrn_lb(inp(I_LBLOG), L, h * 64 + lane);
        {
            u32x4 rq[8], rf[8], ri[8];
#pragma unroll
            for (int i = 0; i < 8; ++i) {
                const int row = (lane >> 3) + 8 * i, ch = lane & 7;
                rq[i] = *(const u32x4*)(z + (size_t)row * ZW + C_HQ + 64 * h + 8 * ch);
                rf[i] = *(const u32x4*)(z + (size_t)row * ZW + C_HF + 64 * h + 8 * ch);
                ri[i] = *(const u32x4*)(z + (size_t)row * ZW + C_HI + 64 * h + 8 * ch);
            }
#pragma unroll
            for (int i = 0; i < 8; ++i) {
                const int row = (lane >> 3) + 8 * i, ch = lane & 7;
                *(LAS u32x4*)(qe + row * 72 + 8 * ch) = rq[i];
                *(LAS u32x4*)(ke + row * 72 + 8 * ch) = rf[i];
                *(LAS u32x4*)(sT + row * 72 + 8 * ch) = ri[i];
            }
        }
        LDSW();
        float ref = 0.f;
#pragma unroll 8
        for (int s = 0; s < 32; ++s) {
            const float fr = bf2f(ke[s * 72 + lane]);
            ref += __logf(lb + (1.0f - lb) * sigmoidf_(fr));
        }
        float cum = 0.f;
#pragma unroll 8
        for (int s = 0; s < 64; ++s) {
            const float fr = bf2f(ke[s * 72 + lane]);
            const float qv = bf2f(qe[s * 72 + lane]);
            const bf16_t vraw = sT[s * 72 + lane];
            const float sg = sigmoidf_(fr);
            const float f = lb + (1.0f - lb) * sg;
            const float ig = (1.0f - lb) * (1.0f - sg);
            cum += __logf(f);
            qe[s * 72 + lane] = f2bf(qv * sigmoidf_(qv) * __expf(cum - ref));
            ke[s * 72 + lane] = f2bf(ig * __expf(ref - cum));
            vT[lane * 72 + s] = vraw;
        }
        LDSW();
        const float* hs = (const float*)(ws + WS_HS) + (size_t)chunk * 4096;
        const float eref = __expf(ref);
        {
            f32x4 hv[16];
#pragma unroll
            for (int i = 0; i < 16; ++i) hv[i] = *(const f32x4*)(hs + ((lane >> 4) + 4 * i) * 64 + (lane & 15) * 4);
#pragma unroll
            for (int i = 0; i < 16; ++i) {
                const int k = (lane >> 4) + 4 * i, v4 = (lane & 15) * 4;
                const float er = __shfl(eref, k);
                sT[(v4 + 0) * 72 + k] = f2bf(hv[i][0] * er); sT[(v4 + 1) * 72 + k] = f2bf(hv[i][1] * er);
                sT[(v4 + 2) * 72 + k] = f2bf(hv[i][2] * er); sT[(v4 + 3) * 72 + k] = f2bf(hv[i][3] * er);
            }
        }
        LDSW();
        const int r32 = lane & 31, hi = lane >> 5;
        f32x16 O[2][2] = {};
#pragma unroll
        for (int tb = 0; tb < 2; ++tb) {
            bf16x8 qf[4];
#pragma unroll
            for (int cc = 0; cc < 4; ++cc) qf[cc] = *(const LAS bf16x8*)(qe + (32 * tb + r32) * 72 + 16 * cc + 8 * hi);
#pragma unroll
            for (int vb = 0; vb < 2; ++vb)
#pragma unroll
                for (int cc = 0; cc < 4; ++cc) {
                    const bf16x8 a = *(const LAS bf16x8*)(sT + (32 * vb + r32) * 72 + 16 * cc + 8 * hi);
                    O[vb][tb] = mfma32(a, qf[cc], O[vb][tb]);
                }
#pragma unroll
            for (int sb = 0; sb <= tb; ++sb) {
                f32x16 sc = {};
#pragma unroll
                for (int cc = 0; cc < 4; ++cc) {
                    const bf16x8 a = *(const LAS bf16x8*)(ke + (32 * sb + r32) * 72 + 16 * cc + 8 * hi);
                    sc = mfma32(a, qf[cc], sc);
                }
                unsigned P[8];
#pragma unroll
                for (int j = 0; j < 8; ++j) {
                    float p0 = sc[2 * j], p1 = sc[2 * j + 1];
                    if (sb == tb) { if (crow(2 * j, hi) > r32) p0 = 0.f; if (crow(2 * j + 1, hi) > r32) p1 = 0.f; }
                    P[j] = pk2(p0, p1);
                }
#pragma unroll
                for (int vb = 0; vb < 2; ++vb)
#pragma unroll
                    for (int c2 = 0; c2 < 2; ++c2) {
                        const u32x2 a0 = *(const LAS u32x2*)(vT + (32 * vb + r32) * 72 + 32 * sb + 16 * c2 + 4 * hi);
                        const u32x2 a1 = *(const LAS u32x2*)(vT + (32 * vb + r32) * 72 + 32 * sb + 16 * c2 + 8 + 4 * hi);
                        const bf16x8 vf = as_bf16x8((u32x4){a0.x, a0.y, a1.x, a1.y});
                        const bf16x8 pf = as_bf16x8((u32x4){P[4 * c2], P[4 * c2 + 1], P[4 * c2 + 2], P[4 * c2 + 3]});
                        O[vb][tb] = mfma32(vf, pf, O[vb][tb]);
                    }
            }
        }
        LDSW();
        const float* on = inp(I_HON) + L * 64;
#pragma unroll
        for (int tb = 0; tb < 2; ++tb) {
            float ss = 0.f;
#pragma unroll
            for (int vb = 0; vb < 2; ++vb)
#pragma unroll
                for (int r = 0; r < 16; ++r) ss += O[vb][tb][r] * O[vb][tb][r];
            ss += __shfl_xor(ss, 32);
            const float rn = rsqrtf(ss * (1.0f / 64.0f) + EPS);
#pragma unroll
            for (int vb = 0; vb < 2; ++vb)
#pragma unroll
                for (int r = 0; r < 16; ++r) { const int v = 32 * vb + crow(r, hi); ke[(32 * tb + r32) * 72 + v] = f2bf(O[vb][tb][r] * rn * on[v]); }
        }
        LDSW();
        bf16_t* mixed = (bf16_t*)(ws + WS_MIX) + row0 * DM + 640 + 64 * h;
#pragma unroll
        for (int i = 0; i < 8; ++i) {
            const int t = i * 8 + (lane >> 3), ch = lane & 7;
            const u32x4 ov = *(const LAS u32x4*)(ke + t * 72 + 8 * ch);
            const u32x4 gv = *(const u32x4*)(z + (size_t)t * ZW + C_HG + 64 * h + 8 * ch);
            u32x4 w;
            { const float g0 = bflo(gv.x), g1 = bfhi(gv.x); w.x = pk2(bflo(ov.x) * g0 * sigmoidf_(g0), bfhi(ov.x) * g1 * sigmoidf_(g1)); }
            { const float g0 = bflo(gv.y), g1 = bfhi(gv.y); w.y = pk2(bflo(ov.y) * g0 * sigmoidf_(g0), bfhi(ov.y) * g1 * sigmoidf_(g1)); }
            { const float g0 = bflo(gv.z), g1 = bfhi(gv.z); w.z = pk2(bflo(ov.z) * g0 * sigmoidf_(g0), bfhi(ov.z) * g1 * sigmoidf_(g1)); }
            { const float g0 = bflo(gv.w), g1 = bfhi(gv.w); w.w = pk2(bflo(ov.w) * g0 * sigmoidf_(g0), bfhi(ov.w) * g1 * sigmoidf_(g1)); }
            *(u32x4*)(mixed + (size_t)t * DM + 8 * ch) = w;
        }
    }
}

constexpr int ATT_K = 0, ATT_V = 18432, ATT_LUT = 35840, ATT_STAGE = 36864;
__device__ __forceinline__ void build_lut(LAS float* lut, const float* rel_bias, int head) {
    const int d = TID();
    if (d <= 128) {
        int bk = d;
        if (d >= 16) { const int far = 16 + (int)(__logf((float)d * (1.0f / 16.0f)) / 2.0794415416798357f * 16.0f); bk = far < 31 ? far : 31; }
        lut[d] = rel_bias[bk * 10 + head] * LOG2E;
    }
}
template <int NMAP, bool HAS_SEL, bool FAST>
__device__ __forceinline__ void attn_tile(const LAS unsigned char* Kb, const LAS unsigned char* Vb, const bf16x8 (&qr)[4], int tq, int k0, int win, float c31, const LAS float* lut, bool sel,
                                          f32x16 (&O)[NMAP][2], float (&l)[NMAP], int r32, int hi) {
    unsigned P[NMAP][2][8];
#pragma unroll
    for (int kh2 = 0; kh2 < 2; ++kh2) {
        f32x16 S[NMAP];
        const float ini = FAST ? ((HAS_SEL && !sel) ? -30000.f : c31) : 0.f;
#pragma unroll
        for (int mp = 0; mp < NMAP; ++mp)
#pragma unroll
            for (int r = 0; r < 16; ++r) S[mp][r] = ini;
#pragma unroll
        for (int c = 0; c < 4; ++c) {
            const bf16x8 kf = *(const LAS bf16x8*)(Kb + (32 * kh2 + r32) * 144 + (16 * c + 8 * hi) * 2);
            const int mp = (NMAP == 2) ? (c >> 1) : 0;
            S[mp] = mfma32(kf, qr[c], S[mp]);
        }
#pragma unroll
        for (int mp = 0; mp < NMAP; ++mp) {
            float p[16];
            if (FAST) {
#pragma unroll
                for (int r = 0; r < 16; ++r) p[r] = ex2(S[mp][r]);
            } else {
#pragma unroll
                for (int r = 0; r < 16; ++r) {
                    const int d = tq - (k0 + 32 * kh2 + crow(r, hi));
                    const bool valid = sel && d >= 0 && d < win;
                    const int dc = d < 0 ? 0 : (d > 128 ? 128 : d);
                    const float e = ex2(S[mp][r] + lut[dc]);
                    p[r] = valid ? e : 0.f;
                }
            }
            float s = 0.f;
#pragma unroll
            for (int r = 0; r < 16; ++r) s += p[r];
            l[mp] += s;
#pragma unroll
            for (int j = 0; j < 8; ++j) P[mp][kh2][j] = pk2(p[2 * j], p[2 * j + 1]);
        }
        if (NMAP == 2) __builtin_amdgcn_sched_barrier(0);
    }
#pragma unroll
    for (int cc = 0; cc < 4; ++cc)
#pragma unroll
        for (int db = 0; db < 2; ++db) {
            const u32x2 a0 = *(const LAS u32x2*)(Vb + (32 * db + r32) * 136 + (16 * cc + 4 * hi) * 2);
            const u32x2 a1 = *(const LAS u32x2*)(Vb + (32 * db + r32) * 136 + (16 * cc + 8 + 4 * hi) * 2);
            const bf16x8 vf = as_bf16x8((u32x4){a0.x, a0.y, a1.x, a1.y});
#pragma unroll
            for (int mp = 0; mp < NMAP; ++mp) {
                const bf16x8 pf = as_bf16x8((u32x4){P[mp][cc >> 1][4 * (cc & 1)], P[mp][cc >> 1][4 * (cc & 1) + 1], P[mp][cc >> 1][4 * (cc & 1) + 2], P[mp][cc >> 1][4 * (cc & 1) + 3]});
                O[mp][db] = mfma32(vf, pf, O[mp][db]);
            }
        }
}
template <int NMAP, bool HAS_SEL>
__device__ __forceinline__ void attn_pass(LAS unsigned char* lds, const bf16_t* Kth, size_t kts, const bf16_t* Vth, int m_lo, int m_hi,
                                          const bf16x8 (&qr)[4], int tq, int qw0, int win, const LAS float* lut, u32x4 selw,
                                          f32x16 (&O)[NMAP][2], float (&l)[NMAP]) {
    const int tid = TID(), lane = tid & 63, r32 = lane & 31, hi = lane >> 5;
    const float c31 = lut[128];
    u32x4 kreg = *(const u32x4*)(Kth + (size_t)m_lo * kts), vreg = *(const u32x4*)(Vth + (size_t)m_lo * 64);
    int buf = 0;
    for (int m = m_lo; m <= m_hi; ++m) {
        *(LAS u32x4*)(lds + ATT_K + buf * 9216 + (tid >> 3) * 144 + (tid & 7) * 16) = kreg;
        { LAS u32x2* vp = (LAS u32x2*)(lds + ATT_V + buf * 8704 + (tid >> 3) * 136 + (tid & 7) * 16); vp[0] = (u32x2){vreg.x, vreg.y}; vp[1] = (u32x2){vreg.z, vreg.w}; }
        __syncthreads();
        if (m < m_hi) { kreg = *(const u32x4*)(Kth + (size_t)(m + 1) * kts); vreg = *(const u32x4*)(Vth + (size_t)(m + 1) * 64); }
        const int k0 = 64 * m, dmin = qw0 - (k0 + 63), dmax = qw0 + 31 - k0;
        bool sel = true;
        if (HAS_SEL) { const unsigned w = m < 32 ? selw.x : (m < 64 ? selw.y : (m < 96 ? selw.z : selw.w)); sel = (w >> (m & 31)) & 1u; }
        bool active = dmax >= 0 && dmin < win;
        if (HAS_SEL) active = active && (__any(sel) != 0);
        if (active) {
            if (NMAP == 1) {
                const LAS unsigned char* Kb = lds + ATT_K + buf * 9216;
                const LAS unsigned char* Vb = lds + ATT_V + buf * 8704;
                if (dmin >= 128 && dmax < win) attn_tile<NMAP, HAS_SEL, true>(Kb, Vb, qr, tq, k0, win, c31, lut, sel, O, l, r32, hi);
                else attn_tile<NMAP, HAS_SEL, false>(Kb, Vb, qr, tq, k0, win, c31, lut, sel, O, l, r32, hi);
            } else {
            const bool fast = dmin >= 128 && dmax < win;
            const LAS unsigned char* Kb = lds + ATT_K + buf * 9216;
            const LAS unsigned char* Vb = lds + ATT_V + buf * 8704;
            unsigned P[NMAP][2][8];
#pragma unroll
            for (int kh2 = 0; kh2 < 2; ++kh2) {
                f32x16 S[NMAP];
#pragma unroll
                for (int mp = 0; mp < NMAP; ++mp) { const float ini = fast ? c31 : 0.f;
#pragma unroll
                    for (int r = 0; r < 16; ++r) S[mp][r] = ini; }
#pragma unroll
                for (int c = 0; c < 4; ++c) {
                    const bf16x8 kf = *(const LAS bf16x8*)(Kb + (32 * kh2 + r32) * 144 + (16 * c + 8 * hi) * 2);
                    const int mp = (NMAP == 2) ? (c >> 1) : 0;
                    S[mp] = mfma32(kf, qr[c], S[mp]);
                }
#pragma unroll
                for (int mp = 0; mp < NMAP; ++mp) {
                    float p[16];
                    if (fast) {
#pragma unroll
                        for (int r = 0; r < 16; ++r) { const float e = ex2(S[mp][r]); p[r] = sel ? e : 0.f; }
                    } else {
#pragma unroll
                        for (int r = 0; r < 16; ++r) {
                            const int d = tq - (k0 + 32 * kh2 + crow(r, hi));
                            const bool valid = sel && d >= 0 && d < win;
                            const int dc = d < 0 ? 0 : (d > 128 ? 128 : d);
                            const float e = ex2(S[mp][r] + lut[dc]);
                            p[r] = valid ? e : 0.f;
                        }
                    }
                    float s = 0.f;
#pragma unroll
                    for (int r = 0; r < 16; ++r) s += p[r];
                    l[mp] += s;
#pragma unroll
                    for (int j = 0; j < 8; ++j) P[mp][kh2][j] = pk2(p[2 * j], p[2 * j + 1]);
                }
            }
#pragma unroll
            for (int db = 0; db < 2; ++db)
#pragma unroll
                for (int cc = 0; cc < 4; ++cc) {
                    const u32x2 a0 = *(const LAS u32x2*)(Vb + (32 * db + r32) * 136 + (16 * cc + 4 * hi) * 2);
                    const u32x2 a1 = *(const LAS u32x2*)(Vb + (32 * db + r32) * 136 + (16 * cc + 8 + 4 * hi) * 2);
                    const bf16x8 vf = as_bf16x8((u32x4){a0.x, a0.y, a1.x, a1.y});
#pragma unroll
                    for (int mp = 0; mp < NMAP; ++mp) {
                        const bf16x8 pf = as_bf16x8((u32x4){P[mp][cc >> 1][4 * (cc & 1)], P[mp][cc >> 1][4 * (cc & 1) + 1], P[mp][cc >> 1][4 * (cc & 1) + 2], P[mp][cc >> 1][4 * (cc & 1) + 3]});
                        O[mp][db] = mfma32(vf, pf, O[mp][db]);
                    }
                }
            }
        }
        buf ^= 1;
    }
    __syncthreads();
}
template <bool ADD>
__device__ __forceinline__ void store_ot(LAS unsigned char* stage, const float (&val)[2][16], bf16_t* dst, int ld, const bf16_t* addsrc = nullptr, int ldadd = 0) {
    const int lane = TID() & 63, r32 = lane & 31, hi = lane >> 5;
    LAS bf16_t* st = (LAS bf16_t*)stage;
#pragma unroll
    for (int db = 0; db < 2; ++db)
#pragma unroll
        for (int r = 0; r < 16; ++r) st[r32 * 72 + 32 * db + crow(r, hi)] = f2bf(val[db][r]);
    LDSW();
#pragma unroll
    for (int i = 0; i < 4; ++i) {
        const int row = i * 8 + (lane >> 3), ch = lane & 7;
        u32x4 v = *(const LAS u32x4*)(st + row * 72 + 8 * ch);
        bf16_t* gp = dst + (size_t)row * ld + 8 * ch;
        if (ADD) {
            const u32x4 o = *(const u32x4*)(addsrc + (size_t)row * ldadd + 8 * ch);
            v.x = pk2(bflo(v.x) + bflo(o.x), bfhi(v.x) + bfhi(o.x)); v.y = pk2(bflo(v.y) + bflo(o.y), bfhi(v.y) + bfhi(o.y));
            v.z = pk2(bflo(v.z) + bflo(o.z), bfhi(v.z) + bfhi(o.z)); v.w = pk2(bflo(v.w) + bflo(o.w), bfhi(v.w) + bfhi(o.w));
        }
        *(u32x4*)gp = v;
    }
    LDSW();
}

__device__ __forceinline__ void task_diff(const float* const* in, unsigned char* ws, int L, int task, LAS unsigned char* lds) {
    const int tid = TID(), lane = tid & 63, wave = tid >> 6, r32 = lane & 31, hi = lane >> 5;
    const int qb = 31 - (task >> 4), b = (task >> 2) & 3, hd = task & 3;
    const bf16_t* z = (const bf16_t*)(ws + WS_R1);
    LAS float* lut = (LAS float*)(lds + ATT_LUT);
    build_lut(lut, inp(I_RELB), 6 + hd);
    __syncthreads();
    const int q0 = 256 * qb, qw0 = q0 + 32 * wave, tq = qw0 + r32;
    bf16x8 qr[4];
#pragma unroll
    for (int c = 0; c < 4; ++c) qr[c] = *(const bf16x8*)(z + (size_t)(b * T + tq) * ZW + C_DQ + 64 * hd + 16 * c + 8 * hi);
    const bf16_t* Kth = z + (size_t)(b * T + (tid >> 3)) * ZW + C_DK + 64 * hd + (tid & 7) * 8;
    const bf16_t* Vth = (const bf16_t*)(ws + WS_VT) + ((size_t)(b * 8 + 4 + hd) * 64 + (tid >> 3)) * T + (tid & 7) * 8;
    f32x16 O[2][2] = {}; float l[2] = {0.f, 0.f};
    attn_pass<2, false>(lds, Kth, (size_t)64 * ZW, Vth, 0, 4 * qb + 3, qr, tq, qw0, 1 << 30, lut, (u32x4){0u, 0u, 0u, 0u}, O, l);
    const float* lp = inp(I_DLAM) + L * 128;
    float s01 = 0.f, s23 = 0.f;
#pragma unroll
    for (int i = 0; i < 32; ++i) { s01 += lp[i] * lp[32 + i]; s23 += lp[64 + i] * lp[96 + i]; }
    const float lam_init = 0.8f - 0.6f * __expf(-0.3f * (float)L);
    const float lam = __expf(s01) - __expf(s23) + lam_init;
    const float l0 = l[0] + __shfl_xor(l[0], 32), l1 = l[1] + __shfl_xor(l[1], 32);
    const float i0 = 1.0f / l0, i1 = lam / l1;
    float val[2][16]; float ss = 0.f;
#pragma unroll
    for (int db = 0; db < 2; ++db)
#pragma unroll
        for (int r = 0; r < 16; ++r) { const float o = O[0][db][r] * i0 - O[1][db][r] * i1; val[db][r] = o; ss += o * o; }
    ss += __shfl_xor(ss, 32);
    const float rn = rsqrtf(ss * (1.0f / 64.0f) + EPS) * (1.0f - lam_init);
    const float* sub = inp(I_DSUB) + L * 64;
#pragma unroll
    for (int db = 0; db < 2; ++db)
#pragma unroll
        for (int r = 0; r < 16; ++r) val[db][r] *= rn * sub[32 * db + crow(r, hi)];
    store_ot<false>(lds + ATT_STAGE + wave * 4608, val, (bf16_t*)(ws + WS_MIX) + (size_t)(b * T + qw0) * DM + 384 + 64 * hd, DM);
}

__device__ __forceinline__ void task_nsa_sw(const float* const* in, unsigned char* ws, int L, int task, LAS unsigned char* lds) {
    const int tid = TID(), lane = tid & 63, wave = tid >> 6, r32 = lane & 31, hi = lane >> 5;
    const int qb = 31 - task / 24, rem = task % 24, b = rem / 6, h = rem % 6, g = h / 3;
    const bf16_t* z = (const bf16_t*)(ws + WS_R1);
    LAS float* lut = (LAS float*)(lds + ATT_LUT);
    build_lut(lut, inp(I_RELB), h);
    __syncthreads();
    const int q0 = 256 * qb, qw0 = q0 + 32 * wave, tq = qw0 + r32;
    const bf16_t* zq = z + (size_t)(b * T + tq) * ZW;
    bf16x8 qr[4];
#pragma unroll
    for (int c = 0; c < 4; ++c) qr[c] = *(const bf16x8*)(zq + C_NQ + 64 * h + 16 * c + 8 * hi);
    const u32x4 selw = *(const u32x4*)((const unsigned*)(ws + WS_SELM) + ((size_t)(b * 2 + g) * T + tq) * 4);
    const float g1 = sigmoidf_(bf2f(zq[C_NG + 3 * h + 1])), g2 = sigmoidf_(bf2f(zq[C_NG + 3 * h + 2]));
    float val[2][16];
    {
        const bf16_t* Kth = z + (size_t)(b * T + (tid >> 3)) * ZW + C_SK + 64 * g + (tid & 7) * 8;
        const bf16_t* Vth = (const bf16_t*)(ws + WS_VT) + ((size_t)(b * 8 + g) * 64 + (tid >> 3)) * T + (tid & 7) * 8;
        f32x16 O[1][2] = {}; float l[1] = {0.f};
        attn_pass<1, true>(lds, Kth, (size_t)64 * ZW, Vth, 0, 4 * qb + 3, qr, tq, qw0, 1 << 30, lut, selw, O, l);
        const float lt = l[0] + __shfl_xor(l[0], 32), sc = g1 / lt;
#pragma unroll
        for (int db = 0; db < 2; ++db)
#pragma unroll
            for (int r = 0; r < 16; ++r) val[db][r] = O[0][db][r] * sc;
    }
    {
        const bf16_t* Kth = z + (size_t)(b * T + (tid >> 3)) * ZW + C_WK + 64 * g + (tid & 7) * 8;
        const bf16_t* Vth = (const bf16_t*)(ws + WS_VT) + ((size_t)(b * 8 + 2 + g) * 64 + (tid >> 3)) * T + (tid & 7) * 8;
        f32x16 O[1][2] = {}; float l[1] = {0.f};
        const int m_lo = q0 >= 512 ? (q0 >> 6) - 8 : 0;
        attn_pass<1, false>(lds, Kth, (size_t)64 * ZW, Vth, m_lo, 4 * qb + 3, qr, tq, qw0, 512, lut, (u32x4){0u, 0u, 0u, 0u}, O, l);
        const float lt = l[0] + __shfl_xor(l[0], 32), sc = g2 / lt;
#pragma unroll
        for (int db = 0; db < 2; ++db)
#pragma unroll
            for (int r = 0; r < 16; ++r) val[db][r] += O[0][db][r] * sc;
    }
    store_ot<true>(lds + ATT_STAGE + wave * 4608, val, (bf16_t*)(ws + WS_MIX) + (size_t)(b * T + qw0) * DM + 64 * h, DM, (const bf16_t*)(ws + WS_OCB) + (size_t)(b * T + qw0) * 384 + 64 * h, 384);
}

__device__ __forceinline__ unsigned wave_max_u32(unsigned v) {
    unsigned t;
    t = (unsigned)__builtin_amdgcn_update_dpp(0, (int)v, 0xB1, 0xF, 0xF, false); v = t > v ? t : v;
    t = (unsigned)__builtin_amdgcn_update_dpp(0, (int)v, 0x4E, 0xF, 0xF, false); v = t > v ? t : v;
    t = (unsigned)__builtin_amdgcn_update_dpp(0, (int)v, 0x141, 0xF, 0xF, false); v = t > v ? t : v;
    t = (unsigned)__builtin_amdgcn_update_dpp(0, (int)v, 0x140, 0xF, 0xF, false); v = t > v ? t : v;
    t = (unsigned)__builtin_amdgcn_update_dpp(0, (int)v, 0x142, 0xA, 0xF, false); v = t > v ? t : v;
    t = (unsigned)__builtin_amdgcn_update_dpp(0, (int)v, 0x143, 0xC, 0xF, false); v = t > v ? t : v;
    return (unsigned)__builtin_amdgcn_readlane((int)v, 63);
}
constexpr int NC_IMP = 18432, NC_IMPW = 129, NC_LINV = NC_IMP + 3 * 64 * NC_IMPW * 4;
__device__ __forceinline__ void task_nsa_c(const float* const* in, unsigned char* ws, int L, int task, LAS unsigned char* lds) {
    const int tid = TID(), lane = tid & 63, wave = tid >> 6, r32 = lane & 31, hi = lane >> 5;
    const int cur = 127 - (task >> 3), b = (task >> 1) & 3, g = task & 1;
    const bf16_t* z = (const bf16_t*)(ws + WS_R1);
    LAS float* imp = (LAS float*)(lds + NC_IMP);
    LAS float* linv = (LAS float*)(lds + NC_LINV);
    const int q0 = 64 * cur;
    const int rh = wave >> 1, half = wave & 1, h = 3 * g + (rh < 3 ? rh : 0);
    const int ql = 32 * half + r32, tq = q0 + ql;
    const bf16_t* zq = z + (size_t)(b * T + tq) * ZW;
    bf16x8 qr[4];
#pragma unroll
    for (int c = 0; c < 4; ++c) qr[c] = *(const bf16x8*)(zq + C_NQ + 64 * h + 16 * c + 8 * hi);
    const bf16_t* Kth = (const bf16_t*)(ws + WS_KC) + ((size_t)(b * 2 + g) * 512 + (tid >> 3)) * 64 + (tid & 7) * 8;
    const bf16_t* Vth = (const bf16_t*)(ws + WS_VCT) + ((size_t)(b * 2 + g) * 64 + (tid >> 3)) * 512 + (tid & 7) * 8;
    const int ntiles = ((4 * cur + 2) >> 6) + 1;
    f32x16 O[2] = {}; float l = 0.f, carry = 0.f;
    u32x4 kreg = *(const u32x4*)(Kth), vreg = *(const u32x4*)(Vth);
    for (int m = 0; m < ntiles; ++m) {
        __syncthreads();
        *(LAS u32x4*)(lds + (tid >> 3) * 144 + (tid & 7) * 16) = kreg;
        { LAS u32x2* vp = (LAS u32x2*)(lds + 9216 + (tid >> 3) * 136 + (tid & 7) * 16); vp[0] = (u32x2){vreg.x, vreg.y}; vp[1] = (u32x2){vreg.z, vreg.w}; }
        __syncthreads();
        if (m + 1 < ntiles) { kreg = *(const u32x4*)(Kth + (size_t)(m + 1) * 64 * 64); vreg = *(const u32x4*)(Vth + (size_t)(m + 1) * 64); }
        if (wave < 6) {
            unsigned P[2][8]; float av[8], bq[8];
#pragma unroll
            for (int kh2 = 0; kh2 < 2; ++kh2) {
                f32x16 S = {};
#pragma unroll
                for (int c = 0; c < 4; ++c) { const bf16x8 kf = *(const LAS bf16x8*)(lds + (32 * kh2 + r32) * 144 + (16 * c + 8 * hi) * 2); S = mfma32(kf, qr[c], S); }
                float p[16];
#pragma unroll
                for (int r = 0; r < 16; ++r) { const int n = 64 * m + 32 * kh2 + crow(r, hi); const float e = ex2(S[r]); p[r] = (16 * n + 31 <= tq) ? e : 0.f; }
                float s = 0.f;
#pragma unroll
                for (int r = 0; r < 16; ++r) s += p[r];
                l += s;
#pragma unroll
                for (int j = 0; j < 8; ++j) P[kh2][j] = pk2(p[2 * j], p[2 * j + 1]);
#pragma unroll
                for (int j = 0; j < 4; ++j) { av[4 * kh2 + j] = p[4 * j] + p[4 * j + 1] + p[4 * j + 2] + 0.5f * p[4 * j + 3]; bq[4 * kh2 + j] = 0.5f * p[4 * j + 3]; }
            }
#pragma unroll
            for (int db = 0; db < 2; ++db)
#pragma unroll
                for (int cc = 0; cc < 4; ++cc) {
                    const u32x2 a0 = *(const LAS u32x2*)(lds + 9216 + (32 * db + r32) * 136 + (16 * cc + 4 * hi) * 2);
                    const u32x2 a1 = *(const LAS u32x2*)(lds + 9216 + (32 * db + r32) * 136 + (16 * cc + 8 + 4 * hi) * 2);
                    const bf16x8 vf = as_bf16x8((u32x4){a0.x, a0.y, a1.x, a1.y});
                    const bf16x8 pf = as_bf16x8((u32x4){P[cc >> 1][4 * (cc & 1)], P[cc >> 1][4 * (cc & 1) + 1], P[cc >> 1][4 * (cc & 1) + 2], P[cc >> 1][4 * (cc & 1) + 3]});
                    O[db] = mfma32(vf, pf, O[db]);
                }
            float recv[8];
#pragma unroll
            for (int jj = 0; jj < 8; ++jj) { auto rr = __builtin_amdgcn_permlane32_swap(__float_as_uint(bq[jj]), __float_as_uint(bq[jj]), false, false); recv[jj] = __uint_as_float(hi ? rr[0] : rr[1]); }
            LAS float* ip = imp + (rh * 64 + ql) * NC_IMPW + 16 * m + hi;
#pragma unroll
            for (int jj = 0; jj < 8; ++jj) {
                const float add = hi ? recv[jj] : (jj == 0 ? carry : recv[jj > 0 ? jj - 1 : 0]);
                ip[2 * jj] = av[jj] + add;
            }
            carry = recv[7];
        }
    }
    if (wave < 6) {
        const float lt = l + __shfl_xor(l, 32);
        const float li = (tq >= 31 && lt > 0.f) ? 1.0f / lt : 0.f;
        if (hi == 0) linv[rh * 64 + ql] = li;
        const float g0 = sigmoidf_(bf2f(zq[C_NG + 3 * h + 0]));
        bf16_t* mx = (bf16_t*)(ws + WS_OCB) + (size_t)(b * T + tq) * 384 + 64 * h;
        const float sc = li * g0;
#pragma unroll
        for (int db = 0; db < 2; ++db)
#pragma unroll
            for (int r = 0; r < 16; ++r) mx[32 * db + crow(r, hi)] = f2bf(O[db][r] * sc);
    }
    __syncthreads();
#pragma unroll 1
    for (int qi = 0; qi < 8; ++qi) {
        const int q = 8 * wave + qi;
        unsigned w0 = 0u, w1 = 0u, w2 = 0u, w3 = 0u;
        if (cur <= 15) { w0 = (1u << (cur + 1)) - 1u; }
        else {
            const float i0 = linv[q], i1 = linv[64 + q], i2 = linv[128 + q];
            const int ma = lane, mb = lane + 64;
            float va = 0.f, vb = 0.f;
            if (ma >= 1 && ma <= cur - 2) va = imp[(0 * 64 + q) * NC_IMPW + ma] * i0 + imp[(1 * 64 + q) * NC_IMPW + ma] * i1 + imp[(2 * 64 + q) * NC_IMPW + ma] * i2;
            if (mb <= cur - 2) vb = imp[(0 * 64 + q) * NC_IMPW + mb] * i0 + imp[(1 * 64 + q) * NC_IMPW + mb] * i1 + imp[(2 * 64 + q) * NC_IMPW + mb] * i2;
            unsigned ka = va > 0.f ? ((__float_as_uint(va) & ~127u) | (unsigned)(127 - ma)) : 0u;
            unsigned kb = vb > 0.f ? ((__float_as_uint(vb) & ~127u) | (unsigned)(127 - mb)) : 0u;
            w0 = 1u;
#pragma unroll 1
            for (int it = 0; it < 13; ++it) {
                const unsigned best = wave_max_u32(ka > kb ? ka : kb);
                if (best != 0u) {
                    const int mw = 127 - (int)(best & 127u);
                    const unsigned bit = 1u << (mw & 31);
                    if (mw < 32) w0 |= bit; else if (mw < 64) w1 |= bit; else if (mw < 96) w2 |= bit; else w3 |= bit;
                    if (ka == best) ka = 0u;
                    if (kb == best) kb = 0u;
                }
            }
#pragma unroll
            for (int f = 0; f < 2; ++f) {
                const int mw = cur - f; const unsigned bit = 1u << (mw & 31);
                if (mw < 32) w0 |= bit; else if (mw < 64) w1 |= bit; else if (mw < 96) w2 |= bit; else w3 |= bit;
            }
        }
        if (lane == 0) *(u32x4*)((unsigned*)(ws + WS_SELM) + ((size_t)(b * 2 + g) * T + q0 + q) * 4) = (u32x4){w0, w1, w2, w3};
    }
}

#define XB_TMO      128
#define XB_XCNT(j)  (256  + 64 * (j))
#define XB_XSUB(j)  (1280 + 64 * (j))
#define XB_XGEN(j)  (2304 + 64 * (j))
#define XB_TOP      3328
#define XB_TOPGEN   3392
#define XCD_BAR_WORDS 3456
#define XB_SPIN_CAP (1u << 18)

__device__ __forceinline__ unsigned xb_ld(unsigned* p)              { return __hip_atomic_load(p, __ATOMIC_RELAXED, __HIP_MEMORY_SCOPE_AGENT); }
__device__ __forceinline__ unsigned xb_add(unsigned* p, unsigned v) { return __hip_atomic_fetch_add(p, v, __ATOMIC_RELAXED, __HIP_MEMORY_SCOPE_AGENT); }
__device__ __forceinline__ unsigned xb_xcc_id() { return (unsigned)__builtin_amdgcn_s_getreg((3 << 11) | 20) & 0xFu; }
#define XB_SPIN(cond, bar) do { unsigned _sp = 0; while (cond) { __builtin_amdgcn_s_sleep(1); \
    if ((++_sp & 255u) == 0u) { if (xb_ld(&(bar)[XB_TMO])) break; if (_sp > XB_SPIN_CAP) { atomicAdd(&(bar)[XB_TMO], 1u); break; } } } } while (0)

struct XcdBarrier {
    unsigned* bar; unsigned x;
    volatile LAS unsigned* st;
};

__device__ __forceinline__ XcdBarrier xcd_barrier_post(unsigned* bar, volatile LAS unsigned* st) {
    XcdBarrier b; b.bar = bar; b.x = xb_xcc_id(); b.st = st;
    if (threadIdx.x == 0) (void)xb_add(&bar[XB_XCNT(b.x)], 1u);
    return b;
}
__device__ __forceinline__ void xcd_barrier_complete(unsigned* bar, unsigned x, unsigned& nloc, unsigned& nx) {
    const unsigned G = gridDim.x * gridDim.y * gridDim.z;
    unsigned sum, cnt, mine, sp = 0u;
    for (;;) {
        sum = 0u; cnt = 0u; mine = 0u;
#pragma unroll
        for (unsigned j = 0; j < 16; ++j) { const unsigned c = xb_ld(&bar[XB_XCNT(j)]); sum += c; cnt += (c > 0u) ? 1u : 0u; mine = (j == x) ? c : mine; }
        if (sum == G) break;
        __builtin_amdgcn_s_sleep(1);
        if ((++sp & 255u) == 0u) { if (xb_ld(&bar[XB_TMO])) break; if (sp > XB_SPIN_CAP) { atomicAdd(&bar[XB_TMO], 1u); break; } }
    }
    nloc = mine > 0u ? mine : 1u; nx = cnt > 0u ? cnt : 1u;
}

__device__ __forceinline__ void xcd_barrier(const XcdBarrier& b) {
    asm volatile("s_waitcnt vmcnt(0)" ::: "memory");
    __syncthreads();
    if (threadIdx.x == 0) {
        unsigned* bar = b.bar;
        __builtin_amdgcn_s_waitcnt(0);
        unsigned nloc = b.st[0], nx = b.st[1];
        if (nloc == 0u) { xcd_barrier_complete(bar, b.x, nloc, nx); b.st[0] = nloc; b.st[1] = nx; }
        const unsigned old = xb_add(&bar[XB_XSUB(b.x)], 1u);
        const unsigned gen = old / nloc;
        if (old + 1u == (gen + 1u) * nloc) {
            __builtin_amdgcn_fence(__ATOMIC_RELEASE, "agent");
            asm volatile("s_waitcnt vmcnt(0)" ::: "memory");
            const unsigned og = xb_add(&bar[XB_TOP], 1u);
            const unsigned tg = og / nx;
            if (og + 1u == (tg + 1u) * nx) xb_add(&bar[XB_TOPGEN], 1u);
            else XB_SPIN(xb_ld(&bar[XB_TOPGEN]) == tg, bar);
            __builtin_amdgcn_fence(__ATOMIC_ACQUIRE, "agent");
            xb_add(&bar[XB_XGEN(b.x)], 1u);
            asm volatile("s_waitcnt vmcnt(0)" ::: "memory");
        } else {
            XB_SPIN(xb_ld(&bar[XB_XGEN(b.x)]) == gen, bar);
            __builtin_amdgcn_fence(__ATOMIC_ACQUIRE, "agent");
            asm volatile("s_waitcnt vmcnt(0)" ::: "memory");
        }
    }
    __syncthreads();
}

struct Args { const float* in[N_IN]; float* out; unsigned char* ws; int ph_lo, ph_hi; };
static_assert(sizeof(Args) == 8 * N_IN + 24, "Args has no padding");
constexpr int PH_PER_LAYER = 12, N_PHASES = DEPTH * PH_PER_LAYER;
#ifndef PH_HI
#ifdef REPJ
#define PH_HI (N_PHASES + DEPTH)
#else
#define PH_HI N_PHASES
#endif
#endif

__global__ void __launch_bounds__(512) mega(Args a) {
    extern __shared__ __attribute__((aligned(16))) unsigned char lds_raw[];
    LAS unsigned char* lds = (LAS unsigned char*)lds_raw;
    LAS int* slot = (LAS int*)(lds + LDS_MISC);
    cg::grid_group grid = cg::this_grid();
    const float* const* in = nullptr;
    volatile LAS unsigned* misc = (volatile LAS unsigned*)(lds + LDS_MISC);
    if (TID() < 16) misc[TID()] = 0u;
    __syncthreads();
    (void)xcd_barrier_post((unsigned*)(a.ws + WS_CTL) + 4096, misc + 8);
#ifndef DUP_GU
#define DUP_GU 0
#endif
#ifndef DUP_IN
#define DUP_IN 0
#endif
#ifndef DUP_DIFF
#define DUP_DIFF 0
#endif
#ifndef DUP_NSAC
#define DUP_NSAC 0
#endif
#ifndef DUP_SW
#define DUP_SW 0
#endif
#ifndef DUP_HOUT
#define DUP_HOUT 0
#endif
#ifndef DUP_M1
#define DUP_M1 0
#endif
#ifndef DUP_SYNC
#define DUP_SYNC 0
#endif
#ifndef DUP_CONV
#define DUP_CONV 0
#endif
#ifndef PHM
#define PHM 0xfff
#endif
    for (int ph = a.ph_lo; ph < a.ph_hi; ++ph) {
#ifdef REPJ
        int L = ph / (PH_PER_LAYER + 1); const int k_ = ph - L * (PH_PER_LAYER + 1); const int j = k_ <= REPJ ? k_ : k_ - 1; const float amul = (k_ == REPJ) ? 0.f : 1.f;
#else
        int L = ph / PH_PER_LAYER; const int j = ph - L * PH_PER_LAYER; const float amul = 1.f;
#endif
        asm volatile("" : "+s"(L));
        unsigned long long ws_ = (unsigned long long)a.ws; asm volatile("" : "+s"(ws_)); unsigned char* ws = (unsigned char*)(GAS unsigned char*)ws_;
        unsigned long long out_ = (unsigned long long)a.out; asm volatile("" : "+s"(out_)); float* out_g = (float*)(GAS float*)out_;
        unsigned* ctl = (unsigned*)(ws + WS_CTL); bf16_t* r1 = (bf16_t*)(ws + WS_R1); bf16_t* mixed = (bf16_t*)(ws + WS_MIX); bf16_t* pb = (bf16_t*)(ws + WS_PB); unsigned char* wb = ws + WS_W; float* rsqp = (float*)(ws + WS_RSQP);
        float* rsq = (float*)(ws + ((L & 1) ? WS_RSQ1 : WS_RSQ0)); float* rsq_next = (float*)(ws + ((L & 1) ? WS_RSQ0 : WS_RSQ1));
        bf16_t* xb = (bf16_t*)(ws + ((L & 1) ? WS_XB1 : WS_XB)); bf16_t* xb_next = (bf16_t*)(ws + ((L & 1) ? WS_XB : WS_XB1));
        if ((PHM >> j) & 1) switch (j) {
        case 0: phase_convert(in, ws, out_g, L, lds); if (DUP_CONV) { __syncthreads(); phase_convert(in, ws, out_g, L, lds); } break;
        case 1: { EpiSwiGLU E{r1, {}}; run_gemm(lds, xb, (const bf16_t*)(wb + W_GU1), 2 * FF, DM, E, rsq); } break;
        case 2: { EpiRes<0> E{out_g, xb, rsq, 0.5f * amul, nullptr, nullptr, nullptr, nullptr, nullptr, {}}; run_gemm(lds, r1, (const bf16_t*)(wb + W_D1), DM, FF, E); } break;
        case 3: { EpiZ E{r1, {}}; run_gemm(lds, xb, (const bf16_t*)(wb + W_IN), ZW, DM, E, rsq); } break;
        case 4: {
            unsigned* ctr = ctl + (L * 4 + 0) * 64;
            constexpr int NCMP = 512 << DUP_M1, NHL = 512 << DUP_M1;
            for (;;) { const int t = next_task(ctr, slot); if (t >= NCMP + NHL + 512) break;
                if (t < NCMP) task_compress(in, ws, L, t >> DUP_M1, lds); else if (t < NCMP + NHL) task_hgrn_local(in, ws, L, (t - NCMP) >> DUP_M1, lds); else task_prep(in, ws, L, t - NCMP - NHL, lds); }
        } break;
        case 5: {
            unsigned* ctr = ctl + (L * 4 + 1) * 64;
            constexpr int ND = 512 << DUP_DIFF, NC = 1024 << DUP_NSAC;
            for (;;) { const int t = next_task(ctr, slot); if (t >= 192 + ND + NC) break;
                if (t < 192) task_hgrn_scan(ws, t); else if (t < 192 + ND) task_diff(in, ws, L, (t - 192) >> DUP_DIFF, lds); else task_nsa_c(in, ws, L, (t - 192 - ND) >> DUP_NSAC, lds); }
        } break;
        case 6: {
            unsigned* ctr = ctl + (L * 4 + 2) * 64;
            constexpr int NS = 768 << DUP_SW, NH = 1024 << DUP_HOUT;
            for (;;) { const int t = next_task(ctr, slot); if (t >= NS + NH) break;
                if (t < NS) task_nsa_sw(in, ws, L, t >> DUP_SW, lds); else task_hgrn_out(in, ws, L, (t - NS) >> DUP_HOUT, lds); }
        } break;
        case 7: { EpiRes<0> E{out_g, xb, rsq, 1.0f * amul, nullptr, nullptr, nullptr, nullptr, nullptr, {}}; run_gemm(lds, mixed, (const bf16_t*)(wb + W_OUT), DM, DM, E); } break;
        case 8: { EpiSwiGLU E{r1, {}}; run_gemm(lds, xb, (const bf16_t*)(wb + W_GU2), 2 * FF, DM, E, rsq); } break;
        case 9: { EpiRes<2> E{nullptr, nullptr, rsqp, 0.f, nullptr, nullptr, nullptr, nullptr, mixed, {}}; run_gemm(lds, pb, (const bf16_t*)(wb + W_PP), DM, PLE, E); } break;
        case 10: { EpiRes<0> E{out_g, xb, rsq, 0.5f * amul, nullptr, nullptr, nullptr, nullptr, nullptr, {}}; run_gemm(lds, r1, (const bf16_t*)(wb + W_D2), DM, FF, E); } break;
        default: { EpiRes<1> E{out_g, xb_next, rsq_next, 0.f, rsq, mixed, rsqp, inp(I_PLPOST) + L * DM, nullptr, {}}; run_gemm(lds, xb, (const bf16_t*)(wb + W_PG), DM, DM, E, rsq, rsqp); } break;
        }
        if (ph + 1 < a.ph_hi) {
            if (ph == 0) { asm volatile("s_waitcnt vmcnt(0) lgkmcnt(0)" ::: "memory"); grid.sync(); __builtin_amdgcn_fence(__ATOMIC_ACQUIRE, "agent"); asm volatile("s_waitcnt vmcnt(0)" ::: "memory"); __syncthreads(); }
            else { XcdBarrier xb_; xb_.bar = (unsigned*)(ws + WS_CTL) + 4096; xb_.x = xb_xcc_id(); xb_.st = misc + 8; xcd_barrier(xb_); if (DUP_SYNC) xcd_barrier(xb_); }
        }
    }
}

#ifdef DUMPK
__global__ void __launch_bounds__(512) dump_kernel(float* out, unsigned char* ws) {
    bf16_t* mixed = (bf16_t*)(ws + WS_MIX); (void)mixed;
    for (size_t idx = (size_t)blockIdx.x * 512 + threadIdx.x; idx < (size_t)M * 1024; idx += (size_t)gridDim.x * 512) {
        const size_t m = idx >> 10; const int c = (int)(idx & 1023);
        float v = 0.f;
#if DUMPK == 3 || DUMPK == 40
        { const bf16_t* z = (const bf16_t*)(ws + WS_R1); v = bf2f(z[m * ZW + c]) + bf2f(z[m * ZW + 1024 + c]) + bf2f(z[m * ZW + 2048 + c]) + (c < 402 ? bf2f(z[m * ZW + 3072 + c]) : 0.f); }
#elif DUMPK == 41
        { const bf16_t* vt = (const bf16_t*)(ws + WS_VT); v = bf2f(vt[m * 512 + (c & 511)]); }
#elif DUMPK == 42
        { const float* hs = (const float*)(ws + WS_HS); const float* hd = (const float*)(ws + WS_HD); v = hs[m * 384 + (c % 384)] + hd[m * 6 + (c % 6)]; }
#elif DUMPK == 43
        { const bf16_t* kc = (const bf16_t*)(ws + WS_KC); const bf16_t* vct = (const bf16_t*)(ws + WS_VCT); v = bf2f(kc[m * 8 + (c & 7)]) + bf2f(vct[m * 8 + (c & 7)]); }
#elif DUMPK == 50 || DUMPK == 60
        v = (c < 384) ? bf2f(mixed[m * 1024 + c]) : 0.f;
#elif DUMPK == 51
        v = (c >= 384 && c < 640) ? bf2f(mixed[m * 1024 + c]) : 0.f;
#elif DUMPK == 52
        { const unsigned* selm = (const unsigned*)(ws + WS_SELM); v = (float)(selm[m * 8 + (c & 7)] & 0xffffu) + (float)(selm[m * 8 + (c & 7)] >> 16); }
#elif DUMPK == 53
        { const float* hs = (const float*)(ws + WS_HS); v = hs[m * 384 + (c % 384)]; }
#elif DUMPK == 61
        v = (c >= 640) ? bf2f(mixed[m * 1024 + c]) : 0.f;
#endif
        out[idx] = v;
    }
}
#endif

extern "C" void kernel_launch(void* const* d_in, const int* in_sizes, int n_in, void* d_out, int out_size, void* d_ws, size_t ws_size, hipStream_t stream) {
    static int grid = 0;
    if (grid == 0) {
        if (n_in != N_IN || out_size != M * DM || ws_size < WS_END) { fprintf(stderr, "kernel_launch: unexpected shapes (n_in %d out %d ws %zu)\n", n_in, out_size, ws_size); grid = -1; return; }
        int dev = 0, cus = 0, per_cu = 0;
        hipGetDevice(&dev); hipDeviceGetAttribute(&cus, hipDeviceAttributeMultiprocessorCount, dev);
        if (hipFuncSetAttribute((const void*)mega, hipFuncAttributeMaxDynamicSharedMemorySize, LDS_BYTES) != hipSuccess) { fprintf(stderr, "hipFuncSetAttribute failed\n"); }
        if (hipOccupancyMaxActiveBlocksPerMultiprocessor(&per_cu, (const void*)mega, 512, LDS_BYTES) != hipSuccess || per_cu < 1) { fprintf(stderr, "occupancy query: %d\n", per_cu); per_cu = 1; }
        (void)hipGetLastError();
        grid = cus;
    }
    if (grid < 0) return;
    hipMemsetAsync((char*)d_ws + WS_CTL, 0, 64 * 1024, stream);
    Args a{};
    for (int i = 0; i < N_IN; ++i) a.in[i] = (const float*)d_in[i];
    a.out = (float*)d_out; a.ws = (unsigned char*)d_ws; a.ph_lo = 0; a.ph_hi = PH_HI;
    void* args[] = {&a};
    hipError_t e = hipLaunchCooperativeKernel((const void*)mega, dim3(grid), dim3(512), args, LDS_BYTES, stream);
    if (e != hipSuccess) fprintf(stderr, "cooperative launch failed: %s (grid %d)\n", hipGetErrorString(e), grid);
#ifdef DUMPK
    dump_kernel<<<dim3(1024), dim3(512), 0, stream>>>((float*)d_out, (unsigned char*)d_ws);
#endif
}
```

```cpp
#include <hip/hip_runtime.h>
#include <hip/hip_cooperative_groups.h>
#include <cstdio>
#include <cstdint>
namespace cg = cooperative_groups;
__device__ __forceinline__ int TID() { int t = threadIdx.x; asm volatile("" : "+v"(t)); return t; }
typedef float f32x4_z __attribute__((ext_vector_type(4)));
__device__ __forceinline__ f32x4_z zero4_() { float z = 0.f; asm volatile("" : "+v"(z)); return (f32x4_z){z, z, z, z}; }
namespace pg8 {
#define PG8_LAS __attribute__((address_space(3)))
typedef unsigned short bf16_t;
typedef short bf16x8 __attribute__((ext_vector_type(8)));
typedef float f32x4 __attribute__((ext_vector_type(4)));
typedef unsigned u32x4 __attribute__((ext_vector_type(4)));
constexpr int BM = 256, BK = 64, HALF = 128, HTB = HALF * BK * 2  , STAGE_BYTES = 8 * HTB, NXCD = 8, WGM = 8;

__host__ __device__ __forceinline__ int lds_byte(int r, int c) { const int st = (r >> 4) * 2 + (c >> 5), rr = r & 15, cc = c & 31, ob = rr * 64 + cc * 2; return st * 1024 + (ob ^ (((ob >> 9) & 1) << 5)); }
__host__ __device__ __forceinline__ void stage_rc(int b, int& R, int& C) { const int st = b / 1024, sb = b % 1024, swz = sb ^ (((sb >> 9) & 1) << 5); R = (st >> 1) * 16 + swz / 64; C = (st & 1) * 32 + (swz % 64) / 2; }
__host__ __device__ __forceinline__ int perm32(int rho) { const int n = rho >> 4, i = rho & 15; return 8 * (i >> 2) + 4 * n + (i & 3); }

struct Unit { int pm, pn; };
struct Gemm { const bf16_t* A; const bf16_t* Bt; int M, N, K; };

struct StaticOrder {
    int nM, nN, nwg, G, c;
    __host__ __device__ void init(int M, int N, int G_, int c_) { nM = M / BM; nN = N / BM; nwg = nM * nN; G = G_; c = c_; }
    __host__ __device__ bool next(int i, Unit& u) const {
        const long L = (long)i * G + c; if (L >= nwg) return false;
        int wgid = (int)L; { const int q = nwg / NXCD, r = nwg % NXCD, xcd = wgid % NXCD, off = wgid / NXCD; wgid = (xcd < r ? xcd * (q + 1) : r * (q + 1) + (xcd - r) * q) + off; }
        const int nig = WGM * nN, gid = wgid / nig, fm = gid * WGM, gsz = (nM - fm) < WGM ? (nM - fm) : WGM;
        u.pm = fm + ((wgid % nig) % gsz); u.pn = (wgid % nig) / gsz; return true;
    }
    __device__ __forceinline__ void a_ready(const Unit&) const {}
    __device__ __forceinline__ void done(const Unit&) const {}
};

template <class Epi, class Sched, bool ALIGN_EPI = false, bool SP2 = false>
__device__ __forceinline__ void gemm_phase(PG8_LAS unsigned char* lds, const Gemm g, const Sched& S, const Epi& E) {
    const int tid = TID(), wid = __builtin_amdgcn_readfirstlane(tid >> 6), lane = tid & 63, wr = wid >> 2, wc = wid & 3, fr = lane & 15, fq = lane >> 4;
    const int K = g.K, nt = K / BK;
    unsigned voffA[2], voffB[2];
#pragma unroll
    for (int i = 0; i < 2; ++i) { int R, C; stage_rc(tid * 16 + i * 8192, R, C); const int Rb = Epi::PERM ? ((R & ~31) + perm32(R & 31)) : R;
        voffA[i] = (unsigned)(R * K + C) * 2u; voffB[i] = (unsigned)(Rb * K + C) * 2u; }
    const size_t kstep = (size_t)(BK * 2);
    const size_t hstep = (size_t)HALF * K * 2;
    const size_t tstep = 2 * hstep;
    const unsigned ldsw = (unsigned)wid * 1024u;
    const int aoff = lds_byte(wr * 64 + fr, fq * 8), boff = lds_byte(wc * 32 + fr, fq * 8);
#define PG8_SA(b, h) (((b) * 2 + (h)) * HTB)
#define PG8_SB(b, h) ((4 + (b) * 2 + (h)) * HTB)
#define PG8_STAGE(bufoff, gbase, voff) do { _Pragma("unroll") for (int _i = 0; _i < 2; ++_i) \
        __builtin_amdgcn_global_load_lds((const unsigned*)((const char*)(gbase) + (voff)[_i]), (PG8_LAS unsigned*)(lds + (bufoff) + ldsw + _i * 8192), 16, 0, 0); } while (0)
#define PG8_LDA(dst, b, h) do { _Pragma("unroll") for (int m = 0; m < 4; ++m) _Pragma("unroll") for (int k = 0; k < 2; ++k) dst[m][k] = *(const PG8_LAS bf16x8*)(lds + PG8_SA(b, h) + aoff + m * 2048 + k * 1024); } while (0)
#define PG8_LDB(dst, b, h) do { _Pragma("unroll") for (int n = 0; n < 2; ++n) _Pragma("unroll") for (int k = 0; k < 2; ++k) dst[n][k] = *(const PG8_LAS bf16x8*)(lds + PG8_SB(b, h) + boff + n * 2048 + k * 1024); } while (0)
#define PG8_MMA(ai, bj, At, Bt) do { __builtin_amdgcn_s_setprio(1); _Pragma("unroll") for (int m = 0; m < 4; ++m) _Pragma("unroll") for (int n = 0; n < 2; ++n) _Pragma("unroll") for (int k = 0; k < 2; ++k) \
        acc[ai][bj][m][n] = __builtin_amdgcn_mfma_f32_16x16x32_bf16(Bt[n][k], At[m][k], acc[ai][bj][m][n], 0, 0, 0); __builtin_amdgcn_s_setprio(0); } while (0)
#define PG8_WAIT_V(n) asm volatile("s_waitcnt vmcnt(" #n ")" ::: "memory")
#define PG8_WAIT_L(n) asm volatile("s_waitcnt lgkmcnt(" #n ")" ::: "memory")
#define PG8_BAR __builtin_amdgcn_s_barrier()
#define PG8_SCHED __builtin_amdgcn_sched_barrier(0)
    Unit cur, nxt; int ui = 0;
    if (!S.next(0, cur)) return;
    f32x4 acc[2][2][4][2];
#pragma unroll
    for (int a = 0; a < 2; ++a)
#pragma unroll
        for (int b = 0; b < 2; ++b)
#pragma unroll
            for (int m = 0; m < 4; ++m)
#pragma unroll
                for (int n = 0; n < 2; ++n) acc[a][b][m][n] = zero4_();
    bf16x8 At[4][2], B0[2][2], B1[2][2];
    const char* cA = (const char*)g.A + (size_t)cur.pm * tstep; const char* cB = (const char*)g.Bt + (size_t)cur.pn * tstep;
    S.a_ready(cur);
    if constexpr (SP2) {
        PG8_STAGE(PG8_SB(0, 0), cB, voffB); PG8_STAGE(PG8_SB(0, 1), cB + hstep, voffB); PG8_STAGE(PG8_SA(0, 0), cA, voffA); PG8_STAGE(PG8_SA(0, 1), cA + hstep, voffA);
        if (wr == 1) PG8_BAR;
        PG8_WAIT_V(2); PG8_BAR;
        PG8_STAGE(PG8_SB(1, 0), cB + kstep, voffB); PG8_STAGE(PG8_SA(1, 0), cA + kstep, voffA); PG8_STAGE(PG8_SB(1, 1), cB + hstep + kstep, voffB);
        PG8_WAIT_V(6); PG8_BAR;
    } else {
        PG8_STAGE(PG8_SB(0, 0), cB, voffB); PG8_STAGE(PG8_SA(0, 0), cA, voffA); PG8_STAGE(PG8_SB(0, 1), cB + hstep, voffB); PG8_STAGE(PG8_SA(0, 1), cA + hstep, voffA);
        if (wr == 1) PG8_BAR;
        PG8_WAIT_V(4); PG8_BAR;
        PG8_STAGE(PG8_SB(1, 0), cB + kstep, voffB); PG8_STAGE(PG8_SA(1, 0), cA + kstep, voffA); PG8_STAGE(PG8_SB(1, 1), cB + hstep + kstep, voffB);
        PG8_WAIT_V(6); PG8_BAR;
    }
    for (;;) {
        const bool has_next = S.next(ui + 1, nxt);
        const char* nA = has_next ? (const char*)g.A + (size_t)nxt.pm * tstep : cA; const char* nB = has_next ? (const char*)g.Bt + (size_t)nxt.pn * tstep : cB;
        for (int t = 0; t < nt; t += 2) {
            const bool last = (t == nt - 2);
            const char* a1 = cA + (size_t)(t + 1) * kstep;
            const char* a2 = last ? nA : cA + (size_t)(t + 2) * kstep; const char* b2 = last ? nB : cB + (size_t)(t + 2) * kstep;
            const char* a3 = a2 + kstep; const char* b3 = b2 + kstep;
            if (last && has_next) S.a_ready(nxt);
            if constexpr (SP2) {
            PG8_LDB(B0, 0, 0); PG8_LDB(B1, 0, 1); PG8_SCHED; PG8_LDA(At, 0, 0); PG8_STAGE(PG8_SA(1, 1), a1 + hstep, voffA);
            PG8_WAIT_V(8); PG8_WAIT_L(0); PG8_BAR; PG8_MMA(0, 0, At, B0); PG8_MMA(0, 1, At, B1); PG8_BAR; PG8_SCHED;
            PG8_LDA(At, 0, 1); PG8_STAGE(PG8_SB(0, 0), b2, voffB); PG8_STAGE(PG8_SB(0, 1), b2 + hstep, voffB); PG8_STAGE(PG8_SA(0, 0), a2, voffA);
            PG8_WAIT_V(8); PG8_WAIT_L(0); PG8_BAR; PG8_MMA(1, 0, At, B0); PG8_MMA(1, 1, At, B1); PG8_BAR; PG8_SCHED;
            PG8_LDB(B0, 1, 0); PG8_LDB(B1, 1, 1); PG8_SCHED; PG8_LDA(At, 1, 0); PG8_STAGE(PG8_SA(0, 1), a2 + hstep, voffA);
            PG8_WAIT_V(8); PG8_WAIT_L(0); PG8_BAR; PG8_MMA(0, 0, At, B0); PG8_MMA(0, 1, At, B1); PG8_BAR; PG8_SCHED;
            PG8_LDA(At, 1, 1); PG8_STAGE(PG8_SB(1, 0), b3, voffB); PG8_STAGE(PG8_SB(1, 1), b3 + hstep, voffB); PG8_STAGE(PG8_SA(1, 0), a3, voffA);
            PG8_WAIT_V(8); PG8_WAIT_L(0); PG8_BAR; PG8_MMA(1, 0, At, B0); PG8_MMA(1, 1, At, B1); PG8_BAR; PG8_SCHED;
            } else {
            PG8_LDB(B0, 0, 0); PG8_SCHED; PG8_LDA(At, 0, 0); PG8_STAGE(PG8_SA(1, 1), a1 + hstep, voffA);
            PG8_WAIT_L(8); PG8_BAR; PG8_WAIT_L(0); PG8_MMA(0, 0, At, B0); PG8_BAR; PG8_SCHED;
            PG8_LDB(B1, 0, 1); PG8_STAGE(PG8_SB(0, 0), b2, voffB);
            PG8_BAR; PG8_WAIT_L(0); PG8_MMA(0, 1, At, B1); PG8_BAR;
            PG8_LDA(At, 0, 1); PG8_STAGE(PG8_SA(0, 0), a2, voffA);
            PG8_BAR; PG8_WAIT_L(0); PG8_MMA(1, 0, At, B0); PG8_BAR; PG8_SCHED;
            PG8_STAGE(PG8_SB(0, 1), b2 + hstep, voffB);
            PG8_WAIT_V(6); PG8_BAR; PG8_MMA(1, 1, At, B1); PG8_BAR;
            PG8_LDB(B0, 1, 0); PG8_SCHED; PG8_LDA(At, 1, 0); PG8_STAGE(PG8_SA(0, 1), a2 + hstep, voffA);
            PG8_WAIT_L(8); PG8_BAR; PG8_WAIT_L(0); PG8_MMA(0, 0, At, B0); PG8_BAR; PG8_SCHED;
            PG8_LDB(B1, 1, 1); PG8_STAGE(PG8_SB(1, 0), b3, voffB);
            PG8_BAR; PG8_WAIT_L(0); PG8_MMA(0, 1, At, B1); PG8_BAR;
            PG8_LDA(At, 1, 1); PG8_STAGE(PG8_SA(1, 0), a3, voffA);
            PG8_BAR; PG8_WAIT_L(0); PG8_MMA(1, 0, At, B0); PG8_BAR; PG8_SCHED;
            PG8_STAGE(PG8_SB(1, 1), b3 + hstep, voffB);
            PG8_WAIT_V(6); PG8_BAR; PG8_MMA(1, 1, At, B1); PG8_BAR;
            }
        }
        if constexpr (ALIGN_EPI) { if (wr == 0) PG8_BAR; }
        if constexpr (!Epi::AFTER_DRAIN) { E(acc, cur, wr, wc, fr, fq); S.done(cur); }
        if (!has_next) break;
#pragma unroll
        for (int a = 0; a < 2; ++a)
#pragma unroll
            for (int b = 0; b < 2; ++b)
#pragma unroll
                for (int m = 0; m < 4; ++m)
#pragma unroll
                    for (int n = 0; n < 2; ++n) acc[a][b][m][n] = zero4_();
        cur = nxt; cA = nA; cB = nB; ++ui;
        if constexpr (ALIGN_EPI) { if (wr == 1) PG8_BAR; }
    }
    PG8_WAIT_V(0);
    if constexpr (!ALIGN_EPI) { if (wr == 0) PG8_BAR; }
    PG8_BAR;
    if constexpr (Epi::AFTER_DRAIN) { E.fused(acc, cur, wr, wc, fr, fq, lds, wid, lane); S.done(cur); }
#undef PG8_SA
#undef PG8_SB
#undef PG8_STAGE
#undef PG8_LDA
#undef PG8_LDB
#undef PG8_MMA
#undef PG8_WAIT_V
#undef PG8_WAIT_L
#undef PG8_BAR
#undef PG8_SCHED
}
}

#define LAS __attribute__((address_space(3)))
typedef unsigned short bf16_t;
typedef short bf16x8 __attribute__((ext_vector_type(8)));
typedef float f32x4 __attribute__((ext_vector_type(4)));
typedef float f32x16 __attribute__((ext_vector_type(16)));
typedef unsigned u32x4 __attribute__((ext_vector_type(4)));
typedef unsigned u32x2 __attribute__((ext_vector_type(2)));

constexpr int NB = 4, T = 8192, DM = 1024, M = NB * T, DEPTH = 4, PLE = 256, FF = 2816, ZW = 3584, INW = 3474;
constexpr int C_NQ = 0, C_CK = 384, C_CV = 512, C_SK = 640, C_SV = 768, C_WK = 896, C_WV = 1024, C_DQ = 1152, C_DK = 1408, C_DV = 1664,
              C_HQ = 1920, C_HF = 2304, C_HI = 2688, C_HG = 3072, C_NG = 3456;
constexpr float EPS = 1e-6f, LOG2E = 1.4426950408889634f;
enum { I_X = 0, I_P, I_RELB, I_LBLOG, I_F1N, I_F1G, I_F1U, I_F1D, I_MIXN, I_WIN, I_WOUT, I_NQN, I_NKN, I_CPOS, I_CW1, I_CW2,
       I_DQN, I_DKN, I_DLAM, I_DSUB, I_HON, I_F2N, I_F2G, I_F2U, I_F2D, I_PLN, I_PLG, I_PLP, I_PLPOST, N_IN };
constexpr size_t MiB = 1u << 20;
constexpr size_t WS_CTL = 0, WS_W = 1 * MiB, WS_PB = 53 * MiB, WS_XB = 69 * MiB, WS_R1 = 133 * MiB, WS_MIX = 357 * MiB, WS_VT = 421 * MiB,
                 WS_HS = 453 * MiB, WS_KC = 501 * MiB, WS_VCT = WS_KC + 512 * 1024, WS_SELM = 503 * MiB, WS_RSQ0 = 504 * MiB, WS_RSQ1 = 506 * MiB,
                 WS_RSQP = 508 * MiB, WS_HD = 510 * MiB, WS_XB1 = 511 * MiB, WS_OCB = 575 * MiB, WS_ONES = 599 * MiB, WS_END = 601 * MiB;
constexpr size_t W_GU1 = 0, W_D1 = 11 * MiB, W_GU2 = W_D1 + 5 * MiB + 512 * 1024, W_D2 = W_GU2 + 11 * MiB, W_IN = 33 * MiB, W_OUT = 40 * MiB, W_PG = 42 * MiB,
                 W_PP = 44 * MiB, W_1T = W_PP + 512 * 1024, W_2T = W_1T + 2 * MiB, W_POSB = W_2T + 64 * 1024;
static_assert(W_D2 + 5 * MiB + 512 * 1024 == W_IN, "weight map");
constexpr int LDS_BYTES = 138 * 1024, LDS_MISC = 131072, LDS_RTAB = LDS_MISC + 1024;

__device__ __forceinline__ float bf2f(unsigned short u) { return __uint_as_float(((unsigned)u) << 16); }
__device__ __forceinline__ float bflo(unsigned w) { return __uint_as_float(w << 16); }
__device__ __forceinline__ float bfhi(unsigned w) { return __uint_as_float(w & 0xffff0000u); }
typedef float f32x2_t __attribute__((ext_vector_type(2))); typedef __bf16 bf16x2_t __attribute__((ext_vector_type(2)));
__device__ __forceinline__ unsigned pk2(float lo, float hi) { f32x2_t v = {lo, hi}; bf16x2_t b = __builtin_convertvector(v, bf16x2_t); return __builtin_bit_cast(unsigned, b); }
__device__ __forceinline__ bf16_t f2bf(float f) { return (bf16_t)(pk2(f, 0.f) & 0xffffu); }
__device__ __forceinline__ float ex2(float x) { return __builtin_amdgcn_exp2f(x); }
__device__ __forceinline__ float sigmoidf_(float x) { return __builtin_amdgcn_rcpf(1.0f + __expf(-x)); }
__device__ __forceinline__ int crow(int r, int hi) { return (r & 3) + 8 * (r >> 2) + 4 * hi; }
__device__ __forceinline__ f32x16 mfma32(bf16x8 a, bf16x8 b, f32x16 c) { return __builtin_amdgcn_mfma_f32_32x32x16_bf16(a, b, c, 0, 0, 0); }
__device__ __forceinline__ f32x4 mfma16(bf16x8 a, bf16x8 b, f32x4 c) { return __builtin_amdgcn_mfma_f32_16x16x32_bf16(a, b, c, 0, 0, 0); }
__device__ __forceinline__ bf16x8 as_bf16x8(u32x4 v) { return __builtin_bit_cast(bf16x8, v); }
#define LDSW() asm volatile("s_waitcnt lgkmcnt(0)" ::: "memory")
#define CFENCE() asm volatile("" ::: "memory")
#define GAS __attribute__((address_space(1)))
__device__ __forceinline__ const float* inp(int i) { asm volatile("" : "+s"(i)); const unsigned long long v = ((const unsigned long long __attribute__((address_space(4)))*)__builtin_amdgcn_kernarg_segment_ptr())[i]; return (const float*)(const GAS float*)v; }

__device__ __forceinline__ float row_rinv(const float* rsq, int row) {
    const f32x4* p = (const f32x4*)(rsq + (size_t)row * 16);
    const f32x4 a = p[0], b = p[1], c = p[2], d = p[3];
    const float s = ((a.x + a.y) + (a.z + a.w)) + ((b.x + b.y) + (b.z + b.w)) + ((c.x + c.y) + (c.z + c.w)) + ((d.x + d.y) + (d.z + d.w));
    return rsqrtf(s * (1.0f / 1024.0f) + EPS);
}
struct RowTab {
    int p0, p1, p2, p3;
    __device__ __forceinline__ int slot(int pm) const { return pm == p0 ? 0 : (pm == p1 ? 1 : (pm == p2 ? 2 : 3)); }
    __device__ __forceinline__ float get(int t, int pm, int r256) const { return ((const LAS float*)(LAS unsigned char*)(size_t)LDS_RTAB)[(t * 4 + slot(pm)) * 256 + r256]; }
};
struct EpiSwiGLU {
    static constexpr bool PERM = true, AFTER_DRAIN = false;
    bf16_t* O; RowTab rt;
    __device__ __forceinline__ void operator()(const f32x4 (&acc)[2][2][4][2], const pg8::Unit& u, int wr, int wc, int fr, int fq) const {
#pragma unroll
        for (int ai = 0; ai < 2; ++ai)
#pragma unroll
            for (int m = 0; m < 4; ++m) {
                const int row = u.pm * 256 + ai * 128 + wr * 64 + m * 16 + fr;
                const float r = rt.get(0, u.pm, row & 255);
                float o[8];
#pragma unroll
                for (int n = 0; n < 2; ++n)
#pragma unroll
                    for (int e = 0; e < 4; ++e) { const float g = acc[ai][0][m][n][e] * r, up = acc[ai][1][m][n][e] * r; o[n * 4 + e] = g * sigmoidf_(g) * up; }
                u32x4 w; w.x = pk2(o[0], o[1]); w.y = pk2(o[2], o[3]); w.z = pk2(o[4], o[5]); w.w = pk2(o[6], o[7]);
                *(u32x4*)(O + (size_t)row * FF + u.pn * 128 + wc * 32 + 8 * fq) = w;
                CFENCE();
            }
    }
};
template <int LD> struct EpiZT {
    static constexpr bool PERM = true, AFTER_DRAIN = false;
    bf16_t* Z; RowTab rt;
    __device__ __forceinline__ void operator()(const f32x4 (&acc)[2][2][4][2], const pg8::Unit& u, int wr, int wc, int fr, int fq) const {
#pragma unroll
        for (int ai = 0; ai < 2; ++ai)
#pragma unroll
            for (int m = 0; m < 4; ++m) {
                const int row = u.pm * 256 + ai * 128 + wr * 64 + m * 16 + fr;
                const float r = rt.get(0, u.pm, row & 255);
#pragma unroll
                for (int bj = 0; bj < 2; ++bj) {
                    const f32x4 v0 = acc[ai][bj][m][0] * r, v1 = acc[ai][bj][m][1] * r;
                    u32x4 w; w.x = pk2(v0[0], v0[1]); w.y = pk2(v0[2], v0[3]); w.z = pk2(v1[0], v1[1]); w.w = pk2(v1[2], v1[3]);
                    *(u32x4*)(Z + (size_t)row * LD + u.pn * 256 + bj * 128 + wc * 32 + 8 * fq) = w;
                }
                CFENCE();
            }
    }
};
typedef EpiZT<ZW> EpiZ;
template <int MODE> struct EpiRes {
    static constexpr bool PERM = true, AFTER_DRAIN = false;
    float* X; bf16_t* XB; float* rsq_out; float alpha; const float* rsq_in; const bf16_t* P; const float* rsqp; const float* post; bf16_t* Pout; RowTab rt;
    __device__ __forceinline__ void operator()(const f32x4 (&acc)[2][2][4][2], const pg8::Unit& u, int wr, int wc, int fr, int fq) const {
        const int rowb = u.pm * 256 + wr * 64 + fr, colb = u.pn * 256 + wc * 32 + 8 * fq;
        f32x4 xn[2][2]; u32x2 pn_[2][2];
        if (MODE != 2) {
#pragma unroll
            for (int bj = 0; bj < 2; ++bj)
#pragma unroll
                for (int n = 0; n < 2; ++n) { const size_t off = (size_t)rowb * DM + colb + bj * 128 + 4 * n; xn[bj][n] = *(const f32x4*)(X + off); if (MODE == 1) pn_[bj][n] = *(const u32x2*)(P + off); }
        }
#pragma unroll
        for (int gI = 0; gI < 8; ++gI) {
            const int ai = gI >> 2, m = gI & 3;
            const int row = rowb + ai * 128 + m * 16;
            f32x4 xc[2][2]; u32x2 pc[2][2];
#pragma unroll
            for (int bj = 0; bj < 2; ++bj)
#pragma unroll
                for (int n = 0; n < 2; ++n) { xc[bj][n] = xn[bj][n]; pc[bj][n] = pn_[bj][n]; }
            if (MODE != 2 && gI < 7) {
                const int row2 = rowb + ((gI + 1) >> 2) * 128 + ((gI + 1) & 3) * 16;
#pragma unroll
                for (int bj = 0; bj < 2; ++bj)
#pragma unroll
                    for (int n = 0; n < 2; ++n) { const size_t off = (size_t)row2 * DM + colb + bj * 128 + 4 * n; xn[bj][n] = *(const f32x4*)(X + off); if (MODE == 1) pn_[bj][n] = *(const u32x2*)(P + off); }
            }
            CFENCE();
            float r = 1.f, rp = 1.f;
            if (MODE == 1) { r = rt.get(0, u.pm, row & 255); rp = rt.get(1, u.pm, row & 255); }
            float ss = 0.f;
#pragma unroll
            for (int bj = 0; bj < 2; ++bj)
#pragma unroll
                for (int n = 0; n < 2; ++n) {
                    const int c0 = colb + bj * 128 + 4 * n;
                    const size_t off = (size_t)row * DM + c0;
                    const f32x4 a = acc[ai][bj][m][n];
                    if (MODE == 2) {
                        u32x2 w; w.x = pk2(a[0], a[1]); w.y = pk2(a[2], a[3]);
                        *(u32x2*)(Pout + off) = w;
                        ss += (a[0] * a[0] + a[1] * a[1]) + (a[2] * a[2] + a[3] * a[3]);
                    } else {
                        f32x4 xv = xc[bj][n];
                        if (MODE == 0) xv += a * alpha;
                        else {
                            const u32x2 pw = pc[bj][n]; const f32x4 po = *(const f32x4*)(post + c0);
                            xv[0] += sigmoidf_(a[0] * r) * (bflo(pw.x) * rp * po[0]);
                            xv[1] += sigmoidf_(a[1] * r) * (bfhi(pw.x) * rp * po[1]);
                            xv[2] += sigmoidf_(a[2] * r) * (bflo(pw.y) * rp * po[2]);
                            xv[3] += sigmoidf_(a[3] * r) * (bfhi(pw.y) * rp * po[3]);
                        }
                        *(f32x4*)(X + off) = xv;
                        u32x2 w; w.x = pk2(xv[0], xv[1]); w.y = pk2(xv[2], xv[3]);
                        *(u32x2*)(XB + off) = w;
                        ss += (xv[0] * xv[0] + xv[1] * xv[1]) + (xv[2] * xv[2] + xv[3] * xv[3]);
                    }
                }
            ss += __shfl_xor(ss, 16); ss += __shfl_xor(ss, 32);
            if (fq == 0) rsq_out[(size_t)row * 16 + u.pn * 4 + wc] = ss;
        }
    }
};

template <class Epi> __device__ __forceinline__ void run_gemm(LAS unsigned char* lds, const bf16_t* A, const bf16_t* Bt, int N, int K, Epi& E, const float* rsqA = nullptr, const float* rsqB = nullptr) {
    int bx = blockIdx.x; asm volatile("" : "+s"(bx)); asm volatile("" : "+s"(K)); asm volatile("" : "+s"(N));
    pg8::Gemm g{A, Bt, M, N, K}; pg8::StaticOrder S; S.init(M, N, (int)gridDim.x, bx);
    if (rsqA) {
        int p0 = -1, p1 = -1, p2 = -1, p3 = -1; pg8::Unit u;
        for (int i = 0; S.next(i, u); ++i) { const int pm = u.pm; if (pm != p0 && pm != p1 && pm != p2 && pm != p3) { if (p0 < 0) p0 = pm; else if (p1 < 0) p1 = pm; else if (p2 < 0) p2 = pm; else p3 = pm; } }
        E.rt.p0 = p0; E.rt.p1 = p1; E.rt.p2 = p2; E.rt.p3 = p3;
        const int tid = TID();
        LAS float* tab = (LAS float*)(lds + LDS_RTAB);
        if (tid < 256) {
#pragma unroll
            for (int s = 0; s < 4; ++s) { const int pm = s == 0 ? p0 : (s == 1 ? p1 : (s == 2 ? p2 : p3));
                if (pm >= 0) { tab[s * 256 + tid] = row_rinv(rsqA, pm * 256 + tid); if (rsqB) tab[(4 + s) * 256 + tid] = row_rinv(rsqB, pm * 256 + tid); } }
        }
        __syncthreads();
    }
    pg8::gemm_phase<Epi, pg8::StaticOrder, true, true>(lds, g, S, E);
    __syncthreads();
}

__device__ __forceinline__ void rowsq_pass(const bf16_t* P, float* rsq_out) {
    const int tid = TID(), lane = tid & 63, wave = tid >> 6;
    for (int base = (blockIdx.x * 8 + wave) * 4; base < M; base += gridDim.x * 8 * 4) {
        u32x4 v[4][2];
#pragma unroll
        for (int i = 0; i < 4; ++i) { const u32x4* pr = (const u32x4*)(P + (size_t)(base + i) * DM) + lane; v[i][0] = pr[0]; v[i][1] = pr[64]; }
#pragma unroll
        for (int i = 0; i < 4; ++i) {
            float s = 0.f;
#pragma unroll
            for (int h2 = 0; h2 < 2; ++h2) { const u32x4 w = v[i][h2];
                s += (bflo(w.x) * bflo(w.x) + bfhi(w.x) * bfhi(w.x)) + (bflo(w.y) * bflo(w.y) + bfhi(w.y) * bfhi(w.y)) + (bflo(w.z) * bflo(w.z) + bfhi(w.z) * bfhi(w.z)) + (bflo(w.w) * bflo(w.w) + bfhi(w.w) * bfhi(w.w)); }
#pragma unroll
            for (int o = 1; o < 64; o <<= 1) s += __shfl_xor(s, o);
            if (lane < 16) rsq_out[(size_t)(base + i) * 16 + lane] = (lane == 0) ? s : 0.f;
        }
    }
}

__device__ __forceinline__ int next_task(unsigned* ctr, LAS int* slot) {
    __syncthreads();
    if (TID() == 0) *slot = (int)atomicAdd(ctr, 1u);
    __syncthreads();
    return *slot;
}

__device__ __forceinline__ int colmap(int mode, int n) {
    if (mode == 1) return 256 * (n >> 7) + (n & 127);
    if (mode == 2) return 256 * (n >> 7) + 128 + (n & 127);
    if (mode == 3) return n < 1152 ? n : (n < 1170 ? 3456 + (n - 1152) : n - 18);
    return n;
}
__device__ __forceinline__ void conv_item(const float* W, int K, int N, bf16_t* WT, const float* gain, int mode, LAS float* scr, int item, int lane) {
    const int nblk = (N + 31) >> 5, kb = item / nblk, nb = item % nblk, k0 = 64 * kb, n0 = 32 * nb;
#pragma unroll 16
    for (int i = 0; i < 32; ++i) {
        const int kk = 2 * i + (lane >> 5), n = n0 + (lane & 31);
        float v = (n < N) ? W[(size_t)(k0 + kk) * N + n] : 0.f;
        if (gain) v *= gain[k0 + kk];
        scr[kk * 33 + (lane & 31)] = v;
    }
    LDSW();
    const int c = lane & 7;
#pragma unroll
    for (int j = 0; j < 4; ++j) {
        const int nl = (lane >> 3) + 8 * j, n = n0 + nl;
        const LAS float* s = scr + (8 * c) * 33 + nl;
        u32x4 o; o.x = pk2(s[0], s[33]); o.y = pk2(s[2 * 33], s[3 * 33]); o.z = pk2(s[4 * 33], s[5 * 33]); o.w = pk2(s[6 * 33], s[7 * 33]);
        if (n < N) *(u32x4*)(WT + (size_t)colmap(mode, n) * K + k0 + 8 * c) = o;
    }
    LDSW();
}

__device__ __forceinline__ void phase_convert(const float* const* in, unsigned char* ws, float* out, int L, LAS unsigned char* lds) {
    const int tid = TID(), lane = tid & 63, wave = tid >> 6;
    const int gw = blockIdx.x * 8 + wave, NGW = gridDim.x * 8;
    LAS float* scr = (LAS float*)(lds + wave * 8704);
    unsigned char* wb = ws + WS_W;
    if (gw < 256) {
        const int ty = gw >> 7, ng = (gw >> 5) & 3, ks = gw & 31, n = ng * 64 + lane;
        const float* w1 = inp(I_CW1) + (size_t)(L * 2 + ty) * 2048 * 256; const float* pos = inp(I_CPOS) + (size_t)(L * 2 + ty) * 2048;
        float acc = 0.f;
#pragma unroll 16
        for (int k = ks * 64; k < ks * 64 + 64; ++k) acc += pos[k] * w1[(size_t)k * 256 + n];
        ((float*)(wb + W_POSB))[(ty * 32 + ks) * 256 + n] = acc;
    }
    const size_t ffo = (size_t)L * DM * FF;
    constexpr int IT_GU = (DM / 64) * (FF / 32), IT_D = (FF / 64) * (DM / 32), IT_IN = (DM / 64) * ((INW + 31) / 32), IT_SQ = (DM / 64) * (DM / 32),
                  IT_PP = (PLE / 64) * (DM / 32), IT_W1 = (2048 / 64) * (256 / 32), IT_W2 = (256 / 64) * (64 / 32);
    constexpr int total = 4 * IT_GU + 2 * IT_D + IT_IN + 2 * IT_SQ + IT_PP + 2 * IT_W1 + 2 * IT_W2;
    for (int it = gw; it < total; it += NGW) {
        const float* W = nullptr; int K = 0, N = 0; bf16_t* WT = nullptr; const float* gain = nullptr; int mode = 0, rr = -1, r = it;
#define JOB(Wp, Kk, Nn, WTp, gp, md, items) { if (rr < 0 && r < (items)) { W = (Wp); K = (Kk); N = (Nn); WT = (bf16_t*)(WTp); gain = (gp); mode = (md); rr = r; } r -= (items); }
        JOB(inp(I_F1G) + ffo, DM, FF, wb + W_GU1, inp(I_F1N) + L * DM, 1, IT_GU)
        JOB(inp(I_F1U) + ffo, DM, FF, wb + W_GU1, inp(I_F1N) + L * DM, 2, IT_GU)
        JOB(inp(I_F1D) + ffo, FF, DM, wb + W_D1, nullptr, 0, IT_D)
        JOB(inp(I_F2G) + ffo, DM, FF, wb + W_GU2, inp(I_F2N) + L * DM, 1, IT_GU)
        JOB(inp(I_F2U) + ffo, DM, FF, wb + W_GU2, inp(I_F2N) + L * DM, 2, IT_GU)
        JOB(inp(I_F2D) + ffo, FF, DM, wb + W_D2, nullptr, 0, IT_D)
        JOB(inp(I_WIN) + (size_t)L * DM * INW, DM, INW, wb + W_IN, inp(I_MIXN) + L * DM, 3, IT_IN)
        JOB(inp(I_WOUT) + (size_t)L * DM * DM, DM, DM, wb + W_OUT, nullptr, 0, IT_SQ)
        JOB(inp(I_PLG) + (size_t)L * DM * DM, DM, DM, wb + W_PG, inp(I_PLN) + L * DM, 0, IT_SQ)
        JOB(inp(I_PLP) + (size_t)L * PLE * DM, PLE, DM, wb + W_PP, nullptr, 0, IT_PP)
        JOB(inp(I_CW1) + (size_t)(L * 2 + 0) * 2048 * 256, 2048, 256, wb + W_1T, nullptr, 0, IT_W1)
        JOB(inp(I_CW1) + (size_t)(L * 2 + 1) * 2048 * 256, 2048, 256, wb + W_1T + 256 * 2048 * 2, nullptr, 0, IT_W1)
        JOB(inp(I_CW2) + (size_t)(L * 2 + 0) * 256 * 64, 256, 64, wb + W_2T, nullptr, 0, IT_W2)
        JOB(inp(I_CW2) + (size_t)(L * 2 + 1) * 256 * 64, 256, 64, wb + W_2T + 64 * 256 * 2, nullptr, 0, IT_W2)
#undef JOB
        conv_item(W, K, N, WT, gain, mode, scr, rr, lane);
    }
    {
        u32x4* z = (u32x4*)((bf16_t*)(wb + W_IN) + (size_t)INW * DM);
        const int n16 = (ZW - INW) * DM / 8;
        for (int i = blockIdx.x * 512 + tid; i < n16; i += gridDim.x * 512) z[i] = (u32x4){0u, 0u, 0u, 0u};
    }
    {
        const f32x4* src = (const f32x4*)(inp(I_P) + (size_t)L * M * PLE); u32x4* dst = (u32x4*)(ws + WS_PB);
        const int n8 = M * PLE / 8;
        for (int i = blockIdx.x * 512 + tid; i < n8; i += gridDim.x * 512) {
            const f32x4 a = src[2 * i], b = src[2 * i + 1];
            u32x4 w; w.x = pk2(a[0], a[1]); w.y = pk2(a[2], a[3]); w.z = pk2(b[0], b[1]); w.w = pk2(b[2], b[3]); dst[i] = w;
        }
    }
    if (L == 0) {
        const float* x = inp(I_X); bf16_t* xb = (bf16_t*)(ws + WS_XB); float* rsq = (float*)(ws + WS_RSQ0);
        for (int m = gw; m < M; m += NGW) {
            const f32x4* xr = (const f32x4*)(x + (size_t)m * DM) + lane; f32x4* orow = (f32x4*)(out + (size_t)m * DM) + lane;
            u32x2* xbr = (u32x2*)(xb + (size_t)m * DM) + lane;
            float s = 0.f;
#pragma unroll
            for (int j = 0; j < 4; ++j) { const f32x4 v = xr[64 * j]; orow[64 * j] = v; u32x2 w; w.x = pk2(v[0], v[1]); w.y = pk2(v[2], v[3]); xbr[64 * j] = w; s += (v[0] * v[0] + v[1] * v[1]) + (v[2] * v[2] + v[3] * v[3]); }
#pragma unroll
            for (int o = 1; o < 64; o <<= 1) s += __shfl_xor(s, o);
            if (lane < 16) rsq[(size_t)m * 16 + lane] = (lane == 0) ? s : 0.f;
        }
    }
}

__device__ __forceinline__ void task_prep(const float* const* in, unsigned char* ws, int L, int tile, LAS unsigned char* lds) {
    const int tid = TID(), lane = tid & 63, wave = tid >> 6;
    bf16_t* z = (bf16_t*)(ws + WS_R1);
    const int row0 = tile * 64;
#pragma unroll
    for (int pass = 0; pass < 3; ++pass) {
        const int seg = pass * 64 + lane;
        int col = 0, gs = 8; const float* gp = inp(I_NQN); float scale = 1.f;
        if (seg < 48) { col = C_NQ + 8 * seg; gp = inp(I_NQN) + L * 64 + ((8 * seg) & 63); scale = 0.125f * LOG2E; }
        else if (seg < 64) { col = C_SK + 8 * (seg - 48); gp = inp(I_NKN) + (L * 3 + 1) * 64 + ((8 * seg) & 63); }
        else if (seg < 80) { col = C_WK + 8 * (seg - 64); gp = inp(I_NKN) + (L * 3 + 2) * 64 + ((8 * seg) & 63); }
        else if (seg < 112) { col = C_DQ + 8 * (seg - 80); gp = inp(I_DQN) + L * 32 + ((8 * seg) & 31); gs = 4; scale = 0.17677669529663689f * LOG2E; }
        else { col = C_DK + 8 * (seg - 112); gp = inp(I_DKN) + L * 32 + ((8 * seg) & 31); gs = 4; }
        const bool act = seg < 144;
        if (!act) { col = 0; }
        const f32x4 g0 = *(const f32x4*)gp, g1 = *(const f32x4*)(gp + 4);
        u32x4 w[8];
#pragma unroll
        for (int i = 0; i < 8; ++i) w[i] = *(const u32x4*)(z + (size_t)(row0 + wave + 8 * i) * ZW + col);
#pragma unroll
        for (int i = 0; i < 8; ++i) {
            float v[8] = {bflo(w[i].x), bfhi(w[i].x), bflo(w[i].y), bfhi(w[i].y), bflo(w[i].z), bfhi(w[i].z), bflo(w[i].w), bfhi(w[i].w)};
            float ss = 0.f;
#pragma unroll
            for (int e2 = 0; e2 < 8; ++e2) ss += v[e2] * v[e2];
            ss += __shfl_xor(ss, 1); ss += __shfl_xor(ss, 2);
            const float t4 = __shfl_xor(ss, 4); if (gs == 8) ss += t4;
            const float r = rsqrtf(ss / (float)(gs * 8) + EPS) * scale;
            u32x4 o; o.x = pk2(v[0] * r * g0[0], v[1] * r * g0[1]); o.y = pk2(v[2] * r * g0[2], v[3] * r * g0[3]);
            o.z = pk2(v[4] * r * g1[0], v[5] * r * g1[1]); o.w = pk2(v[6] * r * g1[2], v[7] * r * g1[3]);
            if (act) *(u32x4*)(z + (size_t)(row0 + wave + 8 * i) * ZW + col) = o;
        }
    }
    LAS bf16_t* tl = (LAS bf16_t*)lds;
#pragma unroll
    for (int i = 0; i < 8; ++i) {
        const int id = i * 512 + tid, row = id >> 6, ch = id & 63;
        const int col = ch < 16 ? C_SV + 8 * ch : (ch < 32 ? C_WV + 8 * (ch - 16) : C_DV + 8 * (ch - 32));
        *(LAS u32x4*)(tl + row * 520 + 8 * ch) = *(const u32x4*)(z + (size_t)(row0 + row) * ZW + col);
    }
    __syncthreads();
    const int b = row0 / T, t0 = row0 % T;
    bf16_t* vt = (bf16_t*)(ws + WS_VT);
#pragma unroll
    for (int i = 0; i < 8; ++i) {
        const int orow = tid, tch = i;
        const LAS bf16_t* s = tl + (tch * 8) * 520 + orow;
        u32x4 o;
        o.x = (unsigned)s[0] | ((unsigned)s[520] << 16); o.y = (unsigned)s[2 * 520] | ((unsigned)s[3 * 520] << 16);
        o.z = (unsigned)s[4 * 520] | ((unsigned)s[5 * 520] << 16); o.w = (unsigned)s[6 * 520] | ((unsigned)s[7 * 520] << 16);
        *(u32x4*)(vt + ((size_t)(b * 8) * 64 + orow) * T + t0 + 8 * tch) = o;
    }
}

__device__ __forceinline__ float gelu_tanh(float x) {
    const float y = 0.7978845608028654f * (x + 0.044715f * x * x * x);
    const float th = 1.0f - 2.0f * __builtin_amdgcn_rcpf(1.0f + __expf(2.0f * y));
    return 0.5f * x * (1.0f + th);
}
__device__ __forceinline__ void task_compress(const float* const* in, unsigned char* ws, int L, int task, LAS unsigned char* lds) {
    const int tid = TID(), lane = tid & 63, wave = tid >> 6;
    const int ty = task >> 8, b = (task >> 6) & 3, g = (task >> 5) & 1, i0 = (task & 31) * 16;
    const bf16_t* z = (const bf16_t*)(ws + WS_R1);
    LAS bf16_t* zt = (LAS bf16_t*)lds;
    LAS bf16_t* hid = (LAS bf16_t*)(lds + 39168);
    LAS float* ofp = (LAS float*)(lds + 39168 + 8448);
    const int ccol = (ty ? C_CV : C_CK) + 64 * g;
    for (int id = tid; id < 272 * 8; id += 512) {
        const int row = id >> 3, ch = id & 7, tok = 16 * i0 + row;
        u32x4 v = (u32x4){0u, 0u, 0u, 0u};
        if (tok < T) v = *(const u32x4*)(z + (size_t)(b * T + tok) * ZW + ccol + 8 * ch);
        *(LAS u32x4*)(zt + row * 72 + 8 * ch) = v;
    }
    __syncthreads();
    const bf16_t* w1t = (const bf16_t*)(ws + WS_W + W_1T) + (size_t)ty * 256 * 2048;
    const bf16_t* w2t = (const bf16_t*)(ws + WS_W + W_2T) + (size_t)ty * 64 * 256;
    const float* posb = (const float*)(ws + WS_W + W_POSB) + ty * 32 * 256;
    const int r16 = lane & 15, kq = lane >> 4;
    f32x4 acc[2] = {(f32x4){0.f, 0.f, 0.f, 0.f}, (f32x4){0.f, 0.f, 0.f, 0.f}};
    const bf16_t* b0p = w1t + (size_t)(16 * (2 * wave) + r16) * 2048 + 8 * kq;
    const bf16_t* b1p = b0p + 16 * 2048;
#pragma unroll 8
    for (int kc = 0; kc < 64; ++kc) {
        const bf16x8 a = *(const LAS bf16x8*)(zt + (16 * r16 + (kc >> 1)) * 72 + (kc & 1) * 32 + 8 * kq);
        const bf16x8 w0 = *(const bf16x8*)(b0p + 32 * kc), w1 = *(const bf16x8*)(b1p + 32 * kc);
        acc[0] = mfma16(a, w0, acc[0]); acc[1] = mfma16(a, w1, acc[1]);
    }
#pragma unroll
    for (int j = 0; j < 2; ++j) {
        const int n = 16 * (2 * wave + j) + r16;
        float pbias = 0.f;
#pragma unroll
        for (int ks = 0; ks < 32; ++ks) pbias += posb[ks * 256 + n];
#pragma unroll
        for (int i = 0; i < 4; ++i) hid[(4 * kq + i) * 264 + n] = f2bf(gelu_tanh(acc[j][i] + pbias));
    }
    __syncthreads();
    if (wave < 4) {
        f32x4 a2 = (f32x4){0.f, 0.f, 0.f, 0.f};
        const bf16_t* bp = w2t + (size_t)(16 * wave + r16) * 256 + 8 * kq;
#pragma unroll
        for (int kc = 0; kc < 8; ++kc) {
            const bf16x8 a = *(const LAS bf16x8*)(hid + r16 * 264 + 32 * kc + 8 * kq);
            const bf16x8 w = *(const bf16x8*)(bp + 32 * kc);
            a2 = mfma16(a, w, a2);
        }
#pragma unroll
        for (int i = 0; i < 4; ++i) ofp[(4 * kq + i) * 64 + 16 * wave + r16] = a2[i];
    }
    __syncthreads();
    if (tid < 256) {
        const int row = tid >> 4, c4 = (tid & 15) * 4, i = i0 + row;
        f32x4 o = *(const LAS f32x4*)(ofp + row * 64 + c4);
        float ss = (o[0] * o[0] + o[1] * o[1]) + (o[2] * o[2] + o[3] * o[3]);
        ss += __shfl_xor(ss, 1); ss += __shfl_xor(ss, 2); ss += __shfl_xor(ss, 4); ss += __shfl_xor(ss, 8);
        if (ty == 0) {
            const float r = rsqrtf(ss * (1.0f / 64.0f) + EPS);
            const f32x4 gn = *(const f32x4*)(inp(I_NKN) + (L * 3 + 0) * 64 + c4);
            o = o * r * gn;
        }
        if (i >= 511) o = (f32x4){0.f, 0.f, 0.f, 0.f};
        if (ty == 0) {
            u32x2 w; w.x = pk2(o[0], o[1]); w.y = pk2(o[2], o[3]);
            *(u32x2*)((bf16_t*)(ws + WS_KC) + ((size_t)(b * 2 + g) * 512 + i) * 64 + c4) = w;
        } else {
            bf16_t* vct = (bf16_t*)(ws + WS_VCT) + (size_t)(b * 2 + g) * 64 * 512;
#pragma unroll
            for (int e = 0; e < 4; ++e) vct[(size_t)(c4 + e) * 512 + i] = f2bf(o[e]);
        }
    }
}

__device__ __forceinline__ float hgrn_lb(const float* logits, int L, int j) {
    if (L == 0) return 0.f;
    const float a0 = logits[j], a1 = logits[384 + j], a2 = logits[768 + j], a3 = logits[1152 + j];
    const float mx = fmaxf(fmaxf(a0, a1), fmaxf(a2, a3));
    const float e0 = __expf(a0 - mx), e1 = __expf(a1 - mx), e2 = __expf(a2 - mx), e3 = __expf(a3 - mx);
    const float inv = 1.0f / (e0 + e1 + e2 + e3);
    float s = e1; if (L >= 2) s += e2; if (L >= 3) s += e3;
    return s * inv;
}
__device__ __forceinline__ void task_hgrn_local(const float* const* in, unsigned char* ws, int L, int task, LAS unsigned char* lds) {
    const int tid = TID(), lane = tid & 63, wave = tid >> 6;
    if (wave < 6) {
        const int chunk = task * 6 + wave;
        const int bh = chunk >> 7, c = chunk & 127, b = bh / 6, h = bh % 6;
        const bf16_t* z = (const bf16_t*)(ws + WS_R1) + (size_t)(b * T + c * 64) * ZW;
        LAS bf16_t* klT = (LAS bf16_t*)(lds + wave * 18432);
        LAS bf16_t* vT = klT + 64 * 72;
        const float lb = hgrn_lb(inp(I_LBLOG), L, h * 64 + lane);
        LAS bf16_t* rawf = klT;
        (void)rawf;
        u32x4 rf[8], ri[8];
#pragma unroll
        for (int i = 0; i < 8; ++i) {
            const int row = (lane >> 3) + 8 * i, ch = lane & 7;
            rf[i] = *(const u32x4*)(z + (size_t)row * ZW + C_HF + 64 * h + 8 * ch);
            ri[i] = *(const u32x4*)(z + (size_t)row * ZW + C_HI + 64 * h + 8 * ch);
        }
#pragma unroll
        for (int i = 0; i < 8; ++i) {
            const int row = (lane >> 3) + 8 * i, ch = lane & 7;
            *(LAS u32x4*)(klT + row * 72 + 8 * ch) = rf[i];
            *(LAS u32x4*)(vT + row * 72 + 8 * ch) = ri[i];
        }
        LDSW();
        float suffix = 0.f;
        bf16_t colf[64], colv[64];
#pragma unroll
        for (int s2 = 0; s2 < 64; ++s2) { colf[s2] = klT[s2 * 72 + lane]; colv[s2] = vT[s2 * 72 + lane]; }
        LDSW();
#pragma unroll
        for (int s = 63; s >= 0; --s) {
            const float fr = bf2f(colf[s]);
            const float sg = sigmoidf_(fr);
            const float f = lb + (1.0f - lb) * sg;
            const float ig = (1.0f - lb) * (1.0f - sg);
            klT[lane * 72 + s] = f2bf(ig * __expf(suffix));
            vT[lane * 72 + s] = colv[s];
            suffix += __logf(f);
        }
        ((float*)(ws + WS_HD))[(size_t)chunk * 64 + lane] = __expf(suffix);
        LDSW();
        const int r32 = lane & 31, hi = lane >> 5;
        float* hs = (float*)(ws + WS_HS) + (size_t)chunk * 4096;
#pragma unroll
        for (int kb = 0; kb < 2; ++kb)
#pragma unroll
            for (int vb = 0; vb < 2; ++vb) {
                f32x16 cacc = {};
#pragma unroll
                for (int cc = 0; cc < 4; ++cc) {
                    const bf16x8 a = *(const LAS bf16x8*)(klT + (32 * kb + r32) * 72 + 16 * cc + 8 * hi);
                    const bf16x8 bb = *(const LAS bf16x8*)(vT + (32 * vb + r32) * 72 + 16 * cc + 8 * hi);
                    cacc = mfma32(a, bb, cacc);
                }
#pragma unroll
                for (int r = 0; r < 16; ++r) hs[(32 * kb + crow(r, hi)) * 64 + 32 * vb + r32] = cacc[r];
            }
    }
}
__device__ __forceinline__ void task_hgrn_scan(unsigned char* ws, int task) {
    const int tid = TID();
    const int bh = task >> 3, k = (task & 7) * 8 + (tid >> 6), v = tid & 63;
    float* hs = (float*)(ws + WS_HS) + (size_t)bh * 128 * 4096 + k * 64 + v;
    const float* hd = (const float*)(ws + WS_HD) + (size_t)bh * 128 * 64 + k;
    float S = 0.f;
#pragma unroll 16
    for (int c = 0; c < 128; ++c) {
        const float a = hs[(size_t)c * 4096], d = hd[c * 64];
        hs[(size_t)c * 4096] = S;
        S = d * S + a;
    }
}
__device__ __forceinline__ void task_hgrn_out(const float* const* in, unsigned char* ws, int L, int task, LAS unsigned char* lds) {
    const int tid = TID(), lane = tid & 63, wave = tid >> 6;
    if (wave < 3) {
        const int chunk = task * 3 + wave;
        const int bh = chunk >> 7, c = chunk & 127, b = bh / 6, h = bh % 6;
        const size_t row0 = (size_t)(b * T + c * 64);
        const bf16_t* z = (const bf16_t*)(ws + WS_R1) + row0 * ZW;
        LAS bf16_t* ke = (LAS bf16_t*)(lds + wave * 36864);
        LAS bf16_t* qe = ke + 64 * 72;
        LAS bf16_t* vT = qe + 64 * 72;
        LAS bf16_t* sT = vT + 64 * 72;
        const float lb = hgrn_lb(inp(I_LBLOG), L, h * 64 + lane);
        {
            u32x4 rq[8], rf[8], ri[8];
#pragma unroll
            for (int i = 0; i < 8; ++i) {
                const int row = (lane >> 3) + 8 * i, ch = lane & 7;
                rq[i] = *(const u32x4*)(z + (size_t)row * ZW + C_HQ + 64 * h + 8 * ch);
                rf[i] = *(const u32x4*)(z + (size_t)row * ZW + C_HF + 64 * h + 8 * ch);
                ri[i] = *(const u32x4*)(z + (size_t)row * ZW + C_HI + 64 * h + 8 * ch);
            }
#pragma unroll
            for (int i = 0; i < 8; ++i) {
                const int row = (lane >> 3) + 8 * i, ch = lane & 7;
                *(LAS u32x4*)(qe + row * 72 + 8 * ch) = rq[i];
                *(LAS u32x4*)(ke + row * 72 + 8 * ch) = rf[i];
                *(LAS u32x4*)(sT + row * 72 + 8 * ch) = ri[i];
            }
        }
        LDSW();
        float ref = 0.f;
#pragma unroll 8
        for (int s = 0; s < 32; ++s) {
            const float fr = bf2f(ke[s * 72 + lane]);
            ref += __logf(lb + (1.0f - lb) * sigmoidf_(fr));
        }
        float cum = 0.f;
#pragma unroll 8
        for (int s = 0; s < 64; ++s) {
            const float fr = bf2f(ke[s * 72 + lane]);
            const float qv = bf2f(qe[s * 72 + lane]);
            const bf16_t vraw = sT[s * 72 + lane];
            const float sg = sigmoidf_(fr);
            const float f = lb + (1.0f - lb) * sg;
            const float ig = (1.0f - lb) * (1.0f - sg);
            cum += __logf(f);
            qe[s * 72 + lane] = f2bf(qv * sigmoidf_(qv) * __expf(cum - ref));
            ke[s * 72 + lane] = f2bf(ig * __expf(ref - cum));
            vT[lane * 72 + s] = vraw;
        }
        LDSW();
        const float* hs = (const float*)(ws + WS_HS) + (size_t)chunk * 4096;
        const float eref = __expf(ref);
        {
            f32x4 hv[16];
#pragma unroll
            for (int i = 0; i < 16; ++i) hv[i] = *(const f32x4*)(hs + ((lane >> 4) + 4 * i) * 64 + (lane & 15) * 4);
#pragma unroll
            for (int i = 0; i < 16; ++i) {
                const int k = (lane >> 4) + 4 * i, v4 = (lane & 15) * 4;
                const float er = __shfl(eref, k);
                sT[(v4 + 0) * 72 + k] = f2bf(hv[i][0] * er); sT[(v4 + 1) * 72 + k] = f2bf(hv[i][1] * er);
                sT[(v4 + 2) * 72 + k] = f2bf(hv[i][2] * er); sT[(v4 + 3) * 72 + k] = f2bf(hv[i][3] * er);
            }
        }
        LDSW();
        const int r32 = lane & 31, hi = lane >> 5;
        f32x16 O[2][2] = {};
#pragma unroll
        for (int tb = 0; tb < 2; ++tb) {
            bf16x8 qf[4];
#pragma unroll
            for (int cc = 0; cc < 4; ++cc) qf[cc] = *(const LAS bf16x8*)(qe + (32 * tb + r32) * 72 + 16 * cc + 8 * hi);
#pragma unroll
            for (int vb = 0; vb < 2; ++vb)
#pragma unroll
                for (int cc = 0; cc < 4; ++cc) {
                    const bf16x8 a = *(const LAS bf16x8*)(sT + (32 * vb + r32) * 72 + 16 * cc + 8 * hi);
                    O[vb][tb] = mfma32(a, qf[cc], O[vb][tb]);
                }
#pragma unroll
            for (int sb = 0; sb <= tb; ++sb) {
                f32x16 sc = {};
#pragma unroll
                for (int cc = 0; cc < 4; ++cc) {
                    const bf16x8 a = *(const LAS bf16x8*)(ke + (32 * sb + r32) * 72 + 16 * cc + 8 * hi);
                    sc = mfma32(a, qf[cc], sc);
                }
                unsigned P[8];
#pragma unroll
                for (int j = 0; j < 8; ++j) {
                    float p0 = sc[2 * j], p1 = sc[2 * j + 1];
                    if (sb == tb) { if (crow(2 * j, hi) > r32) p0 = 0.f; if (crow(2 * j + 1, hi) > r32) p1 = 0.f; }
                    P[j] = pk2(p0, p1);
                }
#pragma unroll
                for (int vb = 0; vb < 2; ++vb)
#pragma unroll
                    for (int c2 = 0; c2 < 2; ++c2) {
                        const u32x2 a0 = *(const LAS u32x2*)(vT + (32 * vb + r32) * 72 + 32 * sb + 16 * c2 + 4 * hi);
                        const u32x2 a1 = *(const LAS u32x2*)(vT + (32 * vb + r32) * 72 + 32 * sb + 16 * c2 + 8 + 4 * hi);
                        const bf16x8 vf = as_bf16x8((u32x4){a0.x, a0.y, a1.x, a1.y});
                        const bf16x8 pf = as_bf16x8((u32x4){P[4 * c2], P[4 * c2 + 1], P[4 * c2 + 2], P[4 * c2 + 3]});
                        O[vb][tb] = mfma32(vf, pf, O[vb][tb]);
                    }
            }
        }
        LDSW();
        const float* on = inp(I_HON) + L * 64;
#pragma unroll
        for (int tb = 0; tb < 2; ++tb) {
            float ss = 0.f;
#pragma unroll
            for (int vb = 0; vb < 2; ++vb)
#pragma unroll
                for (int r = 0; r < 16; ++r) ss += O[vb][tb][r] * O[vb][tb][r];
            ss += __shfl_xor(ss, 32);
            const float rn = rsqrtf(ss * (1.0f / 64.0f) + EPS);
#pragma unroll
            for (int vb = 0; vb < 2; ++vb)
#pragma unroll
                for (int r = 0; r < 16; ++r) { const int v = 32 * vb + crow(r, hi); ke[(32 * tb + r32) * 72 + v] = f2bf(O[vb][tb][r] * rn * on[v]); }
        }
        LDSW();
        bf16_t* mixed = (bf16_t*)(ws + WS_MIX) + row0 * DM + 640 + 64 * h;
#pragma unroll
        for (int i = 0; i < 8; ++i) {
            const int t = i * 8 + (lane >> 3), ch = lane & 7;
            const u32x4 ov = *(const LAS u32x4*)(ke + t * 72 + 8 * ch);
            const u32x4 gv = *(const u32x4*)(z + (size_t)t * ZW + C_HG + 64 * h + 8 * ch);
            u32x4 w;
            { const float g0 = bflo(gv.x), g1 = bfhi(gv.x); w.x = pk2(bflo(ov.x) * g0 * sigmoidf_(g0), bfhi(ov.x) * g1 * sigmoidf_(g1)); }
            { const float g0 = bflo(gv.y), g1 = bfhi(gv.y); w.y = pk2(bflo(ov.y) * g0 * sigmoidf_(g0), bfhi(ov.y) * g1 * sigmoidf_(g1)); }
            { const float g0 = bflo(gv.z), g1 = bfhi(gv.z); w.z = pk2(bflo(ov.z) * g0 * sigmoidf_(g0), bfhi(ov.z) * g1 * sigmoidf_(g1)); }
            { const float g0 = bflo(gv.w), g1 = bfhi(gv.w); w.w = pk2(bflo(ov.w) * g0 * sigmoidf_(g0), bfhi(ov.w) * g1 * sigmoidf_(g1)); }
            *(u32x4*)(mixed + (size_t)t * DM + 8 * ch) = w;
        }
    }
}

constexpr int ATT_K = 0, ATT_V = 18432, ATT_LUT = 35840, ATT_STAGE = 36864;
__device__ __forceinline__ void build_lut(LAS float* lut, const float* rel_bias, int head) {
    const int d = TID();
    if (d <= 128) {
        int bk = d;
        if (d >= 16) { const int far = 16 + (int)(__logf((float)d * (1.0f / 16.0f)) / 2.0794415416798357f * 16.0f); bk = far < 31 ? far : 31; }
        lut[d] = rel_bias[bk * 10 + head] * LOG2E;
    }
}
template <int NMAP, bool HAS_SEL, bool FAST>
__device__ __forceinline__ void attn_tile(const LAS unsigned char* Kb, const LAS unsigned char* Vb, const bf16x8 (&qr)[4], int tq, int k0, int win, float c31, const LAS float* lut, bool sel,
                                          f32x16 (&O)[NMAP][2], float (&l)[NMAP], int r32, int hi) {
    unsigned P[NMAP][2][8];
#pragma unroll
    for (int kh2 = 0; kh2 < 2; ++kh2) {
        f32x16 S[NMAP];
        const float ini = FAST ? ((HAS_SEL && !sel) ? -30000.f : c31) : 0.f;
#pragma unroll
        for (int mp = 0; mp < NMAP; ++mp)
#pragma unroll
            for (int r = 0; r < 16; ++r) S[mp][r] = ini;
#pragma unroll
        for (int c = 0; c < 4; ++c) {
            const bf16x8 kf = *(const LAS bf16x8*)(Kb + (32 * kh2 + r32) * 144 + (16 * c + 8 * hi) * 2);
            const int mp = (NMAP == 2) ? (c >> 1) : 0;
            S[mp] = mfma32(kf, qr[c], S[mp]);
        }
#pragma unroll
        for (int mp = 0; mp < NMAP; ++mp) {
            float p[16];
            if (FAST) {
#pragma unroll
                for (int r = 0; r < 16; ++r) p[r] = ex2(S[mp][r]);
            } else {
#pragma unroll
                for (int r = 0; r < 16; ++r) {
                    const int d = tq - (k0 + 32 * kh2 + crow(r, hi));
                    const bool valid = sel && d >= 0 && d < win;
                    const int dc = d < 0 ? 0 : (d > 128 ? 128 : d);
                    const float e = ex2(S[mp][r] + lut[dc]);
                    p[r] = valid ? e : 0.f;
                }
            }
            float s = 0.f;
#pragma unroll
            for (int r = 0; r < 16; ++r) s += p[r];
            l[mp] += s;
#pragma unroll
            for (int j = 0; j < 8; ++j) P[mp][kh2][j] = pk2(p[2 * j], p[2 * j + 1]);
        }
        if (NMAP == 2) __builtin_amdgcn_sched_barrier(0);
    }
#pragma unroll
    for (int cc = 0; cc < 4; ++cc)
#pragma unroll
        for (int db = 0; db < 2; ++db) {
            const u32x2 a0 = *(const LAS u32x2*)(Vb + (32 * db + r32) * 136 + (16 * cc + 4 * hi) * 2);
            const u32x2 a1 = *(const LAS u32x2*)(Vb + (32 * db + r32) * 136 + (16 * cc + 8 + 4 * hi) * 2);
            const bf16x8 vf = as_bf16x8((u32x4){a0.x, a0.y, a1.x, a1.y});
#pragma unroll
            for (int mp = 0; mp < NMAP; ++mp) {
                const bf16x8 pf = as_bf16x8((u32x4){P[mp][cc >> 1][4 * (cc & 1)], P[mp][cc >> 1][4 * (cc & 1) + 1], P[mp][cc >> 1][4 * (cc & 1) + 2], P[mp][cc >> 1][4 * (cc & 1) + 3]});
                O[mp][db] = mfma32(vf, pf, O[mp][db]);
            }
        }
}
template <int NMAP, bool HAS_SEL>
__device__ __forceinline__ void attn_pass(LAS unsigned char* lds, const bf16_t* Kth, size_t kts, const bf16_t* Vth, int m_lo, int m_hi,
                                          const bf16x8 (&qr)[4], int tq, int qw0, int win, const LAS float* lut, u32x4 selw,
                                          f32x16 (&O)[NMAP][2], float (&l)[NMAP]) {
    const int tid = TID(), lane = tid & 63, r32 = lane & 31, hi = lane >> 5;
    const float c31 = lut[128];
    u32x4 kreg = *(const u32x4*)(Kth + (size_t)m_lo * kts), vreg = *(const u32x4*)(Vth + (size_t)m_lo * 64);
    int buf = 0;
    for (int m = m_lo; m <= m_hi; ++m) {
        *(LAS u32x4*)(lds + ATT_K + buf * 9216 + (tid >> 3) * 144 + (tid & 7) * 16) = kreg;
        { LAS u32x2* vp = (LAS u32x2*)(lds + ATT_V + buf * 8704 + (tid >> 3) * 136 + (tid & 7) * 16); vp[0] = (u32x2){vreg.x, vreg.y}; vp[1] = (u32x2){vreg.z, vreg.w}; }
        __syncthreads();
        if (m < m_hi) { kreg = *(const u32x4*)(Kth + (size_t)(m + 1) * kts); vreg = *(const u32x4*)(Vth + (size_t)(m + 1) * 64); }
        const int k0 = 64 * m, dmin = qw0 - (k0 + 63), dmax = qw0 + 31 - k0;
        bool sel = true;
        if (HAS_SEL) { const unsigned w = m < 32 ? selw.x : (m < 64 ? selw.y : (m < 96 ? selw.z : selw.w)); sel = (w >> (m & 31)) & 1u; }
        bool active = dmax >= 0 && dmin < win;
        if (HAS_SEL) active = active && (__any(sel) != 0);
        if (active) {
            if (NMAP == 1) {
                const LAS unsigned char* Kb = lds + ATT_K + buf * 9216;
                const LAS unsigned char* Vb = lds + ATT_V + buf * 8704;
                if (dmin >= 128 && dmax < win) attn_tile<NMAP, HAS_SEL, true>(Kb, Vb, qr, tq, k0, win, c31, lut, sel, O, l, r32, hi);
                else attn_tile<NMAP, HAS_SEL, false>(Kb, Vb, qr, tq, k0, win, c31, lut, sel, O, l, r32, hi);
            } else {
            const bool fast = dmin >= 128 && dmax < win;
            const LAS unsigned char* Kb = lds + ATT_K + buf * 9216;
            const LAS unsigned char* Vb = lds + ATT_V + buf * 8704;
            unsigned P[NMAP][2][8];
#pragma unroll
            for (int kh2 = 0; kh2 < 2; ++kh2) {
                f32x16 S[NMAP];
#pragma unroll
                for (int mp = 0; mp < NMAP; ++mp) { const float ini = fast ? c31 : 0.f;
#pragma unroll
                    for (int r = 0; r < 16; ++r) S[mp][r] = ini; }
#pragma unroll
                for (int c = 0; c < 4; ++c) {
                    const bf16x8 kf = *(const LAS bf16x8*)(Kb + (32 * kh2 + r32) * 144 + (16 * c + 8 * hi) * 2);
                    const int mp = (NMAP == 2) ? (c >> 1) : 0;
                    S[mp] = mfma32(kf, qr[c], S[mp]);
                }
#pragma unroll
                for (int mp = 0; mp < NMAP; ++mp) {
                    float p[16];
                    if (fast) {
#pragma unroll
                        for (int r = 0; r < 16; ++r) { const float e = ex2(S[mp][r]); p[r] = sel ? e : 0.f; }
                    } else {
#pragma unroll
                        for (int r = 0; r < 16; ++r) {
                            const int d = tq - (k0 + 32 * kh2 + crow(r, hi));
                            const bool valid = sel && d >= 0 && d < win;
                            const int dc = d < 0 ? 0 : (d > 128 ? 128 : d);
                            const float e = ex2(S[mp][r] + lut[dc]);
                            p[r] = valid ? e : 0.f;
                        }
                    }
                    float s = 0.f;
#pragma unroll
                    for (int r = 0; r < 16; ++r) s += p[r];
                    l[mp] += s;
#pragma unroll
                    for (int j = 0; j < 8; ++j) P[mp][kh2][j] = pk2(p[2 * j], p[2 * j + 1]);
                }
            }
#pragma unroll
            for (int db = 0; db < 2; ++db)
#pragma unroll
                for (int cc = 0; cc < 4; ++cc) {
                    const u32x2 a0 = *(const LAS u32x2*)(Vb + (32 * db + r32) * 136 + (16 * cc + 4 * hi) * 2);
                    const u32x2 a1 = *(const LAS u32x2*)(Vb + (32 * db + r32) * 136 + (16 * cc + 8 + 4 * hi) * 2);
                    const bf16x8 vf = as_bf16x8((u32x4){a0.x, a0.y, a1.x, a1.y});
#pragma unroll
                    for (int mp = 0; mp < NMAP; ++mp) {
                        const bf16x8 pf = as_bf16x8((u32x4){P[mp][cc >> 1][4 * (cc & 1)], P[mp][cc >> 1][4 * (cc & 1) + 1], P[mp][cc >> 1][4 * (cc & 1) + 2], P[mp][cc >> 1][4 * (cc & 1) + 3]});
                        O[mp][db] = mfma32(vf, pf, O[mp][db]);
                    }
                }
            }
        }
        buf ^= 1;
    }
    __syncthreads();
}
template <bool ADD>
__device__ __forceinline__ void store_ot(LAS unsigned char* stage, const float (&val)[2][16], bf16_t* dst, int ld, const bf16_t* addsrc = nullptr, int ldadd = 0) {
    const int lane = TID() & 63, r32 = lane & 31, hi = lane >> 5;
    LAS bf16_t* st = (LAS bf16_t*)stage;
#pragma unroll
    for (int db = 0; db < 2; ++db)
#pragma unroll
        for (int r = 0; r < 16; ++r) st[r32 * 72 + 32 * db + crow(r, hi)] = f2bf(val[db][r]);
    LDSW();
#pragma unroll
    for (int i = 0; i < 4; ++i) {
        const int row = i * 8 + (lane >> 3), ch = lane & 7;
        u32x4 v = *(const LAS u32x4*)(st + row * 72 + 8 * ch);
        bf16_t* gp = dst + (size_t)row * ld + 8 * ch;
        if (ADD) {
            const u32x4 o = *(const u32x4*)(addsrc + (size_t)row * ldadd + 8 * ch);
            v.x = pk2(bflo(v.x) + bflo(o.x), bfhi(v.x) + bfhi(o.x)); v.y = pk2(bflo(v.y) + bflo(o.y), bfhi(v.y) + bfhi(o.y));
            v.z = pk2(bflo(v.z) + bflo(o.z), bfhi(v.z) + bfhi(o.z)); v.w = pk2(bflo(v.w) + bflo(o.w), bfhi(v.w) + bfhi(o.w));
        }
        *(u32x4*)gp = v;
    }
    LDSW();
}

__device__ __forceinline__ void task_diff(const float* const* in, unsigned char* ws, int L, int task, LAS unsigned char* lds) {
    const int tid = TID(), lane = tid & 63, wave = tid >> 6, r32 = lane & 31, hi = lane >> 5;
    const int qb = 31 - (task >> 4), b = (task >> 2) & 3, hd = task & 3;
    const bf16_t* z = (const bf16_t*)(ws + WS_R1);
    LAS float* lut = (LAS float*)(lds + ATT_LUT);
    build_lut(lut, inp(I_RELB), 6 + hd);
    __syncthreads();
    const int q0 = 256 * qb, qw0 = q0 + 32 * wave, tq = qw0 + r32;
    bf16x8 qr[4];
#pragma unroll
    for (int c = 0; c < 4; ++c) qr[c] = *(const bf16x8*)(z + (size_t)(b * T + tq) * ZW + C_DQ + 64 * hd + 16 * c + 8 * hi);
    const bf16_t* Kth = z + (size_t)(b * T + (tid >> 3)) * ZW + C_DK + 64 * hd + (tid & 7) * 8;
    const bf16_t* Vth = (const bf16_t*)(ws + WS_VT) + ((size_t)(b * 8 + 4 + hd) * 64 + (tid >> 3)) * T + (tid & 7) * 8;
    f32x16 O[2][2] = {}; float l[2] = {0.f, 0.f};
    attn_pass<2, false>(lds, Kth, (size_t)64 * ZW, Vth, 0, 4 * qb + 3, qr, tq, qw0, 1 << 30, lut, (u32x4){0u, 0u, 0u, 0u}, O, l);
    const float* lp = inp(I_DLAM) + L * 128;
    float s01 = 0.f, s23 = 0.f;
#pragma unroll
    for (int i = 0; i < 32; ++i) { s01 += lp[i] * lp[32 + i]; s23 += lp[64 + i] * lp[96 + i]; }
    const float lam_init = 0.8f - 0.6f * __expf(-0.3f * (float)L);
    const float lam = __expf(s01) - __expf(s23) + lam_init;
    const float l0 = l[0] + __shfl_xor(l[0], 32), l1 = l[1] + __shfl_xor(l[1], 32);
    const float i0 = __builtin_amdgcn_rcpf(l0), i1 = lam * __builtin_amdgcn_rcpf(l1);
    float val[2][16]; float ss = 0.f;
#pragma unroll
    for (int db = 0; db < 2; ++db)
#pragma unroll
        for (int r = 0; r < 16; ++r) { const float o = O[0][db][r] * i0 - O[1][db][r] * i1; val[db][r] = o; ss += o * o; }
    ss += __shfl_xor(ss, 32);
    const float rn = rsqrtf(ss * (1.0f / 64.0f) + EPS) * (1.0f - lam_init);
    const float* sub = inp(I_DSUB) + L * 64;
#pragma unroll
    for (int db = 0; db < 2; ++db)
#pragma unroll
        for (int r = 0; r < 16; ++r) val[db][r] *= rn * sub[32 * db + crow(r, hi)];
    store_ot<false>(lds + ATT_STAGE + wave * 4608, val, (bf16_t*)(ws + WS_MIX) + (size_t)(b * T + qw0) * DM + 384 + 64 * hd, DM);
}

__device__ __forceinline__ void task_nsa_sw(const float* const* in, unsigned char* ws, int L, int task, LAS unsigned char* lds) {
    const int tid = TID(), lane = tid & 63, wave = tid >> 6, r32 = lane & 31, hi = lane >> 5;
    const int qb = 31 - task / 24, rem = task % 24, b = rem / 6, h = rem % 6, g = h / 3;
    const bf16_t* z = (const bf16_t*)(ws + WS_R1);
    LAS float* lut = (LAS float*)(lds + ATT_LUT);
    build_lut(lut, inp(I_RELB), h);
    __syncthreads();
    const int q0 = 256 * qb, qw0 = q0 + 32 * wave, tq = qw0 + r32;
    const bf16_t* zq = z + (size_t)(b * T + tq) * ZW;
    bf16x8 qr[4];
#pragma unroll
    for (int c = 0; c < 4; ++c) qr[c] = *(const bf16x8*)(zq + C_NQ + 64 * h + 16 * c + 8 * hi);
    const u32x4 selw = *(const u32x4*)((const unsigned*)(ws + WS_SELM) + ((size_t)(b * 2 + g) * T + tq) * 4);
    const float g1 = sigmoidf_(bf2f(zq[C_NG + 3 * h + 1])), g2 = sigmoidf_(bf2f(zq[C_NG + 3 * h + 2]));
    float val[2][16];
    {
        const bf16_t* Kth = z + (size_t)(b * T + (tid >> 3)) * ZW + C_SK + 64 * g + (tid & 7) * 8;
        const bf16_t* Vth = (const bf16_t*)(ws + WS_VT) + ((size_t)(b * 8 + g) * 64 + (tid >> 3)) * T + (tid & 7) * 8;
        f32x16 O[1][2] = {}; float l[1] = {0.f};
        attn_pass<1, true>(lds, Kth, (size_t)64 * ZW, Vth, 0, 4 * qb + 3, qr, tq, qw0, 1 << 30, lut, selw, O, l);
        const float lt = l[0] + __shfl_xor(l[0], 32), sc = g1 / lt;
#pragma unroll
        for (int db = 0; db < 2; ++db)
#pragma unroll
            for (int r = 0; r < 16; ++r) val[db][r] = O[0][db][r] * sc;
    }
    {
        const bf16_t* Kth = z + (size_t)(b * T + (tid >> 3)) * ZW + C_WK + 64 * g + (tid & 7) * 8;
        const bf16_t* Vth = (const bf16_t*)(ws + WS_VT) + ((size_t)(b * 8 + 2 + g) * 64 + (tid >> 3)) * T + (tid & 7) * 8;
        f32x16 O[1][2] = {}; float l[1] = {0.f};
        const int m_lo = q0 >= 512 ? (q0 >> 6) - 8 : 0;
        attn_pass<1, false>(lds, Kth, (size_t)64 * ZW, Vth, m_lo, 4 * qb + 3, qr, tq, qw0, 512, lut, (u32x4){0u, 0u, 0u, 0u}, O, l);
        const float lt = l[0] + __shfl_xor(l[0], 32), sc = g2 / lt;
#pragma unroll
        for (int db = 0; db < 2; ++db)
#pragma unroll
            for (int r = 0; r < 16; ++r) val[db][r] += O[0][db][r] * sc;
    }
    store_ot<true>(lds + ATT_STAGE + wave * 4608, val, (bf16_t*)(ws + WS_MIX) + (size_t)(b * T + qw0) * DM + 64 * h, DM, (const bf16_t*)(ws + WS_OCB) + (size_t)(b * T + qw0) * 384 + 64 * h, 384);
}

__device__ __forceinline__ unsigned wave_max_u32(unsigned v) {
    unsigned t;
    t = (unsigned)__builtin_amdgcn_update_dpp(0, (int)v, 0xB1, 0xF, 0xF, false); v = t > v ? t : v;
    t = (unsigned)__builtin_amdgcn_update_dpp(0, (int)v, 0x4E, 0xF, 0xF, false); v = t > v ? t : v;
    t = (unsigned)__builtin_amdgcn_update_dpp(0, (int)v, 0x141, 0xF, 0xF, false); v = t > v ? t : v;
    t = (unsigned)__builtin_amdgcn_update_dpp(0, (int)v, 0x140, 0xF, 0xF, false); v = t > v ? t : v;
    t = (unsigned)__builtin_amdgcn_update_dpp(0, (int)v, 0x142, 0xA, 0xF, false); v = t > v ? t : v;
    t = (unsigned)__builtin_amdgcn_update_dpp(0, (int)v, 0x143, 0xC, 0xF, false); v = t > v ? t : v;
    return (unsigned)__builtin_amdgcn_readlane((int)v, 63);
}
constexpr int NC_IMP = 18432, NC_IMPW = 129, NC_LINV = NC_IMP + 3 * 64 * NC_IMPW * 4;
__device__ __forceinline__ void task_nsa_c(const float* const* in, unsigned char* ws, int L, int task, LAS unsigned char* lds) {
    const int tid = TID(), lane = tid & 63, wave = tid >> 6, r32 = lane & 31, hi = lane >> 5;
    const int cur = 127 - (task >> 3), b = (task >> 1) & 3, g = task & 1;
    const bf16_t* z = (const bf16_t*)(ws + WS_R1);
    LAS float* imp = (LAS float*)(lds + NC_IMP);
    LAS float* linv = (LAS float*)(lds + NC_LINV);
    const int q0 = 64 * cur;
    const int rh = wave >> 1, half = wave & 1, h = 3 * g + (rh < 3 ? rh : 0);
    const int ql = 32 * half + r32, tq = q0 + ql;
    const bf16_t* zq = z + (size_t)(b * T + tq) * ZW;
    bf16x8 qr[4];
#pragma unroll
    for (int c = 0; c < 4; ++c) qr[c] = *(const bf16x8*)(zq + C_NQ + 64 * h + 16 * c + 8 * hi);
    const bf16_t* Kth = (const bf16_t*)(ws + WS_KC) + ((size_t)(b * 2 + g) * 512 + (tid >> 3)) * 64 + (tid & 7) * 8;
    const bf16_t* Vth = (const bf16_t*)(ws + WS_VCT) + ((size_t)(b * 2 + g) * 64 + (tid >> 3)) * 512 + (tid & 7) * 8;
    const int ntiles = ((4 * cur + 2) >> 6) + 1;
    f32x16 O[2] = {}; float l = 0.f, carry = 0.f;
    u32x4 kreg = *(const u32x4*)(Kth), vreg = *(const u32x4*)(Vth);
    for (int m = 0; m < ntiles; ++m) {
        __syncthreads();
        *(LAS u32x4*)(lds + (tid >> 3) * 144 + (tid & 7) * 16) = kreg;
        { LAS u32x2* vp = (LAS u32x2*)(lds + 9216 + (tid >> 3) * 136 + (tid & 7) * 16); vp[0] = (u32x2){vreg.x, vreg.y}; vp[1] = (u32x2){vreg.z, vreg.w}; }
        __syncthreads();
        if (m + 1 < ntiles) { kreg = *(const u32x4*)(Kth + (size_t)(m + 1) * 64 * 64); vreg = *(const u32x4*)(Vth + (size_t)(m + 1) * 64); }
        if (wave < 6) {
            unsigned P[2][8]; float av[8], bq[8];
#pragma unroll
            for (int kh2 = 0; kh2 < 2; ++kh2) {
                f32x16 S = {};
#pragma unroll
                for (int c = 0; c < 4; ++c) { const bf16x8 kf = *(const LAS bf16x8*)(lds + (32 * kh2 + r32) * 144 + (16 * c + 8 * hi) * 2); S = mfma32(kf, qr[c], S); }
                float p[16];
#pragma unroll
                for (int r = 0; r < 16; ++r) { const int n = 64 * m + 32 * kh2 + crow(r, hi); const float e = ex2(S[r]); p[r] = (16 * n + 31 <= tq) ? e : 0.f; }
                float s = 0.f;
#pragma unroll
                for (int r = 0; r < 16; ++r) s += p[r];
                l += s;
#pragma unroll
                for (int j = 0; j < 8; ++j) P[kh2][j] = pk2(p[2 * j], p[2 * j + 1]);
#pragma unroll
                for (int j = 0; j < 4; ++j) { av[4 * kh2 + j] = p[4 * j] + p[4 * j + 1] + p[4 * j + 2] + 0.5f * p[4 * j + 3]; bq[4 * kh2 + j] = 0.5f * p[4 * j + 3]; }
            }
#pragma unroll
            for (int db = 0; db < 2; ++db)
#pragma unroll
                for (int cc = 0; cc < 4; ++cc) {
                    const u32x2 a0 = *(const LAS u32x2*)(lds + 9216 + (32 * db + r32) * 136 + (16 * cc + 4 * hi) * 2);
                    const u32x2 a1 = *(const LAS u32x2*)(lds + 9216 + (32 * db + r32) * 136 + (16 * cc + 8 + 4 * hi) * 2);
                    const bf16x8 vf = as_bf16x8((u32x4){a0.x, a0.y, a1.x, a1.y});
                    const bf16x8 pf = as_bf16x8((u32x4){P[cc >> 1][4 * (cc & 1)], P[cc >> 1][4 * (cc & 1) + 1], P[cc >> 1][4 * (cc & 1) + 2], P[cc >> 1][4 * (cc & 1) + 3]});
                    O[db] = mfma32(vf, pf, O[db]);
                }
            float recv[8];
#pragma unroll
            for (int jj = 0; jj < 8; ++jj) { auto rr = __builtin_amdgcn_permlane32_swap(__float_as_uint(bq[jj]), __float_as_uint(bq[jj]), false, false); recv[jj] = __uint_as_float(hi ? rr[0] : rr[1]); }
            LAS float* ip = imp + (rh * 64 + ql) * NC_IMPW + 16 * m + hi;
#pragma unroll
            for (int jj = 0; jj < 8; ++jj) {
                const float add = hi ? recv[jj] : (jj == 0 ? carry : recv[jj > 0 ? jj - 1 : 0]);
                ip[2 * jj] = av[jj] + add;
            }
            carry = recv[7];
        }
    }
    if (wave < 6) {
        const float lt = l + __shfl_xor(l, 32);
        const float li = (tq >= 31 && lt > 0.f) ? 1.0f / lt : 0.f;
        if (hi == 0) linv[rh * 64 + ql] = li;
        const float g0 = sigmoidf_(bf2f(zq[C_NG + 3 * h + 0]));
        bf16_t* mx = (bf16_t*)(ws + WS_OCB) + (size_t)(b * T + tq) * 384 + 64 * h;
        const float sc = li * g0;
#pragma unroll
        for (int db = 0; db < 2; ++db)
#pragma unroll
            for (int r = 0; r < 16; ++r) mx[32 * db + crow(r, hi)] = f2bf(O[db][r] * sc);
    }
    __syncthreads();
#pragma unroll 1
    for (int qi = 0; qi < 8; ++qi) {
        const int q = 8 * wave + qi;
        unsigned w0 = 0u, w1 = 0u, w2 = 0u, w3 = 0u;
        if (cur <= 15) { w0 = (1u << (cur + 1)) - 1u; }
        else {
            const float i0 = linv[q], i1 = linv[64 + q], i2 = linv[128 + q];
            const int ma = lane, mb = lane + 64;
            float va = 0.f, vb = 0.f;
            if (ma >= 1 && ma <= cur - 2) va = imp[(0 * 64 + q) * NC_IMPW + ma] * i0 + imp[(1 * 64 + q) * NC_IMPW + ma] * i1 + imp[(2 * 64 + q) * NC_IMPW + ma] * i2;
            if (mb <= cur - 2) vb = imp[(0 * 64 + q) * NC_IMPW + mb] * i0 + imp[(1 * 64 + q) * NC_IMPW + mb] * i1 + imp[(2 * 64 + q) * NC_IMPW + mb] * i2;
            unsigned ka = va > 0.f ? ((__float_as_uint(va) & ~127u) | (unsigned)(127 - ma)) : 0u;
            unsigned kb = vb > 0.f ? ((__float_as_uint(vb) & ~127u) | (unsigned)(127 - mb)) : 0u;
            w0 = 1u;
#pragma unroll 1
            for (int it = 0; it < 13; ++it) {
                const unsigned best = wave_max_u32(ka > kb ? ka : kb);
                if (best != 0u) {
                    const int mw = 127 - (int)(best & 127u);
                    const unsigned bit = 1u << (mw & 31);
                    if (mw < 32) w0 |= bit; else if (mw < 64) w1 |= bit; else if (mw < 96) w2 |= bit; else w3 |= bit;
                    if (ka == best) ka = 0u;
                    if (kb == best) kb = 0u;
                }
            }
#pragma unroll
            for (int f = 0; f < 2; ++f) {
                const int mw = cur - f; const unsigned bit = 1u << (mw & 31);
                if (mw < 32) w0 |= bit; else if (mw < 64) w1 |= bit; else if (mw < 96) w2 |= bit; else w3 |= bit;
            }
        }
        if (lane == 0) *(u32x4*)((unsigned*)(ws + WS_SELM) + ((size_t)(b * 2 + g) * T + q0 + q) * 4) = (u32x4){w0, w1, w2, w3};
    }
}

#define XB_TMO      128
#define XB_XCNT(j)  (256  + 64 * (j))
#define XB_XSUB(j)  (1280 + 64 * (j))
#define XB_XGEN(j)  (2304 + 64 * (j))
#define XB_TOP      3328
#define XB_TOPGEN   3392
#define XCD_BAR_WORDS 3456
#define XB_SPIN_CAP (1u << 18)

__device__ __forceinline__ unsigned xb_ld(unsigned* p)              { return __hip_atomic_load(p, __ATOMIC_RELAXED, __HIP_MEMORY_SCOPE_AGENT); }
__device__ __forceinline__ unsigned xb_add(unsigned* p, unsigned v) { return __hip_atomic_fetch_add(p, v, __ATOMIC_RELAXED, __HIP_MEMORY_SCOPE_AGENT); }
__device__ __forceinline__ unsigned xb_xcc_id() { return (unsigned)__builtin_amdgcn_s_getreg((3 << 11) | 20) & 0xFu; }
#define XB_SPIN(cond, bar) do { unsigned _sp = 0; while (cond) { __builtin_amdgcn_s_sleep(1); \
    if ((++_sp & 255u) == 0u) { if (xb_ld(&(bar)[XB_TMO])) break; if (_sp > XB_SPIN_CAP) { atomicAdd(&(bar)[XB_TMO], 1u); break; } } } } while (0)

struct XcdBarrier {
    unsigned* bar; unsigned x;
    volatile LAS unsigned* st;
};

__device__ __forceinline__ XcdBarrier xcd_barrier_post(unsigned* bar, volatile LAS unsigned* st) {
    XcdBarrier b; b.bar = bar; b.x = xb_xcc_id(); b.st = st;
    if (threadIdx.x == 0) (void)xb_add(&bar[XB_XCNT(b.x)], 1u);
    return b;
}
__device__ __forceinline__ void xcd_barrier_complete(unsigned* bar, unsigned x, unsigned& nloc, unsigned& nx) {
    const unsigned G = gridDim.x * gridDim.y * gridDim.z;
    unsigned sum, cnt, mine, sp = 0u;
    for (;;) {
        sum = 0u; cnt = 0u; mine = 0u;
#pragma unroll
        for (unsigned j = 0; j < 16; ++j) { const unsigned c = xb_ld(&bar[XB_XCNT(j)]); sum += c; cnt += (c > 0u) ? 1u : 0u; mine = (j == x) ? c : mine; }
        if (sum == G) break;
        __builtin_amdgcn_s_sleep(1);
        if ((++sp & 255u) == 0u) { if (xb_ld(&bar[XB_TMO])) break; if (sp > XB_SPIN_CAP) { atomicAdd(&bar[XB_TMO], 1u); break; } }
    }
    nloc = mine > 0u ? mine : 1u; nx = cnt > 0u ? cnt : 1u;
}

__device__ __forceinline__ void xcd_barrier(const XcdBarrier& b) {
    asm volatile("s_waitcnt vmcnt(0)" ::: "memory");
    __syncthreads();
    if (threadIdx.x == 0) {
        unsigned* bar = b.bar;
        __builtin_amdgcn_s_waitcnt(0);
        unsigned nloc = b.st[0], nx = b.st[1];
        if (nloc == 0u) { xcd_barrier_complete(bar, b.x, nloc, nx); b.st[0] = nloc; b.st[1] = nx; }
        const unsigned old = xb_add(&bar[XB_XSUB(b.x)], 1u);
        const unsigned gen = old / nloc;
        if (old + 1u == (gen + 1u) * nloc) {
            __builtin_amdgcn_fence(__ATOMIC_RELEASE, "agent");
            asm volatile("s_waitcnt vmcnt(0)" ::: "memory");
            const unsigned og = xb_add(&bar[XB_TOP], 1u);
            const unsigned tg = og / nx;
            if (og + 1u == (tg + 1u) * nx) xb_add(&bar[XB_TOPGEN], 1u);
            else XB_SPIN(xb_ld(&bar[XB_TOPGEN]) == tg, bar);
            __builtin_amdgcn_fence(__ATOMIC_ACQUIRE, "agent");
            xb_add(&bar[XB_XGEN(b.x)], 1u);
            asm volatile("s_waitcnt vmcnt(0)" ::: "memory");
        } else {
            XB_SPIN(xb_ld(&bar[XB_XGEN(b.x)]) == gen, bar);
            __builtin_amdgcn_fence(__ATOMIC_ACQUIRE, "agent");
            asm volatile("s_waitcnt vmcnt(0)" ::: "memory");
        }
    }
    __syncthreads();
}

struct Args { const float* in[N_IN]; float* out; unsigned char* ws; int ph_lo, ph_hi; };
static_assert(sizeof(Args) == 8 * N_IN + 24, "Args has no padding");
constexpr int PH_PER_LAYER = 12, N_PHASES = DEPTH * PH_PER_LAYER;
#ifndef PH_HI
#ifdef REPJ
#define PH_HI (N_PHASES + DEPTH)
#else
#define PH_HI N_PHASES
#endif
#endif

__global__ void __launch_bounds__(512) mega(Args a) {
    extern __shared__ __attribute__((aligned(16))) unsigned char lds_raw[];
    LAS unsigned char* lds = (LAS unsigned char*)lds_raw;
    LAS int* slot = (LAS int*)(lds + LDS_MISC);
    cg::grid_group grid = cg::this_grid();
    const float* const* in = nullptr;
    volatile LAS unsigned* misc = (volatile LAS unsigned*)(lds + LDS_MISC);
    if (TID() < 16) misc[TID()] = 0u;
    __syncthreads();
    (void)xcd_barrier_post((unsigned*)(a.ws + WS_CTL) + 4096, misc + 8);
#ifndef DUP_GU
#define DUP_GU 0
#endif
#ifndef DUP_IN
#define DUP_IN 0
#endif
#ifndef DUP_DIFF
#define DUP_DIFF 0
#endif
#ifndef DUP_NSAC
#define DUP_NSAC 0
#endif
#ifndef DUP_SW
#define DUP_SW 0
#endif
#ifndef DUP_HOUT
#define DUP_HOUT 0
#endif
#ifndef DUP_M1
#define DUP_M1 0
#endif
#ifndef DUP_SYNC
#define DUP_SYNC 0
#endif
#ifndef DUP_CONV
#define DUP_CONV 0
#endif
#ifndef PHM
#define PHM 0xfff
#endif
    for (int ph = a.ph_lo; ph < a.ph_hi; ++ph) {
#ifdef REPJ
        int L = ph / (PH_PER_LAYER + 1); const int k_ = ph - L * (PH_PER_LAYER + 1); const int j = k_ <= REPJ ? k_ : k_ - 1; const float amul = (k_ == REPJ) ? 0.f : 1.f;
#else
        int L = ph / PH_PER_LAYER; const int j = ph - L * PH_PER_LAYER; const float amul = 1.f;
#endif
        asm volatile("" : "+s"(L));
        unsigned long long ws_ = (unsigned long long)a.ws; asm volatile("" : "+s"(ws_)); unsigned char* ws = (unsigned char*)(GAS unsigned char*)ws_;
        unsigned long long out_ = (unsigned long long)a.out; asm volatile("" : "+s"(out_)); float* out_g = (float*)(GAS float*)out_;
        unsigned* ctl = (unsigned*)(ws + WS_CTL); bf16_t* r1 = (bf16_t*)(ws + WS_R1); bf16_t* mixed = (bf16_t*)(ws + WS_MIX); bf16_t* pb = (bf16_t*)(ws + WS_PB); unsigned char* wb = ws + WS_W; float* rsqp = (float*)(ws + WS_RSQP);
        float* rsq = (float*)(ws + ((L & 1) ? WS_RSQ1 : WS_RSQ0)); float* rsq_next = (float*)(ws + ((L & 1) ? WS_RSQ0 : WS_RSQ1));
        bf16_t* xb = (bf16_t*)(ws + ((L & 1) ? WS_XB1 : WS_XB)); bf16_t* xb_next = (bf16_t*)(ws + ((L & 1) ? WS_XB : WS_XB1));
        if ((PHM >> j) & 1) switch (j) {
        case 0: phase_convert(in, ws, out_g, L, lds); if (DUP_CONV) { __syncthreads(); phase_convert(in, ws, out_g, L, lds); } break;
        case 1: { EpiSwiGLU E{r1, {}}; run_gemm(lds, xb, (const bf16_t*)(wb + W_GU1), 2 * FF, DM, E, rsq); } break;
        case 2: { EpiRes<0> E{out_g, xb, rsq, 0.5f * amul, nullptr, nullptr, nullptr, nullptr, nullptr, {}}; run_gemm(lds, r1, (const bf16_t*)(wb + W_D1), DM, FF, E); } break;
        case 3: { EpiZ E{r1, {}}; run_gemm(lds, xb, (const bf16_t*)(wb + W_IN), ZW, DM, E, rsq); } break;
        case 4: {
            unsigned* ctr = ctl + (L * 4 + 0) * 64;
            constexpr int NCMP = 512 << DUP_M1, NHL = 512 << DUP_M1;
            for (;;) { const int t = next_task(ctr, slot); if (t >= NCMP + NHL + 512) break;
                if (t < NCMP) task_compress(in, ws, L, t >> DUP_M1, lds); else if (t < NCMP + NHL) task_hgrn_local(in, ws, L, (t - NCMP) >> DUP_M1, lds); else task_prep(in, ws, L, t - NCMP - NHL, lds); }
        } break;
        case 5: {
            unsigned* ctr = ctl + (L * 4 + 1) * 64;
            constexpr int ND = 512 << DUP_DIFF, NC = 1024 << DUP_NSAC;
            for (;;) { const int t = next_task(ctr, slot); if (t >= 192 + ND + NC) break;
                if (t < 192) task_hgrn_scan(ws, t); else if (t < 192 + ND) task_diff(in, ws, L, (t - 192) >> DUP_DIFF, lds); else task_nsa_c(in, ws, L, (t - 192 - ND) >> DUP_NSAC, lds); }
        } break;
        case 6: {
            unsigned* ctr = ctl + (L * 4 + 2) * 64;
            constexpr int NS = 768 << DUP_SW, NH = 1024 << DUP_HOUT;
            for (;;) { const int t = next_task(ctr, slot); if (t >= NS + NH) break;
                if (t < NS) task_nsa_sw(in, ws, L, t >> DUP_SW, lds); else task_hgrn_out(in, ws, L, (t - NS) >> DUP_HOUT, lds); }
        } break;
        case 7: { EpiRes<0> E{out_g, xb, rsq, 1.0f * amul, nullptr, nullptr, nullptr, nullptr, nullptr, {}}; run_gemm(lds, mixed, (const bf16_t*)(wb + W_OUT), DM, DM, E); } break;
        case 8: { EpiSwiGLU E{r1, {}}; run_gemm(lds, xb, (const bf16_t*)(wb + W_GU2), 2 * FF, DM, E, rsq); } break;
        case 9: { EpiRes<2> E{nullptr, nullptr, rsqp, 0.f, nullptr, nullptr, nullptr, nullptr, mixed, {}}; run_gemm(lds, pb, (const bf16_t*)(wb + W_PP), DM, PLE, E); } break;
        case 10: { EpiRes<0> E{out_g, xb, rsq, 0.5f * amul, nullptr, nullptr, nullptr, nullptr, nullptr, {}}; run_gemm(lds, r1, (const bf16_t*)(wb + W_D2), DM, FF, E); } break;
        default: { EpiRes<1> E{out_g, xb_next, rsq_next, 0.f, rsq, mixed, rsqp, inp(I_PLPOST) + L * DM, nullptr, {}}; run_gemm(lds, xb, (const bf16_t*)(wb + W_PG), DM, DM, E, rsq, rsqp); } break;
        }
        if (ph + 1 < a.ph_hi) {
            if (ph == 0) { asm volatile("s_waitcnt vmcnt(0) lgkmcnt(0)" ::: "memory"); grid.sync(); __builtin_amdgcn_fence(__ATOMIC_ACQUIRE, "agent"); asm volatile("s_waitcnt vmcnt(0)" ::: "memory"); __syncthreads(); }
            else { XcdBarrier xb_; xb_.bar = (unsigned*)(ws + WS_CTL) + 4096; xb_.x = xb_xcc_id(); xb_.st = misc + 8; xcd_barrier(xb_); if (DUP_SYNC) xcd_barrier(xb_); }
        }
    }
}

#ifdef DUMPK
__global__ void __launch_bounds__(512) dump_kernel(float* out, unsigned char* ws) {
    bf16_t* mixed = (bf16_t*)(ws + WS_MIX); (void)mixed;
    for (size_t idx = (size_t)blockIdx.x * 512 + threadIdx.x; idx < (size_t)M * 1024; idx += (size_t)gridDim.x * 512) {
        const size_t m = idx >> 10; const int c = (int)(idx & 1023);
        float v = 0.f;
#if DUMPK == 3 || DUMPK == 40
        { const bf16_t* z = (const bf16_t*)(ws + WS_R1); v = bf2f(z[m * ZW + c]) + bf2f(z[m * ZW + 1024 + c]) + bf2f(z[m * ZW + 2048 + c]) + (c < 402 ? bf2f(z[m * ZW + 3072 + c]) : 0.f); }
#elif DUMPK == 41
        { const bf16_t* vt = (const bf16_t*)(ws + WS_VT); v = bf2f(vt[m * 512 + (c & 511)]); }
#elif DUMPK == 42
        { const float* hs = (const float*)(ws + WS_HS); const float* hd = (const float*)(ws + WS_HD); v = hs[m * 384 + (c % 384)] + hd[m * 6 + (c % 6)]; }
#elif DUMPK == 43
        { const bf16_t* kc = (const bf16_t*)(ws + WS_KC); const bf16_t* vct = (const bf16_t*)(ws + WS_VCT); v = bf2f(kc[m * 8 + (c & 7)]) + bf2f(vct[m * 8 + (c & 7)]); }
#elif DUMPK == 50 || DUMPK == 60
        v = (c < 384) ? bf2f(mixed[m * 1024 + c]) : 0.f;
#elif DUMPK == 51
        v = (c >= 384 && c < 640) ? bf2f(mixed[m * 1024 + c]) : 0.f;
#elif DUMPK == 52
        { const unsigned* selm = (const unsigned*)(ws + WS_SELM); v = (float)(selm[m * 8 + (c & 7)] & 0xffffu) + (float)(selm[m * 8 + (c & 7)] >> 16); }
#elif DUMPK == 53
        { const float* hs = (const float*)(ws + WS_HS); v = hs[m * 384 + (c % 384)]; }
#elif DUMPK == 61
        v = (c >= 640) ? bf2f(mixed[m * 1024 + c]) : 0.f;
#endif
        out[idx] = v;
    }
}
#endif

extern "C" void kernel_launch(void* const* d_in, const int* in_sizes, int n_in, void* d_out, int out_size, void* d_ws, size_t ws_size, hipStream_t stream) {
    static int grid = 0;
    if (grid == 0) {
        if (n_in != N_IN || out_size != M * DM || ws_size < WS_END) { fprintf(stderr, "kernel_launch: unexpected shapes (n_in %d out %d ws %zu)\n", n_in, out_size, ws_size); grid = -1; return; }
        int dev = 0, cus = 0, per_cu = 0;
        hipGetDevice(&dev); hipDeviceGetAttribute(&cus, hipDeviceAttributeMultiprocessorCount, dev);
        if (hipFuncSetAttribute((const void*)mega, hipFuncAttributeMaxDynamicSharedMemorySize, LDS_BYTES) != hipSuccess) { fprintf(stderr, "hipFuncSetAttribute failed\n"); }
        if (hipOccupancyMaxActiveBlocksPerMultiprocessor(&per_cu, (const void*)mega, 512, LDS_BYTES) != hipSuccess || per_cu < 1) { fprintf(stderr, "occupancy query: %d\n", per_cu); per_cu = 1; }
        (void)hipGetLastError();
        grid = cus;
    }
    if (grid < 0) return;
    hipMemsetAsync((char*)d_ws + WS_CTL, 0, 64 * 1024, stream);
    Args a{};
    for (int i = 0; i < N_IN; ++i) a.in[i] = (const float*)d_in[i];
    a.out = (float*)d_out; a.ws = (unsigned char*)d_ws; a.ph_lo = 0; a.ph_hi = PH_HI;
    void* args[] = {&a};
    hipError_t e = hipLaunchCooperativeKernel((const void*)mega, dim3(grid), dim3(512), args, LDS_BYTES, stream);
    if (e != hipSuccess) fprintf(stderr, "cooperative launch failed: %s (grid %d)\n", hipGetErrorString(e), grid);
#ifdef DUMPK
    dump_kernel<<<dim3(1024), dim3(512), 0, stream>>>((float*)d_out, (unsigned char*)d_ws);
#endif
}
```

```cpp
#include <hip/hip_runtime.h>
#include <hip/hip_cooperative_groups.h>
#include <cstdio>
#include <cstdint>
namespace cg = cooperative_groups;
__device__ __forceinline__ int TID() { int t = threadIdx.x; asm volatile("" : "+v"(t)); return t; }
typedef float f32x4_z __attribute__((ext_vector_type(4)));
__device__ __forceinline__ f32x4_z zero4_() { float z = 0.f; asm volatile("" : "+v"(z)); return (f32x4_z){z, z, z, z}; }
namespace pg8 {
#define PG8_LAS __attribute__((address_space(3)))
typedef unsigned short bf16_t;
typedef short bf16x8 __attribute__((ext_vector_type(8)));
typedef float f32x4 __attribute__((ext_vector_type(4)));
typedef unsigned u32x4 __attribute__((ext_vector_type(4)));
constexpr int BM = 256, BK = 64, HALF = 128, HTB = HALF * BK * 2  , STAGE_BYTES = 8 * HTB, NXCD = 8, WGM = 8;

__host__ __device__ __forceinline__ int lds_byte(int r, int c) { const int st = (r >> 4) * 2 + (c >> 5), rr = r & 15, cc = c & 31, ob = rr * 64 + cc * 2; return st * 1024 + (ob ^ (((ob >> 9) & 1) << 5)); }
__host__ __device__ __forceinline__ void stage_rc(int b, int& R, int& C) { const int st = b / 1024, sb = b % 1024, swz = sb ^ (((sb >> 9) & 1) << 5); R = (st >> 1) * 16 + swz / 64; C = (st & 1) * 32 + (swz % 64) / 2; }
__host__ __device__ __forceinline__ int perm32(int rho) { const int n = rho >> 4, i = rho & 15; return 8 * (i >> 2) + 4 * n + (i & 3); }

struct Unit { int pm, pn; };
struct Gemm { const bf16_t* A; const bf16_t* Bt; int M, N, K; };

struct StaticOrder {
    int nM, nN, nwg, G, c;
    __host__ __device__ void init(int M, int N, int G_, int c_) { nM = M / BM; nN = N / BM; nwg = nM * nN; G = G_; c = c_; }
    __host__ __device__ bool next(int i, Unit& u) const {
        const long L = (long)i * G + c; if (L >= nwg) return false;
        int wgid = (int)L; { const int q = nwg / NXCD, r = nwg % NXCD, xcd = wgid % NXCD, off = wgid / NXCD; wgid = (xcd < r ? xcd * (q + 1) : r * (q + 1) + (xcd - r) * q) + off; }
        const int nig = WGM * nN, gid = wgid / nig, fm = gid * WGM, gsz = (nM - fm) < WGM ? (nM - fm) : WGM;
        u.pm = fm + ((wgid % nig) % gsz); u.pn = (wgid % nig) / gsz; return true;
    }
    __device__ __forceinline__ void a_ready(const Unit&) const {}
    __device__ __forceinline__ void done(const Unit&) const {}
};

template <class Epi, class Sched, bool ALIGN_EPI = false, bool SP2 = false>
__device__ __forceinline__ void gemm_phase(PG8_LAS unsigned char* lds, const Gemm g, const Sched& S, const Epi& E) {
    const int tid = TID(), wid = __builtin_amdgcn_readfirstlane(tid >> 6), lane = tid & 63, wr = wid >> 2, wc = wid & 3, fr = lane & 15, fq = lane >> 4;
    const int K = g.K, nt = K / BK;
    unsigned voffA[2], voffB[2];
#pragma unroll
    for (int i = 0; i < 2; ++i) { int R, C; stage_rc(tid * 16 + i * 8192, R, C); const int Rb = Epi::PERM ? ((R & ~31) + perm32(R & 31)) : R;
        voffA[i] = (unsigned)(R * K + C) * 2u; voffB[i] = (unsigned)(Rb * K + C) * 2u; }
    const size_t kstep = (size_t)(BK * 2);
    const size_t hstep = (size_t)HALF * K * 2;
    const size_t tstep = 2 * hstep;
    const unsigned ldsw = (unsigned)wid * 1024u;
    const int aoff = lds_byte(wr * 64 + fr, fq * 8), boff = lds_byte(wc * 32 + fr, fq * 8);
#define PG8_SA(b, h) (((b) * 2 + (h)) * HTB)
#define PG8_SB(b, h) ((4 + (b) * 2 + (h)) * HTB)
#define PG8_STAGE(bufoff, gbase, voff) do { _Pragma("unroll") for (int _i = 0; _i < 2; ++_i) \
        __builtin_amdgcn_global_load_lds((const unsigned*)((const char*)(gbase) + (voff)[_i]), (PG8_LAS unsigned*)(lds + (bufoff) + ldsw + _i * 8192), 16, 0, 0); } while (0)
#define PG8_LDA(dst, b, h) do { _Pragma("unroll") for (int m = 0; m < 4; ++m) _Pragma("unroll") for (int k = 0; k < 2; ++k) dst[m][k] = *(const PG8_LAS bf16x8*)(lds + PG8_SA(b, h) + aoff + m * 2048 + k * 1024); } while (0)
#define PG8_LDB(dst, b, h) do { _Pragma("unroll") for (int n = 0; n < 2; ++n) _Pragma("unroll") for (int k = 0; k < 2; ++k) dst[n][k] = *(const PG8_LAS bf16x8*)(lds + PG8_SB(b, h) + boff + n * 2048 + k * 1024); } while (0)
#define PG8_MMA(ai, bj, At, Bt) do { __builtin_amdgcn_s_setprio(1); _Pragma("unroll") for (int m = 0; m < 4; ++m) _Pragma("unroll") for (int n = 0; n < 2; ++n) _Pragma("unroll") for (int k = 0; k < 2; ++k) \
        acc[ai][bj][m][n] = __builtin_amdgcn_mfma_f32_16x16x32_bf16(Bt[n][k], At[m][k], acc[ai][bj][m][n], 0, 0, 0); __builtin_amdgcn_s_setprio(0); } while (0)
#define PG8_WAIT_V(n) asm volatile("s_waitcnt vmcnt(" #n ")" ::: "memory")
#define PG8_WAIT_L(n) asm volatile("s_waitcnt lgkmcnt(" #n ")" ::: "memory")
#define PG8_BAR __builtin_amdgcn_s_barrier()
#define PG8_SCHED __builtin_amdgcn_sched_barrier(0)
    Unit cur, nxt; int ui = 0;
    if (!S.next(0, cur)) return;
    f32x4 acc[2][2][4][2];
#pragma unroll
    for (int a = 0; a < 2; ++a)
#pragma unroll
        for (int b = 0; b < 2; ++b)
#pragma unroll
            for (int m = 0; m < 4; ++m)
#pragma unroll
                for (int n = 0; n < 2; ++n) acc[a][b][m][n] = zero4_();
    bf16x8 At[4][2], B0[2][2], B1[2][2];
    const char* cA = (const char*)g.A + (size_t)cur.pm * tstep; const char* cB = (const char*)g.Bt + (size_t)cur.pn * tstep;
    S.a_ready(cur);
    if constexpr (SP2) {
        PG8_STAGE(PG8_SB(0, 0), cB, voffB); PG8_STAGE(PG8_SB(0, 1), cB + hstep, voffB); PG8_STAGE(PG8_SA(0, 0), cA, voffA); PG8_STAGE(PG8_SA(0, 1), cA + hstep, voffA);
        if (wr == 1) PG8_BAR;
        PG8_WAIT_V(2); PG8_BAR;
        PG8_STAGE(PG8_SB(1, 0), cB + kstep, voffB); PG8_STAGE(PG8_SA(1, 0), cA + kstep, voffA); PG8_STAGE(PG8_SB(1, 1), cB + hstep + kstep, voffB);
        PG8_WAIT_V(6); PG8_BAR;
    } else {
        PG8_STAGE(PG8_SB(0, 0), cB, voffB); PG8_STAGE(PG8_SA(0, 0), cA, voffA); PG8_STAGE(PG8_SB(0, 1), cB + hstep, voffB); PG8_STAGE(PG8_SA(0, 1), cA + hstep, voffA);
        if (wr == 1) PG8_BAR;
        PG8_WAIT_V(4); PG8_BAR;
        PG8_STAGE(PG8_SB(1, 0), cB + kstep, voffB); PG8_STAGE(PG8_SA(1, 0), cA + kstep, voffA); PG8_STAGE(PG8_SB(1, 1), cB + hstep + kstep, voffB);
        PG8_WAIT_V(6); PG8_BAR;
    }
    for (;;) {
        const bool has_next = S.next(ui + 1, nxt);
        const char* nA = has_next ? (const char*)g.A + (size_t)nxt.pm * tstep : cA; const char* nB = has_next ? (const char*)g.Bt + (size_t)nxt.pn * tstep : cB;
        for (int t = 0; t < nt; t += 2) {
            const bool last = (t == nt - 2);
            const char* a1 = cA + (size_t)(t + 1) * kstep;
            const char* a2 = last ? nA : cA + (size_t)(t + 2) * kstep; const char* b2 = last ? nB : cB + (size_t)(t + 2) * kstep;
            const char* a3 = a2 + kstep; const char* b3 = b2 + kstep;
            if (last && has_next) S.a_ready(nxt);
            if constexpr (SP2) {
            PG8_LDB(B0, 0, 0); PG8_LDB(B1, 0, 1); PG8_SCHED; PG8_LDA(At, 0, 0); PG8_STAGE(PG8_SA(1, 1), a1 + hstep, voffA);
            PG8_WAIT_V(8); PG8_WAIT_L(0); PG8_BAR; PG8_MMA(0, 0, At, B0); PG8_MMA(0, 1, At, B1); PG8_BAR; PG8_SCHED;
            PG8_LDA(At, 0, 1); PG8_STAGE(PG8_SB(0, 0), b2, voffB); PG8_STAGE(PG8_SB(0, 1), b2 + hstep, voffB); PG8_STAGE(PG8_SA(0, 0), a2, voffA);
            PG8_WAIT_V(8); PG8_WAIT_L(0); PG8_BAR; PG8_MMA(1, 0, At, B0); PG8_MMA(1, 1, At, B1); PG8_BAR; PG8_SCHED;
            PG8_LDB(B0, 1, 0); PG8_LDB(B1, 1, 1); PG8_SCHED; PG8_LDA(At, 1, 0); PG8_STAGE(PG8_SA(0, 1), a2 + hstep, voffA);
            PG8_WAIT_V(8); PG8_WAIT_L(0); PG8_BAR; PG8_MMA(0, 0, At, B0); PG8_MMA(0, 1, At, B1); PG8_BAR; PG8_SCHED;
            PG8_LDA(At, 1, 1); PG8_STAGE(PG8_SB(1, 0), b3, voffB); PG8_STAGE(PG8_SB(1, 1), b3 + hstep, voffB); PG8_STAGE(PG8_SA(1, 0), a3, voffA);
            PG8_WAIT_V(8); PG8_WAIT_L(0); PG8_BAR; PG8_MMA(1, 0, At, B0); PG8_MMA(1, 1, At, B1); PG8_BAR; PG8_SCHED;
            } else {
            PG8_LDB(B0, 0, 0); PG8_SCHED; PG8_LDA(At, 0, 0); PG8_STAGE(PG8_SA(1, 1), a1 + hstep, voffA);
            PG8_WAIT_L(8); PG8_BAR; PG8_WAIT_L(0); PG8_MMA(0, 0, At, B0); PG8_BAR; PG8_SCHED;
            PG8_LDB(B1, 0, 1); PG8_STAGE(PG8_SB(0, 0), b2, voffB);
            PG8_BAR; PG8_WAIT_L(0); PG8_MMA(0, 1, At, B1); PG8_BAR;
            PG8_LDA(At, 0, 1); PG8_STAGE(PG8_SA(0, 0), a2, voffA);
            PG8_BAR; PG8_WAIT_L(0); PG8_MMA(1, 0, At, B0); PG8_BAR; PG8_SCHED;
            PG8_STAGE(PG8_SB(0, 1), b2 + hstep, voffB);
            PG8_WAIT_V(6); PG8_BAR; PG8_MMA(1, 1, At, B1); PG8_BAR;
            PG8_LDB(B0, 1, 0); PG8_SCHED; PG8_LDA(At, 1, 0); PG8_STAGE(PG8_SA(0, 1), a2 + hstep, voffA);
            PG8_WAIT_L(8); PG8_BAR; PG8_WAIT_L(0); PG8_MMA(0, 0, At, B0); PG8_BAR; PG8_SCHED;
            PG8_LDB(B1, 1, 1); PG8_STAGE(PG8_SB(1, 0), b3, voffB);
            PG8_BAR; PG8_WAIT_L(0); PG8_MMA(0, 1, At, B1); PG8_BAR;
            PG8_LDA(At, 1, 1); PG8_STAGE(PG8_SA(1, 0), a3, voffA);
            PG8_BAR; PG8_WAIT_L(0); PG8_MMA(1, 0, At, B0); PG8_BAR; PG8_SCHED;
            PG8_STAGE(PG8_SB(1, 1), b3 + hstep, voffB);
            PG8_WAIT_V(6); PG8_BAR; PG8_MMA(1, 1, At, B1); PG8_BAR;
            }
        }
        if constexpr (ALIGN_EPI) { if (wr == 0) PG8_BAR; }
        if constexpr (!Epi::AFTER_DRAIN) { E(acc, cur, wr, wc, fr, fq); S.done(cur); }
        if (!has_next) break;
#pragma unroll
        for (int a = 0; a < 2; ++a)
#pragma unroll
            for (int b = 0; b < 2; ++b)
#pragma unroll
                for (int m = 0; m < 4; ++m)
#pragma unroll
                    for (int n = 0; n < 2; ++n) acc[a][b][m][n] = zero4_();
        cur = nxt; cA = nA; cB = nB; ++ui;
        if constexpr (ALIGN_EPI) { if (wr == 1) PG8_BAR; }
    }
    PG8_WAIT_V(0);
    if constexpr (!ALIGN_EPI) { if (wr == 0) PG8_BAR; }
    PG8_BAR;
    if constexpr (Epi::AFTER_DRAIN) { E.fused(acc, cur, wr, wc, fr, fq, lds, wid, lane); S.done(cur); }
#undef PG8_SA
#undef PG8_SB
#undef PG8_STAGE
#undef PG8_LDA
#undef PG8_LDB
#undef PG8_MMA
#undef PG8_WAIT_V
#undef PG8_WAIT_L
#undef PG8_BAR
#undef PG8_SCHED
}
}

#define LAS __attribute__((address_space(3)))
typedef unsigned short bf16_t;
typedef short bf16x8 __attribute__((ext_vector_type(8)));
typedef float f32x4 __attribute__((ext_vector_type(4)));
typedef float f32x16 __attribute__((ext_vector_type(16)));
typedef unsigned u32x4 __attribute__((ext_vector_type(4)));
typedef unsigned u32x2 __attribute__((ext_vector_type(2)));

constexpr int NB = 4, T = 8192, DM = 1024, M = NB * T, DEPTH = 4, PLE = 256, FF = 2816, ZW = 3584, INW = 3474;
constexpr int C_NQ = 0, C_CK = 384, C_CV = 512, C_SK = 640, C_SV = 768, C_WK = 896, C_WV = 1024, C_DQ = 1152, C_DK = 1408, C_DV = 1664,
              C_HQ = 1920, C_HF = 2304, C_HI = 2688, C_HG = 3072, C_NG = 3456;
constexpr float EPS = 1e-6f, LOG2E = 1.4426950408889634f;
enum { I_X = 0, I_P, I_RELB, I_LBLOG, I_F1N, I_F1G, I_F1U, I_F1D, I_MIXN, I_WIN, I_WOUT, I_NQN, I_NKN, I_CPOS, I_CW1, I_CW2,
       I_DQN, I_DKN, I_DLAM, I_DSUB, I_HON, I_F2N, I_F2G, I_F2U, I_F2D, I_PLN, I_PLG, I_PLP, I_PLPOST, N_IN };
constexpr size_t MiB = 1u << 20;
constexpr size_t WS_CTL = 0, WS_W = 1 * MiB, WS_PB = 53 * MiB, WS_XB = 69 * MiB, WS_R1 = 133 * MiB, WS_MIX = 357 * MiB, WS_VT = 421 * MiB,
                 WS_HS = 453 * MiB, WS_KC = 501 * MiB, WS_VCT = WS_KC + 512 * 1024, WS_SELM = 503 * MiB, WS_RSQ0 = 504 * MiB, WS_RSQ1 = 506 * MiB,
                 WS_RSQP = 508 * MiB, WS_HD = 510 * MiB, WS_XB1 = 511 * MiB, WS_OCB = 575 * MiB, WS_ONES = 599 * MiB, WS_END = 601 * MiB;
constexpr size_t W_GU1 = 0, W_D1 = 11 * MiB, W_GU2 = W_D1 + 5 * MiB + 512 * 1024, W_D2 = W_GU2 + 11 * MiB, W_IN = 33 * MiB, W_OUT = 40 * MiB, W_PG = 42 * MiB,
                 W_PP = 44 * MiB, W_1T = W_PP + 512 * 1024, W_2T = W_1T + 2 * MiB, W_POSB = W_2T + 64 * 1024;
static_assert(W_D2 + 5 * MiB + 512 * 1024 == W_IN, "weight map");
constexpr int LDS_BYTES = 138 * 1024, LDS_MISC = 131072, LDS_RTAB = LDS_MISC + 1024;

__device__ __forceinline__ float bf2f(unsigned short u) { return __uint_as_float(((unsigned)u) << 16); }
__device__ __forceinline__ float bflo(unsigned w) { return __uint_as_float(w << 16); }
__device__ __forceinline__ float bfhi(unsigned w) { return __uint_as_float(w & 0xffff0000u); }
typedef float f32x2_t __attribute__((ext_vector_type(2))); typedef __bf16 bf16x2_t __attribute__((ext_vector_type(2)));
__device__ __forceinline__ unsigned pk2(float lo, float hi) { f32x2_t v = {lo, hi}; bf16x2_t b = __builtin_convertvector(v, bf16x2_t); return __builtin_bit_cast(unsigned, b); }
__device__ __forceinline__ bf16_t f2bf(float f) { return (bf16_t)(pk2(f, 0.f) & 0xffffu); }
__device__ __forceinline__ float ex2(float x) { return __builtin_amdgcn_exp2f(x); }
__device__ __forceinline__ float sigmoidf_(float x) { return __builtin_amdgcn_rcpf(1.0f + __expf(-x)); }
__device__ __forceinline__ int crow(int r, int hi) { return (r & 3) + 8 * (r >> 2) + 4 * hi; }
__device__ __forceinline__ f32x16 mfma32(bf16x8 a, bf16x8 b, f32x16 c) { return __builtin_amdgcn_mfma_f32_32x32x16_bf16(a, b, c, 0, 0, 0); }
__device__ __forceinline__ f32x4 mfma16(bf16x8 a, bf16x8 b, f32x4 c) { return __builtin_amdgcn_mfma_f32_16x16x32_bf16(a, b, c, 0, 0, 0); }
__device__ __forceinline__ bf16x8 as_bf16x8(u32x4 v) { return __builtin_bit_cast(bf16x8, v); }
#define LDSW() asm volatile("s_waitcnt lgkmcnt(0)" ::: "memory")
#define CFENCE() asm volatile("" ::: "memory")
#define GAS __attribute__((address_space(1)))
__device__ __forceinline__ const float* inp(int i) { asm volatile("" : "+s"(i)); const unsigned long long v = ((const unsigned long long __attribute__((address_space(4)))*)__builtin_amdgcn_kernarg_segment_ptr())[i]; return (const float*)(const GAS float*)v; }

__device__ __forceinline__ float row_rinv(const float* rsq, int row) {
    const f32x4* p = (const f32x4*)(rsq + (size_t)row * 16);
    const f32x4 a = p[0], b = p[1], c = p[2], d = p[3];
    const float s = ((a.x + a.y) + (a.z + a.w)) + ((b.x + b.y) + (b.z + b.w)) + ((c.x + c.y) + (c.z + c.w)) + ((d.x + d.y) + (d.z + d.w));
    return rsqrtf(s * (1.0f / 1024.0f) + EPS);
}
struct RowTab {
    int p0, p1, p2, p3;
    __device__ __forceinline__ int slot(int pm) const { return pm == p0 ? 0 : (pm == p1 ? 1 : (pm == p2 ? 2 : 3)); }
    __device__ __forceinline__ float get(int t, int pm, int r256) const { return ((const LAS float*)(LAS unsigned char*)(size_t)LDS_RTAB)[(t * 4 + slot(pm)) * 256 + r256]; }
};
struct EpiSwiGLU {
    static constexpr bool PERM = true, AFTER_DRAIN = false;
    bf16_t* O; RowTab rt;
    __device__ __forceinline__ void operator()(const f32x4 (&acc)[2][2][4][2], const pg8::Unit& u, int wr, int wc, int fr, int fq) const {
#pragma unroll
        for (int ai = 0; ai < 2; ++ai)
#pragma unroll
            for (int m = 0; m < 4; ++m) {
                const int row = u.pm * 256 + ai * 128 + wr * 64 + m * 16 + fr;
                const float r = rt.get(0, u.pm, row & 255);
                float o[8];
#pragma unroll
                for (int n = 0; n < 2; ++n)
#pragma unroll
                    for (int e = 0; e < 4; ++e) { const float g = acc[ai][0][m][n][e] * r, up = acc[ai][1][m][n][e] * r; o[n * 4 + e] = g * sigmoidf_(g) * up; }
                u32x4 w; w.x = pk2(o[0], o[1]); w.y = pk2(o[2], o[3]); w.z = pk2(o[4], o[5]); w.w = pk2(o[6], o[7]);
                *(u32x4*)(O + (size_t)row * FF + u.pn * 128 + wc * 32 + 8 * fq) = w;
                CFENCE();
            }
    }
};
template <int LD> struct EpiZT {
    static constexpr bool PERM = true, AFTER_DRAIN = false;
    bf16_t* Z; RowTab rt;
    __device__ __forceinline__ void operator()(const f32x4 (&acc)[2][2][4][2], const pg8::Unit& u, int wr, int wc, int fr, int fq) const {
#pragma unroll
        for (int ai = 0; ai < 2; ++ai)
#pragma unroll
            for (int m = 0; m < 4; ++m) {
                const int row = u.pm * 256 + ai * 128 + wr * 64 + m * 16 + fr;
                const float r = rt.get(0, u.pm, row & 255);
#pragma unroll
                for (int bj = 0; bj < 2; ++bj) {
                    const f32x4 v0 = acc[ai][bj][m][0] * r, v1 = acc[ai][bj][m][1] * r;
                    u32x4 w; w.x = pk2(v0[0], v0[1]); w.y = pk2(v0[2], v0[3]); w.z = pk2(v1[0], v1[1]); w.w = pk2(v1[2], v1[3]);
                    *(u32x4*)(Z + (size_t)row * LD + u.pn * 256 + bj * 128 + wc * 32 + 8 * fq) = w;
                }
                CFENCE();
            }
    }
};
typedef EpiZT<ZW> EpiZ;
template <int MODE> struct EpiRes {
    static constexpr bool PERM = true, AFTER_DRAIN = false;
    float* X; bf16_t* XB; float* rsq_out; float alpha; const float* rsq_in; const bf16_t* P; const float* rsqp; const float* post; bf16_t* Pout; RowTab rt;
    __device__ __forceinline__ void operator()(const f32x4 (&acc)[2][2][4][2], const pg8::Unit& u, int wr, int wc, int fr, int fq) const {
        const int rowb = u.pm * 256 + wr * 64 + fr, colb = u.pn * 256 + wc * 32 + 8 * fq;
        f32x4 xn[2][2]; u32x2 pn_[2][2];
        if (MODE != 2) {
#pragma unroll
            for (int bj = 0; bj < 2; ++bj)
#pragma unroll
                for (int n = 0; n < 2; ++n) { const size_t off = (size_t)rowb * DM + colb + bj * 128 + 4 * n; xn[bj][n] = *(const f32x4*)(X + off); if (MODE == 1) pn_[bj][n] = *(const u32x2*)(P + off); }
        }
#pragma unroll
        for (int gI = 0; gI < 8; ++gI) {
            const int ai = gI >> 2, m = gI & 3;
            const int row = rowb + ai * 128 + m * 16;
            f32x4 xc[2][2]; u32x2 pc[2][2];
#pragma unroll
            for (int bj = 0; bj < 2; ++bj)
#pragma unroll
                for (int n = 0; n < 2; ++n) { xc[bj][n] = xn[bj][n]; pc[bj][n] = pn_[bj][n]; }
            if (MODE != 2 && gI < 7) {
                const int row2 = rowb + ((gI + 1) >> 2) * 128 + ((gI + 1) & 3) * 16;
#pragma unroll
                for (int bj = 0; bj < 2; ++bj)
#pragma unroll
                    for (int n = 0; n < 2; ++n) { const size_t off = (size_t)row2 * DM + colb + bj * 128 + 4 * n; xn[bj][n] = *(const f32x4*)(X + off); if (MODE == 1) pn_[bj][n] = *(const u32x2*)(P + off); }
            }
            CFENCE();
            float r = 1.f, rp = 1.f;
            if (MODE == 1) { r = rt.get(0, u.pm, row & 255); rp = rt.get(1, u.pm, row & 255); }
            float ss = 0.f;
#pragma unroll
            for (int bj = 0; bj < 2; ++bj)
#pragma unroll
                for (int n = 0; n < 2; ++n) {
                    const int c0 = colb + bj * 128 + 4 * n;
                    const size_t off = (size_t)row * DM + c0;
                    const f32x4 a = acc[ai][bj][m][n];
                    if (MODE == 2) {
                        u32x2 w; w.x = pk2(a[0], a[1]); w.y = pk2(a[2], a[3]);
                        *(u32x2*)(Pout + off) = w;
                        ss += (a[0] * a[0] + a[1] * a[1]) + (a[2] * a[2] + a[3] * a[3]);
                    } else {
                        f32x4 xv = xc[bj][n];
                        if (MODE == 0) xv += a * alpha;
                        else {
                            const u32x2 pw = pc[bj][n]; const f32x4 po = *(const f32x4*)(post + c0);
                            xv[0] += sigmoidf_(a[0] * r) * (bflo(pw.x) * rp * po[0]);
                            xv[1] += sigmoidf_(a[1] * r) * (bfhi(pw.x) * rp * po[1]);
                            xv[2] += sigmoidf_(a[2] * r) * (bflo(pw.y) * rp * po[2]);
                            xv[3] += sigmoidf_(a[3] * r) * (bfhi(pw.y) * rp * po[3]);
                        }
                        *(f32x4*)(X + off) = xv;
                        u32x2 w; w.x = pk2(xv[0], xv[1]); w.y = pk2(xv[2], xv[3]);
                        *(u32x2*)(XB + off) = w;
                        ss += (xv[0] * xv[0] + xv[1] * xv[1]) + (xv[2] * xv[2] + xv[3] * xv[3]);
                    }
                }
            ss += __shfl_xor(ss, 16); ss += __shfl_xor(ss, 32);
            if (fq == 0) rsq_out[(size_t)row * 16 + u.pn * 4 + wc] = ss;
        }
    }
};

template <class Epi> __device__ __forceinline__ void run_gemm(LAS unsigned char* lds, const bf16_t* A, const bf16_t* Bt, int N, int K, Epi& E, const float* rsqA = nullptr, const float* rsqB = nullptr) {
    int bx = blockIdx.x; asm volatile("" : "+s"(bx)); asm volatile("" : "+s"(K)); asm volatile("" : "+s"(N));
    pg8::Gemm g{A, Bt, M, N, K}; pg8::StaticOrder S; S.init(M, N, (int)gridDim.x, bx);
    if (rsqA) {
        int p0 = -1, p1 = -1, p2 = -1, p3 = -1; pg8::Unit u;
        for (int i = 0; S.next(i, u); ++i) { const int pm = u.pm; if (pm != p0 && pm != p1 && pm != p2 && pm != p3) { if (p0 < 0) p0 = pm; else if (p1 < 0) p1 = pm; else if (p2 < 0) p2 = pm; else p3 = pm; } }
        E.rt.p0 = p0; E.rt.p1 = p1; E.rt.p2 = p2; E.rt.p3 = p3;
        const int tid = TID();
        LAS float* tab = (LAS float*)(lds + LDS_RTAB);
        if (tid < 256) {
#pragma unroll
            for (int s = 0; s < 4; ++s) { const int pm = s == 0 ? p0 : (s == 1 ? p1 : (s == 2 ? p2 : p3));
                if (pm >= 0) { tab[s * 256 + tid] = row_rinv(rsqA, pm * 256 + tid); if (rsqB) tab[(4 + s) * 256 + tid] = row_rinv(rsqB, pm * 256 + tid); } }
        }
        __syncthreads();
    }
    pg8::gemm_phase<Epi, pg8::StaticOrder, true, true>(lds, g, S, E);
    __syncthreads();
}

__device__ __forceinline__ void rowsq_pass(const bf16_t* P, float* rsq_out) {
    const int tid = TID(), lane = tid & 63, wave = tid >> 6;
    for (int base = (blockIdx.x * 8 + wave) * 4; base < M; base += gridDim.x * 8 * 4) {
        u32x4 v[4][2];
#pragma unroll
        for (int i = 0; i < 4; ++i) { const u32x4* pr = (const u32x4*)(P + (size_t)(base + i) * DM) + lane; v[i][0] = pr[0]; v[i][1] = pr[64]; }
#pragma unroll
        for (int i = 0; i < 4; ++i) {
            float s = 0.f;
#pragma unroll
            for (int h2 = 0; h2 < 2; ++h2) { const u32x4 w = v[i][h2];
                s += (bflo(w.x) * bflo(w.x) + bfhi(w.x) * bfhi(w.x)) + (bflo(w.y) * bflo(w.y) + bfhi(w.y) * bfhi(w.y)) + (bflo(w.z) * bflo(w.z) + bfhi(w.z) * bfhi(w.z)) + (bflo(w.w) * bflo(w.w) + bfhi(w.w) * bfhi(w.w)); }
#pragma unroll
            for (int o = 1; o < 64; o <<= 1) s += __shfl_xor(s, o);
            if (lane < 16) rsq_out[(size_t)(base + i) * 16 + lane] = (lane == 0) ? s : 0.f;
        }
    }
}

__device__ __forceinline__ int next_task(unsigned* ctr, LAS int* slot) {
    __syncthreads();
    if (TID() == 0) *slot = (int)atomicAdd(ctr, 1u);
    __syncthreads();
    return *slot;
}

__device__ __forceinline__ int colmap(int mode, int n) {
    if (mode == 1) return 256 * (n >> 7) + (n & 127);
    if (mode == 2) return 256 * (n >> 7) + 128 + (n & 127);
    if (mode == 3) return n < 1152 ? n : (n < 1170 ? 3456 + (n - 1152) : n - 18);
    return n;
}
__device__ __forceinline__ void conv_item(const float* W, int K, int N, bf16_t* WT, const float* gain, int mode, LAS float* scr, int item, int lane) {
    const int nblk = (N + 31) >> 5, kb = item / nblk, nb = item % nblk, k0 = 64 * kb, n0 = 32 * nb;
    if (mode != 3) {
        f32x4 v[8];
#pragma unroll
        for (int i = 0; i < 8; ++i) v[i] = *(const f32x4*)(W + (size_t)(k0 + 8 * i + (lane >> 3)) * N + n0 + 4 * (lane & 7));
#pragma unroll
        for (int i = 0; i < 8; ++i) {
            const int kk = 8 * i + (lane >> 3);
            f32x4 t = v[i];
            if (gain) t = t * gain[k0 + kk];
            LAS float* d = scr + kk * 33 + 4 * (lane & 7);
            d[0] = t[0]; d[1] = t[1]; d[2] = t[2]; d[3] = t[3];
        }
    } else {
#pragma unroll 16
        for (int i = 0; i < 32; ++i) {
            const int kk = 2 * i + (lane >> 5), n = n0 + (lane & 31);
            float v = (n < N) ? W[(size_t)(k0 + kk) * N + n] : 0.f;
            if (gain) v *= gain[k0 + kk];
            scr[kk * 33 + (lane & 31)] = v;
        }
    }
    LDSW();
    const int c = lane & 7;
#pragma unroll
    for (int j = 0; j < 4; ++j) {
        const int nl = (lane >> 3) + 8 * j, n = n0 + nl;
        const LAS float* s = scr + (8 * c) * 33 + nl;
        u32x4 o; o.x = pk2(s[0], s[33]); o.y = pk2(s[2 * 33], s[3 * 33]); o.z = pk2(s[4 * 33], s[5 * 33]); o.w = pk2(s[6 * 33], s[7 * 33]);
        if (n < N) *(u32x4*)(WT + (size_t)colmap(mode, n) * K + k0 + 8 * c) = o;
    }
    LDSW();
}
constexpr int IT_GU = (DM / 64) * (FF / 32), IT_D = (FF / 64) * (DM / 32), IT_IN = (DM / 64) * ((INW + 31) / 32), IT_SQ = (DM / 64) * (DM / 32),
              IT_PP = (PLE / 64) * (DM / 32), IT_W1 = (2048 / 64) * (256 / 32), IT_W2 = (256 / 64) * (64 / 32);
constexpr int IT_SETA = 2 * IT_GU + IT_D + IT_IN + 2 * IT_W1 + 2 * IT_W2;
constexpr int IT_SETB = 2 * IT_GU + IT_D + 2 * IT_SQ + IT_PP;
__device__ __forceinline__ void conv_one(unsigned char* ws, int LA, int LB, bool enA, int it, LAS float* scr, int lane) {
    unsigned char* wb = ws + WS_W;
    const size_t fa = (size_t)LA * DM * FF, fb = (size_t)LB * DM * FF;
    const float* W = nullptr; int K = 0, N = 0; bf16_t* WT = nullptr; const float* gain = nullptr; int mode = 0, rr = -1, r = it;
#define JOB(Wp, Kk, Nn, WTp, gp, md, items) { if (rr < 0 && r < (items)) { W = (Wp); K = (Kk); N = (Nn); WT = (bf16_t*)(WTp); gain = (gp); mode = (md); rr = r; } r -= (items); }
    JOB(inp(I_F1G) + fa, DM, FF, wb + W_GU1, inp(I_F1N) + LA * DM, 1, enA ? IT_GU : 0)
    JOB(inp(I_F1U) + fa, DM, FF, wb + W_GU1, inp(I_F1N) + LA * DM, 2, enA ? IT_GU : 0)
    JOB(inp(I_F1D) + fa, FF, DM, wb + W_D1, nullptr, 0, enA ? IT_D : 0)
    JOB(inp(I_WIN) + (size_t)LA * DM * INW, DM, INW, wb + W_IN, inp(I_MIXN) + LA * DM, 3, enA ? IT_IN : 0)
    JOB(inp(I_CW1) + (size_t)(LA * 2 + 0) * 2048 * 256, 2048, 256, wb + W_1T, nullptr, 0, enA ? IT_W1 : 0)
    JOB(inp(I_CW1) + (size_t)(LA * 2 + 1) * 2048 * 256, 2048, 256, wb + W_1T + 256 * 2048 * 2, nullptr, 0, enA ? IT_W1 : 0)
    JOB(inp(I_CW2) + (size_t)(LA * 2 + 0) * 256 * 64, 256, 64, wb + W_2T, nullptr, 0, enA ? IT_W2 : 0)
    JOB(inp(I_CW2) + (size_t)(LA * 2 + 1) * 256 * 64, 256, 64, wb + W_2T + 64 * 256 * 2, nullptr, 0, enA ? IT_W2 : 0)
    JOB(inp(I_F2G) + fb, DM, FF, wb + W_GU2, inp(I_F2N) + LB * DM, 1, IT_GU)
    JOB(inp(I_F2U) + fb, DM, FF, wb + W_GU2, inp(I_F2N) + LB * DM, 2, IT_GU)
    JOB(inp(I_F2D) + fb, FF, DM, wb + W_D2, nullptr, 0, IT_D)
    JOB(inp(I_WOUT) + (size_t)LB * DM * DM, DM, DM, wb + W_OUT, nullptr, 0, IT_SQ)
    JOB(inp(I_PLG) + (size_t)LB * DM * DM, DM, DM, wb + W_PG, inp(I_PLN) + LB * DM, 0, IT_SQ)
    JOB(inp(I_PLP) + (size_t)LB * PLE * DM, PLE, DM, wb + W_PP, nullptr, 0, IT_PP)
#undef JOB
    if (rr >= 0) conv_item(W, K, N, WT, gain, mode, scr, rr, lane);
}
__device__ __forceinline__ void posb_job(unsigned char* ws, int LA, int jid, int lane) {
    const int ty = jid >> 7, ng = (jid >> 5) & 3, ks = jid & 31, n = ng * 64 + lane;
    const float* w1 = inp(I_CW1) + (size_t)(LA * 2 + ty) * 2048 * 256; const float* pos = inp(I_CPOS) + (size_t)(LA * 2 + ty) * 2048;
    float acc = 0.f;
#pragma unroll 16
    for (int k = ks * 64; k < ks * 64 + 64; ++k) acc += pos[k] * w1[(size_t)k * 256 + n];
    ((float*)(ws + WS_W + W_POSB))[(ty * 32 + ks) * 256 + n] = acc;
}
__device__ __forceinline__ void phase_convert(const float* const* in, unsigned char* ws, float* out, int L, LAS unsigned char* lds) {
    const int tid = TID(), lane = tid & 63, wave = tid >> 6;
    const int gw = blockIdx.x * 8 + wave, NGW = gridDim.x * 8;
    LAS float* scr = (LAS float*)(lds + wave * 8704);
    if (gw < 256) posb_job(ws, 0, gw, lane);
    for (int it = gw; it < IT_SETA; it += NGW) conv_one(ws, 0, 0, true, it, scr, lane);
    {
        u32x4* z = (u32x4*)((bf16_t*)(ws + WS_W + W_IN) + (size_t)INW * DM);
        const int n16 = (ZW - INW) * DM / 8;
        for (int i = blockIdx.x * 512 + tid; i < n16; i += gridDim.x * 512) z[i] = (u32x4){0u, 0u, 0u, 0u};
    }
    {
        const float* x = inp(I_X); bf16_t* xb = (bf16_t*)(ws + WS_XB); float* rsq = (float*)(ws + WS_RSQ0);
        for (int m = gw; m < M; m += NGW) {
            const f32x4* xr = (const f32x4*)(x + (size_t)m * DM) + lane; f32x4* orow = (f32x4*)(out + (size_t)m * DM) + lane;
            u32x2* xbr = (u32x2*)(xb + (size_t)m * DM) + lane;
            float s = 0.f;
#pragma unroll
            for (int j = 0; j < 4; ++j) { const f32x4 v = xr[64 * j]; orow[64 * j] = v; u32x2 w; w.x = pk2(v[0], v[1]); w.y = pk2(v[2], v[3]); xbr[64 * j] = w; s += (v[0] * v[0] + v[1] * v[1]) + (v[2] * v[2] + v[3] * v[3]); }
#pragma unroll
            for (int o = 1; o < 64; o <<= 1) s += __shfl_xor(s, o);
            if (lane < 16) rsq[(size_t)m * 16 + lane] = (lane == 0) ? s : 0.f;
        }
    }
}
__device__ __forceinline__ void task_conv(unsigned char* ws, int L, int c, LAS unsigned char* lds) {
    const int tid = TID(), lane = tid & 63, wave = tid >> 6;
    LAS float* scr = (LAS float*)(lds + wave * 8704);
    const bool enA = L < DEPTH - 1;
    const int total = (enA ? IT_SETA : 0) + IT_SETB;
    if (enA && wave == 7) posb_job(ws, L + 1, c, lane);
    for (int i = 0; i < 6; ++i) { const int it = c * 48 + wave * 6 + i; if (it < total) conv_one(ws, L + 1, L, enA, it, scr, lane); }
    if (enA && tid < 55) { u32x4* z = (u32x4*)((bf16_t*)(ws + WS_W + W_IN) + (size_t)INW * DM); z[c * 55 + tid] = (u32x4){0u, 0u, 0u, 0u}; }
    {
        const f32x4* src = (const f32x4*)(inp(I_P) + (size_t)L * M * PLE); u32x4* dst = (u32x4*)(ws + WS_PB);
#pragma unroll
        for (int i = 0; i < 8; ++i) {
            const int idx = c * 4096 + i * 512 + tid;
            const f32x4 a = src[2 * idx], b = src[2 * idx + 1];
            u32x4 w; w.x = pk2(a[0], a[1]); w.y = pk2(a[2], a[3]); w.z = pk2(b[0], b[1]); w.w = pk2(b[2], b[3]); dst[idx] = w;
        }
    }
}

__device__ __forceinline__ void task_prep(const float* const* in, unsigned char* ws, int L, int tile, LAS unsigned char* lds) {
    const int tid = TID(), lane = tid & 63, wave = tid >> 6;
    bf16_t* z = (bf16_t*)(ws + WS_R1);
    const int row0 = tile * 64;
#pragma unroll
    for (int pass = 0; pass < 3; ++pass) {
        const int seg = pass * 64 + lane;
        int col = 0, gs = 8; const float* gp = inp(I_NQN); float scale = 1.f;
        if (seg < 48) { col = C_NQ + 8 * seg; gp = inp(I_NQN) + L * 64 + ((8 * seg) & 63); scale = 0.125f * LOG2E; }
        else if (seg < 64) { col = C_SK + 8 * (seg - 48); gp = inp(I_NKN) + (L * 3 + 1) * 64 + ((8 * seg) & 63); }
        else if (seg < 80) { col = C_WK + 8 * (seg - 64); gp = inp(I_NKN) + (L * 3 + 2) * 64 + ((8 * seg) & 63); }
        else if (seg < 112) { col = C_DQ + 8 * (seg - 80); gp = inp(I_DQN) + L * 32 + ((8 * seg) & 31); gs = 4; scale = 0.17677669529663689f * LOG2E; }
        else { col = C_DK + 8 * (seg - 112); gp = inp(I_DKN) + L * 32 + ((8 * seg) & 31); gs = 4; }
        const bool act = seg < 144;
        if (!act) { col = 0; }
        const f32x4 g0 = *(const f32x4*)gp, g1 = *(const f32x4*)(gp + 4);
        u32x4 w[8];
#pragma unroll
        for (int i = 0; i < 8; ++i) w[i] = *(const u32x4*)(z + (size_t)(row0 + wave + 8 * i) * ZW + col);
#pragma unroll
        for (int i = 0; i < 8; ++i) {
            float v[8] = {bflo(w[i].x), bfhi(w[i].x), bflo(w[i].y), bfhi(w[i].y), bflo(w[i].z), bfhi(w[i].z), bflo(w[i].w), bfhi(w[i].w)};
            float ss = 0.f;
#pragma unroll
            for (int e2 = 0; e2 < 8; ++e2) ss += v[e2] * v[e2];
            ss += __shfl_xor(ss, 1); ss += __shfl_xor(ss, 2);
            const float t4 = __shfl_xor(ss, 4); if (gs == 8) ss += t4;
            const float r = rsqrtf(ss / (float)(gs * 8) + EPS) * scale;
            u32x4 o; o.x = pk2(v[0] * r * g0[0], v[1] * r * g0[1]); o.y = pk2(v[2] * r * g0[2], v[3] * r * g0[3]);
            o.z = pk2(v[4] * r * g1[0], v[5] * r * g1[1]); o.w = pk2(v[6] * r * g1[2], v[7] * r * g1[3]);
            if (act) *(u32x4*)(z + (size_t)(row0 + wave + 8 * i) * ZW + col) = o;
        }
    }
    LAS bf16_t* tl = (LAS bf16_t*)lds;
#pragma unroll
    for (int i = 0; i < 8; ++i) {
        const int id = i * 512 + tid, row = id >> 6, ch = id & 63;
        const int col = ch < 16 ? C_SV + 8 * ch : (ch < 32 ? C_WV + 8 * (ch - 16) : C_DV + 8 * (ch - 32));
        *(LAS u32x4*)(tl + row * 520 + 8 * ch) = *(const u32x4*)(z + (size_t)(row0 + row) * ZW + col);
    }
    __syncthreads();
    const int b = row0 / T, t0 = row0 % T;
    bf16_t* vt = (bf16_t*)(ws + WS_VT);
#pragma unroll
    for (int i = 0; i < 8; ++i) {
        const int orow = tid, tch = i;
        const LAS bf16_t* s = tl + (tch * 8) * 520 + orow;
        u32x4 o;
        o.x = (unsigned)s[0] | ((unsigned)s[520] << 16); o.y = (unsigned)s[2 * 520] | ((unsigned)s[3 * 520] << 16);
        o.z = (unsigned)s[4 * 520] | ((unsigned)s[5 * 520] << 16); o.w = (unsigned)s[6 * 520] | ((unsigned)s[7 * 520] << 16);
        *(u32x4*)(vt + ((size_t)(b * 8) * 64 + orow) * T + t0 + 8 * tch) = o;
    }
}

__device__ __forceinline__ float gelu_tanh(float x) {
    const float y = 0.7978845608028654f * (x + 0.044715f * x * x * x);
    const float th = 1.0f - 2.0f * __builtin_amdgcn_rcpf(1.0f + __expf(2.0f * y));
    return 0.5f * x * (1.0f + th);
}
__device__ __forceinline__ void task_compress(const float* const* in, unsigned char* ws, int L, int task, LAS unsigned char* lds) {
    const int tid = TID(), lane = tid & 63, wave = tid >> 6;
    const int ty = task >> 8, b = (task >> 6) & 3, g = (task >> 5) & 1, i0 = (task & 31) * 16;
    const bf16_t* z = (const bf16_t*)(ws + WS_R1);
    LAS bf16_t* zt = (LAS bf16_t*)lds;
    LAS bf16_t* hid = (LAS bf16_t*)(lds + 39168);
    LAS float* ofp = (LAS float*)(lds + 39168 + 8448);
    const int ccol = (ty ? C_CV : C_CK) + 64 * g;
    for (int id = tid; id < 272 * 8; id += 512) {
        const int row = id >> 3, ch = id & 7, tok = 16 * i0 + row;
        u32x4 v = (u32x4){0u, 0u, 0u, 0u};
        if (tok < T) v = *(const u32x4*)(z + (size_t)(b * T + tok) * ZW + ccol + 8 * ch);
        *(LAS u32x4*)(zt + row * 72 + 8 * ch) = v;
    }
    __syncthreads();
    const bf16_t* w1t = (const bf16_t*)(ws + WS_W + W_1T) + (size_t)ty * 256 * 2048;
    const bf16_t* w2t = (const bf16_t*)(ws + WS_W + W_2T) + (size_t)ty * 64 * 256;
    const float* posb = (const float*)(ws + WS_W + W_POSB) + ty * 32 * 256;
    const int r16 = lane & 15, kq = lane >> 4;
    f32x4 acc[2] = {(f32x4){0.f, 0.f, 0.f, 0.f}, (f32x4){0.f, 0.f, 0.f, 0.f}};
    const bf16_t* b0p = w1t + (size_t)(16 * (2 * wave) + r16) * 2048 + 8 * kq;
    const bf16_t* b1p = b0p + 16 * 2048;
#pragma unroll 8
    for (int kc = 0; kc < 64; ++kc) {
        const bf16x8 a = *(const LAS bf16x8*)(zt + (16 * r16 + (kc >> 1)) * 72 + (kc & 1) * 32 + 8 * kq);
        const bf16x8 w0 = *(const bf16x8*)(b0p + 32 * kc), w1 = *(const bf16x8*)(b1p + 32 * kc);
        acc[0] = mfma16(a, w0, acc[0]); acc[1] = mfma16(a, w1, acc[1]);
    }
#pragma unroll
    for (int j = 0; j < 2; ++j) {
        const int n = 16 * (2 * wave + j) + r16;
        float pbias = 0.f;
#pragma unroll
        for (int ks = 0; ks < 32; ++ks) pbias += posb[ks * 256 + n];
#pragma unroll
        for (int i = 0; i < 4; ++i) hid[(4 * kq + i) * 264 + n] = f2bf(gelu_tanh(acc[j][i] + pbias));
    }
    __syncthreads();
    if (wave < 4) {
        f32x4 a2 = (f32x4){0.f, 0.f, 0.f, 0.f};
        const bf16_t* bp = w2t + (size_t)(16 * wave + r16) * 256 + 8 * kq;
#pragma unroll
        for (int kc = 0; kc < 8; ++kc) {
            const bf16x8 a = *(const LAS bf16x8*)(hid + r16 * 264 + 32 * kc + 8 * kq);
            const bf16x8 w = *(const bf16x8*)(bp + 32 * kc);
            a2 = mfma16(a, w, a2);
        }
#pragma unroll
        for (int i = 0; i < 4; ++i) ofp[(4 * kq + i) * 64 + 16 * wave + r16] = a2[i];
    }
    __syncthreads();
    if (tid < 256) {
        const int row = tid >> 4, c4 = (tid & 15) * 4, i = i0 + row;
        f32x4 o = *(const LAS f32x4*)(ofp + row * 64 + c4);
        float ss = (o[0] * o[0] + o[1] * o[1]) + (o[2] * o[2] + o[3] * o[3]);
        ss += __shfl_xor(ss, 1); ss += __shfl_xor(ss, 2); ss += __shfl_xor(ss, 4); ss += __shfl_xor(ss, 8);
        if (ty == 0) {
            const float r = rsqrtf(ss * (1.0f / 64.0f) + EPS);
            const f32x4 gn = *(const f32x4*)(inp(I_NKN) + (L * 3 + 0) * 64 + c4);
            o = o * r * gn;
        }
        if (i >= 511) o = (f32x4){0.f, 0.f, 0.f, 0.f};
        if (ty == 0) {
            u32x2 w; w.x = pk2(o[0], o[1]); w.y = pk2(o[2], o[3]);
            *(u32x2*)((bf16_t*)(ws + WS_KC) + ((size_t)(b * 2 + g) * 512 + i) * 64 + c4) = w;
        } else {
            bf16_t* vct = (bf16_t*)(ws + WS_VCT) + (size_t)(b * 2 + g) * 64 * 512;
#pragma unroll
            for (int e = 0; e < 4; ++e) vct[(size_t)(c4 + e) * 512 + i] = f2bf(o[e]);
        }
    }
}

__device__ __forceinline__ float hgrn_lb(const float* logits, int L, int j) {
    if (L == 0) return 0.f;
    const float a0 = logits[j], a1 = logits[384 + j], a2 = logits[768 + j], a3 = logits[1152 + j];
    const float mx = fmaxf(fmaxf(a0, a1), fmaxf(a2, a3));
    const float e0 = __expf(a0 - mx), e1 = __expf(a1 - mx), e2 = __expf(a2 - mx), e3 = __expf(a3 - mx);
    const float inv = 1.0f / (e0 + e1 + e2 + e3);
    float s = e1; if (L >= 2) s += e2; if (L >= 3) s += e3;
    return s * inv;
}
__device__ __forceinline__ void task_hgrn_local(const float* const* in, unsigned char* ws, int L, int task, LAS unsigned char* lds) {
    const int tid = TID(), lane = tid & 63, wave = tid >> 6;
    if (wave < 6) {
        const int chunk = task * 6 + wave;
        const int bh = chunk >> 7, c = chunk & 127, b = bh / 6, h = bh % 6;
        const bf16_t* z = (const bf16_t*)(ws + WS_R1) + (size_t)(b * T + c * 64) * ZW;
        LAS bf16_t* klT = (LAS bf16_t*)(lds + wave * 18432);
        LAS bf16_t* vT = klT + 64 * 72;
        const float lb = hgrn_lb(inp(I_LBLOG), L, h * 64 + lane);
        LAS bf16_t* rawf = klT;
        (void)rawf;
        u32x4 rf[8], ri[8];
#pragma unroll
        for (int i = 0; i < 8; ++i) {
            const int row = (lane >> 3) + 8 * i, ch = lane & 7;
            rf[i] = *(const u32x4*)(z + (size_t)row * ZW + C_HF + 64 * h + 8 * ch);
            ri[i] = *(const u32x4*)(z + (size_t)row * ZW + C_HI + 64 * h + 8 * ch);
        }
#pragma unroll
        for (int i = 0; i < 8; ++i) {
            const int row = (lane >> 3) + 8 * i, ch = lane & 7;
            *(LAS u32x4*)(klT + row * 72 + 8 * ch) = rf[i];
            *(LAS u32x4*)(vT + row * 72 + 8 * ch) = ri[i];
        }
        LDSW();
        float suffix = 0.f;
        bf16_t colf[64], colv[64];
#pragma unroll
        for (int s2 = 0; s2 < 64; ++s2) { colf[s2] = klT[s2 * 72 + lane]; colv[s2] = vT[s2 * 72 + lane]; }
        LDSW();
#pragma unroll
        for (int s = 63; s >= 0; --s) {
            const float fr = bf2f(colf[s]);
            const float sg = sigmoidf_(fr);
            const float f = lb + (1.0f - lb) * sg;
            const float ig = (1.0f - lb) * (1.0f - sg);
            klT[lane * 72 + s] = f2bf(ig * __expf(suffix));
            vT[lane * 72 + s] = colv[s];
            suffix += __logf(f);
        }
        ((float*)(ws + WS_HD))[(size_t)chunk * 64 + lane] = __expf(suffix);
        LDSW();
        const int r32 = lane & 31, hi = lane >> 5;
        float* hs = (float*)(ws + WS_HS) + (size_t)chunk * 4096;
#pragma unroll
        for (int kb = 0; kb < 2; ++kb)
#pragma unroll
            for (int vb = 0; vb < 2; ++vb) {
                f32x16 cacc = {};
#pragma unroll
                for (int cc = 0; cc < 4; ++cc) {
                    const bf16x8 a = *(const LAS bf16x8*)(klT + (32 * kb + r32) * 72 + 16 * cc + 8 * hi);
                    const bf16x8 bb = *(const LAS bf16x8*)(vT + (32 * vb + r32) * 72 + 16 * cc + 8 * hi);
                    cacc = mfma32(a, bb, cacc);
                }
#pragma unroll
                for (int r = 0; r < 16; ++r) hs[(32 * kb + crow(r, hi)) * 64 + 32 * vb + r32] = cacc[r];
            }
    }
}
__device__ __forceinline__ void task_hgrn_scan(unsigned char* ws, int task) {
    const int tid = TID();
    const int bh = task >> 3, k = (task & 7) * 8 + (tid >> 6), v = tid & 63;
    float* hs = (float*)(ws + WS_HS) + (size_t)bh * 128 * 4096 + k * 64 + v;
    const float* hd = (const float*)(ws + WS_HD) + (size_t)bh * 128 * 64 + k;
    float S = 0.f;
#pragma unroll 16
    for (int c = 0; c < 128; ++c) {
        const float a = hs[(size_t)c * 4096], d = hd[c * 64];
        hs[(size_t)c * 4096] = S;
        S = d * S + a;
    }
}
__device__ __forceinline__ void task_hgrn_out(const float* const* in, unsigned char* ws, int L, int task, LAS unsigned char* lds) {
    const int tid = TID(), lane = tid & 63, wave = tid >> 6;
    if (wave < 3) {
        const int chunk = task * 3 + wave;
        const int bh = chunk >> 7, c = chunk & 127, b = bh / 6, h = bh % 6;
        const size_t row0 = (size_t)(b * T + c * 64);
        const bf16_t* z = (const bf16_t*)(ws + WS_R1) + row0 * ZW;
        LAS bf16_t* ke = (LAS bf16_t*)(lds + wave * 36864);
        LAS bf16_t* qe = ke + 64 * 72;
        LAS bf16_t* vT = qe + 64 * 72;
        LAS bf16_t* sT = vT + 64 * 72;
        const float lb = hgrn_lb(inp(I_LBLOG), L, h * 64 + lane);
        {
            u32x4 rq[8], rf[8], ri[8];
#pragma unroll
            for (int i = 0; i < 8; ++i) {
                const int row = (lane >> 3) + 8 * i, ch = lane & 7;
                rq[i] = *(const u32x4*)(z + (size_t)row * ZW + C_HQ + 64 * h + 8 * ch);
                rf[i] = *(const u32x4*)(z + (size_t)row * ZW + C_HF + 64 * h + 8 * ch);
                ri[i] = *(const u32x4*)(z + (size_t)row * ZW + C_HI + 64 * h + 8 * ch);
            }
#pragma unroll
            for (int i = 0; i < 8; ++i) {
                const int row = (lane >> 3) + 8 * i, ch = lane & 7;
                *(LAS u32x4*)(qe + row * 72 + 8 * ch) = rq[i];
                *(LAS u32x4*)(ke + row * 72 + 8 * ch) = rf[i];
                *(LAS u32x4*)(sT + row * 72 + 8 * ch) = ri[i];
            }
        }
        LDSW();
        float ref = 0.f;
#pragma unroll 8
        for (int s = 0; s < 32; ++s) {
            const float fr = bf2f(ke[s * 72 + lane]);
            ref += __logf(lb + (1.0f - lb) * sigmoidf_(fr));
        }
        float cum = 0.f;
#pragma unroll 8
        for (int s = 0; s < 64; ++s) {
            const float fr = bf2f(ke[s * 72 + lane]);
            const float qv = bf2f(qe[s * 72 + lane]);
            const bf16_t vraw = sT[s * 72 + lane];
            const float sg = sigmoidf_(fr);
            const float f = lb + (1.0f - lb) * sg;
            const float ig = (1.0f - lb) * (1.0f - sg);
            cum += __logf(f);
            qe[s * 72 + lane] = f2bf(qv * sigmoidf_(qv) * __expf(cum - ref));
            ke[s * 72 + lane] = f2bf(ig * __expf(ref - cum));
            vT[lane * 72 + s] = vraw;
        }
        LDSW();
        const float* hs = (const float*)(ws + WS_HS) + (size_t)chunk * 4096;
        const float eref = __expf(ref);
        {
            f32x4 hv[16];
#pragma unroll
            for (int i = 0; i < 16; ++i) hv[i] = *(const f32x4*)(hs + ((lane >> 4) + 4 * i) * 64 + (lane & 15) * 4);
#pragma unroll
            for (int i = 0; i < 16; ++i) {
                const int k = (lane >> 4) + 4 * i, v4 = (lane & 15) * 4;
                const float er = __shfl(eref, k);
                sT[(v4 + 0) * 72 + k] = f2bf(hv[i][0] * er); sT[(v4 + 1) * 72 + k] = f2bf(hv[i][1] * er);
                sT[(v4 + 2) * 72 + k] = f2bf(hv[i][2] * er); sT[(v4 + 3) * 72 + k] = f2bf(hv[i][3] * er);
            }
        }
        LDSW();
        const int r32 = lane & 31, hi = lane >> 5;
        f32x16 O[2][2] = {};
#pragma unroll
        for (int tb = 0; tb < 2; ++tb) {
            bf16x8 qf[4];
#pragma unroll
            for (int cc = 0; cc < 4; ++cc) qf[cc] = *(const LAS bf16x8*)(qe + (32 * tb + r32) * 72 + 16 * cc + 8 * hi);
#pragma unroll
            for (int vb = 0; vb < 2; ++vb)
#pragma unroll
                for (int cc = 0; cc < 4; ++cc) {
                    const bf16x8 a = *(const LAS bf16x8*)(sT + (32 * vb + r32) * 72 + 16 * cc + 8 * hi);
                    O[vb][tb] = mfma32(a, qf[cc], O[vb][tb]);
                }
#pragma unroll
            for (int sb = 0; sb <= tb; ++sb) {
                f32x16 sc = {};
#pragma unroll
                for (int cc = 0; cc < 4; ++cc) {
                    const bf16x8 a = *(const LAS bf16x8*)(ke + (32 * sb + r32) * 72 + 16 * cc + 8 * hi);
                    sc = mfma32(a, qf[cc], sc);
                }
                unsigned P[8];
#pragma unroll
                for (int j = 0; j < 8; ++j) {
                    float p0 = sc[2 * j], p1 = sc[2 * j + 1];
                    if (sb == tb) { if (crow(2 * j, hi) > r32) p0 = 0.f; if (crow(2 * j + 1, hi) > r32) p1 = 0.f; }
                    P[j] = pk2(p0, p1);
                }
#pragma unroll
                for (int vb = 0; vb < 2; ++vb)
#pragma unroll
                    for (int c2 = 0; c2 < 2; ++c2) {
                        const u32x2 a0 = *(const LAS u32x2*)(vT + (32 * vb + r32) * 72 + 32 * sb + 16 * c2 + 4 * hi);
                        const u32x2 a1 = *(const LAS u32x2*)(vT + (32 * vb + r32) * 72 + 32 * sb + 16 * c2 + 8 + 4 * hi);
                        const bf16x8 vf = as_bf16x8((u32x4){a0.x, a0.y, a1.x, a1.y});
                        const bf16x8 pf = as_bf16x8((u32x4){P[4 * c2], P[4 * c2 + 1], P[4 * c2 + 2], P[4 * c2 + 3]});
                        O[vb][tb] = mfma32(vf, pf, O[vb][tb]);
                    }
            }
        }
        LDSW();
        const float* on = inp(I_HON) + L * 64;
#pragma unroll
        for (int tb = 0; tb < 2; ++tb) {
            float ss = 0.f;
#pragma unroll
            for (int vb = 0; vb < 2; ++vb)
#pragma unroll
                for (int r = 0; r < 16; ++r) ss += O[vb][tb][r] * O[vb][tb][r];
            ss += __shfl_xor(ss, 32);
            const float rn = rsqrtf(ss * (1.0f / 64.0f) + EPS);
#pragma unroll
            for (int vb = 0; vb < 2; ++vb)
#pragma unroll
                for (int r = 0; r < 16; ++r) { const int v = 32 * vb + crow(r, hi); ke[(32 * tb + r32) * 72 + v] = f2bf(O[vb][tb][r] * rn * on[v]); }
        }
        LDSW();
        bf16_t* mixed = (bf16_t*)(ws + WS_MIX) + row0 * DM + 640 + 64 * h;
#pragma unroll
        for (int i = 0; i < 8; ++i) {
            const int t = i * 8 + (lane >> 3), ch = lane & 7;
            const u32x4 ov = *(const LAS u32x4*)(ke + t * 72 + 8 * ch);
            const u32x4 gv = *(const u32x4*)(z + (size_t)t * ZW + C_HG + 64 * h + 8 * ch);
            u32x4 w;
            { const float g0 = bflo(gv.x), g1 = bfhi(gv.x); w.x = pk2(bflo(ov.x) * g0 * sigmoidf_(g0), bfhi(ov.x) * g1 * sigmoidf_(g1)); }
            { const float g0 = bflo(gv.y), g1 = bfhi(gv.y); w.y = pk2(bflo(ov.y) * g0 * sigmoidf_(g0), bfhi(ov.y) * g1 * sigmoidf_(g1)); }
            { const float g0 = bflo(gv.z), g1 = bfhi(gv.z); w.z = pk2(bflo(ov.z) * g0 * sigmoidf_(g0), bfhi(ov.z) * g1 * sigmoidf_(g1)); }
            { const float g0 = bflo(gv.w), g1 = bfhi(gv.w); w.w = pk2(bflo(ov.w) * g0 * sigmoidf_(g0), bfhi(ov.w) * g1 * sigmoidf_(g1)); }
            *(u32x4*)(mixed + (size_t)t * DM + 8 * ch) = w;
        }
    }
}

constexpr int ATT_K = 0, ATT_V = 18432, ATT_LUT = 35840, ATT_STAGE = 36864;
__device__ __forceinline__ void build_lut(LAS float* lut, const float* rel_bias, int head) {
    const int d = TID();
    if (d <= 128) {
        int bk = d;
        if (d >= 16) { const int far = 16 + (int)(__logf((float)d * (1.0f / 16.0f)) / 2.0794415416798357f * 16.0f); bk = far < 31 ? far : 31; }
        lut[d] = rel_bias[bk * 10 + head] * LOG2E;
    }
}
template <int NMAP, bool HAS_SEL, bool FAST>
__device__ __forceinline__ void attn_tile(const LAS unsigned char* Kb, const LAS unsigned char* Vb, const bf16x8 (&qr)[4], int tq, int k0, int win, float c31, const LAS float* lut, bool sel,
                                          f32x16 (&O)[NMAP][2], float (&l)[NMAP], int r32, int hi) {
    unsigned P[NMAP][2][8];
#pragma unroll
    for (int kh2 = 0; kh2 < 2; ++kh2) {
        f32x16 S[NMAP];
        const float ini = FAST ? ((HAS_SEL && !sel) ? -30000.f : c31) : 0.f;
#pragma unroll
        for (int mp = 0; mp < NMAP; ++mp)
#pragma unroll
            for (int r = 0; r < 16; ++r) S[mp][r] = ini;
#pragma unroll
        for (int c = 0; c < 4; ++c) {
            const bf16x8 kf = *(const LAS bf16x8*)(Kb + (32 * kh2 + r32) * 144 + (16 * c + 8 * hi) * 2);
            const int mp = (NMAP == 2) ? (c >> 1) : 0;
            S[mp] = mfma32(kf, qr[c], S[mp]);
        }
#pragma unroll
        for (int mp = 0; mp < NMAP; ++mp) {
            float p[16];
            if (FAST) {
#pragma unroll
                for (int r = 0; r < 16; ++r) p[r] = ex2(S[mp][r]);
            } else {
#pragma unroll
                for (int r = 0; r < 16; ++r) {
                    const int d = tq - (k0 + 32 * kh2 + crow(r, hi));
                    const bool valid = sel && d >= 0 && d < win;
                    const int dc = d < 0 ? 0 : (d > 128 ? 128 : d);
                    const float e = ex2(S[mp][r] + lut[dc]);
                    p[r] = valid ? e : 0.f;
                }
            }
            float s = 0.f;
#pragma unroll
            for (int r = 0; r < 16; ++r) s += p[r];
            l[mp] += s;
#pragma unroll
            for (int j = 0; j < 8; ++j) P[mp][kh2][j] = pk2(p[2 * j], p[2 * j + 1]);
        }
        if (NMAP == 2) __builtin_amdgcn_sched_barrier(0);
    }
#pragma unroll
    for (int cc = 0; cc < 4; ++cc)
#pragma unroll
        for (int db = 0; db < 2; ++db) {
            const u32x2 a0 = *(const LAS u32x2*)(Vb + (32 * db + r32) * 136 + (16 * cc + 4 * hi) * 2);
            const u32x2 a1 = *(const LAS u32x2*)(Vb + (32 * db + r32) * 136 + (16 * cc + 8 + 4 * hi) * 2);
            const bf16x8 vf = as_bf16x8((u32x4){a0.x, a0.y, a1.x, a1.y});
#pragma unroll
            for (int mp = 0; mp < NMAP; ++mp) {
                const bf16x8 pf = as_bf16x8((u32x4){P[mp][cc >> 1][4 * (cc & 1)], P[mp][cc >> 1][4 * (cc & 1) + 1], P[mp][cc >> 1][4 * (cc & 1) + 2], P[mp][cc >> 1][4 * (cc & 1) + 3]});
                O[mp][db] = mfma32(vf, pf, O[mp][db]);
            }
        }
}
template <int NMAP, bool HAS_SEL>
__device__ __forceinline__ void attn_pass(LAS unsigned char* lds, const bf16_t* Kth, size_t kts, const bf16_t* Vth, int m_lo, int m_hi,
                                          const bf16x8 (&qr)[4], int tq, int qw0, int win, const LAS float* lut, u32x4 selw,
                                          f32x16 (&O)[NMAP][2], float (&l)[NMAP]) {
    const int tid = TID(), lane = tid & 63, r32 = lane & 31, hi = lane >> 5;
    const float c31 = lut[128];
    u32x4 kreg = *(const u32x4*)(Kth + (size_t)m_lo * kts), vreg = *(const u32x4*)(Vth + (size_t)m_lo * 64);
    int buf = 0;
    for (int m = m_lo; m <= m_hi; ++m) {
        *(LAS u32x4*)(lds + ATT_K + buf * 9216 + (tid >> 3) * 144 + (tid & 7) * 16) = kreg;
        { LAS u32x2* vp = (LAS u32x2*)(lds + ATT_V + buf * 8704 + (tid >> 3) * 136 + (tid & 7) * 16); vp[0] = (u32x2){vreg.x, vreg.y}; vp[1] = (u32x2){vreg.z, vreg.w}; }
        __syncthreads();
        if (m < m_hi) { kreg = *(const u32x4*)(Kth + (size_t)(m + 1) * kts); vreg = *(const u32x4*)(Vth + (size_t)(m + 1) * 64); }
        const int k0 = 64 * m, dmin = qw0 - (k0 + 63), dmax = qw0 + 31 - k0;
        bool sel = true;
        if (HAS_SEL) { const unsigned w = m < 32 ? selw.x : (m < 64 ? selw.y : (m < 96 ? selw.z : selw.w)); sel = (w >> (m & 31)) & 1u; }
        bool active = dmax >= 0 && dmin < win;
        if (HAS_SEL) active = active && (__any(sel) != 0);
        if (active) {
            if (NMAP == 1) {
                const LAS unsigned char* Kb = lds + ATT_K + buf * 9216;
                const LAS unsigned char* Vb = lds + ATT_V + buf * 8704;
                if (dmin >= 128 && dmax < win) attn_tile<NMAP, HAS_SEL, true>(Kb, Vb, qr, tq, k0, win, c31, lut, sel, O, l, r32, hi);
                else attn_tile<NMAP, HAS_SEL, false>(Kb, Vb, qr, tq, k0, win, c31, lut, sel, O, l, r32, hi);
            } else {
            const bool fast = dmin >= 128 && dmax < win;
            const LAS unsigned char* Kb = lds + ATT_K + buf * 9216;
            const LAS unsigned char* Vb = lds + ATT_V + buf * 8704;
            unsigned P[NMAP][2][8];
#pragma unroll
            for (int kh2 = 0; kh2 < 2; ++kh2) {
                f32x16 S[NMAP];
#pragma unroll
                for (int mp = 0; mp < NMAP; ++mp) { const float ini = fast ? c31 : 0.f;
#pragma unroll
                    for (int r = 0; r < 16; ++r) S[mp][r] = ini; }
#pragma unroll
                for (int c = 0; c < 4; ++c) {
                    const bf16x8 kf = *(const LAS bf16x8*)(Kb + (32 * kh2 + r32) * 144 + (16 * c + 8 * hi) * 2);
                    const int mp = (NMAP == 2) ? (c >> 1) : 0;
                    S[mp] = mfma32(kf, qr[c], S[mp]);
                }
#pragma unroll
                for (int mp = 0; mp < NMAP; ++mp) {
                    float p[16];
                    if (fast) {
#pragma unroll
                        for (int r = 0; r < 16; ++r) { const float e = ex2(S[mp][r]); p[r] = sel ? e : 0.f; }
                    } else {
#pragma unroll
                        for (int r = 0; r < 16; ++r) {
                            const int d = tq - (k0 + 32 * kh2 + crow(r, hi));
                            const bool valid = sel && d >= 0 && d < win;
                            const int dc = d < 0 ? 0 : (d > 128 ? 128 : d);
                            const float e = ex2(S[mp][r] + lut[dc]);
                            p[r] = valid ? e : 0.f;
                        }
                    }
                    float s = 0.f;
#pragma unroll
                    for (int r = 0; r < 16; ++r) s += p[r];
                    l[mp] += s;
#pragma unroll
                    for (int j = 0; j < 8; ++j) P[mp][kh2][j] = pk2(p[2 * j], p[2 * j + 1]);
                }
            }
#pragma unroll
            for (int db = 0; db < 2; ++db)
#pragma unroll
                for (int cc = 0; cc < 4; ++cc) {
                    const u32x2 a0 = *(const LAS u32x2*)(Vb + (32 * db + r32) * 136 + (16 * cc + 4 * hi) * 2);
                    const u32x2 a1 = *(const LAS u32x2*)(Vb + (32 * db + r32) * 136 + (16 * cc + 8 + 4 * hi) * 2);
                    const bf16x8 vf = as_bf16x8((u32x4){a0.x, a0.y, a1.x, a1.y});
#pragma unroll
                    for (int mp = 0; mp < NMAP; ++mp) {
                        const bf16x8 pf = as_bf16x8((u32x4){P[mp][cc >> 1][4 * (cc & 1)], P[mp][cc >> 1][4 * (cc & 1) + 1], P[mp][cc >> 1][4 * (cc & 1) + 2], P[mp][cc >> 1][4 * (cc & 1) + 3]});
                        O[mp][db] = mfma32(vf, pf, O[mp][db]);
                    }
                }
            }
        }
        buf ^= 1;
    }
    __syncthreads();
}
template <bool ADD>
__device__ __forceinline__ void store_ot(LAS unsigned char* stage, const float (&val)[2][16], bf16_t* dst, int ld, const bf16_t* addsrc = nullptr, int ldadd = 0) {
    const int lane = TID() & 63, r32 = lane & 31, hi = lane >> 5;
    LAS bf16_t* st = (LAS bf16_t*)stage;
#pragma unroll
    for (int db = 0; db < 2; ++db)
#pragma unroll
        for (int r = 0; r < 16; ++r) st[r32 * 72 + 32 * db + crow(r, hi)] = f2bf(val[db][r]);
    LDSW();
#pragma unroll
    for (int i = 0; i < 4; ++i) {
        const int row = i * 8 + (lane >> 3), ch = lane & 7;
        u32x4 v = *(const LAS u32x4*)(st + row * 72 + 8 * ch);
        bf16_t* gp = dst + (size_t)row * ld + 8 * ch;
        if (ADD) {
            const u32x4 o = *(const u32x4*)(addsrc + (size_t)row * ldadd + 8 * ch);
            v.x = pk2(bflo(v.x) + bflo(o.x), bfhi(v.x) + bfhi(o.x)); v.y = pk2(bflo(v.y) + bflo(o.y), bfhi(v.y) + bfhi(o.y));
            v.z = pk2(bflo(v.z) + bflo(o.z), bfhi(v.z) + bfhi(o.z)); v.w = pk2(bflo(v.w) + bflo(o.w), bfhi(v.w) + bfhi(o.w));
        }
        *(u32x4*)gp = v;
    }
    LDSW();
}

__device__ __forceinline__ void task_diff(const float* const* in, unsigned char* ws, int L, int task, LAS unsigned char* lds) {
    const int tid = TID(), lane = tid & 63, wave = tid >> 6, r32 = lane & 31, hi = lane >> 5;
    const int qb = 31 - (task >> 4), b = (task >> 2) & 3, hd = task & 3;
    const bf16_t* z = (const bf16_t*)(ws + WS_R1);
    LAS float* lut = (LAS float*)(lds + ATT_LUT);
    build_lut(lut, inp(I_RELB), 6 + hd);
    __syncthreads();
    const int q0 = 256 * qb, qw0 = q0 + 32 * wave, tq = qw0 + r32;
    bf16x8 qr[4];
#pragma unroll
    for (int c = 0; c < 4; ++c) qr[c] = *(const bf16x8*)(z + (size_t)(b * T + tq) * ZW + C_DQ + 64 * hd + 16 * c + 8 * hi);
    const bf16_t* Kth = z + (size_t)(b * T + (tid >> 3)) * ZW + C_DK + 64 * hd + (tid & 7) * 8;
    const bf16_t* Vth = (const bf16_t*)(ws + WS_VT) + ((size_t)(b * 8 + 4 + hd) * 64 + (tid >> 3)) * T + (tid & 7) * 8;
    f32x16 O[2][2] = {}; float l[2] = {0.f, 0.f};
    attn_pass<2, false>(lds, Kth, (size_t)64 * ZW, Vth, 0, 4 * qb + 3, qr, tq, qw0, 1 << 30, lut, (u32x4){0u, 0u, 0u, 0u}, O, l);
    const float* lp = inp(I_DLAM) + L * 128;
    float s01 = 0.f, s23 = 0.f;
#pragma unroll
    for (int i = 0; i < 32; ++i) { s01 += lp[i] * lp[32 + i]; s23 += lp[64 + i] * lp[96 + i]; }
    const float lam_init = 0.8f - 0.6f * __expf(-0.3f * (float)L);
    const float lam = __expf(s01) - __expf(s23) + lam_init;
    const float l0 = l[0] + __shfl_xor(l[0], 32), l1 = l[1] + __shfl_xor(l[1], 32);
    const float i0 = __builtin_amdgcn_rcpf(l0), i1 = lam * __builtin_amdgcn_rcpf(l1);
    float val[2][16]; float ss = 0.f;
#pragma unroll
    for (int db = 0; db < 2; ++db)
#pragma unroll
        for (int r = 0; r < 16; ++r) { const float o = O[0][db][r] * i0 - O[1][db][r] * i1; val[db][r] = o; ss += o * o; }
    ss += __shfl_xor(ss, 32);
    const float rn = rsqrtf(ss * (1.0f / 64.0f) + EPS) * (1.0f - lam_init);
    const float* sub = inp(I_DSUB) + L * 64;
#pragma unroll
    for (int db = 0; db < 2; ++db)
#pragma unroll
        for (int r = 0; r < 16; ++r) val[db][r] *= rn * sub[32 * db + crow(r, hi)];
    store_ot<false>(lds + ATT_STAGE + wave * 4608, val, (bf16_t*)(ws + WS_MIX) + (size_t)(b * T + qw0) * DM + 384 + 64 * hd, DM);
}

__device__ __forceinline__ void task_nsa_sw(const float* const* in, unsigned char* ws, int L, int task, LAS unsigned char* lds) {
    const int tid = TID(), lane = tid & 63, wave = tid >> 6, r32 = lane & 31, hi = lane >> 5;
    const int qb = 31 - task / 24, rem = task % 24, b = rem / 6, h = rem % 6, g = h / 3;
    const bf16_t* z = (const bf16_t*)(ws + WS_R1);
    LAS float* lut = (LAS float*)(lds + ATT_LUT);
    build_lut(lut, inp(I_RELB), h);
    __syncthreads();
    const int q0 = 256 * qb, qw0 = q0 + 32 * wave, tq = qw0 + r32;
    const bf16_t* zq = z + (size_t)(b * T + tq) * ZW;
    bf16x8 qr[4];
#pragma unroll
    for (int c = 0; c < 4; ++c) qr[c] = *(const bf16x8*)(zq + C_NQ + 64 * h + 16 * c + 8 * hi);
    const u32x4 selw = *(const u32x4*)((const unsigned*)(ws + WS_SELM) + ((size_t)(b * 2 + g) * T + tq) * 4);
    const float g1 = sigmoidf_(bf2f(zq[C_NG + 3 * h + 1])), g2 = sigmoidf_(bf2f(zq[C_NG + 3 * h + 2]));
    float val[2][16];
    {
        const bf16_t* Kth = z + (size_t)(b * T + (tid >> 3)) * ZW + C_SK + 64 * g + (tid & 7) * 8;
        const bf16_t* Vth = (const bf16_t*)(ws + WS_VT) + ((size_t)(b * 8 + g) * 64 + (tid >> 3)) * T + (tid & 7) * 8;
        f32x16 O[1][2] = {}; float l[1] = {0.f};
        attn_pass<1, true>(lds, Kth, (size_t)64 * ZW, Vth, 0, 4 * qb + 3, qr, tq, qw0, 1 << 30, lut, selw, O, l);
        const float lt = l[0] + __shfl_xor(l[0], 32), sc = g1 / lt;
#pragma unroll
        for (int db = 0; db < 2; ++db)
#pragma unroll
            for (int r = 0; r < 16; ++r) val[db][r] = O[0][db][r] * sc;
    }
    {
        const bf16_t* Kth = z + (size_t)(b * T + (tid >> 3)) * ZW + C_WK + 64 * g + (tid & 7) * 8;
        const bf16_t* Vth = (const bf16_t*)(ws + WS_VT) + ((size_t)(b * 8 + 2 + g) * 64 + (tid >> 3)) * T + (tid & 7) * 8;
        f32x16 O[1][2] = {}; float l[1] = {0.f};
        const int m_lo = q0 >= 512 ? (q0 >> 6) - 8 : 0;
        attn_pass<1, false>(lds, Kth, (size_t)64 * ZW, Vth, m_lo, 4 * qb + 3, qr, tq, qw0, 512, lut, (u32x4){0u, 0u, 0u, 0u}, O, l);
        const float lt = l[0] + __shfl_xor(l[0], 32), sc = g2 / lt;
#pragma unroll
        for (int db = 0; db < 2; ++db)
#pragma unroll
            for (int r = 0; r < 16; ++r) val[db][r] += O[0][db][r] * sc;
    }
    store_ot<true>(lds + ATT_STAGE + wave * 4608, val, (bf16_t*)(ws + WS_MIX) + (size_t)(b * T + qw0) * DM + 64 * h, DM, (const bf16_t*)(ws + WS_OCB) + (size_t)(b * T + qw0) * 384 + 64 * h, 384);
}

__device__ __forceinline__ unsigned wave_max_u32(unsigned v) {
    unsigned t;
    t = (unsigned)__builtin_amdgcn_update_dpp(0, (int)v, 0xB1, 0xF, 0xF, false); v = t > v ? t : v;
    t = (unsigned)__builtin_amdgcn_update_dpp(0, (int)v, 0x4E, 0xF, 0xF, false); v = t > v ? t : v;
    t = (unsigned)__builtin_amdgcn_update_dpp(0, (int)v, 0x141, 0xF, 0xF, false); v = t > v ? t : v;
    t = (unsigned)__builtin_amdgcn_update_dpp(0, (int)v, 0x140, 0xF, 0xF, false); v = t > v ? t : v;
    t = (unsigned)__builtin_amdgcn_update_dpp(0, (int)v, 0x142, 0xA, 0xF, false); v = t > v ? t : v;
    t = (unsigned)__builtin_amdgcn_update_dpp(0, (int)v, 0x143, 0xC, 0xF, false); v = t > v ? t : v;
    return (unsigned)__builtin_amdgcn_readlane((int)v, 63);
}
constexpr int NC_IMP = 18432, NC_IMPW = 129, NC_LINV = NC_IMP + 3 * 64 * NC_IMPW * 4;
__device__ __forceinline__ void task_nsa_c(const float* const* in, unsigned char* ws, int L, int task, LAS unsigned char* lds) {
    const int tid = TID(), lane = tid & 63, wave = tid >> 6, r32 = lane & 31, hi = lane >> 5;
    const int cur = 127 - (task >> 3), b = (task >> 1) & 3, g = task & 1;
    const bf16_t* z = (const bf16_t*)(ws + WS_R1);
    LAS float* imp = (LAS float*)(lds + NC_IMP);
    LAS float* linv = (LAS float*)(lds + NC_LINV);
    const int q0 = 64 * cur;
    const int rh = wave >> 1, half = wave & 1, h = 3 * g + (rh < 3 ? rh : 0);
    const int ql = 32 * half + r32, tq = q0 + ql;
    const bf16_t* zq = z + (size_t)(b * T + tq) * ZW;
    bf16x8 qr[4];
#pragma unroll
    for (int c = 0; c < 4; ++c) qr[c] = *(const bf16x8*)(zq + C_NQ + 64 * h + 16 * c + 8 * hi);
    const bf16_t* Kth = (const bf16_t*)(ws + WS_KC) + ((size_t)(b * 2 + g) * 512 + (tid >> 3)) * 64 + (tid & 7) * 8;
    const bf16_t* Vth = (const bf16_t*)(ws + WS_VCT) + ((size_t)(b * 2 + g) * 64 + (tid >> 3)) * 512 + (tid & 7) * 8;
    const int ntiles = ((4 * cur + 2) >> 6) + 1;
    f32x16 O[2] = {}; float l = 0.f, carry = 0.f;
    u32x4 kreg = *(const u32x4*)(Kth), vreg = *(const u32x4*)(Vth);
    for (int m = 0; m < ntiles; ++m) {
        __syncthreads();
        *(LAS u32x4*)(lds + (tid >> 3) * 144 + (tid & 7) * 16) = kreg;
        { LAS u32x2* vp = (LAS u32x2*)(lds + 9216 + (tid >> 3) * 136 + (tid & 7) * 16); vp[0] = (u32x2){vreg.x, vreg.y}; vp[1] = (u32x2){vreg.z, vreg.w}; }
        __syncthreads();
        if (m + 1 < ntiles) { kreg = *(const u32x4*)(Kth + (size_t)(m + 1) * 64 * 64); vreg = *(const u32x4*)(Vth + (size_t)(m + 1) * 64); }
        if (wave < 6) {
            unsigned P[2][8]; float av[8], bq[8];
#pragma unroll
            for (int kh2 = 0; kh2 < 2; ++kh2) {
                f32x16 S = {};
#pragma unroll
                for (int c = 0; c < 4; ++c) { const bf16x8 kf = *(const LAS bf16x8*)(lds + (32 * kh2 + r32) * 144 + (16 * c + 8 * hi) * 2); S = mfma32(kf, qr[c], S); }
                float p[16];
#pragma unroll
                for (int r = 0; r < 16; ++r) { const int n = 64 * m + 32 * kh2 + crow(r, hi); const float e = ex2(S[r]); p[r] = (16 * n + 31 <= tq) ? e : 0.f; }
                float s = 0.f;
#pragma unroll
                for (int r = 0; r < 16; ++r) s += p[r];
                l += s;
#pragma unroll
                for (int j = 0; j < 8; ++j) P[kh2][j] = pk2(p[2 * j], p[2 * j + 1]);
#pragma unroll
                for (int j = 0; j < 4; ++j) { av[4 * kh2 + j] = p[4 * j] + p[4 * j + 1] + p[4 * j + 2] + 0.5f * p[4 * j + 3]; bq[4 * kh2 + j] = 0.5f * p[4 * j + 3]; }
            }
#pragma unroll
            for (int db = 0; db < 2; ++db)
#pragma unroll
                for (int cc = 0; cc < 4; ++cc) {
                    const u32x2 a0 = *(const LAS u32x2*)(lds + 9216 + (32 * db + r32) * 136 + (16 * cc + 4 * hi) * 2);
                    const u32x2 a1 = *(const LAS u32x2*)(lds + 9216 + (32 * db + r32) * 136 + (16 * cc + 8 + 4 * hi) * 2);
                    const bf16x8 vf = as_bf16x8((u32x4){a0.x, a0.y, a1.x, a1.y});
                    const bf16x8 pf = as_bf16x8((u32x4){P[cc >> 1][4 * (cc & 1)], P[cc >> 1][4 * (cc & 1) + 1], P[cc >> 1][4 * (cc & 1) + 2], P[cc >> 1][4 * (cc & 1) + 3]});
                    O[db] = mfma32(vf, pf, O[db]);
                }
            float recv[8];
#pragma unroll
            for (int jj = 0; jj < 8; ++jj) { auto rr = __builtin_amdgcn_permlane32_swap(__float_as_uint(bq[jj]), __float_as_uint(bq[jj]), false, false); recv[jj] = __uint_as_float(hi ? rr[0] : rr[1]); }
            LAS float* ip = imp + (rh * 64 + ql) * NC_IMPW + 16 * m + hi;
#pragma unroll
            for (int jj = 0; jj < 8; ++jj) {
                const float add = hi ? recv[jj] : (jj == 0 ? carry : recv[jj > 0 ? jj - 1 : 0]);
                ip[2 * jj] = av[jj] + add;
            }
            carry = recv[7];
        }
    }
    if (wave < 6) {
        const float lt = l + __shfl_xor(l, 32);
        const float li = (tq >= 31 && lt > 0.f) ? 1.0f / lt : 0.f;
        if (hi == 0) linv[rh * 64 + ql] = li;
        const float g0 = sigmoidf_(bf2f(zq[C_NG + 3 * h + 0]));
        bf16_t* mx = (bf16_t*)(ws + WS_OCB) + (size_t)(b * T + tq) * 384 + 64 * h;
        const float sc = li * g0;
#pragma unroll
        for (int db = 0; db < 2; ++db)
#pragma unroll
            for (int r = 0; r < 16; ++r) mx[32 * db + crow(r, hi)] = f2bf(O[db][r] * sc);
    }
    __syncthreads();
#pragma unroll 1
    for (int qi = 0; qi < 8; ++qi) {
        const int q = 8 * wave + qi;
        unsigned w0 = 0u, w1 = 0u, w2 = 0u, w3 = 0u;
        if (cur <= 15) { w0 = (1u << (cur + 1)) - 1u; }
        else {
            const float i0 = linv[q], i1 = linv[64 + q], i2 = linv[128 + q];
            const int ma = lane, mb = lane + 64;
            float va = 0.f, vb = 0.f;
            if (ma >= 1 && ma <= cur - 2) va = imp[(0 * 64 + q) * NC_IMPW + ma] * i0 + imp[(1 * 64 + q) * NC_IMPW + ma] * i1 + imp[(2 * 64 + q) * NC_IMPW + ma] * i2;
            if (mb <= cur - 2) vb = imp[(0 * 64 + q) * NC_IMPW + mb] * i0 + imp[(1 * 64 + q) * NC_IMPW + mb] * i1 + imp[(2 * 64 + q) * NC_IMPW + mb] * i2;
            unsigned ka = va > 0.f ? ((__float_as_uint(va) & ~127u) | (unsigned)(127 - ma)) : 0u;
            unsigned kb = vb > 0.f ? ((__float_as_uint(vb) & ~127u) | (unsigned)(127 - mb)) : 0u;
            w0 = 1u;
#pragma unroll 1
            for (int it = 0; it < 13; ++it) {
                const unsigned best = wave_max_u32(ka > kb ? ka : kb);
                if (best != 0u) {
                    const int mw = 127 - (int)(best & 127u);
                    const unsigned bit = 1u << (mw & 31);
                    if (mw < 32) w0 |= bit; else if (mw < 64) w1 |= bit; else if (mw < 96) w2 |= bit; else w3 |= bit;
                    if (ka == best) ka = 0u;
                    if (kb == best) kb = 0u;
                }
            }
#pragma unroll
            for (int f = 0; f < 2; ++f) {
                const int mw = cur - f; const unsigned bit = 1u << (mw & 31);
                if (mw < 32) w0 |= bit; else if (mw < 64) w1 |= bit; else if (mw < 96) w2 |= bit; else w3 |= bit;
            }
        }
        if (lane == 0) *(u32x4*)((unsigned*)(ws + WS_SELM) + ((size_t)(b * 2 + g) * T + q0 + q) * 4) = (u32x4){w0, w1, w2, w3};
    }
}

#define XB_TMO      128
#define XB_XCNT(j)  (256  + 64 * (j))
#define XB_XSUB(j)  (1280 + 64 * (j))
#define XB_XGEN(j)  (2304 + 64 * (j))
#define XB_TOP      3328
#define XB_TOPGEN   3392
#define XCD_BAR_WORDS 3456
#define XB_SPIN_CAP (1u << 18)

__device__ __forceinline__ unsigned xb_ld(unsigned* p)              { return __hip_atomic_load(p, __ATOMIC_RELAXED, __HIP_MEMORY_SCOPE_AGENT); }
__device__ __forceinline__ unsigned xb_add(unsigned* p, unsigned v) { return __hip_atomic_fetch_add(p, v, __ATOMIC_RELAXED, __HIP_MEMORY_SCOPE_AGENT); }
__device__ __forceinline__ unsigned xb_xcc_id() { return (unsigned)__builtin_amdgcn_s_getreg((3 << 11) | 20) & 0xFu; }
#define XB_SPIN(cond, bar) do { unsigned _sp = 0; while (cond) { __builtin_amdgcn_s_sleep(1); \
    if ((++_sp & 255u) == 0u) { if (xb_ld(&(bar)[XB_TMO])) break; if (_sp > XB_SPIN_CAP) { atomicAdd(&(bar)[XB_TMO], 1u); break; } } } } while (0)

struct XcdBarrier {
    unsigned* bar; unsigned x;
    volatile LAS unsigned* st;
};

__device__ __forceinline__ XcdBarrier xcd_barrier_post(unsigned* bar, volatile LAS unsigned* st) {
    XcdBarrier b; b.bar = bar; b.x = xb_xcc_id(); b.st = st;
    if (threadIdx.x == 0) (void)xb_add(&bar[XB_XCNT(b.x)], 1u);
    return b;
}
__device__ __forceinline__ void xcd_barrier_complete(unsigned* bar, unsigned x, unsigned& nloc, unsigned& nx) {
    const unsigned G = gridDim.x * gridDim.y * gridDim.z;
    unsigned sum, cnt, mine, sp = 0u;
    for (;;) {
        sum = 0u; cnt = 0u; mine = 0u;
#pragma unroll
        for (unsigned j = 0; j < 16; ++j) { const unsigned c = xb_ld(&bar[XB_XCNT(j)]); sum += c; cnt += (c > 0u) ? 1u : 0u; mine = (j == x) ? c : mine; }
        if (sum == G) break;
        __builtin_amdgcn_s_sleep(1);
        if ((++sp & 255u) == 0u) { if (xb_ld(&bar[XB_TMO])) break; if (sp > XB_SPIN_CAP) { atomicAdd(&bar[XB_TMO], 1u); break; } }
    }
    nloc = mine > 0u ? mine : 1u; nx = cnt > 0u ? cnt : 1u;
}

__device__ __forceinline__ void xcd_barrier(const XcdBarrier& b) {
    asm volatile("s_waitcnt vmcnt(0)" ::: "memory");
    __syncthreads();
    if (threadIdx.x == 0) {
        unsigned* bar = b.bar;
        __builtin_amdgcn_s_waitcnt(0);
        unsigned nloc = b.st[0], nx = b.st[1];
        if (nloc == 0u) { xcd_barrier_complete(bar, b.x, nloc, nx); b.st[0] = nloc; b.st[1] = nx; }
        const unsigned old = xb_add(&bar[XB_XSUB(b.x)], 1u);
        const unsigned gen = old / nloc;
        if (old + 1u == (gen + 1u) * nloc) {
            __builtin_amdgcn_fence(__ATOMIC_RELEASE, "agent");
            asm volatile("s_waitcnt vmcnt(0)" ::: "memory");
            const unsigned og = xb_add(&bar[XB_TOP], 1u);
            const unsigned tg = og / nx;
            if (og + 1u == (tg + 1u) * nx) xb_add(&bar[XB_TOPGEN], 1u);
            else XB_SPIN(xb_ld(&bar[XB_TOPGEN]) == tg, bar);
            __builtin_amdgcn_fence(__ATOMIC_ACQUIRE, "agent");
            xb_add(&bar[XB_XGEN(b.x)], 1u);
            asm volatile("s_waitcnt vmcnt(0)" ::: "memory");
        } else {
            XB_SPIN(xb_ld(&bar[XB_XGEN(b.x)]) == gen, bar);
            __builtin_amdgcn_fence(__ATOMIC_ACQUIRE, "agent");
            asm volatile("s_waitcnt vmcnt(0)" ::: "memory");
        }
    }
    __syncthreads();
}

struct Args { const float* in[N_IN]; float* out; unsigned char* ws; int ph_lo, ph_hi; };
static_assert(sizeof(Args) == 8 * N_IN + 24, "Args has no padding");
constexpr int PH_PER_LAYER = 12, N_PHASES = DEPTH * PH_PER_LAYER;
#ifndef PH_HI
#ifdef REPJ
#define PH_HI (N_PHASES + DEPTH)
#else
#define PH_HI N_PHASES
#endif
#endif

__global__ void __launch_bounds__(512) mega(Args a) {
    extern __shared__ __attribute__((aligned(16))) unsigned char lds_raw[];
    LAS unsigned char* lds = (LAS unsigned char*)lds_raw;
    LAS int* slot = (LAS int*)(lds + LDS_MISC);
    cg::grid_group grid = cg::this_grid();
    const float* const* in = nullptr;
    volatile LAS unsigned* misc = (volatile LAS unsigned*)(lds + LDS_MISC);
    if (TID() < 16) misc[TID()] = 0u;
    __syncthreads();
    (void)xcd_barrier_post((unsigned*)(a.ws + WS_CTL) + 4096, misc + 8);
#ifndef DUP_GU
#define DUP_GU 0
#endif
#ifndef DUP_IN
#define DUP_IN 0
#endif
#ifndef DUP_DIFF
#define DUP_DIFF 0
#endif
#ifndef DUP_NSAC
#define DUP_NSAC 0
#endif
#ifndef DUP_SW
#define DUP_SW 0
#endif
#ifndef DUP_HOUT
#define DUP_HOUT 0
#endif
#ifndef DUP_M1
#define DUP_M1 0
#endif
#ifndef DUP_SYNC
#define DUP_SYNC 0
#endif
#ifndef DUP_CONV
#define DUP_CONV 0
#endif
#ifndef PHM
#define PHM 0xfff
#endif
    for (int ph = a.ph_lo; ph < a.ph_hi; ++ph) {
#ifdef REPJ
        int L = ph / (PH_PER_LAYER + 1); const int k_ = ph - L * (PH_PER_LAYER + 1); const int j = k_ <= REPJ ? k_ : k_ - 1; const float amul = (k_ == REPJ) ? 0.f : 1.f;
#else
        int L = ph / PH_PER_LAYER; const int j = ph - L * PH_PER_LAYER; const float amul = 1.f;
#endif
        asm volatile("" : "+s"(L));
        unsigned long long ws_ = (unsigned long long)a.ws; asm volatile("" : "+s"(ws_)); unsigned char* ws = (unsigned char*)(GAS unsigned char*)ws_;
        unsigned long long out_ = (unsigned long long)a.out; asm volatile("" : "+s"(out_)); float* out_g = (float*)(GAS float*)out_;
        unsigned* ctl = (unsigned*)(ws + WS_CTL); bf16_t* r1 = (bf16_t*)(ws + WS_R1); bf16_t* mixed = (bf16_t*)(ws + WS_MIX); bf16_t* pb = (bf16_t*)(ws + WS_PB); unsigned char* wb = ws + WS_W; float* rsqp = (float*)(ws + WS_RSQP);
        float* rsq = (float*)(ws + ((L & 1) ? WS_RSQ1 : WS_RSQ0)); float* rsq_next = (float*)(ws + ((L & 1) ? WS_RSQ0 : WS_RSQ1));
        bf16_t* xb = (bf16_t*)(ws + ((L & 1) ? WS_XB1 : WS_XB)); bf16_t* xb_next = (bf16_t*)(ws + ((L & 1) ? WS_XB : WS_XB1));
        if (j == 0 && L > 0) continue;
        if ((PHM >> j) & 1) switch (j) {
        case 0: phase_convert(in, ws, out_g, L, lds); break;
        case 1: { EpiSwiGLU E{r1, {}}; run_gemm(lds, xb, (const bf16_t*)(wb + W_GU1), 2 * FF, DM, E, rsq); } break;
        case 2: { EpiRes<0> E{out_g, xb, rsq, 0.5f * amul, nullptr, nullptr, nullptr, nullptr, nullptr, {}}; run_gemm(lds, r1, (const bf16_t*)(wb + W_D1), DM, FF, E); } break;
        case 3: { EpiZ E{r1, {}}; run_gemm(lds, xb, (const bf16_t*)(wb + W_IN), ZW, DM, E, rsq); } break;
        case 4: {
            unsigned* ctr = ctl + (L * 4 + 0) * 64;
            constexpr int NCMP = 512 << DUP_M1, NHL = 512 << DUP_M1;
            for (;;) { const int t = next_task(ctr, slot); if (t >= NCMP + NHL + 512) break;
                if (t < NCMP) task_compress(in, ws, L, t >> DUP_M1, lds); else if (t < NCMP + NHL) task_hgrn_local(in, ws, L, (t - NCMP) >> DUP_M1, lds); else task_prep(in, ws, L, t - NCMP - NHL, lds); }
        } break;
        case 5: {
            unsigned* ctr = ctl + (L * 4 + 1) * 64;
            constexpr int ND = 512 << DUP_DIFF, NC = 1024 << DUP_NSAC, NCV = 256;
            for (;;) { const int t = next_task(ctr, slot); if (t >= 192 + ND + NCV + NC) break;
                if (t < 192) task_hgrn_scan(ws, t);
                else if (t < 192 + ND + NCV) { const int u = t - 192;
                    if (u < 3 * NCV) { const int grp = u / 3, r = u - 3 * grp; if (r == 2) task_conv(ws, L, grp, lds); else task_diff(in, ws, L, (2 * grp + r) >> DUP_DIFF, lds); }
                    else task_diff(in, ws, L, (u - NCV) >> DUP_DIFF, lds); }
                else task_nsa_c(in, ws, L, (t - 192 - ND - NCV) >> DUP_NSAC, lds); }
        } break;
        case 6: {
            unsigned* ctr = ctl + (L * 4 + 2) * 64;
            constexpr int NS = 768 << DUP_SW, NH = 1024 << DUP_HOUT;
            for (;;) { const int t = next_task(ctr, slot); if (t >= NS + NH) break;
                if (t < NS) task_nsa_sw(in, ws, L, t >> DUP_SW, lds); else task_hgrn_out(in, ws, L, (t - NS) >> DUP_HOUT, lds); }
        } break;
        case 7: { EpiRes<0> E{out_g, xb, rsq, 1.0f * amul, nullptr, nullptr, nullptr, nullptr, nullptr, {}}; run_gemm(lds, mixed, (const bf16_t*)(wb + W_OUT), DM, DM, E); } break;
        case 8: { EpiSwiGLU E{r1, {}}; run_gemm(lds, xb, (const bf16_t*)(wb + W_GU2), 2 * FF, DM, E, rsq); } break;
        case 9: { EpiRes<2> E{nullptr, nullptr, rsqp, 0.f, nullptr, nullptr, nullptr, nullptr, mixed, {}}; run_gemm(lds, pb, (const bf16_t*)(wb + W_PP), DM, PLE, E); } break;
        case 10: { EpiRes<0> E{out_g, xb, rsq, 0.5f * amul, nullptr, nullptr, nullptr, nullptr, nullptr, {}}; run_gemm(lds, r1, (const bf16_t*)(wb + W_D2), DM, FF, E); } break;
        default: { EpiRes<1> E{out_g, xb_next, rsq_next, 0.f, rsq, mixed, rsqp, inp(I_PLPOST) + L * DM, nullptr, {}}; run_gemm(lds, xb, (const bf16_t*)(wb + W_PG), DM, DM, E, rsq, rsqp); } break;
        }
        if (ph + 1 < a.ph_hi) {
            if (ph == 0) { asm volatile("s_waitcnt vmcnt(0) lgkmcnt(0)" ::: "memory"); grid.sync(); __builtin_amdgcn_fence(__ATOMIC_ACQUIRE, "agent"); asm volatile("s_waitcnt vmcnt(0)" ::: "memory"); __syncthreads(); }
            else { XcdBarrier xb_; xb_.bar = (unsigned*)(ws + WS_CTL) + 4096; xb_.x = xb_xcc_id(); xb_.st = misc + 8; xcd_barrier(xb_); if (DUP_SYNC) xcd_barrier(xb_); }
        }
    }
}

#ifdef DUMPK
__global__ void __launch_bounds__(512) dump_kernel(float* out, unsigned char* ws) {
    bf16_t* mixed = (bf16_t*)(ws + WS_MIX); (void)mixed;
    for (size_t idx = (size_t)blockIdx.x * 512 + threadIdx.x; idx < (size_t)M * 1024; idx += (size_t)gridDim.x * 512) {
        const size_t m = idx >> 10; const int c = (int)(idx & 1023);
        float v = 0.f;
#if DUMPK == 3 || DUMPK == 40
        { const bf16_t* z = (const bf16_t*)(ws + WS_R1); v = bf2f(z[m * ZW + c]) + bf2f(z[m * ZW + 1024 + c]) + bf2f(z[m * ZW + 2048 + c]) + (c < 402 ? bf2f(z[m * ZW + 3072 + c]) : 0.f); }
#elif DUMPK == 41
        { const bf16_t* vt = (const bf16_t*)(ws + WS_VT); v = bf2f(vt[m * 512 + (c & 511)]); }
#elif DUMPK == 42
        { const float* hs = (const float*)(ws + WS_HS); const float* hd = (const float*)(ws + WS_HD); v = hs[m * 384 + (c % 384)] + hd[m * 6 + (c % 6)]; }
#elif DUMPK == 43
        { const bf16_t* kc = (const bf16_t*)(ws + WS_KC); const bf16_t* vct = (const bf16_t*)(ws + WS_VCT); v = bf2f(kc[m * 8 + (c & 7)]) + bf2f(vct[m * 8 + (c & 7)]); }
#elif DUMPK == 50 || DUMPK == 60
        v = (c < 384) ? bf2f(mixed[m * 1024 + c]) : 0.f;
#elif DUMPK == 51
        v = (c >= 384 && c < 640) ? bf2f(mixed[m * 1024 + c]) : 0.f;
#elif DUMPK == 52
        { const unsigned* selm = (const unsigned*)(ws + WS_SELM); v = (float)(selm[m * 8 + (c & 7)] & 0xffffu) + (float)(selm[m * 8 + (c & 7)] >> 16); }
#elif DUMPK == 53
        { const float* hs = (const float*)(ws + WS_HS); v = hs[m * 384 + (c % 384)]; }
#elif DUMPK == 61
        v = (c >= 640) ? bf2f(mixed[m * 1024 + c]) : 0.f;
#endif
        out[idx] = v;
    }
}
#endif

extern "C" void kernel_launch(void* const* d_in, const int* in_sizes, int n_in, void* d_out, int out_size, void* d_ws, size_t ws_size, hipStream_t stream) {
    static int grid = 0;
    if (grid == 0) {
        if (n_in != N_IN || out_size != M * DM || ws_size < WS_END) { fprintf(stderr, "kernel_launch: unexpected shapes (n_in %d out %d ws %zu)\n", n_in, out_size, ws_size); grid = -1; return; }
        int dev = 0, cus = 0, per_cu = 0;
        hipGetDevice(&dev); hipDeviceGetAttribute(&cus, hipDeviceAttributeMultiprocessorCount, dev);
        if (hipFuncSetAttribute((const void*)mega, hipFuncAttributeMaxDynamicSharedMemorySize, LDS_BYTES) != hipSuccess) { fprintf(stderr, "hipFuncSetAttribute failed\n"); }
        if (hipOccupancyMaxActiveBlocksPerMultiprocessor(&per_cu, (const void*)mega, 512, LDS_BYTES) != hipSuccess || per_cu < 1) { fprintf(stderr, "occupancy query: %d\n", per_cu); per_cu = 1; }
        (void)hipGetLastError();
        grid = cus;
    }
    if (grid < 0) return;
    hipMemsetAsync((char*)d_ws + WS_CTL, 0, 64 * 1024, stream);
    Args a{};
    for (int i = 0; i < N_IN; ++i) a.in[i] = (const float*)d_in[i];
    a.out = (float*)d_out; a.ws = (unsigned char*)d_ws; a.ph_lo = 0; a.ph_hi = PH_HI;
    void* args[] = {&a};
    hipError_t e = hipLaunchCooperativeKernel((const void*)mega, dim3(grid), dim3(512), args, LDS_BYTES, stream);
    if (e != hipSuccess) fprintf(stderr, "cooperative launch failed: %s (grid %d)\n", hipGetErrorString(e), grid);
#ifdef DUMPK
    dump_kernel<<<dim3(1024), dim3(512), 0, stream>>>((float*)d_out, (unsigned char*)d_ws);
#endif
}
```

```cpp
#include <hip/hip_runtime.h>
#include <hip/hip_cooperative_groups.h>
#include <cstdio>
#include <cstdint>
namespace cg = cooperative_groups;
__device__ __forceinline__ int TID() { int t = threadIdx.x; asm volatile("" : "+v"(t)); return t; }
typedef float f32x4_z __attribute__((ext_vector_type(4)));
__device__ __forceinline__ f32x4_z zero4_() { float z = 0.f; asm volatile("" : "+v"(z)); return (f32x4_z){z, z, z, z}; }
namespace pg8 {
#define PG8_LAS __attribute__((address_space(3)))
typedef unsigned short bf16_t;
typedef short bf16x8 __attribute__((ext_vector_type(8)));
typedef float f32x4 __attribute__((ext_vector_type(4)));
typedef unsigned u32x4 __attribute__((ext_vector_type(4)));
constexpr int BM = 256, BK = 64, HALF = 128, HTB = HALF * BK * 2  , STAGE_BYTES = 8 * HTB, NXCD = 8, WGM = 8;

__host__ __device__ __forceinline__ int lds_byte(int r, int c) { const int st = (r >> 4) * 2 + (c >> 5), rr = r & 15, cc = c & 31, ob = rr * 64 + cc * 2; return st * 1024 + (ob ^ (((ob >> 9) & 1) << 5)); }
__host__ __device__ __forceinline__ void stage_rc(int b, int& R, int& C) { const int st = b / 1024, sb = b % 1024, swz = sb ^ (((sb >> 9) & 1) << 5); R = (st >> 1) * 16 + swz / 64; C = (st & 1) * 32 + (swz % 64) / 2; }
__host__ __device__ __forceinline__ int perm32(int rho) { const int n = rho >> 4, i = rho & 15; return 8 * (i >> 2) + 4 * n + (i & 3); }

struct Unit { int pm, pn; };
struct Gemm { const bf16_t* A; const bf16_t* Bt; int M, N, K; };

struct StaticOrder {
    int nM, nN, nwg, G, c;
    __host__ __device__ void init(int M, int N, int G_, int c_) { nM = M / BM; nN = N / BM; nwg = nM * nN; G = G_; c = c_; }
    __host__ __device__ bool next(int i, Unit& u) const {
        const long L = (long)i * G + c; if (L >= nwg) return false;
        int wgid = (int)L; { const int q = nwg / NXCD, r = nwg % NXCD, xcd = wgid % NXCD, off = wgid / NXCD; wgid = (xcd < r ? xcd * (q + 1) : r * (q + 1) + (xcd - r) * q) + off; }
        const int nig = WGM * nN, gid = wgid / nig, fm = gid * WGM, gsz = (nM - fm) < WGM ? (nM - fm) : WGM;
        u.pm = fm + ((wgid % nig) % gsz); u.pn = (wgid % nig) / gsz; return true;
    }
    __device__ __forceinline__ void a_ready(const Unit&) const {}
    __device__ __forceinline__ void done(const Unit&) const {}
};

template <class Epi, class Sched, bool ALIGN_EPI = false, bool SP2 = false>
__device__ __forceinline__ void gemm_phase(PG8_LAS unsigned char* lds, const Gemm g, const Sched& S, const Epi& E) {
    const int tid = TID(), wid = __builtin_amdgcn_readfirstlane(tid >> 6), lane = tid & 63, wr = wid >> 2, wc = wid & 3, fr = lane & 15, fq = lane >> 4;
    const int K = g.K, nt = K / BK;
    unsigned voffA[2], voffB[2];
#pragma unroll
    for (int i = 0; i < 2; ++i) { int R, C; stage_rc(tid * 16 + i * 8192, R, C); const int Rb = Epi::PERM ? ((R & ~31) + perm32(R & 31)) : R;
        voffA[i] = (unsigned)(R * K + C) * 2u; voffB[i] = (unsigned)(Rb * K + C) * 2u; }
    const size_t kstep = (size_t)(BK * 2);
    const size_t hstep = (size_t)HALF * K * 2;
    const size_t tstep = 2 * hstep;
    const unsigned ldsw = (unsigned)wid * 1024u;
    const int aoff = lds_byte(wr * 64 + fr, fq * 8), boff = lds_byte(wc * 32 + fr, fq * 8);
#define PG8_SA(b, h) (((b) * 2 + (h)) * HTB)
#define PG8_SB(b, h) ((4 + (b) * 2 + (h)) * HTB)
#define PG8_STAGE(bufoff, gbase, voff) do { _Pragma("unroll") for (int _i = 0; _i < 2; ++_i) \
        __builtin_amdgcn_global_load_lds((const unsigned*)((const char*)(gbase) + (voff)[_i]), (PG8_LAS unsigned*)(lds + (bufoff) + ldsw + _i * 8192), 16, 0, 0); } while (0)
#define PG8_LDA(dst, b, h) do { _Pragma("unroll") for (int m = 0; m < 4; ++m) _Pragma("unroll") for (int k = 0; k < 2; ++k) dst[m][k] = *(const PG8_LAS bf16x8*)(lds + PG8_SA(b, h) + aoff + m * 2048 + k * 1024); } while (0)
#define PG8_LDB(dst, b, h) do { _Pragma("unroll") for (int n = 0; n < 2; ++n) _Pragma("unroll") for (int k = 0; k < 2; ++k) dst[n][k] = *(const PG8_LAS bf16x8*)(lds + PG8_SB(b, h) + boff + n * 2048 + k * 1024); } while (0)
#define PG8_MMA(ai, bj, At, Bt) do { __builtin_amdgcn_s_setprio(1); _Pragma("unroll") for (int m = 0; m < 4; ++m) _Pragma("unroll") for (int n = 0; n < 2; ++n) _Pragma("unroll") for (int k = 0; k < 2; ++k) \
        acc[ai][bj][m][n] = __builtin_amdgcn_mfma_f32_16x16x32_bf16(Bt[n][k], At[m][k], acc[ai][bj][m][n], 0, 0, 0); __builtin_amdgcn_s_setprio(0); } while (0)
#define PG8_WAIT_V(n) asm volatile("s_waitcnt vmcnt(" #n ")" ::: "memory")
#define PG8_WAIT_L(n) asm volatile("s_waitcnt lgkmcnt(" #n ")" ::: "memory")
#define PG8_BAR __builtin_amdgcn_s_barrier()
#define PG8_SCHED __builtin_amdgcn_sched_barrier(0)
    Unit cur, nxt; int ui = 0;
    if (!S.next(0, cur)) return;
    f32x4 acc[2][2][4][2];
#pragma unroll
    for (int a = 0; a < 2; ++a)
#pragma unroll
        for (int b = 0; b < 2; ++b)
#pragma unroll
            for (int m = 0; m < 4; ++m)
#pragma unroll
                for (int n = 0; n < 2; ++n) acc[a][b][m][n] = zero4_();
    bf16x8 At[4][2], B0[2][2], B1[2][2];
    const char* cA = (const char*)g.A + (size_t)cur.pm * tstep; const char* cB = (const char*)g.Bt + (size_t)cur.pn * tstep;
    S.a_ready(cur);
    if constexpr (SP2) {
        PG8_STAGE(PG8_SB(0, 0), cB, voffB); PG8_STAGE(PG8_SB(0, 1), cB + hstep, voffB); PG8_STAGE(PG8_SA(0, 0), cA, voffA); PG8_STAGE(PG8_SA(0, 1), cA + hstep, voffA);
        if (wr == 1) PG8_BAR;
        PG8_WAIT_V(2); PG8_BAR;
        PG8_STAGE(PG8_SB(1, 0), cB + kstep, voffB); PG8_STAGE(PG8_SA(1, 0), cA + kstep, voffA); PG8_STAGE(PG8_SB(1, 1), cB + hstep + kstep, voffB);
        PG8_WAIT_V(6); PG8_BAR;
    } else {
        PG8_STAGE(PG8_SB(0, 0), cB, voffB); PG8_STAGE(PG8_SA(0, 0), cA, voffA); PG8_STAGE(PG8_SB(0, 1), cB + hstep, voffB); PG8_STAGE(PG8_SA(0, 1), cA + hstep, voffA);
        if (wr == 1) PG8_BAR;
        PG8_WAIT_V(4); PG8_BAR;
        PG8_STAGE(PG8_SB(1, 0), cB + kstep, voffB); PG8_STAGE(PG8_SA(1, 0), cA + kstep, voffA); PG8_STAGE(PG8_SB(1, 1), cB + hstep + kstep, voffB);
        PG8_WAIT_V(6); PG8_BAR;
    }
    for (;;) {
        const bool has_next = S.next(ui + 1, nxt);
        const char* nA = has_next ? (const char*)g.A + (size_t)nxt.pm * tstep : cA; const char* nB = has_next ? (const char*)g.Bt + (size_t)nxt.pn * tstep : cB;
        for (int t = 0; t < nt; t += 2) {
            const bool last = (t == nt - 2);
            const char* a1 = cA + (size_t)(t + 1) * kstep;
            const char* a2 = last ? nA : cA + (size_t)(t + 2) * kstep; const char* b2 = last ? nB : cB + (size_t)(t + 2) * kstep;
            const char* a3 = a2 + kstep; const char* b3 = b2 + kstep;
            if (last && has_next) S.a_ready(nxt);
            if constexpr (SP2) {
            PG8_LDB(B0, 0, 0); PG8_LDB(B1, 0, 1); PG8_SCHED; PG8_LDA(At, 0, 0); PG8_STAGE(PG8_SA(1, 1), a1 + hstep, voffA);
            PG8_WAIT_V(8); PG8_WAIT_L(0); PG8_BAR; PG8_MMA(0, 0, At, B0); PG8_MMA(0, 1, At, B1); PG8_BAR; PG8_SCHED;
            PG8_LDA(At, 0, 1); PG8_STAGE(PG8_SB(0, 0), b2, voffB); PG8_STAGE(PG8_SB(0, 1), b2 + hstep, voffB); PG8_STAGE(PG8_SA(0, 0), a2, voffA);
            PG8_WAIT_V(8); PG8_WAIT_L(0); PG8_BAR; PG8_MMA(1, 0, At, B0); PG8_MMA(1, 1, At, B1); PG8_BAR; PG8_SCHED;
            PG8_LDB(B0, 1, 0); PG8_LDB(B1, 1, 1); PG8_SCHED; PG8_LDA(At, 1, 0); PG8_STAGE(PG8_SA(0, 1), a2 + hstep, voffA);
            PG8_WAIT_V(8); PG8_WAIT_L(0); PG8_BAR; PG8_MMA(0, 0, At, B0); PG8_MMA(0, 1, At, B1); PG8_BAR; PG8_SCHED;
            PG8_LDA(At, 1, 1); PG8_STAGE(PG8_SB(1, 0), b3, voffB); PG8_STAGE(PG8_SB(1, 1), b3 + hstep, voffB); PG8_STAGE(PG8_SA(1, 0), a3, voffA);
            PG8_WAIT_V(8); PG8_WAIT_L(0); PG8_BAR; PG8_MMA(1, 0, At, B0); PG8_MMA(1, 1, At, B1); PG8_BAR; PG8_SCHED;
            } else {
            PG8_LDB(B0, 0, 0); PG8_SCHED; PG8_LDA(At, 0, 0); PG8_STAGE(PG8_SA(1, 1), a1 + hstep, voffA);
            PG8_WAIT_L(8); PG8_BAR; PG8_WAIT_L(0); PG8_MMA(0, 0, At, B0); PG8_BAR; PG8_SCHED;
            PG8_LDB(B1, 0, 1); PG8_STAGE(PG8_SB(0, 0), b2, voffB);
            PG8_BAR; PG8_WAIT_L(0); PG8_MMA(0, 1, At, B1); PG8_BAR;
            PG8_LDA(At, 0, 1); PG8_STAGE(PG8_SA(0, 0), a2, voffA);
            PG8_BAR; PG8_WAIT_L(0); PG8_MMA(1, 0, At, B0); PG8_BAR; PG8_SCHED;
            PG8_STAGE(PG8_SB(0, 1), b2 + hstep, voffB);
            PG8_WAIT_V(6); PG8_BAR; PG8_MMA(1, 1, At, B1); PG8_BAR;
            PG8_LDB(B0, 1, 0); PG8_SCHED; PG8_LDA(At, 1, 0); PG8_STAGE(PG8_SA(0, 1), a2 + hstep, voffA);
            PG8_WAIT_L(8); PG8_BAR; PG8_WAIT_L(0); PG8_MMA(0, 0, At, B0); PG8_BAR; PG8_SCHED;
            PG8_LDB(B1, 1, 1); PG8_STAGE(PG8_SB(1, 0), b3, voffB);
            PG8_BAR; PG8_WAIT_L(0); PG8_MMA(0, 1, At, B1); PG8_BAR;
            PG8_LDA(At, 1, 1); PG8_STAGE(PG8_SA(1, 0), a3, voffA);
            PG8_BAR; PG8_WAIT_L(0); PG8_MMA(1, 0, At, B0); PG8_BAR; PG8_SCHED;
            PG8_STAGE(PG8_SB(1, 1), b3 + hstep, voffB);
            PG8_WAIT_V(6); PG8_BAR; PG8_MMA(1, 1, At, B1); PG8_BAR;
            }
        }
        if constexpr (ALIGN_EPI) { if (wr == 0) PG8_BAR; }
        if constexpr (!Epi::AFTER_DRAIN) { E(acc, cur, wr, wc, fr, fq); S.done(cur); }
        if (!has_next) break;
#pragma unroll
        for (int a = 0; a < 2; ++a)
#pragma unroll
            for (int b = 0; b < 2; ++b)
#pragma unroll
                for (int m = 0; m < 4; ++m)
#pragma unroll
                    for (int n = 0; n < 2; ++n) acc[a][b][m][n] = zero4_();
        cur = nxt; cA = nA; cB = nB; ++ui;
        if constexpr (ALIGN_EPI) { if (wr == 1) PG8_BAR; }
    }
    PG8_WAIT_V(0);
    if constexpr (!ALIGN_EPI) { if (wr == 0) PG8_BAR; }
    PG8_BAR;
    if constexpr (Epi::AFTER_DRAIN) { E.fused(acc, cur, wr, wc, fr, fq, lds, wid, lane); S.done(cur); }
#undef PG8_SA
#undef PG8_SB
#undef PG8_STAGE
#undef PG8_LDA
#undef PG8_LDB
#undef PG8_MMA
#undef PG8_WAIT_V
#undef PG8_WAIT_L
#undef PG8_BAR
#undef PG8_SCHED
}
}

#define LAS __attribute__((address_space(3)))
typedef unsigned short bf16_t;
typedef short bf16x8 __attribute__((ext_vector_type(8)));
typedef float f32x4 __attribute__((ext_vector_type(4)));
typedef float f32x16 __attribute__((ext_vector_type(16)));
typedef unsigned u32x4 __attribute__((ext_vector_type(4)));
typedef unsigned u32x2 __attribute__((ext_vector_type(2)));

constexpr int NB = 4, T = 8192, DM = 1024, M = NB * T, DEPTH = 4, PLE = 256, FF = 2816, ZW = 3584, INW = 3474;
constexpr int C_NQ = 0, C_CK = 384, C_CV = 512, C_SK = 640, C_SV = 768, C_WK = 896, C_WV = 1024, C_DQ = 1152, C_DK = 1408, C_DV = 1664,
              C_HQ = 1920, C_HF = 2304, C_HI = 2688, C_HG = 3072, C_NG = 3456;
constexpr float EPS = 1e-6f, LOG2E = 1.4426950408889634f;
enum { I_X = 0, I_P, I_RELB, I_LBLOG, I_F1N, I_F1G, I_F1U, I_F1D, I_MIXN, I_WIN, I_WOUT, I_NQN, I_NKN, I_CPOS, I_CW1, I_CW2,
       I_DQN, I_DKN, I_DLAM, I_DSUB, I_HON, I_F2N, I_F2G, I_F2U, I_F2D, I_PLN, I_PLG, I_PLP, I_PLPOST, N_IN };
constexpr size_t MiB = 1u << 20;
constexpr size_t WS_CTL = 0, WS_W = 1 * MiB, WS_PB = 53 * MiB, WS_XB = 69 * MiB, WS_R1 = 133 * MiB, WS_MIX = 357 * MiB, WS_VT = 421 * MiB,
                 WS_HS = 453 * MiB, WS_KC = 501 * MiB, WS_VCT = WS_KC + 512 * 1024, WS_SELM = 503 * MiB, WS_RSQ0 = 504 * MiB, WS_RSQ1 = 506 * MiB,
                 WS_RSQP = 508 * MiB, WS_HD = 510 * MiB, WS_XB1 = 511 * MiB, WS_OCB = 575 * MiB, WS_ONES = 599 * MiB, WS_END = 601 * MiB;
constexpr size_t W_GU1 = 0, W_D1 = 11 * MiB, W_GU2 = W_D1 + 5 * MiB + 512 * 1024, W_D2 = W_GU2 + 11 * MiB, W_IN = 33 * MiB, W_OUT = 40 * MiB, W_PG = 42 * MiB,
                 W_PP = 44 * MiB, W_1T = W_PP + 512 * 1024, W_2T = W_1T + 2 * MiB, W_POSB = W_2T + 64 * 1024;
static_assert(W_D2 + 5 * MiB + 512 * 1024 == W_IN, "weight map");
constexpr int LDS_MISC = 147456, LDS_RTAB = LDS_MISC + 1024, LDS_BYTES = LDS_RTAB + 8192;

__device__ __forceinline__ float bf2f(unsigned short u) { return __uint_as_float(((unsigned)u) << 16); }
__device__ __forceinline__ float bflo(unsigned w) { return __uint_as_float(w << 16); }
__device__ __forceinline__ float bfhi(unsigned w) { return __uint_as_float(w & 0xffff0000u); }
typedef float f32x2_t __attribute__((ext_vector_type(2))); typedef __bf16 bf16x2_t __attribute__((ext_vector_type(2)));
__device__ __forceinline__ unsigned pk2(float lo, float hi) { f32x2_t v = {lo, hi}; bf16x2_t b = __builtin_convertvector(v, bf16x2_t); return __builtin_bit_cast(unsigned, b); }
__device__ __forceinline__ bf16_t f2bf(float f) { return (bf16_t)(pk2(f, 0.f) & 0xffffu); }
__device__ __forceinline__ float ex2(float x) { return __builtin_amdgcn_exp2f(x); }
__device__ __forceinline__ float sigmoidf_(float x) { return __builtin_amdgcn_rcpf(1.0f + __expf(-x)); }
__device__ __forceinline__ int crow(int r, int hi) { return (r & 3) + 8 * (r >> 2) + 4 * hi; }
__device__ __forceinline__ f32x16 mfma32(bf16x8 a, bf16x8 b, f32x16 c) { return __builtin_amdgcn_mfma_f32_32x32x16_bf16(a, b, c, 0, 0, 0); }
__device__ __forceinline__ f32x4 mfma16(bf16x8 a, bf16x8 b, f32x4 c) { return __builtin_amdgcn_mfma_f32_16x16x32_bf16(a, b, c, 0, 0, 0); }
__device__ __forceinline__ bf16x8 as_bf16x8(u32x4 v) { return __builtin_bit_cast(bf16x8, v); }
#define LDSW() asm volatile("s_waitcnt lgkmcnt(0)" ::: "memory")
#define CFENCE() asm volatile("" ::: "memory")
#define GAS __attribute__((address_space(1)))
__device__ __forceinline__ const float* inp(int i) { asm volatile("" : "+s"(i)); const unsigned long long v = ((const unsigned long long __attribute__((address_space(4)))*)__builtin_amdgcn_kernarg_segment_ptr())[i]; return (const float*)(const GAS float*)v; }

__device__ __forceinline__ unsigned pk_bf8(float a, float b, float c, float d) { int w = __builtin_amdgcn_cvt_pk_bf8_f32(a, b, 0, false); w = __builtin_amdgcn_cvt_pk_bf8_f32(c, d, w, true); return (unsigned)w; }
__device__ __forceinline__ void unpk_bf8(unsigned w, float* o) { const f32x2_t r0 = __builtin_amdgcn_cvt_pk_f32_bf8((int)w, false), r1 = __builtin_amdgcn_cvt_pk_f32_bf8((int)w, true); o[0] = r0.x; o[1] = r0.y; o[2] = r1.x; o[3] = r1.y; }
__device__ __forceinline__ float row_rinv(const float* rsq, int row) {
    const f32x4* p = (const f32x4*)(rsq + (size_t)row * 16);
    const f32x4 a = p[0], b = p[1], c = p[2], d = p[3];
    const float s = ((a.x + a.y) + (a.z + a.w)) + ((b.x + b.y) + (b.z + b.w)) + ((c.x + c.y) + (c.z + c.w)) + ((d.x + d.y) + (d.z + d.w));
    return rsqrtf(s * (1.0f / 1024.0f) + EPS);
}
struct RowTab {
    int p0, p1, p2, p3;
    __device__ __forceinline__ int slot(int pm) const { return pm == p0 ? 0 : (pm == p1 ? 1 : (pm == p2 ? 2 : 3)); }
    __device__ __forceinline__ float get(int t, int pm, int r256) const { return ((const LAS float*)(LAS unsigned char*)(size_t)LDS_RTAB)[(t * 4 + slot(pm)) * 256 + r256]; }
};
struct EpiSwiGLU {
    static constexpr bool PERM = true, AFTER_DRAIN = false;
    bf16_t* O; RowTab rt;
    __device__ __forceinline__ void operator()(const f32x4 (&acc)[2][2][4][2], const pg8::Unit& u, int wr, int wc, int fr, int fq) const {
#pragma unroll
        for (int ai = 0; ai < 2; ++ai)
#pragma unroll
            for (int m = 0; m < 4; ++m) {
                const int row = u.pm * 256 + ai * 128 + wr * 64 + m * 16 + fr;
                const float r = rt.get(0, u.pm, row & 255);
                float o[8];
#pragma unroll
                for (int n = 0; n < 2; ++n)
#pragma unroll
                    for (int e = 0; e < 4; ++e) { const float g = acc[ai][0][m][n][e] * r, up = acc[ai][1][m][n][e] * r; o[n * 4 + e] = g * sigmoidf_(g) * up; }
                u32x4 w; w.x = pk2(o[0], o[1]); w.y = pk2(o[2], o[3]); w.z = pk2(o[4], o[5]); w.w = pk2(o[6], o[7]);
                *(u32x4*)(O + (size_t)row * FF + u.pn * 128 + wc * 32 + 8 * fq) = w;
                CFENCE();
            }
    }
};
template <int LD> struct EpiZT {
    static constexpr bool PERM = true, AFTER_DRAIN = false;
    bf16_t* Z; RowTab rt;
    __device__ __forceinline__ void operator()(const f32x4 (&acc)[2][2][4][2], const pg8::Unit& u, int wr, int wc, int fr, int fq) const {
#pragma unroll
        for (int ai = 0; ai < 2; ++ai)
#pragma unroll
            for (int m = 0; m < 4; ++m) {
                const int row = u.pm * 256 + ai * 128 + wr * 64 + m * 16 + fr;
                const float r = rt.get(0, u.pm, row & 255);
#pragma unroll
                for (int bj = 0; bj < 2; ++bj) {
                    const f32x4 v0 = acc[ai][bj][m][0] * r, v1 = acc[ai][bj][m][1] * r;
                    u32x4 w; w.x = pk2(v0[0], v0[1]); w.y = pk2(v0[2], v0[3]); w.z = pk2(v1[0], v1[1]); w.w = pk2(v1[2], v1[3]);
                    *(u32x4*)(Z + (size_t)row * LD + u.pn * 256 + bj * 128 + wc * 32 + 8 * fq) = w;
                }
                CFENCE();
            }
    }
};
typedef EpiZT<ZW> EpiZ;
template <int MODE> struct EpiRes {
    static constexpr bool PERM = true, AFTER_DRAIN = false;
    float* X; bf16_t* XB; float* rsq_out; float alpha; const float* rsq_in; const bf16_t* P; const float* rsqp; const float* post; bf16_t* Pout; RowTab rt; const bf16_t* HIin; unsigned char* LO;
    __device__ __forceinline__ void operator()(const f32x4 (&acc)[2][2][4][2], const pg8::Unit& u, int wr, int wc, int fr, int fq) const {
        const int rowb = u.pm * 256 + wr * 64 + fr, colb = u.pn * 256 + wc * 32 + 8 * fq;
        u32x4 hn[2], pn_[2]; u32x2 ln[2];
        if (MODE != 2) {
#pragma unroll
            for (int bj = 0; bj < 2; ++bj) { const size_t off = (size_t)rowb * DM + colb + bj * 128; hn[bj] = *(const u32x4*)(HIin + off); ln[bj] = *(const u32x2*)(LO + off); if (MODE == 1) pn_[bj] = *(const u32x4*)(P + off); }
        }
#pragma unroll
        for (int gI = 0; gI < 8; ++gI) {
            const int ai = gI >> 2, m = gI & 3;
            const int row = rowb + ai * 128 + m * 16;
            u32x4 hc[2], pc[2]; u32x2 lc[2];
#pragma unroll
            for (int bj = 0; bj < 2; ++bj) { hc[bj] = hn[bj]; lc[bj] = ln[bj]; pc[bj] = pn_[bj]; }
            if (MODE != 2 && gI < 7) {
                const int row2 = rowb + ((gI + 1) >> 2) * 128 + ((gI + 1) & 3) * 16;
#pragma unroll
                for (int bj = 0; bj < 2; ++bj) { const size_t off = (size_t)row2 * DM + colb + bj * 128; hn[bj] = *(const u32x4*)(HIin + off); ln[bj] = *(const u32x2*)(LO + off); if (MODE == 1) pn_[bj] = *(const u32x4*)(P + off); }
            }
            CFENCE();
            float r = 1.f, rp = 1.f;
            if (MODE == 1) { r = rt.get(0, u.pm, row & 255); rp = rt.get(1, u.pm, row & 255); }
            float ss = 0.f;
#pragma unroll
            for (int bj = 0; bj < 2; ++bj) {
                const int c0 = colb + bj * 128;
                const size_t off = (size_t)row * DM + c0;
                if (MODE == 2) {
                    const f32x4 a0 = acc[ai][bj][m][0], a1 = acc[ai][bj][m][1];
                    u32x4 w; w.x = pk2(a0[0], a0[1]); w.y = pk2(a0[2], a0[3]); w.z = pk2(a1[0], a1[1]); w.w = pk2(a1[2], a1[3]);
                    *(u32x4*)(Pout + off) = w;
                    ss += (a0[0] * a0[0] + a0[1] * a0[1]) + (a0[2] * a0[2] + a0[3] * a0[3]) + (a1[0] * a1[0] + a1[1] * a1[1]) + (a1[2] * a1[2] + a1[3] * a1[3]);
                } else {
                    const u32x4 h = hc[bj], pw = pc[bj]; const u32x2 lo = lc[bj];
                    float lf[8]; unpk_bf8(lo.x, lf); unpk_bf8(lo.y, lf + 4);
                    float xv[8] = {bflo(h.x) + lf[0], bfhi(h.x) + lf[1], bflo(h.y) + lf[2], bfhi(h.y) + lf[3],
                                   bflo(h.z) + lf[4], bfhi(h.z) + lf[5], bflo(h.w) + lf[6], bfhi(h.w) + lf[7]};
                    if (MODE == 0) {
#pragma unroll
                        for (int e = 0; e < 8; ++e) xv[e] += acc[ai][bj][m][e >> 2][e & 3] * alpha;
                    } else {
                        const f32x4 po0 = *(const f32x4*)(post + c0), po1 = *(const f32x4*)(post + c0 + 4);
                        const float pf[8] = {bflo(pw.x), bfhi(pw.x), bflo(pw.y), bfhi(pw.y), bflo(pw.z), bfhi(pw.z), bflo(pw.w), bfhi(pw.w)};
#pragma unroll
                        for (int e = 0; e < 8; ++e) xv[e] += sigmoidf_(acc[ai][bj][m][e >> 2][e & 3] * r) * (pf[e] * rp * (e < 4 ? po0[e & 3] : po1[e & 3]));
                    }
                    if (X) { *(f32x4*)(X + off) = (f32x4){xv[0], xv[1], xv[2], xv[3]}; *(f32x4*)(X + off + 4) = (f32x4){xv[4], xv[5], xv[6], xv[7]}; }
                    if (!X) {
                    u32x4 w; w.x = pk2(xv[0], xv[1]); w.y = pk2(xv[2], xv[3]); w.z = pk2(xv[4], xv[5]); w.w = pk2(xv[6], xv[7]);
                    *(u32x4*)(XB + off) = w;
                    u32x2 lw; lw.x = pk_bf8(xv[0] - bflo(w.x), xv[1] - bfhi(w.x), xv[2] - bflo(w.y), xv[3] - bfhi(w.y));
                    lw.y = pk_bf8(xv[4] - bflo(w.z), xv[5] - bfhi(w.z), xv[6] - bflo(w.w), xv[7] - bfhi(w.w));
                    *(u32x2*)(LO + off) = lw;
                    }
#pragma unroll
                    for (int e = 0; e < 8; ++e) ss += xv[e] * xv[e];
                }
            }
            ss += __shfl_xor(ss, 16); ss += __shfl_xor(ss, 32);
            if (fq == 0 && !(MODE == 1 && X)) rsq_out[(size_t)row * 16 + u.pn * 4 + wc] = ss;
        }
    }
};

template <class Epi> __device__ __forceinline__ void run_gemm(LAS unsigned char* lds, const bf16_t* A, const bf16_t* Bt, int N, int K, Epi& E, const float* rsqA = nullptr, const float* rsqB = nullptr, bool stagger = false) {
    int bx = blockIdx.x; asm volatile("" : "+s"(bx)); asm volatile("" : "+s"(K)); asm volatile("" : "+s"(N));
    pg8::Gemm g{A, Bt, M, N, K}; pg8::StaticOrder S; S.init(M, N, (int)gridDim.x, bx);
    if (rsqA) {
        int p0 = -1, p1 = -1, p2 = -1, p3 = -1; pg8::Unit u;
        for (int i = 0; S.next(i, u); ++i) { const int pm = u.pm; if (pm != p0 && pm != p1 && pm != p2 && pm != p3) { if (p0 < 0) p0 = pm; else if (p1 < 0) p1 = pm; else if (p2 < 0) p2 = pm; else p3 = pm; } }
        E.rt.p0 = p0; E.rt.p1 = p1; E.rt.p2 = p2; E.rt.p3 = p3;
        const int tid = TID();
        LAS float* tab = (LAS float*)(lds + LDS_RTAB);
        if (tid < 256) {
#pragma unroll
            for (int s = 0; s < 4; ++s) { const int pm = s == 0 ? p0 : (s == 1 ? p1 : (s == 2 ? p2 : p3));
                if (pm >= 0) { tab[s * 256 + tid] = row_rinv(rsqA, pm * 256 + tid); if (rsqB) tab[(4 + s) * 256 + tid] = row_rinv(rsqB, pm * 256 + tid); } }
        }
        __syncthreads();
    }
#ifndef STAGGER_TICKS
#define STAGGER_TICKS 2000
#endif
    if (stagger && ((bx >> 3) & 1)) { const unsigned long long t0 = __builtin_amdgcn_s_memrealtime(); while (__builtin_amdgcn_s_memrealtime() - t0 < (unsigned long long)STAGGER_TICKS) __builtin_amdgcn_s_sleep(16); }
    pg8::gemm_phase<Epi, pg8::StaticOrder, true, true>(lds, g, S, E);
    __syncthreads();
}

__device__ __forceinline__ void rowsq_pass(const bf16_t* P, float* rsq_out) {
    const int tid = TID(), lane = tid & 63, wave = tid >> 6;
    for (int base = (blockIdx.x * 8 + wave) * 4; base < M; base += gridDim.x * 8 * 4) {
        u32x4 v[4][2];
#pragma unroll
        for (int i = 0; i < 4; ++i) { const u32x4* pr = (const u32x4*)(P + (size_t)(base + i) * DM) + lane; v[i][0] = pr[0]; v[i][1] = pr[64]; }
#pragma unroll
        for (int i = 0; i < 4; ++i) {
            float s = 0.f;
#pragma unroll
            for (int h2 = 0; h2 < 2; ++h2) { const u32x4 w = v[i][h2];
                s += (bflo(w.x) * bflo(w.x) + bfhi(w.x) * bfhi(w.x)) + (bflo(w.y) * bflo(w.y) + bfhi(w.y) * bfhi(w.y)) + (bflo(w.z) * bflo(w.z) + bfhi(w.z) * bfhi(w.z)) + (bflo(w.w) * bflo(w.w) + bfhi(w.w) * bfhi(w.w)); }
#pragma unroll
            for (int o = 1; o < 64; o <<= 1) s += __shfl_xor(s, o);
            if (lane < 16) rsq_out[(size_t)(base + i) * 16 + lane] = (lane == 0) ? s : 0.f;
        }
    }
}

__device__ __forceinline__ int next_task(unsigned* ctr, LAS int* slot) {
    __syncthreads();
    if (TID() == 0) *slot = (int)atomicAdd(ctr, 1u);
    __syncthreads();
    return *slot;
}

__device__ __forceinline__ int colmap(int mode, int n) {
    if (mode == 1) return 256 * (n >> 7) + (n & 127);
    if (mode == 2) return 256 * (n >> 7) + 128 + (n & 127);
    if (mode == 3) return n < 1152 ? n : (n < 1170 ? 3456 + (n - 1152) : n - 18);
    return n;
}
__device__ __forceinline__ void conv_item(const float* W, int K, int N, bf16_t* WT, const float* gain, int mode, LAS float* scr, int item, int lane) {
    const int nblk = (N + 31) >> 5, kb = item / nblk, nb = item % nblk, k0 = 64 * kb, n0 = 32 * nb;
    if (mode != 3) {
        f32x4 v[8];
#pragma unroll
        for (int i = 0; i < 8; ++i) v[i] = *(const f32x4*)(W + (size_t)(k0 + 8 * i + (lane >> 3)) * N + n0 + 4 * (lane & 7));
#pragma unroll
        for (int i = 0; i < 8; ++i) {
            const int kk = 8 * i + (lane >> 3);
            f32x4 t = v[i];
            if (gain) t = t * gain[k0 + kk];
            LAS float* d = scr + kk * 33 + 4 * (lane & 7);
            d[0] = t[0]; d[1] = t[1]; d[2] = t[2]; d[3] = t[3];
        }
    } else {
#pragma unroll 16
        for (int i = 0; i < 32; ++i) {
            const int kk = 2 * i + (lane >> 5), n = n0 + (lane & 31);
            float v = (n < N) ? W[(size_t)(k0 + kk) * N + n] : 0.f;
            if (gain) v *= gain[k0 + kk];
            scr[kk * 33 + (lane & 31)] = v;
        }
    }
    LDSW();
    const int c = lane & 7;
#pragma unroll
    for (int j = 0; j < 4; ++j) {
        const int nl = (lane >> 3) + 8 * j, n = n0 + nl;
        const LAS float* s = scr + (8 * c) * 33 + nl;
        u32x4 o; o.x = pk2(s[0], s[33]); o.y = pk2(s[2 * 33], s[3 * 33]); o.z = pk2(s[4 * 33], s[5 * 33]); o.w = pk2(s[6 * 33], s[7 * 33]);
        if (n < N) *(u32x4*)(WT + (size_t)colmap(mode, n) * K + k0 + 8 * c) = o;
    }
    LDSW();
}
constexpr int IT_GU = (DM / 64) * (FF / 32), IT_D = (FF / 64) * (DM / 32), IT_IN = (DM / 64) * ((INW + 31) / 32), IT_SQ = (DM / 64) * (DM / 32),
              IT_PP = (PLE / 64) * (DM / 32), IT_W1 = (2048 / 64) * (256 / 32), IT_W2 = (256 / 64) * (64 / 32);
constexpr int IT_SETA = 2 * IT_GU + IT_D + IT_IN + 2 * IT_W1 + 2 * IT_W2;
constexpr int IT_SETB = 2 * IT_GU + IT_D + 2 * IT_SQ + IT_PP;
__device__ __forceinline__ void conv_one(unsigned char* ws, int LA, int LB, bool enA, int it, LAS float* scr, int lane) {
    unsigned char* wb = ws + WS_W;
    const size_t fa = (size_t)LA * DM * FF, fb = (size_t)LB * DM * FF;
    const float* W = nullptr; int K = 0, N = 0; bf16_t* WT = nullptr; const float* gain = nullptr; int mode = 0, rr = -1, r = it;
#define JOB(Wp, Kk, Nn, WTp, gp, md, items) { if (rr < 0 && r < (items)) { W = (Wp); K = (Kk); N = (Nn); WT = (bf16_t*)(WTp); gain = (gp); mode = (md); rr = r; } r -= (items); }
    JOB(inp(I_F1G) + fa, DM, FF, wb + W_GU1, inp(I_F1N) + LA * DM, 1, enA ? IT_GU : 0)
    JOB(inp(I_F1U) + fa, DM, FF, wb + W_GU1, inp(I_F1N) + LA * DM, 2, enA ? IT_GU : 0)
    JOB(inp(I_F1D) + fa, FF, DM, wb + W_D1, nullptr, 0, enA ? IT_D : 0)
    JOB(inp(I_WIN) + (size_t)LA * DM * INW, DM, INW, wb + W_IN, inp(I_MIXN) + LA * DM, 3, enA ? IT_IN : 0)
    JOB(inp(I_CW1) + (size_t)(LA * 2 + 0) * 2048 * 256, 2048, 256, wb + W_1T, nullptr, 0, enA ? IT_W1 : 0)
    JOB(inp(I_CW1) + (size_t)(LA * 2 + 1) * 2048 * 256, 2048, 256, wb + W_1T + 256 * 2048 * 2, nullptr, 0, enA ? IT_W1 : 0)
    JOB(inp(I_CW2) + (size_t)(LA * 2 + 0) * 256 * 64, 256, 64, wb + W_2T, nullptr, 0, enA ? IT_W2 : 0)
    JOB(inp(I_CW2) + (size_t)(LA * 2 + 1) * 256 * 64, 256, 64, wb + W_2T + 64 * 256 * 2, nullptr, 0, enA ? IT_W2 : 0)
    JOB(inp(I_F2G) + fb, DM, FF, wb + W_GU2, inp(I_F2N) + LB * DM, 1, IT_GU)
    JOB(inp(I_F2U) + fb, DM, FF, wb + W_GU2, inp(I_F2N) + LB * DM, 2, IT_GU)
    JOB(inp(I_F2D) + fb, FF, DM, wb + W_D2, nullptr, 0, IT_D)
    JOB(inp(I_WOUT) + (size_t)LB * DM * DM, DM, DM, wb + W_OUT, nullptr, 0, IT_SQ)
    JOB(inp(I_PLG) + (size_t)LB * DM * DM, DM, DM, wb + W_PG, inp(I_PLN) + LB * DM, 0, IT_SQ)
    JOB(inp(I_PLP) + (size_t)LB * PLE * DM, PLE, DM, wb + W_PP, nullptr, 0, IT_PP)
#undef JOB
    if (rr >= 0) conv_item(W, K, N, WT, gain, mode, scr, rr, lane);
}
__device__ __forceinline__ void posb_job(unsigned char* ws, int LA, int jid, int lane) {
    const int ty = jid >> 7, ng = (jid >> 5) & 3, ks = jid & 31, n = ng * 64 + lane;
    const float* w1 = inp(I_CW1) + (size_t)(LA * 2 + ty) * 2048 * 256; const float* pos = inp(I_CPOS) + (size_t)(LA * 2 + ty) * 2048;
    float acc = 0.f;
#pragma unroll 16
    for (int k = ks * 64; k < ks * 64 + 64; ++k) acc += pos[k] * w1[(size_t)k * 256 + n];
    ((float*)(ws + WS_W + W_POSB))[(ty * 32 + ks) * 256 + n] = acc;
}
__device__ __forceinline__ void phase_convert(const float* const* in, unsigned char* ws, float* out, int L, LAS unsigned char* lds) {
    const int tid = TID(), lane = tid & 63, wave = tid >> 6;
    const int gw = blockIdx.x * 8 + wave, NGW = gridDim.x * 8;
    LAS float* scr = (LAS float*)(lds + wave * 8704);
    if (gw < 256) posb_job(ws, 0, gw, lane);
    for (int it = gw; it < IT_SETA; it += NGW) conv_one(ws, 0, 0, true, it, scr, lane);
    {
        u32x4* z = (u32x4*)((bf16_t*)(ws + WS_W + W_IN) + (size_t)INW * DM);
        const int n16 = (ZW - INW) * DM / 8;
        for (int i = blockIdx.x * 512 + tid; i < n16; i += gridDim.x * 512) z[i] = (u32x4){0u, 0u, 0u, 0u};
    }
    {
        const float* x = inp(I_X); bf16_t* xb = (bf16_t*)(ws + WS_XB); float* rsq = (float*)(ws + WS_RSQ0);
        for (int m = gw; m < M; m += NGW) {
            const f32x4* xr = (const f32x4*)(x + (size_t)m * DM) + lane;
            u32x2* xbr = (u32x2*)(xb + (size_t)m * DM) + lane; unsigned* xlr = (unsigned*)(ws + WS_XB1 + (size_t)m * DM) + lane;
            float s = 0.f;
#pragma unroll
            for (int j = 0; j < 4; ++j) { const f32x4 v = xr[64 * j]; u32x2 w; w.x = pk2(v[0], v[1]); w.y = pk2(v[2], v[3]); xbr[64 * j] = w;
                xlr[64 * j] = pk_bf8(v[0] - bflo(w.x), v[1] - bfhi(w.x), v[2] - bflo(w.y), v[3] - bfhi(w.y));
                s += (v[0] * v[0] + v[1] * v[1]) + (v[2] * v[2] + v[3] * v[3]); }
#pragma unroll
            for (int o = 1; o < 64; o <<= 1) s += __shfl_xor(s, o);
            if (lane < 16) rsq[(size_t)m * 16 + lane] = (lane == 0) ? s : 0.f;
        }
    }
}
__device__ __forceinline__ void task_conv(unsigned char* ws, int L, int c, LAS unsigned char* lds) {
    const int tid = TID(), lane = tid & 63, wave = tid >> 6;
    LAS float* scr = (LAS float*)(lds + wave * 8704);
    const bool enA = L < DEPTH - 1;
    const int total = (enA ? IT_SETA : 0) + IT_SETB;
    if (enA && wave == 7) posb_job(ws, L + 1, c, lane);
    for (int i = 0; i < 6; ++i) { const int it = c * 48 + wave * 6 + i; if (it < total) conv_one(ws, L + 1, L, enA, it, scr, lane); }
    if (enA && tid < 55) { u32x4* z = (u32x4*)((bf16_t*)(ws + WS_W + W_IN) + (size_t)INW * DM); z[c * 55 + tid] = (u32x4){0u, 0u, 0u, 0u}; }
    {
        const f32x4* src = (const f32x4*)(inp(I_P) + (size_t)L * M * PLE); u32x4* dst = (u32x4*)(ws + WS_PB);
#pragma unroll
        for (int i = 0; i < 8; ++i) {
            const int idx = c * 4096 + i * 512 + tid;
            const f32x4 a = src[2 * idx], b = src[2 * idx + 1];
            u32x4 w; w.x = pk2(a[0], a[1]); w.y = pk2(a[2], a[3]); w.z = pk2(b[0], b[1]); w.w = pk2(b[2], b[3]); dst[idx] = w;
        }
    }
}

__device__ __forceinline__ void task_prep(const float* const* in, unsigned char* ws, int L, int tile, LAS unsigned char* lds) {
    const int tid = TID(), lane = tid & 63, wave = tid >> 6;
    bf16_t* z = (bf16_t*)(ws + WS_R1);
    const int row0 = tile * 64;
#pragma unroll
    for (int pass = 0; pass < 3; ++pass) {
        const int seg = pass * 64 + lane;
        int col = 0, gs = 8; const float* gp = inp(I_NQN); float scale = 1.f;
        if (seg < 48) { col = C_NQ + 8 * seg; gp = inp(I_NQN) + L * 64 + ((8 * seg) & 63); scale = 0.125f * LOG2E; }
        else if (seg < 64) { col = C_SK + 8 * (seg - 48); gp = inp(I_NKN) + (L * 3 + 1) * 64 + ((8 * seg) & 63); }
        else if (seg < 80) { col = C_WK + 8 * (seg - 64); gp = inp(I_NKN) + (L * 3 + 2) * 64 + ((8 * seg) & 63); }
        else if (seg < 112) { col = C_DQ + 8 * (seg - 80); gp = inp(I_DQN) + L * 32 + ((8 * seg) & 31); gs = 4; scale = 0.17677669529663689f * LOG2E; }
        else { col = C_DK + 8 * (seg - 112); gp = inp(I_DKN) + L * 32 + ((8 * seg) & 31); gs = 4; }
        const bool act = seg < 144;
        if (!act) { col = 0; }
        const f32x4 g0 = *(const f32x4*)gp, g1 = *(const f32x4*)(gp + 4);
        u32x4 w[8];
#pragma unroll
        for (int i = 0; i < 8; ++i) w[i] = *(const u32x4*)(z + (size_t)(row0 + wave + 8 * i) * ZW + col);
#pragma unroll
        for (int i = 0; i < 8; ++i) {
            float v[8] = {bflo(w[i].x), bfhi(w[i].x), bflo(w[i].y), bfhi(w[i].y), bflo(w[i].z), bfhi(w[i].z), bflo(w[i].w), bfhi(w[i].w)};
            float ss = 0.f;
#pragma unroll
            for (int e2 = 0; e2 < 8; ++e2) ss += v[e2] * v[e2];
            ss += __shfl_xor(ss, 1); ss += __shfl_xor(ss, 2);
            const float t4 = __shfl_xor(ss, 4); if (gs == 8) ss += t4;
            const float r = rsqrtf(ss / (float)(gs * 8) + EPS) * scale;
            u32x4 o; o.x = pk2(v[0] * r * g0[0], v[1] * r * g0[1]); o.y = pk2(v[2] * r * g0[2], v[3] * r * g0[3]);
            o.z = pk2(v[4] * r * g1[0], v[5] * r * g1[1]); o.w = pk2(v[6] * r * g1[2], v[7] * r * g1[3]);
            if (act) *(u32x4*)(z + (size_t)(row0 + wave + 8 * i) * ZW + col) = o;
        }
    }
    LAS bf16_t* tl = (LAS bf16_t*)lds;
#pragma unroll
    for (int i = 0; i < 8; ++i) {
        const int id = i * 512 + tid, row = id >> 6, ch = id & 63;
        const int col = ch < 16 ? C_SV + 8 * ch : (ch < 32 ? C_WV + 8 * (ch - 16) : C_DV + 8 * (ch - 32));
        *(LAS u32x4*)(tl + row * 520 + 8 * ch) = *(const u32x4*)(z + (size_t)(row0 + row) * ZW + col);
    }
    __syncthreads();
    const int b = row0 / T, t0 = row0 % T;
    bf16_t* vt = (bf16_t*)(ws + WS_VT);
#pragma unroll
    for (int i = 0; i < 8; ++i) {
        const int orow = tid, tch = i;
        const LAS bf16_t* s = tl + (tch * 8) * 520 + orow;
        u32x4 o;
        o.x = (unsigned)s[0] | ((unsigned)s[520] << 16); o.y = (unsigned)s[2 * 520] | ((unsigned)s[3 * 520] << 16);
        o.z = (unsigned)s[4 * 520] | ((unsigned)s[5 * 520] << 16); o.w = (unsigned)s[6 * 520] | ((unsigned)s[7 * 520] << 16);
        *(u32x4*)(vt + ((size_t)(b * 8) * 64 + orow) * T + t0 + 8 * tch) = o;
    }
}

__device__ __forceinline__ float gelu_tanh(float x) {
    const float y = 0.7978845608028654f * (x + 0.044715f * x * x * x);
    const float th = 1.0f - 2.0f * __builtin_amdgcn_rcpf(1.0f + __expf(2.0f * y));
    return 0.5f * x * (1.0f + th);
}
__device__ __forceinline__ void task_compress(const float* const* in, unsigned char* ws, int L, int task, LAS unsigned char* lds) {
    const int tid = TID(), lane = tid & 63, wave = tid >> 6;
    const int ty = task >> 8, b = (task >> 6) & 3, g = (task >> 5) & 1, i0 = (task & 31) * 16;
    const bf16_t* z = (const bf16_t*)(ws + WS_R1);
    LAS bf16_t* zt = (LAS bf16_t*)lds;
    LAS bf16_t* hid = (LAS bf16_t*)(lds + 39168);
    LAS float* ofp = (LAS float*)(lds + 39168 + 8448);
    const int ccol = (ty ? C_CV : C_CK) + 64 * g;
    for (int id = tid; id < 272 * 8; id += 512) {
        const int row = id >> 3, ch = id & 7, tok = 16 * i0 + row;
        u32x4 v = (u32x4){0u, 0u, 0u, 0u};
        if (tok < T) v = *(const u32x4*)(z + (size_t)(b * T + tok) * ZW + ccol + 8 * ch);
        *(LAS u32x4*)(zt + row * 72 + 8 * ch) = v;
    }
    __syncthreads();
    const bf16_t* w1t = (const bf16_t*)(ws + WS_W + W_1T) + (size_t)ty * 256 * 2048;
    const bf16_t* w2t = (const bf16_t*)(ws + WS_W + W_2T) + (size_t)ty * 64 * 256;
    const float* posb = (const float*)(ws + WS_W + W_POSB) + ty * 32 * 256;
    const int r16 = lane & 15, kq = lane >> 4;
    f32x4 acc[2] = {(f32x4){0.f, 0.f, 0.f, 0.f}, (f32x4){0.f, 0.f, 0.f, 0.f}};
    const bf16_t* b0p = w1t + (size_t)(16 * (2 * wave) + r16) * 2048 + 8 * kq;
    const bf16_t* b1p = b0p + 16 * 2048;
#pragma unroll 8
    for (int kc = 0; kc < 64; ++kc) {
        const bf16x8 a = *(const LAS bf16x8*)(zt + (16 * r16 + (kc >> 1)) * 72 + (kc & 1) * 32 + 8 * kq);
        const bf16x8 w0 = *(const bf16x8*)(b0p + 32 * kc), w1 = *(const bf16x8*)(b1p + 32 * kc);
        acc[0] = mfma16(a, w0, acc[0]); acc[1] = mfma16(a, w1, acc[1]);
    }
#pragma unroll
    for (int j = 0; j < 2; ++j) {
        const int n = 16 * (2 * wave + j) + r16;
        float pbias = 0.f;
#pragma unroll
        for (int ks = 0; ks < 32; ++ks) pbias += posb[ks * 256 + n];
#pragma unroll
        for (int i = 0; i < 4; ++i) hid[(4 * kq + i) * 264 + n] = f2bf(gelu_tanh(acc[j][i] + pbias));
    }
    __syncthreads();
    if (wave < 4) {
        f32x4 a2 = (f32x4){0.f, 0.f, 0.f, 0.f};
        const bf16_t* bp = w2t + (size_t)(16 * wave + r16) * 256 + 8 * kq;
#pragma unroll
        for (int kc = 0; kc < 8; ++kc) {
            const bf16x8 a = *(const LAS bf16x8*)(hid + r16 * 264 + 32 * kc + 8 * kq);
            const bf16x8 w = *(const bf16x8*)(bp + 32 * kc);
            a2 = mfma16(a, w, a2);
        }
#pragma unroll
        for (int i = 0; i < 4; ++i) ofp[(4 * kq + i) * 64 + 16 * wave + r16] = a2[i];
    }
    __syncthreads();
    if (tid < 256) {
        const int row = tid >> 4, c4 = (tid & 15) * 4, i = i0 + row;
        f32x4 o = *(const LAS f32x4*)(ofp + row * 64 + c4);
        float ss = (o[0] * o[0] + o[1] * o[1]) + (o[2] * o[2] + o[3] * o[3]);
        ss += __shfl_xor(ss, 1); ss += __shfl_xor(ss, 2); ss += __shfl_xor(ss, 4); ss += __shfl_xor(ss, 8);
        if (ty == 0) {
            const float r = rsqrtf(ss * (1.0f / 64.0f) + EPS);
            const f32x4 gn = *(const f32x4*)(inp(I_NKN) + (L * 3 + 0) * 64 + c4);
            o = o * r * gn;
        }
        if (i >= 511) o = (f32x4){0.f, 0.f, 0.f, 0.f};
        if (ty == 0) {
            u32x2 w; w.x = pk2(o[0], o[1]); w.y = pk2(o[2], o[3]);
            *(u32x2*)((bf16_t*)(ws + WS_KC) + ((size_t)(b * 2 + g) * 512 + i) * 64 + c4) = w;
        } else {
            bf16_t* vct = (bf16_t*)(ws + WS_VCT) + (size_t)(b * 2 + g) * 64 * 512;
#pragma unroll
            for (int e = 0; e < 4; ++e) vct[(size_t)(c4 + e) * 512 + i] = f2bf(o[e]);
        }
    }
}

__device__ __forceinline__ float hgrn_lb(const float* logits, int L, int j) {
    if (L == 0) return 0.f;
    const float a0 = logits[j], a1 = logits[384 + j], a2 = logits[768 + j], a3 = logits[1152 + j];
    const float mx = fmaxf(fmaxf(a0, a1), fmaxf(a2, a3));
    const float e0 = __expf(a0 - mx), e1 = __expf(a1 - mx), e2 = __expf(a2 - mx), e3 = __expf(a3 - mx);
    const float inv = 1.0f / (e0 + e1 + e2 + e3);
    float s = e1; if (L >= 2) s += e2; if (L >= 3) s += e3;
    return s * inv;
}
__device__ __forceinline__ void task_hgrn_local(const float* const* in, unsigned char* ws, int L, int task, LAS unsigned char* lds) {
    const int tid = TID(), lane = tid & 63, wave = tid >> 6;
    {
        const int chunk = task * 8 + wave;
        const int bh = chunk >> 7, c = chunk & 127, b = bh / 6, h = bh % 6;
        const bf16_t* z = (const bf16_t*)(ws + WS_R1) + (size_t)(b * T + c * 64) * ZW;
        LAS bf16_t* klT = (LAS bf16_t*)(lds + wave * 18432);
        LAS bf16_t* vT = klT + 64 * 72;
        const float lb = hgrn_lb(inp(I_LBLOG), L, h * 64 + lane);
        LAS bf16_t* rawf = klT;
        (void)rawf;
        u32x4 rf[8], ri[8];
#pragma unroll
        for (int i = 0; i < 8; ++i) {
            const int row = (lane >> 3) + 8 * i, ch = lane & 7;
            rf[i] = *(const u32x4*)(z + (size_t)row * ZW + C_HF + 64 * h + 8 * ch);
            ri[i] = *(const u32x4*)(z + (size_t)row * ZW + C_HI + 64 * h + 8 * ch);
        }
#pragma unroll
        for (int i = 0; i < 8; ++i) {
            const int row = (lane >> 3) + 8 * i, ch = lane & 7;
            *(LAS u32x4*)(klT + row * 72 + 8 * ch) = rf[i];
            *(LAS u32x4*)(vT + row * 72 + 8 * ch) = ri[i];
        }
        LDSW();
        float suffix = 0.f;
        bf16_t colf[64], colv[64];
#pragma unroll
        for (int s2 = 0; s2 < 64; ++s2) { colf[s2] = klT[s2 * 72 + lane]; colv[s2] = vT[s2 * 72 + lane]; }
        LDSW();
#pragma unroll
        for (int s = 63; s >= 0; --s) {
            const float fr = bf2f(colf[s]);
            const float sg = sigmoidf_(fr);
            const float f = lb + (1.0f - lb) * sg;
            const float ig = (1.0f - lb) * (1.0f - sg);
            klT[lane * 72 + s] = f2bf(ig * __expf(suffix));
            vT[lane * 72 + s] = colv[s];
            suffix += __logf(f);
        }
        ((float*)(ws + WS_HD))[(size_t)chunk * 64 + lane] = __expf(suffix);
        LDSW();
        const int r32 = lane & 31, hi = lane >> 5;
        float* hs = (float*)(ws + WS_HS) + (size_t)chunk * 4096;
#pragma unroll
        for (int kb = 0; kb < 2; ++kb)
#pragma unroll
            for (int vb = 0; vb < 2; ++vb) {
                f32x16 cacc = {};
#pragma unroll
                for (int cc = 0; cc < 4; ++cc) {
                    const bf16x8 a = *(const LAS bf16x8*)(klT + (32 * kb + r32) * 72 + 16 * cc + 8 * hi);
                    const bf16x8 bb = *(const LAS bf16x8*)(vT + (32 * vb + r32) * 72 + 16 * cc + 8 * hi);
                    cacc = mfma32(a, bb, cacc);
                }
#pragma unroll
                for (int r = 0; r < 16; ++r) hs[(32 * kb + crow(r, hi)) * 64 + 32 * vb + r32] = cacc[r];
            }
    }
}
__device__ __forceinline__ void task_hgrn_scan(unsigned char* ws, int task) {
    const int tid = TID();
    const int bh = task >> 3, k = (task & 7) * 8 + (tid >> 6), v = tid & 63;
    float* hs = (float*)(ws + WS_HS) + (size_t)bh * 128 * 4096 + k * 64 + v;
    const float* hd = (const float*)(ws + WS_HD) + (size_t)bh * 128 * 64 + k;
    float S = 0.f;
#pragma unroll 16
    for (int c = 0; c < 128; ++c) {
        const float a = hs[(size_t)c * 4096], d = hd[c * 64];
        hs[(size_t)c * 4096] = S;
        S = d * S + a;
    }
}
__device__ __forceinline__ void task_hgrn_out(const float* const* in, unsigned char* ws, int L, int task, LAS unsigned char* lds) {
    const int tid = TID(), lane = tid & 63, wave = tid >> 6;
    if (wave < 4) {
        const int chunk = task * 4 + wave;
        const int bh = chunk >> 7, c = chunk & 127, b = bh / 6, h = bh % 6;
        const size_t row0 = (size_t)(b * T + c * 64);
        const bf16_t* z = (const bf16_t*)(ws + WS_R1) + row0 * ZW;
        LAS bf16_t* ke = (LAS bf16_t*)(lds + wave * 36864);
        LAS bf16_t* qe = ke + 64 * 72;
        LAS bf16_t* vT = qe + 64 * 72;
        LAS bf16_t* sT = vT + 64 * 72;
        const float lb = hgrn_lb(inp(I_LBLOG), L, h * 64 + lane);
        {
            u32x4 rq[8], rf[8], ri[8];
#pragma unroll
            for (int i = 0; i < 8; ++i) {
                const int row = (lane >> 3) + 8 * i, ch = lane & 7;
                rq[i] = *(const u32x4*)(z + (size_t)row * ZW + C_HQ + 64 * h + 8 * ch);
                rf[i] = *(const u32x4*)(z + (size_t)row * ZW + C_HF + 64 * h + 8 * ch);
                ri[i] = *(const u32x4*)(z + (size_t)row * ZW + C_HI + 64 * h + 8 * ch);
            }
#pragma unroll
            for (int i = 0; i < 8; ++i) {
                const int row = (lane >> 3) + 8 * i, ch = lane & 7;
                *(LAS u32x4*)(qe + row * 72 + 8 * ch) = rq[i];
                *(LAS u32x4*)(ke + row * 72 + 8 * ch) = rf[i];
                *(LAS u32x4*)(sT + row * 72 + 8 * ch) = ri[i];
            }
        }
        LDSW();
        float ref = 0.f;
#pragma unroll 8
        for (int s = 0; s < 32; ++s) {
            const float fr = bf2f(ke[s * 72 + lane]);
            ref += __logf(lb + (1.0f - lb) * sigmoidf_(fr));
        }
        float cum = 0.f;
#pragma unroll 8
        for (int s = 0; s < 64; ++s) {
            const float fr = bf2f(ke[s * 72 + lane]);
            const float qv = bf2f(qe[s * 72 + lane]);
            const bf16_t vraw = sT[s * 72 + lane];
            const float sg = sigmoidf_(fr);
            const float f = lb + (1.0f - lb) * sg;
            const float ig = (1.0f - lb) * (1.0f - sg);
            cum += __logf(f);
            qe[s * 72 + lane] = f2bf(qv * sigmoidf_(qv) * __expf(cum - ref));
            ke[s * 72 + lane] = f2bf(ig * __expf(ref - cum));
            vT[lane * 72 + s] = vraw;
        }
        LDSW();
        const float* hs = (const float*)(ws + WS_HS) + (size_t)chunk * 4096;
        const float eref = __expf(ref);
        {
            f32x4 hv[16];
#pragma unroll
            for (int i = 0; i < 16; ++i) hv[i] = *(const f32x4*)(hs + ((lane >> 4) + 4 * i) * 64 + (lane & 15) * 4);
#pragma unroll
            for (int i = 0; i < 16; ++i) {
                const int k = (lane >> 4) + 4 * i, v4 = (lane & 15) * 4;
                const float er = __shfl(eref, k);
                sT[(v4 + 0) * 72 + k] = f2bf(hv[i][0] * er); sT[(v4 + 1) * 72 + k] = f2bf(hv[i][1] * er);
                sT[(v4 + 2) * 72 + k] = f2bf(hv[i][2] * er); sT[(v4 + 3) * 72 + k] = f2bf(hv[i][3] * er);
            }
        }
        LDSW();
        const int r32 = lane & 31, hi = lane >> 5;
        f32x16 O[2][2] = {};
#pragma unroll
        for (int tb = 0; tb < 2; ++tb) {
            bf16x8 qf[4];
#pragma unroll
            for (int cc = 0; cc < 4; ++cc) qf[cc] = *(const LAS bf16x8*)(qe + (32 * tb + r32) * 72 + 16 * cc + 8 * hi);
#pragma unroll
            for (int vb = 0; vb < 2; ++vb)
#pragma unroll
                for (int cc = 0; cc < 4; ++cc) {
                    const bf16x8 a = *(const LAS bf16x8*)(sT + (32 * vb + r32) * 72 + 16 * cc + 8 * hi);
                    O[vb][tb] = mfma32(a, qf[cc], O[vb][tb]);
                }
#pragma unroll
            for (int sb = 0; sb <= tb; ++sb) {
                f32x16 sc = {};
#pragma unroll
                for (int cc = 0; cc < 4; ++cc) {
                    const bf16x8 a = *(const LAS bf16x8*)(ke + (32 * sb + r32) * 72 + 16 * cc + 8 * hi);
                    sc = mfma32(a, qf[cc], sc);
                }
                unsigned P[8];
#pragma unroll
                for (int j = 0; j < 8; ++j) {
                    float p0 = sc[2 * j], p1 = sc[2 * j + 1];
                    if (sb == tb) { if (crow(2 * j, hi) > r32) p0 = 0.f; if (crow(2 * j + 1, hi) > r32) p1 = 0.f; }
                    P[j] = pk2(p0, p1);
                }
#pragma unroll
                for (int vb = 0; vb < 2; ++vb)
#pragma unroll
                    for (int c2 = 0; c2 < 2; ++c2) {
                        const u32x2 a0 = *(const LAS u32x2*)(vT + (32 * vb + r32) * 72 + 32 * sb + 16 * c2 + 4 * hi);
                        const u32x2 a1 = *(const LAS u32x2*)(vT + (32 * vb + r32) * 72 + 32 * sb + 16 * c2 + 8 + 4 * hi);
                        const bf16x8 vf = as_bf16x8((u32x4){a0.x, a0.y, a1.x, a1.y});
                        const bf16x8 pf = as_bf16x8((u32x4){P[4 * c2], P[4 * c2 + 1], P[4 * c2 + 2], P[4 * c2 + 3]});
                        O[vb][tb] = mfma32(vf, pf, O[vb][tb]);
                    }
            }
        }
        LDSW();
        const float* on = inp(I_HON) + L * 64;
#pragma unroll
        for (int tb = 0; tb < 2; ++tb) {
            float ss = 0.f;
#pragma unroll
            for (int vb = 0; vb < 2; ++vb)
#pragma unroll
                for (int r = 0; r < 16; ++r) ss += O[vb][tb][r] * O[vb][tb][r];
            ss += __shfl_xor(ss, 32);
            const float rn = rsqrtf(ss * (1.0f / 64.0f) + EPS);
#pragma unroll
            for (int vb = 0; vb < 2; ++vb)
#pragma unroll
                for (int r = 0; r < 16; ++r) { const int v = 32 * vb + crow(r, hi); ke[(32 * tb + r32) * 72 + v] = f2bf(O[vb][tb][r] * rn * on[v]); }
        }
        LDSW();
        bf16_t* mixed = (bf16_t*)(ws + WS_MIX) + row0 * DM + 640 + 64 * h;
#pragma unroll
        for (int i = 0; i < 8; ++i) {
            const int t = i * 8 + (lane >> 3), ch = lane & 7;
            const u32x4 ov = *(const LAS u32x4*)(ke + t * 72 + 8 * ch);
            const u32x4 gv = *(const u32x4*)(z + (size_t)t * ZW + C_HG + 64 * h + 8 * ch);
            u32x4 w;
            { const float g0 = bflo(gv.x), g1 = bfhi(gv.x); w.x = pk2(bflo(ov.x) * g0 * sigmoidf_(g0), bfhi(ov.x) * g1 * sigmoidf_(g1)); }
            { const float g0 = bflo(gv.y), g1 = bfhi(gv.y); w.y = pk2(bflo(ov.y) * g0 * sigmoidf_(g0), bfhi(ov.y) * g1 * sigmoidf_(g1)); }
            { const float g0 = bflo(gv.z), g1 = bfhi(gv.z); w.z = pk2(bflo(ov.z) * g0 * sigmoidf_(g0), bfhi(ov.z) * g1 * sigmoidf_(g1)); }
            { const float g0 = bflo(gv.w), g1 = bfhi(gv.w); w.w = pk2(bflo(ov.w) * g0 * sigmoidf_(g0), bfhi(ov.w) * g1 * sigmoidf_(g1)); }
            *(u32x4*)(mixed + (size_t)t * DM + 8 * ch) = w;
        }
    }
}

constexpr int ATT_K = 0, ATT_V = 18432, ATT_LUT = 35840, ATT_STAGE = 36864;
__device__ __forceinline__ void build_lut(LAS float* lut, const float* rel_bias, int head) {
    const int d = TID();
    if (d <= 128) {
        int bk = d;
        if (d >= 16) { const int far = 16 + (int)(__logf((float)d * (1.0f / 16.0f)) / 2.0794415416798357f * 16.0f); bk = far < 31 ? far : 31; }
        lut[d] = rel_bias[bk * 10 + head] * LOG2E;
    }
}
template <int NMAP, bool HAS_SEL, bool FAST>
__device__ __forceinline__ void attn_tile(const LAS unsigned char* Kb, const LAS unsigned char* Vb, const bf16x8 (&qr)[4], int tq, int k0, int win, float c31, const LAS float* lut, bool sel,
                                          f32x16 (&O)[NMAP][2], float (&l)[NMAP], int r32, int hi) {
    unsigned P[NMAP][2][8];
#pragma unroll
    for (int kh2 = 0; kh2 < 2; ++kh2) {
        f32x16 S[NMAP];
        const float ini = FAST ? ((HAS_SEL && !sel) ? -30000.f : c31) : 0.f;
#pragma unroll
        for (int mp = 0; mp < NMAP; ++mp)
#pragma unroll
            for (int r = 0; r < 16; ++r) S[mp][r] = ini;
#pragma unroll
        for (int c = 0; c < 4; ++c) {
            const bf16x8 kf = *(const LAS bf16x8*)(Kb + (32 * kh2 + r32) * 144 + (16 * c + 8 * hi) * 2);
            const int mp = (NMAP == 2) ? (c >> 1) : 0;
            S[mp] = mfma32(kf, qr[c], S[mp]);
        }
#pragma unroll
        for (int mp = 0; mp < NMAP; ++mp) {
            float p[16];
            if (FAST) {
#pragma unroll
                for (int r = 0; r < 16; ++r) p[r] = ex2(S[mp][r]);
            } else {
#pragma unroll
                for (int r = 0; r < 16; ++r) {
                    const int d = tq - (k0 + 32 * kh2 + crow(r, hi));
                    const bool valid = sel && d >= 0 && d < win;
                    const int dc = d < 0 ? 0 : (d > 128 ? 128 : d);
                    const float e = ex2(S[mp][r] + lut[dc]);
                    p[r] = valid ? e : 0.f;
                }
            }
            float s = 0.f;
#pragma unroll
            for (int r = 0; r < 16; ++r) s += p[r];
            l[mp] += s;
#pragma unroll
            for (int j = 0; j < 8; ++j) P[mp][kh2][j] = pk2(p[2 * j], p[2 * j + 1]);
        }
        if (NMAP == 2) __builtin_amdgcn_sched_barrier(0);
    }
#pragma unroll
    for (int cc = 0; cc < 4; ++cc)
#pragma unroll
        for (int db = 0; db < 2; ++db) {
            const u32x2 a0 = *(const LAS u32x2*)(Vb + (32 * db + r32) * 136 + (16 * cc + 4 * hi) * 2);
            const u32x2 a1 = *(const LAS u32x2*)(Vb + (32 * db + r32) * 136 + (16 * cc + 8 + 4 * hi) * 2);
            const bf16x8 vf = as_bf16x8((u32x4){a0.x, a0.y, a1.x, a1.y});
#pragma unroll
            for (int mp = 0; mp < NMAP; ++mp) {
                const bf16x8 pf = as_bf16x8((u32x4){P[mp][cc >> 1][4 * (cc & 1)], P[mp][cc >> 1][4 * (cc & 1) + 1], P[mp][cc >> 1][4 * (cc & 1) + 2], P[mp][cc >> 1][4 * (cc & 1) + 3]});
                O[mp][db] = mfma32(vf, pf, O[mp][db]);
            }
        }
}
template <bool HAS_SEL>
__device__ __forceinline__ void attn_tile1_fast(const LAS unsigned char* Kb, const LAS unsigned char* Vb, const bf16x8 (&qr)[4], float c31, bool sel,
                                                f32x16 (&O)[1][2], float (&l)[1], int r32, int hi) {
    const float ini = (HAS_SEL && !sel) ? -30000.f : c31;
    f32x16 S[2];
#pragma unroll
    for (int kh2 = 0; kh2 < 2; ++kh2) {
#pragma unroll
        for (int r = 0; r < 16; ++r) S[kh2][r] = ini;
#pragma unroll
        for (int c = 0; c < 4; ++c) {
            const bf16x8 kf = *(const LAS bf16x8*)(Kb + (32 * kh2 + r32) * 144 + (16 * c + 8 * hi) * 2);
            S[kh2] = mfma32(kf, qr[c], S[kh2]);
        }
    }
    float s = 0.f;
#pragma unroll
    for (int kh2 = 0; kh2 < 2; ++kh2) {
        float p[16]; unsigned P[8];
#pragma unroll
        for (int r = 0; r < 16; ++r) { p[r] = ex2(S[kh2][r]); s += p[r]; }
#pragma unroll
        for (int j = 0; j < 8; ++j) P[j] = pk2(p[2 * j], p[2 * j + 1]);
#pragma unroll
        for (int c2 = 0; c2 < 2; ++c2)
#pragma unroll
            for (int db = 0; db < 2; ++db) {
                const int cc = 2 * kh2 + c2;
                const u32x2 a0 = *(const LAS u32x2*)(Vb + (32 * db + r32) * 136 + (16 * cc + 4 * hi) * 2);
                const u32x2 a1 = *(const LAS u32x2*)(Vb + (32 * db + r32) * 136 + (16 * cc + 8 + 4 * hi) * 2);
                const bf16x8 vf = as_bf16x8((u32x4){a0.x, a0.y, a1.x, a1.y});
                const bf16x8 pf = as_bf16x8((u32x4){P[4 * c2], P[4 * c2 + 1], P[4 * c2 + 2], P[4 * c2 + 3]});
                O[0][db] = mfma32(vf, pf, O[0][db]);
            }
    }
    l[0] += s;
}
__device__ __forceinline__ void attn_tile2_fast(const LAS unsigned char* Kb, const LAS unsigned char* Vb, const bf16x8 (&qr)[4], const f32x16& cini,
                                                f32x16 (&O)[2][2], float (&l)[2], int r32, int hi) {
#pragma unroll
    for (int mp = 0; mp < 2; ++mp) {
        f32x16 S[2];
#pragma unroll
        for (int kh2 = 0; kh2 < 2; ++kh2) {
            const bf16x8 kf0 = *(const LAS bf16x8*)(Kb + (32 * kh2 + r32) * 144 + (32 * mp + 8 * hi) * 2);
            const bf16x8 kf1 = *(const LAS bf16x8*)(Kb + (32 * kh2 + r32) * 144 + (32 * mp + 16 + 8 * hi) * 2);
            S[kh2] = mfma32(kf0, qr[2 * mp], cini);
            S[kh2] = mfma32(kf1, qr[2 * mp + 1], S[kh2]);
        }
        float s = 0.f;
#pragma unroll
        for (int kh2 = 0; kh2 < 2; ++kh2) {
            float p[16]; unsigned P[8];
#pragma unroll
            for (int r = 0; r < 16; ++r) { p[r] = ex2(S[kh2][r]); s += p[r]; }
#pragma unroll
            for (int j = 0; j < 8; ++j) P[j] = pk2(p[2 * j], p[2 * j + 1]);
#pragma unroll
            for (int c2 = 0; c2 < 2; ++c2)
#pragma unroll
                for (int db = 0; db < 2; ++db) {
                    const int cc = 2 * kh2 + c2;
                    const u32x2 a0 = *(const LAS u32x2*)(Vb + (32 * db + r32) * 136 + (16 * cc + 4 * hi) * 2);
                    const u32x2 a1 = *(const LAS u32x2*)(Vb + (32 * db + r32) * 136 + (16 * cc + 8 + 4 * hi) * 2);
                    const bf16x8 vf = as_bf16x8((u32x4){a0.x, a0.y, a1.x, a1.y});
                    const bf16x8 pf = as_bf16x8((u32x4){P[4 * c2], P[4 * c2 + 1], P[4 * c2 + 2], P[4 * c2 + 3]});
                    O[mp][db] = mfma32(vf, pf, O[mp][db]);
                }
        }
        l[mp] += s;
    }
}
template <int NMAP, bool HAS_SEL>
__device__ __forceinline__ void attn_pass(LAS unsigned char* lds, const bf16_t* Kth, size_t kts, const bf16_t* Vth, int m_lo, int m_hi,
                                          const bf16x8 (&qr)[4], int tq, int qw0, int win, const LAS float* lut, u32x4 selw,
                                          f32x16 (&O)[NMAP][2], float (&l)[NMAP]) {
    const int tid = TID(), lane = tid & 63, r32 = lane & 31, hi = lane >> 5;
    const float c31 = lut[128];
    f32x16 cini;
#pragma unroll
    for (int r = 0; r < 16; ++r) cini[r] = c31;
    asm volatile("" : "+v"(cini));
    u32x4 kreg = *(const u32x4*)(Kth + (size_t)m_lo * kts), vreg = *(const u32x4*)(Vth + (size_t)m_lo * 64);
    int buf = 0;
    for (int m = m_lo; m <= m_hi; ++m) {
        *(LAS u32x4*)(lds + ATT_K + buf * 9216 + (tid >> 3) * 144 + (tid & 7) * 16) = kreg;
        { LAS u32x2* vp = (LAS u32x2*)(lds + ATT_V + buf * 8704 + (tid >> 3) * 136 + (tid & 7) * 16); vp[0] = (u32x2){vreg.x, vreg.y}; vp[1] = (u32x2){vreg.z, vreg.w}; }
        __syncthreads();
        if (m < m_hi) { kreg = *(const u32x4*)(Kth + (size_t)(m + 1) * kts); vreg = *(const u32x4*)(Vth + (size_t)(m + 1) * 64); }
        const int k0 = 64 * m, dmin = qw0 - (k0 + 63), dmax = qw0 + 31 - k0;
        bool sel = true;
        if (HAS_SEL) { const unsigned w = m < 32 ? selw.x : (m < 64 ? selw.y : (m < 96 ? selw.z : selw.w)); sel = (w >> (m & 31)) & 1u; }
        bool active = dmax >= 0 && dmin < win;
        if (HAS_SEL) active = active && (__any(sel) != 0);
        if (active) {
            if (NMAP == 1) {
                const LAS unsigned char* Kb = lds + ATT_K + buf * 9216;
                const LAS unsigned char* Vb = lds + ATT_V + buf * 8704;
                if (dmin >= 128 && dmax < win) { if constexpr (NMAP == 1) attn_tile1_fast<HAS_SEL>(Kb, Vb, qr, c31, sel, O, l, r32, hi); }
                else attn_tile<NMAP, HAS_SEL, false>(Kb, Vb, qr, tq, k0, win, c31, lut, sel, O, l, r32, hi);
            } else if (NMAP == 2 && dmin >= 128 && dmax < win) {
                if constexpr (NMAP == 2) attn_tile2_fast(lds + ATT_K + buf * 9216, lds + ATT_V + buf * 8704, qr, cini, O, l, r32, hi);
            } else {
            const bool fast = false;
            const LAS unsigned char* Kb = lds + ATT_K + buf * 9216;
            const LAS unsigned char* Vb = lds + ATT_V + buf * 8704;
            unsigned P[NMAP][2][8];
#pragma unroll
            for (int kh2 = 0; kh2 < 2; ++kh2) {
                f32x16 S[NMAP];
#pragma unroll
                for (int mp = 0; mp < NMAP; ++mp) { const float ini = fast ? c31 : 0.f;
#pragma unroll
                    for (int r = 0; r < 16; ++r) S[mp][r] = ini; }
#pragma unroll
                for (int c = 0; c < 4; ++c) {
                    const bf16x8 kf = *(const LAS bf16x8*)(Kb + (32 * kh2 + r32) * 144 + (16 * c + 8 * hi) * 2);
                    const int mp = (NMAP == 2) ? (c >> 1) : 0;
                    S[mp] = mfma32(kf, qr[c], S[mp]);
                }
#pragma unroll
                for (int mp = 0; mp < NMAP; ++mp) {
                    float p[16];
                    if (fast) {
#pragma unroll
                        for (int r = 0; r < 16; ++r) { const float e = ex2(S[mp][r]); p[r] = sel ? e : 0.f; }
                    } else {
#pragma unroll
                        for (int r = 0; r < 16; ++r) {
                            const int d = tq - (k0 + 32 * kh2 + crow(r, hi));
                            const bool valid = sel && d >= 0 && d < win;
                            const int dc = d < 0 ? 0 : (d > 128 ? 128 : d);
                            const float e = ex2(S[mp][r] + lut[dc]);
                            p[r] = valid ? e : 0.f;
                        }
                    }
                    float s = 0.f;
#pragma unroll
                    for (int r = 0; r < 16; ++r) s += p[r];
                    l[mp] += s;
#pragma unroll
                    for (int j = 0; j < 8; ++j) P[mp][kh2][j] = pk2(p[2 * j], p[2 * j + 1]);
                }
            }
#pragma unroll
            for (int db = 0; db < 2; ++db)
#pragma unroll
                for (int cc = 0; cc < 4; ++cc) {
                    const u32x2 a0 = *(const LAS u32x2*)(Vb + (32 * db + r32) * 136 + (16 * cc + 4 * hi) * 2);
                    const u32x2 a1 = *(const LAS u32x2*)(Vb + (32 * db + r32) * 136 + (16 * cc + 8 + 4 * hi) * 2);
                    const bf16x8 vf = as_bf16x8((u32x4){a0.x, a0.y, a1.x, a1.y});
#pragma unroll
                    for (int mp = 0; mp < NMAP; ++mp) {
                        const bf16x8 pf = as_bf16x8((u32x4){P[mp][cc >> 1][4 * (cc & 1)], P[mp][cc >> 1][4 * (cc & 1) + 1], P[mp][cc >> 1][4 * (cc & 1) + 2], P[mp][cc >> 1][4 * (cc & 1) + 3]});
                        O[mp][db] = mfma32(vf, pf, O[mp][db]);
                    }
                }
            }
        }
        buf ^= 1;
    }
    __syncthreads();
}
template <bool ADD>
__device__ __forceinline__ void store_ot(LAS unsigned char* stage, const float (&val)[2][16], bf16_t* dst, int ld, const bf16_t* addsrc = nullptr, int ldadd = 0) {
    const int lane = TID() & 63, r32 = lane & 31, hi = lane >> 5;
    LAS bf16_t* st = (LAS bf16_t*)stage;
#pragma unroll
    for (int db = 0; db < 2; ++db)
#pragma unroll
        for (int r = 0; r < 16; ++r) st[r32 * 72 + 32 * db + crow(r, hi)] = f2bf(val[db][r]);
    LDSW();
#pragma unroll
    for (int i = 0; i < 4; ++i) {
        const int row = i * 8 + (lane >> 3), ch = lane & 7;
        u32x4 v = *(const LAS u32x4*)(st + row * 72 + 8 * ch);
        bf16_t* gp = dst + (size_t)row * ld + 8 * ch;
        if (ADD) {
            const u32x4 o = *(const u32x4*)(addsrc + (size_t)row * ldadd + 8 * ch);
            v.x = pk2(bflo(v.x) + bflo(o.x), bfhi(v.x) + bfhi(o.x)); v.y = pk2(bflo(v.y) + bflo(o.y), bfhi(v.y) + bfhi(o.y));
            v.z = pk2(bflo(v.z) + bflo(o.z), bfhi(v.z) + bfhi(o.z)); v.w = pk2(bflo(v.w) + bflo(o.w), bfhi(v.w) + bfhi(o.w));
        }
        *(u32x4*)gp = v;
    }
    LDSW();
}

__device__ __forceinline__ void task_diff(const float* const* in, unsigned char* ws, int L, int task, LAS unsigned char* lds) {
    const int tid = TID(), lane = tid & 63, wave = tid >> 6, r32 = lane & 31, hi = lane >> 5;
    const int qb = 31 - (task >> 4), b = (task >> 2) & 3, hd = task & 3;
    const bf16_t* z = (const bf16_t*)(ws + WS_R1);
    LAS float* lut = (LAS float*)(lds + ATT_LUT);
    build_lut(lut, inp(I_RELB), 6 + hd);
    __syncthreads();
    const int q0 = 256 * qb, qw0 = q0 + 32 * wave, tq = qw0 + r32;
    bf16x8 qr[4];
#pragma unroll
    for (int c = 0; c < 4; ++c) qr[c] = *(const bf16x8*)(z + (size_t)(b * T + tq) * ZW + C_DQ + 64 * hd + 16 * c + 8 * hi);
    const bf16_t* Kth = z + (size_t)(b * T + (tid >> 3)) * ZW + C_DK + 64 * hd + (tid & 7) * 8;
    const bf16_t* Vth = (const bf16_t*)(ws + WS_VT) + ((size_t)(b * 8 + 4 + hd) * 64 + (tid >> 3)) * T + (tid & 7) * 8;
    f32x16 O[2][2] = {}; float l[2] = {0.f, 0.f};
    attn_pass<2, false>(lds, Kth, (size_t)64 * ZW, Vth, 0, 4 * qb + 3, qr, tq, qw0, 1 << 30, lut, (u32x4){0u, 0u, 0u, 0u}, O, l);
    const float* lp = inp(I_DLAM) + L * 128;
    float s01 = 0.f, s23 = 0.f;
#pragma unroll
    for (int i = 0; i < 32; ++i) { s01 += lp[i] * lp[32 + i]; s23 += lp[64 + i] * lp[96 + i]; }
    const float lam_init = 0.8f - 0.6f * __expf(-0.3f * (float)L);
    const float lam = __expf(s01) - __expf(s23) + lam_init;
    const float l0 = l[0] + __shfl_xor(l[0], 32), l1 = l[1] + __shfl_xor(l[1], 32);
    const float i0 = __builtin_amdgcn_rcpf(l0), i1 = lam * __builtin_amdgcn_rcpf(l1);
    float val[2][16]; float ss = 0.f;
#pragma unroll
    for (int db = 0; db < 2; ++db)
#pragma unroll
        for (int r = 0; r < 16; ++r) { const float o = O[0][db][r] * i0 - O[1][db][r] * i1; val[db][r] = o; ss += o * o; }
    ss += __shfl_xor(ss, 32);
    const float rn = rsqrtf(ss * (1.0f / 64.0f) + EPS) * (1.0f - lam_init);
    const float* sub = inp(I_DSUB) + L * 64;
#pragma unroll
    for (int db = 0; db < 2; ++db)
#pragma unroll
        for (int r = 0; r < 16; ++r) val[db][r] *= rn * sub[32 * db + crow(r, hi)];
    store_ot<false>(lds + ATT_STAGE + wave * 4608, val, (bf16_t*)(ws + WS_MIX) + (size_t)(b * T + qw0) * DM + 384 + 64 * hd, DM);
}

__device__ __forceinline__ void task_nsa_sw(const float* const* in, unsigned char* ws, int L, int task, LAS unsigned char* lds) {
    const int tid = TID(), lane = tid & 63, wave = tid >> 6, r32 = lane & 31, hi = lane >> 5;
    const int qb = 31 - task / 24, rem = task % 24, b = rem / 6, h = rem % 6, g = h / 3;
    const bf16_t* z = (const bf16_t*)(ws + WS_R1);
    LAS float* lut = (LAS float*)(lds + ATT_LUT);
    build_lut(lut, inp(I_RELB), h);
    __syncthreads();
    const int q0 = 256 * qb, qw0 = q0 + 32 * wave, tq = qw0 + r32;
    const bf16_t* zq = z + (size_t)(b * T + tq) * ZW;
    bf16x8 qr[4];
#pragma unroll
    for (int c = 0; c < 4; ++c) qr[c] = *(const bf16x8*)(zq + C_NQ + 64 * h + 16 * c + 8 * hi);
    const u32x4 selw = *(const u32x4*)((const unsigned*)(ws + WS_SELM) + ((size_t)(b * 2 + g) * T + tq) * 4);
    const float g1 = sigmoidf_(bf2f(zq[C_NG + 3 * h + 1])), g2 = sigmoidf_(bf2f(zq[C_NG + 3 * h + 2]));
    float val[2][16];
    {
        const bf16_t* Kth = z + (size_t)(b * T + (tid >> 3)) * ZW + C_SK + 64 * g + (tid & 7) * 8;
        const bf16_t* Vth = (const bf16_t*)(ws + WS_VT) + ((size_t)(b * 8 + g) * 64 + (tid >> 3)) * T + (tid & 7) * 8;
        f32x16 O[1][2] = {}; float l[1] = {0.f};
        attn_pass<1, true>(lds, Kth, (size_t)64 * ZW, Vth, 0, 4 * qb + 3, qr, tq, qw0, 1 << 30, lut, selw, O, l);
        const float lt = l[0] + __shfl_xor(l[0], 32), sc = g1 / lt;
#pragma unroll
        for (int db = 0; db < 2; ++db)
#pragma unroll
            for (int r = 0; r < 16; ++r) val[db][r] = O[0][db][r] * sc;
    }
    {
        const bf16_t* Kth = z + (size_t)(b * T + (tid >> 3)) * ZW + C_WK + 64 * g + (tid & 7) * 8;
        const bf16_t* Vth = (const bf16_t*)(ws + WS_VT) + ((size_t)(b * 8 + 2 + g) * 64 + (tid >> 3)) * T + (tid & 7) * 8;
        f32x16 O[1][2] = {}; float l[1] = {0.f};
        const int m_lo = q0 >= 512 ? (q0 >> 6) - 8 : 0;
        attn_pass<1, false>(lds, Kth, (size_t)64 * ZW, Vth, m_lo, 4 * qb + 3, qr, tq, qw0, 512, lut, (u32x4){0u, 0u, 0u, 0u}, O, l);
        const float lt = l[0] + __shfl_xor(l[0], 32), sc = g2 / lt;
#pragma unroll
        for (int db = 0; db < 2; ++db)
#pragma unroll
            for (int r = 0; r < 16; ++r) val[db][r] += O[0][db][r] * sc;
    }
    store_ot<true>(lds + ATT_STAGE + wave * 4608, val, (bf16_t*)(ws + WS_MIX) + (size_t)(b * T + qw0) * DM + 64 * h, DM, (const bf16_t*)(ws + WS_OCB) + (size_t)(b * T + qw0) * 384 + 64 * h, 384);
}

__device__ __forceinline__ unsigned wave_max_u32(unsigned v) {
    unsigned t;
    t = (unsigned)__builtin_amdgcn_update_dpp(0, (int)v, 0xB1, 0xF, 0xF, false); v = t > v ? t : v;
    t = (unsigned)__builtin_amdgcn_update_dpp(0, (int)v, 0x4E, 0xF, 0xF, false); v = t > v ? t : v;
    t = (unsigned)__builtin_amdgcn_update_dpp(0, (int)v, 0x141, 0xF, 0xF, false); v = t > v ? t : v;
    t = (unsigned)__builtin_amdgcn_update_dpp(0, (int)v, 0x140, 0xF, 0xF, false); v = t > v ? t : v;
    t = (unsigned)__builtin_amdgcn_update_dpp(0, (int)v, 0x142, 0xA, 0xF, false); v = t > v ? t : v;
    t = (unsigned)__builtin_amdgcn_update_dpp(0, (int)v, 0x143, 0xC, 0xF, false); v = t > v ? t : v;
    return (unsigned)__builtin_amdgcn_readlane((int)v, 63);
}
constexpr int NC_IMP = 18432, NC_IMPW = 129, NC_LINV = NC_IMP + 3 * 64 * NC_IMPW * 4;
__device__ __forceinline__ void task_nsa_c(const float* const* in, unsigned char* ws, int L, int task, LAS unsigned char* lds) {
    const int tid = TID(), lane = tid & 63, wave = tid >> 6, r32 = lane & 31, hi = lane >> 5;
    const int cur = 127 - (task >> 3), b = (task >> 1) & 3, g = task & 1;
    const bf16_t* z = (const bf16_t*)(ws + WS_R1);
    LAS float* imp = (LAS float*)(lds + NC_IMP);
    LAS float* linv = (LAS float*)(lds + NC_LINV);
    const int q0 = 64 * cur;
    const int rh = wave >> 1, half = wave & 1, h = 3 * g + (rh < 3 ? rh : 0);
    const int ql = 32 * half + r32, tq = q0 + ql;
    const bf16_t* zq = z + (size_t)(b * T + tq) * ZW;
    bf16x8 qr[4];
#pragma unroll
    for (int c = 0; c < 4; ++c) qr[c] = *(const bf16x8*)(zq + C_NQ + 64 * h + 16 * c + 8 * hi);
    const bf16_t* Kth = (const bf16_t*)(ws + WS_KC) + ((size_t)(b * 2 + g) * 512 + (tid >> 3)) * 64 + (tid & 7) * 8;
    const bf16_t* Vth = (const bf16_t*)(ws + WS_VCT) + ((size_t)(b * 2 + g) * 64 + (tid >> 3)) * 512 + (tid & 7) * 8;
    const int ntiles = ((4 * cur + 2) >> 6) + 1;
    f32x16 O[2] = {}; float l = 0.f, carry = 0.f;
    u32x4 kreg = *(const u32x4*)(Kth), vreg = *(const u32x4*)(Vth);
    for (int m = 0; m < ntiles; ++m) {
        __syncthreads();
        *(LAS u32x4*)(lds + (tid >> 3) * 144 + (tid & 7) * 16) = kreg;
        { LAS u32x2* vp = (LAS u32x2*)(lds + 9216 + (tid >> 3) * 136 + (tid & 7) * 16); vp[0] = (u32x2){vreg.x, vreg.y}; vp[1] = (u32x2){vreg.z, vreg.w}; }
        __syncthreads();
        if (m + 1 < ntiles) { kreg = *(const u32x4*)(Kth + (size_t)(m + 1) * 64 * 64); vreg = *(const u32x4*)(Vth + (size_t)(m + 1) * 64); }
        if (wave < 6) {
            unsigned P[2][8]; float av[8], bq[8];
#pragma unroll
            for (int kh2 = 0; kh2 < 2; ++kh2) {
                f32x16 S = {};
#pragma unroll
                for (int c = 0; c < 4; ++c) { const bf16x8 kf = *(const LAS bf16x8*)(lds + (32 * kh2 + r32) * 144 + (16 * c + 8 * hi) * 2); S = mfma32(kf, qr[c], S); }
                float p[16];
#pragma unroll
                for (int r = 0; r < 16; ++r) { const int n = 64 * m + 32 * kh2 + crow(r, hi); const float e = ex2(S[r]); p[r] = (16 * n + 31 <= tq) ? e : 0.f; }
                float s = 0.f;
#pragma unroll
                for (int r = 0; r < 16; ++r) s += p[r];
                l += s;
#pragma unroll
                for (int j = 0; j < 8; ++j) P[kh2][j] = pk2(p[2 * j], p[2 * j + 1]);
#pragma unroll
                for (int j = 0; j < 4; ++j) { av[4 * kh2 + j] = p[4 * j] + p[4 * j + 1] + p[4 * j + 2] + 0.5f * p[4 * j + 3]; bq[4 * kh2 + j] = 0.5f * p[4 * j + 3]; }
            }
#pragma unroll
            for (int db = 0; db < 2; ++db)
#pragma unroll
                for (int cc = 0; cc < 4; ++cc) {
                    const u32x2 a0 = *(const LAS u32x2*)(lds + 9216 + (32 * db + r32) * 136 + (16 * cc + 4 * hi) * 2);
                    const u32x2 a1 = *(const LAS u32x2*)(lds + 9216 + (32 * db + r32) * 136 + (16 * cc + 8 + 4 * hi) * 2);
                    const bf16x8 vf = as_bf16x8((u32x4){a0.x, a0.y, a1.x, a1.y});
                    const bf16x8 pf = as_bf16x8((u32x4){P[cc >> 1][4 * (cc & 1)], P[cc >> 1][4 * (cc & 1) + 1], P[cc >> 1][4 * (cc & 1) + 2], P[cc >> 1][4 * (cc & 1) + 3]});
                    O[db] = mfma32(vf, pf, O[db]);
                }
            float recv[8];
#pragma unroll
            for (int jj = 0; jj < 8; ++jj) { auto rr = __builtin_amdgcn_permlane32_swap(__float_as_uint(bq[jj]), __float_as_uint(bq[jj]), false, false); recv[jj] = __uint_as_float(hi ? rr[0] : rr[1]); }
            LAS float* ip = imp + (rh * 64 + ql) * NC_IMPW + 16 * m + hi;
#pragma unroll
            for (int jj = 0; jj < 8; ++jj) {
                const float add = hi ? recv[jj] : (jj == 0 ? carry : recv[jj > 0 ? jj - 1 : 0]);
                ip[2 * jj] = av[jj] + add;
            }
            carry = recv[7];
        }
    }
    if (wave < 6) {
        const float lt = l + __shfl_xor(l, 32);
        const float li = (tq >= 31 && lt > 0.f) ? 1.0f / lt : 0.f;
        if (hi == 0) linv[rh * 64 + ql] = li;
        const float g0 = sigmoidf_(bf2f(zq[C_NG + 3 * h + 0]));
        bf16_t* mx = (bf16_t*)(ws + WS_OCB) + (size_t)(b * T + tq) * 384 + 64 * h;
        const float sc = li * g0;
#pragma unroll
        for (int db = 0; db < 2; ++db)
#pragma unroll
            for (int r = 0; r < 16; ++r) mx[32 * db + crow(r, hi)] = f2bf(O[db][r] * sc);
    }
    __syncthreads();
#pragma unroll 1
    for (int qi = 0; qi < 8; ++qi) {
        const int q = 8 * wave + qi;
        unsigned w0 = 0u, w1 = 0u, w2 = 0u, w3 = 0u;
        if (cur <= 15) { w0 = (1u << (cur + 1)) - 1u; }
        else {
            const float i0 = linv[q], i1 = linv[64 + q], i2 = linv[128 + q];
            const int ma = lane, mb = lane + 64;
            float va = 0.f, vb = 0.f;
            if (ma >= 1 && ma <= cur - 2) va = imp[(0 * 64 + q) * NC_IMPW + ma] * i0 + imp[(1 * 64 + q) * NC_IMPW + ma] * i1 + imp[(2 * 64 + q) * NC_IMPW + ma] * i2;
            if (mb <= cur - 2) vb = imp[(0 * 64 + q) * NC_IMPW + mb] * i0 + imp[(1 * 64 + q) * NC_IMPW + mb] * i1 + imp[(2 * 64 + q) * NC_IMPW + mb] * i2;
            unsigned ka = va > 0.f ? ((__float_as_uint(va) & ~127u) | (unsigned)(127 - ma)) : 0u;
            unsigned kb = vb > 0.f ? ((__float_as_uint(vb) & ~127u) | (unsigned)(127 - mb)) : 0u;
            w0 = 1u;
#pragma unroll 1
            for (int it = 0; it < 13; ++it) {
                const unsigned best = wave_max_u32(ka > kb ? ka : kb);
                if (best != 0u) {
                    const int mw = 127 - (int)(best & 127u);
                    const unsigned bit = 1u << (mw & 31);
                    if (mw < 32) w0 |= bit; else if (mw < 64) w1 |= bit; else if (mw < 96) w2 |= bit; else w3 |= bit;
                    if (ka == best) ka = 0u;
                    if (kb == best) kb = 0u;
                }
            }
#pragma unroll
            for (int f = 0; f < 2; ++f) {
                const int mw = cur - f; const unsigned bit = 1u << (mw & 31);
                if (mw < 32) w0 |= bit; else if (mw < 64) w1 |= bit; else if (mw < 96) w2 |= bit; else w3 |= bit;
            }
        }
        if (lane == 0) *(u32x4*)((unsigned*)(ws + WS_SELM) + ((size_t)(b * 2 + g) * T + q0 + q) * 4) = (u32x4){w0, w1, w2, w3};
    }
}

#define XB_TMO      128
#define XB_XCNT(j)  (256  + 64 * (j))
#define XB_XSUB(j)  (1280 + 64 * (j))
#define XB_XGEN(j)  (2304 + 64 * (j))
#define XB_TOP      3328
#define XB_TOPGEN   3392
#define XCD_BAR_WORDS 3456
#define XB_SPIN_CAP (1u << 18)

__device__ __forceinline__ unsigned xb_ld(unsigned* p)              { return __hip_atomic_load(p, __ATOMIC_RELAXED, __HIP_MEMORY_SCOPE_AGENT); }
__device__ __forceinline__ unsigned xb_add(unsigned* p, unsigned v) { return __hip_atomic_fetch_add(p, v, __ATOMIC_RELAXED, __HIP_MEMORY_SCOPE_AGENT); }
__device__ __forceinline__ unsigned xb_xcc_id() { return (unsigned)__builtin_amdgcn_s_getreg((3 << 11) | 20) & 0xFu; }
#define XB_SPIN(cond, bar) do { unsigned _sp = 0; while (cond) { __builtin_amdgcn_s_sleep(1); \
    if ((++_sp & 255u) == 0u) { if (xb_ld(&(bar)[XB_TMO])) break; if (_sp > XB_SPIN_CAP) { atomicAdd(&(bar)[XB_TMO], 1u); break; } } } } while (0)

struct XcdBarrier {
    unsigned* bar; unsigned x;
    volatile LAS unsigned* st;
};

__device__ __forceinline__ XcdBarrier xcd_barrier_post(unsigned* bar, volatile LAS unsigned* st) {
    XcdBarrier b; b.bar = bar; b.x = xb_xcc_id(); b.st = st;
    if (threadIdx.x == 0) (void)xb_add(&bar[XB_XCNT(b.x)], 1u);
    return b;
}
__device__ __forceinline__ void xcd_barrier_complete(unsigned* bar, unsigned x, unsigned& nloc, unsigned& nx) {
    const unsigned G = gridDim.x * gridDim.y * gridDim.z;
    unsigned sum, cnt, mine, sp = 0u;
    for (;;) {
        sum = 0u; cnt = 0u; mine = 0u;
#pragma unroll
        for (unsigned j = 0; j < 16; ++j) { const unsigned c = xb_ld(&bar[XB_XCNT(j)]); sum += c; cnt += (c > 0u) ? 1u : 0u; mine = (j == x) ? c : mine; }
        if (sum == G) break;
        __builtin_amdgcn_s_sleep(1);
        if ((++sp & 255u) == 0u) { if (xb_ld(&bar[XB_TMO])) break; if (sp > XB_SPIN_CAP) { atomicAdd(&bar[XB_TMO], 1u); break; } }
    }
    nloc = mine > 0u ? mine : 1u; nx = cnt > 0u ? cnt : 1u;
}

__device__ __forceinline__ void xcd_barrier(const XcdBarrier& b) {
    asm volatile("s_waitcnt vmcnt(0)" ::: "memory");
    __syncthreads();
    if (threadIdx.x == 0) {
        unsigned* bar = b.bar;
        __builtin_amdgcn_s_waitcnt(0);
        unsigned nloc = b.st[0], nx = b.st[1];
        if (nloc == 0u) { xcd_barrier_complete(bar, b.x, nloc, nx); b.st[0] = nloc; b.st[1] = nx; }
        const unsigned old = xb_add(&bar[XB_XSUB(b.x)], 1u);
        const unsigned gen = old / nloc;
        if (old + 1u == (gen + 1u) * nloc) {
            __builtin_amdgcn_fence(__ATOMIC_RELEASE, "agent");
            asm volatile("s_waitcnt vmcnt(0)" ::: "memory");
            const unsigned og = xb_add(&bar[XB_TOP], 1u);
            const unsigned tg = og / nx;
            if (og + 1u == (tg + 1u) * nx) xb_add(&bar[XB_TOPGEN], 1u);
            else XB_SPIN(xb_ld(&bar[XB_TOPGEN]) == tg, bar);
            __builtin_amdgcn_fence(__ATOMIC_ACQUIRE, "agent");
            xb_add(&bar[XB_XGEN(b.x)], 1u);
            asm volatile("s_waitcnt vmcnt(0)" ::: "memory");
        } else {
            XB_SPIN(xb_ld(&bar[XB_XGEN(b.x)]) == gen, bar);
            __builtin_amdgcn_fence(__ATOMIC_ACQUIRE, "agent");
            asm volatile("s_waitcnt vmcnt(0)" ::: "memory");
        }
    }
    __syncthreads();
}

struct Args { const float* in[N_IN]; float* out; unsigned char* ws; int ph_lo, ph_hi; };
static_assert(sizeof(Args) == 8 * N_IN + 24, "Args has no padding");
constexpr int PH_PER_LAYER = 12, N_PHASES = DEPTH * PH_PER_LAYER;
#ifndef PH_HI
#ifdef REPJ
#define PH_HI (N_PHASES + DEPTH)
#else
#define PH_HI N_PHASES
#endif
#endif

__global__ void __launch_bounds__(512) mega(Args a) {
    extern __shared__ __attribute__((aligned(16))) unsigned char lds_raw[];
    LAS unsigned char* lds = (LAS unsigned char*)lds_raw;
    LAS int* slot = (LAS int*)(lds + LDS_MISC);
    cg::grid_group grid = cg::this_grid();
    const float* const* in = nullptr;
    volatile LAS unsigned* misc = (volatile LAS unsigned*)(lds + LDS_MISC);
    if (TID() < 16) misc[TID()] = 0u;
    __syncthreads();
    (void)xcd_barrier_post((unsigned*)(a.ws + WS_CTL) + 4096, misc + 8);
#ifndef DUP_GU
#define DUP_GU 0
#endif
#ifndef DUP_IN
#define DUP_IN 0
#endif
#ifndef DUP_DIFF
#define DUP_DIFF 0
#endif
#ifndef DUP_NSAC
#define DUP_NSAC 0
#endif
#ifndef DUP_SW
#define DUP_SW 0
#endif
#ifndef DUP_HOUT
#define DUP_HOUT 0
#endif
#ifndef DUP_M1
#define DUP_M1 0
#endif
#ifndef DUP_SYNC
#define DUP_SYNC 0
#endif
#ifndef DUP_CONV
#define DUP_CONV 0
#endif
#ifndef PHM
#define PHM 0xfff
#endif
#define TASK_LOOP(ctr, ntasks, BODY) { int t = next_task(ctr, slot); while (t < (ntasks)) { int nxt_ = 0; if (TID() == 0) nxt_ = (int)atomicAdd(ctr, 1u); \
        { BODY } __syncthreads(); if (TID() == 0) *slot = nxt_; __syncthreads(); t = *slot; } }
    for (int ph = a.ph_lo; ph < a.ph_hi; ++ph) {
#ifdef REPJ
        int L = ph / (PH_PER_LAYER + 1); const int k_ = ph - L * (PH_PER_LAYER + 1); const int j = k_ <= REPJ ? k_ : k_ - 1; const float amul = (k_ == REPJ) ? 0.f : 1.f;
#else
        int L = ph / PH_PER_LAYER; const int j = ph - L * PH_PER_LAYER; const float amul = 1.f;
#endif
        asm volatile("" : "+s"(L));
        unsigned long long ws_ = (unsigned long long)a.ws; asm volatile("" : "+s"(ws_)); unsigned char* ws = (unsigned char*)(GAS unsigned char*)ws_;
        unsigned long long out_ = (unsigned long long)a.out; asm volatile("" : "+s"(out_)); float* out_g = (float*)(GAS float*)out_;
        unsigned* ctl = (unsigned*)(ws + WS_CTL); bf16_t* r1 = (bf16_t*)(ws + WS_R1); bf16_t* mixed = (bf16_t*)(ws + WS_MIX); bf16_t* pb = (bf16_t*)(ws + WS_PB); unsigned char* wb = ws + WS_W; float* rsqp = (float*)(ws + WS_RSQP);
        float* rsq = (float*)(ws + ((L & 1) ? WS_RSQ1 : WS_RSQ0)); float* rsq_next = (float*)(ws + ((L & 1) ? WS_RSQ0 : WS_RSQ1));
        bf16_t* xb = (bf16_t*)(ws + WS_XB); unsigned char* xlo = ws + WS_XB1; bf16_t* xb1 = (L == 0) ? xb : mixed;
        if (j == 0 && L > 0) continue;
        if ((PHM >> j) & 1) switch (j) {
        case 0: phase_convert(in, ws, out_g, L, lds); break;
        case 1: { EpiSwiGLU E{r1, {}}; run_gemm(lds, xb1, (const bf16_t*)(wb + W_GU1), 2 * FF, DM, E, rsq); } break;
        case 2: { EpiRes<0> E{nullptr, xb, rsq, 0.5f * amul, nullptr, nullptr, nullptr, nullptr, nullptr, {}, xb1, xlo}; run_gemm(lds, r1, (const bf16_t*)(wb + W_D1), DM, FF, E, nullptr, nullptr, false); } break;
        case 3: { EpiZ E{r1, {}}; run_gemm(lds, xb, (const bf16_t*)(wb + W_IN), ZW, DM, E, rsq); } break;
        case 4: {
            unsigned* ctr = ctl + (L * 4 + 0) * 64;
            constexpr int NCMP = 512 << DUP_M1, NHL = 384 << DUP_M1;
            for (;;) { const int t = next_task(ctr, slot); if (t >= NCMP + NHL + 512) break;
                if (t < NCMP) task_compress(in, ws, L, t >> DUP_M1, lds); else if (t < NCMP + NHL) task_hgrn_local(in, ws, L, (t - NCMP) >> DUP_M1, lds); else task_prep(in, ws, L, t - NCMP - NHL, lds); }
        } break;
        case 5: {
            unsigned* ctr = ctl + (L * 4 + 1) * 64;
            constexpr int ND = 512 << DUP_DIFF, NC = 1024 << DUP_NSAC, NCV = 256;
            for (;;) { const int t = next_task(ctr, slot); if (t >= 192 + ND + NCV + NC) break;
                if (t < 192) task_hgrn_scan(ws, t);
                else if (t < 192 + ND + NCV) { const int u = t - 192;
                    if (u < 3 * NCV) { const int grp = u / 3, r = u - 3 * grp; if (r == 2) task_conv(ws, L, grp, lds); else task_diff(in, ws, L, (2 * grp + r) >> DUP_DIFF, lds); }
                    else task_diff(in, ws, L, (u - NCV) >> DUP_DIFF, lds); }
                else task_nsa_c(in, ws, L, (t - 192 - ND - NCV) >> DUP_NSAC, lds); }
        } break;
        case 6: {
            unsigned* ctr = ctl + (L * 4 + 2) * 64;
            constexpr int NS = 768 << DUP_SW, NH = 768 << DUP_HOUT;
            for (;;) { const int t = next_task(ctr, slot); if (t >= NS + NH) break;
                if (t < NS) task_nsa_sw(in, ws, L, t >> DUP_SW, lds); else task_hgrn_out(in, ws, L, (t - NS) >> DUP_HOUT, lds); }
        } break;
#ifdef EXTRA7
        case 7: if (amul == 0.f) { EpiZT<DM> E{(bf16_t*)(ws + WS_VT), {}}; run_gemm(lds, mixed, (const bf16_t*)(wb + W_OUT), DM, DM, E, rsq); }
                else { EpiRes<0> E{nullptr, xb, rsq, 1.0f * amul, nullptr, nullptr, nullptr, nullptr, nullptr, {}, xb, xlo}; run_gemm(lds, mixed, (const bf16_t*)(wb + W_OUT), DM, DM, E, nullptr, nullptr, false); } break;
#else
        case 7: { EpiRes<0> E{nullptr, xb, rsq, 1.0f * amul, nullptr, nullptr, nullptr, nullptr, nullptr, {}, xb, xlo}; run_gemm(lds, mixed, (const bf16_t*)(wb + W_OUT), DM, DM, E, nullptr, nullptr, false); } break;
#endif
        case 8: { EpiSwiGLU E{r1, {}}; run_gemm(lds, xb, (const bf16_t*)(wb + W_GU2), 2 * FF, DM, E, rsq); } break;
        case 9: { EpiRes<2> E{nullptr, nullptr, rsqp, 0.f, nullptr, nullptr, nullptr, nullptr, mixed, {}, nullptr, nullptr}; run_gemm(lds, pb, (const bf16_t*)(wb + W_PP), DM, PLE, E); } break;
        case 10: { EpiRes<0> E{nullptr, xb, rsq, 0.5f * amul, nullptr, nullptr, nullptr, nullptr, nullptr, {}, xb, xlo}; run_gemm(lds, r1, (const bf16_t*)(wb + W_D2), DM, FF, E, nullptr, nullptr, false); } break;
        default: { EpiRes<1> E{(L == DEPTH - 1) ? out_g : nullptr, mixed, rsq_next, 0.f, rsq, mixed, rsqp, inp(I_PLPOST) + L * DM, nullptr, {}, xb, xlo}; run_gemm(lds, xb, (const bf16_t*)(wb + W_PG), DM, DM, E, rsq, rsqp, false); } break;
        }
        if (ph + 1 < a.ph_hi) {
            if (ph == 0) { asm volatile("s_waitcnt vmcnt(0) lgkmcnt(0)" ::: "memory"); grid.sync(); __builtin_amdgcn_fence(__ATOMIC_ACQUIRE, "agent"); asm volatile("s_waitcnt vmcnt(0)" ::: "memory"); __syncthreads(); }
            else { XcdBarrier xb_; xb_.bar = (unsigned*)(ws + WS_CTL) + 4096; xb_.x = xb_xcc_id(); xb_.st = misc + 8; xcd_barrier(xb_); if (DUP_SYNC) xcd_barrier(xb_); }
        }
    }
}

#ifdef DUMPK
__global__ void __launch_bounds__(512) dump_kernel(float* out, unsigned char* ws) {
    bf16_t* mixed = (bf16_t*)(ws + WS_MIX); (void)mixed;
    for (size_t idx = (size_t)blockIdx.x * 512 + threadIdx.x; idx < (size_t)M * 1024; idx += (size_t)gridDim.x * 512) {
        const size_t m = idx >> 10; const int c = (int)(idx & 1023);
        float v = 0.f;
#if DUMPK == 3 || DUMPK == 40
        { const bf16_t* z = (const bf16_t*)(ws + WS_R1); v = bf2f(z[m * ZW + c]) + bf2f(z[m * ZW + 1024 + c]) + bf2f(z[m * ZW + 2048 + c]) + (c < 402 ? bf2f(z[m * ZW + 3072 + c]) : 0.f); }
#elif DUMPK == 41
        { const bf16_t* vt = (const bf16_t*)(ws + WS_VT); v = bf2f(vt[m * 512 + (c & 511)]); }
#elif DUMPK == 42
        { const float* hs = (const float*)(ws + WS_HS); const float* hd = (const float*)(ws + WS_HD); v = hs[m * 384 + (c % 384)] + hd[m * 6 + (c % 6)]; }
#elif DUMPK == 43
        { const bf16_t* kc = (const bf16_t*)(ws + WS_KC); const bf16_t* vct = (const bf16_t*)(ws + WS_VCT); v = bf2f(kc[m * 8 + (c & 7)]) + bf2f(vct[m * 8 + (c & 7)]); }
#elif DUMPK == 50 || DUMPK == 60
        v = (c < 384) ? bf2f(mixed[m * 1024 + c]) : 0.f;
#elif DUMPK == 51
        v = (c >= 384 && c < 640) ? bf2f(mixed[m * 1024 + c]) : 0.f;
#elif DUMPK == 52
        { const unsigned* selm = (const unsigned*)(ws + WS_SELM); v = (float)(selm[m * 8 + (c & 7)] & 0xffffu) + (float)(selm[m * 8 + (c & 7)] >> 16); }
#elif DUMPK == 53
        { const float* hs = (const float*)(ws + WS_HS); v = hs[m * 384 + (c % 384)]; }
#elif DUMPK == 61
        v = (c >= 640) ? bf2f(mixed[m * 1024 + c]) : 0.f;
#endif
        out[idx] = v;
    }
}
#endif

extern "C" void kernel_launch(void* const* d_in, const int* in_sizes, int n_in, void* d_out, int out_size, void* d_ws, size_t ws_size, hipStream_t stream) {
    static int grid = 0;
    if (grid == 0) {
        if (n_in != N_IN || out_size != M * DM || ws_size < WS_END) { fprintf(stderr, "kernel_launch: unexpected shapes (n_in %d out %d ws %zu)\n", n_in, out_size, ws_size); grid = -1; return; }
        int dev = 0, cus = 0, per_cu = 0;
        hipGetDevice(&dev); hipDeviceGetAttribute(&cus, hipDeviceAttributeMultiprocessorCount, dev);
        if (hipFuncSetAttribute((const void*)mega, hipFuncAttributeMaxDynamicSharedMemorySize, LDS_BYTES) != hipSuccess) { fprintf(stderr, "hipFuncSetAttribute failed\n"); }
        if (hipOccupancyMaxActiveBlocksPerMultiprocessor(&per_cu, (const void*)mega, 512, LDS_BYTES) != hipSuccess || per_cu < 1) { fprintf(stderr, "occupancy query: %d\n", per_cu); per_cu = 1; }
        (void)hipGetLastError();
        grid = cus;
    }
    if (grid < 0) return;
    hipMemsetAsync((char*)d_ws + WS_CTL, 0, 64 * 1024, stream);
    Args a{};
    for (int i = 0; i < N_IN; ++i) a.in[i] = (const float*)d_in[i];
    a.out = (float*)d_out; a.ws = (unsigned char*)d_ws; a.ph_lo = 0; a.ph_hi = PH_HI;
    void* args[] = {&a};
    hipError_t e = hipLaunchCooperativeKernel((const void*)mega, dim3(grid), dim3(512), args, LDS_BYTES, stream);
    if (e != hipSuccess) fprintf(stderr, "cooperative launch failed: %s (grid %d)\n", hipGetErrorString(e), grid);
#ifdef DUMPK
    dump_kernel<<<dim3(1024), dim3(512), 0, stream>>>((float*)d_out, (unsigned char*)d_ws);
#endif
}
```

```cpp
#include <hip/hip_runtime.h>
#include <hip/hip_cooperative_groups.h>
#include <cstdio>
#include <cstdint>
namespace cg = cooperative_groups;
__device__ __forceinline__ int TID() { int t = threadIdx.x; asm volatile("" : "+v"(t)); return t; }
typedef float f32x4_z __attribute__((ext_vector_type(4)));
__device__ __forceinline__ f32x4_z zero4_() { float z = 0.f; asm volatile("" : "+v"(z)); return (f32x4_z){z, z, z, z}; }
namespace pg8 {
#define PG8_LAS __attribute__((address_space(3)))
typedef unsigned short bf16_t;
typedef short bf16x8 __attribute__((ext_vector_type(8)));
typedef float f32x4 __attribute__((ext_vector_type(4)));
typedef unsigned u32x4 __attribute__((ext_vector_type(4)));
constexpr int BM = 256, BK = 64, HALF = 128, HTB = HALF * BK * 2  , STAGE_BYTES = 8 * HTB, NXCD = 8, WGM = 8;

__host__ __device__ __forceinline__ int lds_byte(int r, int c) { const int st = (r >> 4) * 2 + (c >> 5), rr = r & 15, cc = c & 31, ob = rr * 64 + cc * 2; return st * 1024 + (ob ^ (((ob >> 9) & 1) << 5)); }
__host__ __device__ __forceinline__ void stage_rc(int b, int& R, int& C) { const int st = b / 1024, sb = b % 1024, swz = sb ^ (((sb >> 9) & 1) << 5); R = (st >> 1) * 16 + swz / 64; C = (st & 1) * 32 + (swz % 64) / 2; }
__host__ __device__ __forceinline__ int perm32(int rho) { const int n = rho >> 4, i = rho & 15; return 8 * (i >> 2) + 4 * n + (i & 3); }

struct Unit { int pm, pn; };
struct Gemm { const bf16_t* A; const bf16_t* Bt; int M, N, K; };

struct StaticOrder {
    int nM, nN, nwg, G, c;
    __host__ __device__ void init(int M, int N, int G_, int c_) { nM = M / BM; nN = N / BM; nwg = nM * nN; G = G_; c = c_; }
    __host__ __device__ bool next(int i, Unit& u) const {
        const long L = (long)i * G + c; if (L >= nwg) return false;
        int wgid = (int)L; { const int q = nwg / NXCD, r = nwg % NXCD, xcd = wgid % NXCD, off = wgid / NXCD; wgid = (xcd < r ? xcd * (q + 1) : r * (q + 1) + (xcd - r) * q) + off; }
        const int nig = WGM * nN, gid = wgid / nig, fm = gid * WGM, gsz = (nM - fm) < WGM ? (nM - fm) : WGM;
        u.pm = fm + ((wgid % nig) % gsz); u.pn = (wgid % nig) / gsz; return true;
    }
    __device__ __forceinline__ void a_ready(const Unit&) const {}
    __device__ __forceinline__ void done(const Unit&) const {}
};

template <class Epi, class Sched, bool ALIGN_EPI = false, bool SP2 = false>
__device__ __forceinline__ void gemm_phase(PG8_LAS unsigned char* lds, const Gemm g, const Sched& S, const Epi& E) {
    const int tid = TID(), wid = __builtin_amdgcn_readfirstlane(tid >> 6), lane = tid & 63, wr = wid >> 2, wc = wid & 3, fr = lane & 15, fq = lane >> 4;
    const int K = g.K, nt = K / BK;
    unsigned voffA[2], voffB[2];
#pragma unroll
    for (int i = 0; i < 2; ++i) { int R, C; stage_rc(tid * 16 + i * 8192, R, C); const int Rb = Epi::PERM ? ((R & ~31) + perm32(R & 31)) : R;
        voffA[i] = (unsigned)(R * K + C) * 2u; voffB[i] = (unsigned)(Rb * K + C) * 2u; }
    const size_t kstep = (size_t)(BK * 2);
    const size_t hstep = (size_t)HALF * K * 2;
    const size_t tstep = 2 * hstep;
    const unsigned ldsw = (unsigned)wid * 1024u;
    const int aoff = lds_byte(wr * 64 + fr, fq * 8), boff = lds_byte(wc * 32 + fr, fq * 8);
#define PG8_SA(b, h) (((b) * 2 + (h)) * HTB)
#define PG8_SB(b, h) ((4 + (b) * 2 + (h)) * HTB)
#define PG8_STAGE(bufoff, gbase, voff) do { _Pragma("unroll") for (int _i = 0; _i < 2; ++_i) \
        __builtin_amdgcn_global_load_lds((const unsigned*)((const char*)(gbase) + (voff)[_i]), (PG8_LAS unsigned*)(lds + (bufoff) + ldsw + _i * 8192), 16, 0, 0); } while (0)
#define PG8_LDA(dst, b, h) do { _Pragma("unroll") for (int m = 0; m < 4; ++m) _Pragma("unroll") for (int k = 0; k < 2; ++k) dst[m][k] = *(const PG8_LAS bf16x8*)(lds + PG8_SA(b, h) + aoff + m * 2048 + k * 1024); } while (0)
#define PG8_LDB(dst, b, h) do { _Pragma("unroll") for (int n = 0; n < 2; ++n) _Pragma("unroll") for (int k = 0; k < 2; ++k) dst[n][k] = *(const PG8_LAS bf16x8*)(lds + PG8_SB(b, h) + boff + n * 2048 + k * 1024); } while (0)
#define PG8_MMA(ai, bj, At, Bt) do { __builtin_amdgcn_s_setprio(1); _Pragma("unroll") for (int m = 0; m < 4; ++m) _Pragma("unroll") for (int n = 0; n < 2; ++n) _Pragma("unroll") for (int k = 0; k < 2; ++k) \
        acc[ai][bj][m][n] = __builtin_amdgcn_mfma_f32_16x16x32_bf16(Bt[n][k], At[m][k], acc[ai][bj][m][n], 0, 0, 0); __builtin_amdgcn_s_setprio(0); } while (0)
#define PG8_WAIT_V(n) asm volatile("s_waitcnt vmcnt(" #n ")" ::: "memory")
#define PG8_WAIT_L(n) asm volatile("s_waitcnt lgkmcnt(" #n ")" ::: "memory")
#define PG8_BAR __builtin_amdgcn_s_barrier()
#define PG8_SCHED __builtin_amdgcn_sched_barrier(0)
    Unit cur, nxt; int ui = 0;
    if (!S.next(0, cur)) return;
    f32x4 acc[2][2][4][2];
#pragma unroll
    for (int a = 0; a < 2; ++a)
#pragma unroll
        for (int b = 0; b < 2; ++b)
#pragma unroll
            for (int m = 0; m < 4; ++m)
#pragma unroll
                for (int n = 0; n < 2; ++n) acc[a][b][m][n] = zero4_();
    bf16x8 At[4][2], B0[2][2], B1[2][2];
    const char* cA = (const char*)g.A + (size_t)cur.pm * tstep; const char* cB = (const char*)g.Bt + (size_t)cur.pn * tstep;
    S.a_ready(cur);
    if constexpr (SP2) {
        PG8_STAGE(PG8_SB(0, 0), cB, voffB); PG8_STAGE(PG8_SB(0, 1), cB + hstep, voffB); PG8_STAGE(PG8_SA(0, 0), cA, voffA); PG8_STAGE(PG8_SA(0, 1), cA + hstep, voffA);
        if (wr == 1) PG8_BAR;
        PG8_WAIT_V(2); PG8_BAR;
        PG8_STAGE(PG8_SB(1, 0), cB + kstep, voffB); PG8_STAGE(PG8_SA(1, 0), cA + kstep, voffA); PG8_STAGE(PG8_SB(1, 1), cB + hstep + kstep, voffB);
        PG8_WAIT_V(6); PG8_BAR;
    } else {
        PG8_STAGE(PG8_SB(0, 0), cB, voffB); PG8_STAGE(PG8_SA(0, 0), cA, voffA); PG8_STAGE(PG8_SB(0, 1), cB + hstep, voffB); PG8_STAGE(PG8_SA(0, 1), cA + hstep, voffA);
        if (wr == 1) PG8_BAR;
        PG8_WAIT_V(4); PG8_BAR;
        PG8_STAGE(PG8_SB(1, 0), cB + kstep, voffB); PG8_STAGE(PG8_SA(1, 0), cA + kstep, voffA); PG8_STAGE(PG8_SB(1, 1), cB + hstep + kstep, voffB);
        PG8_WAIT_V(6); PG8_BAR;
    }
    for (;;) {
        const bool has_next = S.next(ui + 1, nxt);
        const char* nA = has_next ? (const char*)g.A + (size_t)nxt.pm * tstep : cA; const char* nB = has_next ? (const char*)g.Bt + (size_t)nxt.pn * tstep : cB;
        for (int t = 0; t < nt; t += 2) {
            const bool last = (t == nt - 2);
            const char* a1 = cA + (size_t)(t + 1) * kstep;
            const char* a2 = last ? nA : cA + (size_t)(t + 2) * kstep; const char* b2 = last ? nB : cB + (size_t)(t + 2) * kstep;
            const char* a3 = a2 + kstep; const char* b3 = b2 + kstep;
            if (last && has_next) S.a_ready(nxt);
            if constexpr (SP2) {
            PG8_LDB(B0, 0, 0); PG8_LDB(B1, 0, 1); PG8_SCHED; PG8_LDA(At, 0, 0); PG8_STAGE(PG8_SA(1, 1), a1 + hstep, voffA);
            PG8_WAIT_V(8); PG8_WAIT_L(0); PG8_BAR; PG8_MMA(0, 0, At, B0); PG8_MMA(0, 1, At, B1); PG8_BAR; PG8_SCHED;
            PG8_LDA(At, 0, 1); PG8_STAGE(PG8_SB(0, 0), b2, voffB); PG8_STAGE(PG8_SB(0, 1), b2 + hstep, voffB); PG8_STAGE(PG8_SA(0, 0), a2, voffA);
            PG8_WAIT_V(8); PG8_WAIT_L(0); PG8_BAR; PG8_MMA(1, 0, At, B0); PG8_MMA(1, 1, At, B1); PG8_BAR; PG8_SCHED;
            PG8_LDB(B0, 1, 0); PG8_LDB(B1, 1, 1); PG8_SCHED; PG8_LDA(At, 1, 0); PG8_STAGE(PG8_SA(0, 1), a2 + hstep, voffA);
            PG8_WAIT_V(8); PG8_WAIT_L(0); PG8_BAR; PG8_MMA(0, 0, At, B0); PG8_MMA(0, 1, At, B1); PG8_BAR; PG8_SCHED;
            PG8_LDA(At, 1, 1); PG8_STAGE(PG8_SB(1, 0), b3, voffB); PG8_STAGE(PG8_SB(1, 1), b3 + hstep, voffB); PG8_STAGE(PG8_SA(1, 0), a3, voffA);
            PG8_WAIT_V(8); PG8_WAIT_L(0); PG8_BAR; PG8_MMA(1, 0, At, B0); PG8_MMA(1, 1, At, B1); PG8_BAR; PG8_SCHED;
            } else {
            PG8_LDB(B0, 0, 0); PG8_SCHED; PG8_LDA(At, 0, 0); PG8_STAGE(PG8_SA(1, 1), a1 + hstep, voffA);
            PG8_WAIT_L(8); PG8_BAR; PG8_WAIT_L(0); PG8_MMA(0, 0, At, B0); PG8_BAR; PG8_SCHED;
            PG8_LDB(B1, 0, 1); PG8_STAGE(PG8_SB(0, 0), b2, voffB);
            PG8_BAR; PG8_WAIT_L(0); PG8_MMA(0, 1, At, B1); PG8_BAR;
            PG8_LDA(At, 0, 1); PG8_STAGE(PG8_SA(0, 0), a2, voffA);
            PG8_BAR; PG8_WAIT_L(0); PG8_MMA(1, 0, At, B0); PG8_BAR; PG8_SCHED;
            PG8_STAGE(PG8_SB(0, 1), b2 + hstep, voffB);
            PG8_WAIT_V(6); PG8_BAR; PG8_MMA(1, 1, At, B1); PG8_BAR;
            PG8_LDB(B0, 1, 0); PG8_SCHED; PG8_LDA(At, 1, 0); PG8_STAGE(PG8_SA(0, 1), a2 + hstep, voffA);
            PG8_WAIT_L(8); PG8_BAR; PG8_WAIT_L(0); PG8_MMA(0, 0, At, B0); PG8_BAR; PG8_SCHED;
            PG8_LDB(B1, 1, 1); PG8_STAGE(PG8_SB(1, 0), b3, voffB);
            PG8_BAR; PG8_WAIT_L(0); PG8_MMA(0, 1, At, B1); PG8_BAR;
            PG8_LDA(At, 1, 1); PG8_STAGE(PG8_SA(1, 0), a3, voffA);
            PG8_BAR; PG8_WAIT_L(0); PG8_MMA(1, 0, At, B0); PG8_BAR; PG8_SCHED;
            PG8_STAGE(PG8_SB(1, 1), b3 + hstep, voffB);
            PG8_WAIT_V(6); PG8_BAR; PG8_MMA(1, 1, At, B1); PG8_BAR;
            }
        }
        if constexpr (ALIGN_EPI) { if (wr == 0) PG8_BAR; }
        if constexpr (!Epi::AFTER_DRAIN) { E(acc, cur, wr, wc, fr, fq); S.done(cur); }
        if (!has_next) break;
#pragma unroll
        for (int a = 0; a < 2; ++a)
#pragma unroll
            for (int b = 0; b < 2; ++b)
#pragma unroll
                for (int m = 0; m < 4; ++m)
#pragma unroll
                    for (int n = 0; n < 2; ++n) acc[a][b][m][n] = zero4_();
        cur = nxt; cA = nA; cB = nB; ++ui;
        if constexpr (ALIGN_EPI) { if (wr == 1) PG8_BAR; }
    }
    PG8_WAIT_V(0);
    if constexpr (!ALIGN_EPI) { if (wr == 0) PG8_BAR; }
    PG8_BAR;
    if constexpr (Epi::AFTER_DRAIN) { E.fused(acc, cur, wr, wc, fr, fq, lds, wid, lane); S.done(cur); }
#undef PG8_SA
#undef PG8_SB
#undef PG8_STAGE
#undef PG8_LDA
#undef PG8_LDB
#undef PG8_MMA
#undef PG8_WAIT_V
#undef PG8_WAIT_L
#undef PG8_BAR
#undef PG8_SCHED
}
}

#define LAS __attribute__((address_space(3)))
typedef unsigned short bf16_t;
typedef short bf16x8 __attribute__((ext_vector_type(8)));
typedef float f32x4 __attribute__((ext_vector_type(4)));
typedef float f32x16 __attribute__((ext_vector_type(16)));
typedef unsigned u32x4 __attribute__((ext_vector_type(4)));
typedef unsigned u32x2 __attribute__((ext_vector_type(2)));

constexpr int NB = 4, T = 8192, DM = 1024, M = NB * T, DEPTH = 4, PLE = 256, FF = 2816, ZW = 3584, INW = 3474;
constexpr int C_NQ = 0, C_CK = 384, C_CV = 512, C_SK = 640, C_SV = 768, C_WK = 896, C_WV = 1024, C_DQ = 1152, C_DK = 1408, C_DV = 1664,
              C_HQ = 1920, C_HF = 2304, C_HI = 2688, C_HG = 3072, C_NG = 3456;
constexpr float EPS = 1e-6f, LOG2E = 1.4426950408889634f;
enum { I_X = 0, I_P, I_RELB, I_LBLOG, I_F1N, I_F1G, I_F1U, I_F1D, I_MIXN, I_WIN, I_WOUT, I_NQN, I_NKN, I_CPOS, I_CW1, I_CW2,
       I_DQN, I_DKN, I_DLAM, I_DSUB, I_HON, I_F2N, I_F2G, I_F2U, I_F2D, I_PLN, I_PLG, I_PLP, I_PLPOST, N_IN };
constexpr size_t MiB = 1u << 20;
constexpr size_t WS_CTL = 0, WS_W = 1 * MiB, WS_PB = 53 * MiB, WS_XB = 69 * MiB, WS_R1 = 133 * MiB, WS_MIX = 357 * MiB, WS_VT = 421 * MiB,
                 WS_HS = 453 * MiB, WS_KC = 501 * MiB, WS_VCT = WS_KC + 512 * 1024, WS_SELM = 503 * MiB, WS_RSQ0 = 504 * MiB, WS_RSQ1 = 506 * MiB,
                 WS_RSQP = 508 * MiB, WS_HD = 510 * MiB, WS_XB1 = 511 * MiB, WS_OCB = 575 * MiB, WS_ONES = 599 * MiB, WS_END = 601 * MiB;
constexpr size_t W_GU1 = 0, W_D1 = 11 * MiB, W_GU2 = W_D1 + 5 * MiB + 512 * 1024, W_D2 = W_GU2 + 11 * MiB, W_IN = 33 * MiB, W_OUT = 40 * MiB, W_PG = 42 * MiB,
                 W_PP = 44 * MiB, W_1T = W_PP + 512 * 1024, W_2T = W_1T + 2 * MiB, W_POSB = W_2T + 64 * 1024;
static_assert(W_D2 + 5 * MiB + 512 * 1024 == W_IN, "weight map");
constexpr int LDS_MISC = 147456, LDS_RTAB = LDS_MISC + 1024, LDS_BYTES = LDS_RTAB + 8192;

__device__ __forceinline__ float bf2f(unsigned short u) { return __uint_as_float(((unsigned)u) << 16); }
__device__ __forceinline__ float bflo(unsigned w) { return __uint_as_float(w << 16); }
__device__ __forceinline__ float bfhi(unsigned w) { return __uint_as_float(w & 0xffff0000u); }
typedef float f32x2_t __attribute__((ext_vector_type(2))); typedef __bf16 bf16x2_t __attribute__((ext_vector_type(2)));
__device__ __forceinline__ unsigned pk2(float lo, float hi) { f32x2_t v = {lo, hi}; bf16x2_t b = __builtin_convertvector(v, bf16x2_t); return __builtin_bit_cast(unsigned, b); }
__device__ __forceinline__ bf16_t f2bf(float f) { return (bf16_t)(pk2(f, 0.f) & 0xffffu); }
__device__ __forceinline__ float ex2(float x) { return __builtin_amdgcn_exp2f(x); }
__device__ __forceinline__ float sigmoidf_(float x) { return __builtin_amdgcn_rcpf(1.0f + __expf(-x)); }
__device__ __forceinline__ int crow(int r, int hi) { return (r & 3) + 8 * (r >> 2) + 4 * hi; }
__device__ __forceinline__ f32x16 mfma32(bf16x8 a, bf16x8 b, f32x16 c) { return __builtin_amdgcn_mfma_f32_32x32x16_bf16(a, b, c, 0, 0, 0); }
__device__ __forceinline__ f32x4 mfma16(bf16x8 a, bf16x8 b, f32x4 c) { return __builtin_amdgcn_mfma_f32_16x16x32_bf16(a, b, c, 0, 0, 0); }
__device__ __forceinline__ bf16x8 as_bf16x8(u32x4 v) { return __builtin_bit_cast(bf16x8, v); }
#define LDSW() asm volatile("s_waitcnt lgkmcnt(0)" ::: "memory")
#define CFENCE() asm volatile("" ::: "memory")
#define GAS __attribute__((address_space(1)))
__device__ __forceinline__ const float* inp(int i) { asm volatile("" : "+s"(i)); const unsigned long long v = ((const unsigned long long __attribute__((address_space(4)))*)__builtin_amdgcn_kernarg_segment_ptr())[i]; return (const float*)(const GAS float*)v; }

__device__ __forceinline__ unsigned pk_bf8(float a, float b, float c, float d) { int w = __builtin_amdgcn_cvt_pk_bf8_f32(a, b, 0, false); w = __builtin_amdgcn_cvt_pk_bf8_f32(c, d, w, true); return (unsigned)w; }
__device__ __forceinline__ void unpk_bf8(unsigned w, float* o) { const f32x2_t r0 = __builtin_amdgcn_cvt_pk_f32_bf8((int)w, false), r1 = __builtin_amdgcn_cvt_pk_f32_bf8((int)w, true); o[0] = r0.x; o[1] = r0.y; o[2] = r1.x; o[3] = r1.y; }
__device__ __forceinline__ float row_rinv(const float* rsq, int row) {
    const f32x4* p = (const f32x4*)(rsq + (size_t)row * 16);
    const f32x4 a = p[0], b = p[1], c = p[2], d = p[3];
    const float s = ((a.x + a.y) + (a.z + a.w)) + ((b.x + b.y) + (b.z + b.w)) + ((c.x + c.y) + (c.z + c.w)) + ((d.x + d.y) + (d.z + d.w));
    return rsqrtf(s * (1.0f / 1024.0f) + EPS);
}
struct RowTab {
    int p0, p1, p2, p3;
    __device__ __forceinline__ int slot(int pm) const { return pm == p0 ? 0 : (pm == p1 ? 1 : (pm == p2 ? 2 : 3)); }
    __device__ __forceinline__ float get(int t, int pm, int r256) const { return ((const LAS float*)(LAS unsigned char*)(size_t)LDS_RTAB)[(t * 4 + slot(pm)) * 256 + r256]; }
};
struct EpiSwiGLU {
    static constexpr bool PERM = true, AFTER_DRAIN = false;
    bf16_t* O; RowTab rt;
    __device__ __forceinline__ void operator()(const f32x4 (&acc)[2][2][4][2], const pg8::Unit& u, int wr, int wc, int fr, int fq) const {
#pragma unroll
        for (int ai = 0; ai < 2; ++ai)
#pragma unroll
            for (int m = 0; m < 4; ++m) {
                const int row = u.pm * 256 + ai * 128 + wr * 64 + m * 16 + fr;
                const float r = rt.get(0, u.pm, row & 255);
                float o[8];
#pragma unroll
                for (int n = 0; n < 2; ++n)
#pragma unroll
                    for (int e = 0; e < 4; ++e) { const float g = acc[ai][0][m][n][e] * r, up = acc[ai][1][m][n][e] * r; o[n * 4 + e] = g * sigmoidf_(g) * up; }
                u32x4 w; w.x = pk2(o[0], o[1]); w.y = pk2(o[2], o[3]); w.z = pk2(o[4], o[5]); w.w = pk2(o[6], o[7]);
                *(u32x4*)(O + (size_t)row * FF + u.pn * 128 + wc * 32 + 8 * fq) = w;
                CFENCE();
            }
    }
};
template <int LD> struct EpiZT {
    static constexpr bool PERM = true, AFTER_DRAIN = false;
    bf16_t* Z; RowTab rt;
    __device__ __forceinline__ void operator()(const f32x4 (&acc)[2][2][4][2], const pg8::Unit& u, int wr, int wc, int fr, int fq) const {
#pragma unroll
        for (int ai = 0; ai < 2; ++ai)
#pragma unroll
            for (int m = 0; m < 4; ++m) {
                const int row = u.pm * 256 + ai * 128 + wr * 64 + m * 16 + fr;
                const float r = rt.get(0, u.pm, row & 255);
#pragma unroll
                for (int bj = 0; bj < 2; ++bj) {
                    const f32x4 v0 = acc[ai][bj][m][0] * r, v1 = acc[ai][bj][m][1] * r;
                    u32x4 w; w.x = pk2(v0[0], v0[1]); w.y = pk2(v0[2], v0[3]); w.z = pk2(v1[0], v1[1]); w.w = pk2(v1[2], v1[3]);
                    *(u32x4*)(Z + (size_t)row * LD + u.pn * 256 + bj * 128 + wc * 32 + 8 * fq) = w;
                }
                CFENCE();
            }
    }
};
typedef EpiZT<ZW> EpiZ;
template <int MODE> struct EpiRes {
    static constexpr bool PERM = true, AFTER_DRAIN = false;
    float* X; bf16_t* XB; float* rsq_out; float alpha; const float* rsq_in; const bf16_t* P; const float* rsqp; const float* post; bf16_t* Pout; RowTab rt; const bf16_t* HIin; unsigned char* LO;
    __device__ __forceinline__ void operator()(const f32x4 (&acc)[2][2][4][2], const pg8::Unit& u, int wr, int wc, int fr, int fq) const {
        const int rowb = u.pm * 256 + wr * 64 + fr, colb = u.pn * 256 + wc * 32 + 8 * fq;
        u32x4 hn[2], pn_[2]; u32x2 ln[2];
        if (MODE != 2) {
#pragma unroll
            for (int bj = 0; bj < 2; ++bj) { const size_t off = (size_t)rowb * DM + colb + bj * 128; hn[bj] = *(const u32x4*)(HIin + off); ln[bj] = *(const u32x2*)(LO + off); if (MODE == 1) pn_[bj] = *(const u32x4*)(P + off); }
        }
#pragma unroll
        for (int gI = 0; gI < 8; ++gI) {
            const int ai = gI >> 2, m = gI & 3;
            const int row = rowb + ai * 128 + m * 16;
            u32x4 hc[2], pc[2]; u32x2 lc[2];
#pragma unroll
            for (int bj = 0; bj < 2; ++bj) { hc[bj] = hn[bj]; lc[bj] = ln[bj]; pc[bj] = pn_[bj]; }
            if (MODE != 2 && gI < 7) {
                const int row2 = rowb + ((gI + 1) >> 2) * 128 + ((gI + 1) & 3) * 16;
#pragma unroll
                for (int bj = 0; bj < 2; ++bj) { const size_t off = (size_t)row2 * DM + colb + bj * 128; hn[bj] = *(const u32x4*)(HIin + off); ln[bj] = *(const u32x2*)(LO + off); if (MODE == 1) pn_[bj] = *(const u32x4*)(P + off); }
            }
            CFENCE();
            float r = 1.f, rp = 1.f;
            if (MODE == 1) { r = rt.get(0, u.pm, row & 255); rp = rt.get(1, u.pm, row & 255); }
            float ss = 0.f;
#pragma unroll
            for (int bj = 0; bj < 2; ++bj) {
                const int c0 = colb + bj * 128;
                const size_t off = (size_t)row * DM + c0;
                if (MODE == 2) {
                    const f32x4 a0 = acc[ai][bj][m][0], a1 = acc[ai][bj][m][1];
                    u32x4 w; w.x = pk2(a0[0], a0[1]); w.y = pk2(a0[2], a0[3]); w.z = pk2(a1[0], a1[1]); w.w = pk2(a1[2], a1[3]);
                    *(u32x4*)(Pout + off) = w;
                    ss += (a0[0] * a0[0] + a0[1] * a0[1]) + (a0[2] * a0[2] + a0[3] * a0[3]) + (a1[0] * a1[0] + a1[1] * a1[1]) + (a1[2] * a1[2] + a1[3] * a1[3]);
                } else {
                    const u32x4 h = hc[bj], pw = pc[bj]; const u32x2 lo = lc[bj];
                    float lf[8]; unpk_bf8(lo.x, lf); unpk_bf8(lo.y, lf + 4);
                    float xv[8] = {bflo(h.x) + lf[0], bfhi(h.x) + lf[1], bflo(h.y) + lf[2], bfhi(h.y) + lf[3],
                                   bflo(h.z) + lf[4], bfhi(h.z) + lf[5], bflo(h.w) + lf[6], bfhi(h.w) + lf[7]};
                    if (MODE == 0) {
#pragma unroll
                        for (int e = 0; e < 8; ++e) xv[e] += acc[ai][bj][m][e >> 2][e & 3] * alpha;
                    } else {
                        const f32x4 po0 = *(const f32x4*)(post + c0), po1 = *(const f32x4*)(post + c0 + 4);
                        const float pf[8] = {bflo(pw.x), bfhi(pw.x), bflo(pw.y), bfhi(pw.y), bflo(pw.z), bfhi(pw.z), bflo(pw.w), bfhi(pw.w)};
#pragma unroll
                        for (int e = 0; e < 8; ++e) xv[e] += sigmoidf_(acc[ai][bj][m][e >> 2][e & 3] * r) * (pf[e] * rp * (e < 4 ? po0[e & 3] : po1[e & 3]));
                    }
                    if (X) { *(f32x4*)(X + off) = (f32x4){xv[0], xv[1], xv[2], xv[3]}; *(f32x4*)(X + off + 4) = (f32x4){xv[4], xv[5], xv[6], xv[7]}; }
                    if (!X) {
                    u32x4 w; w.x = pk2(xv[0], xv[1]); w.y = pk2(xv[2], xv[3]); w.z = pk2(xv[4], xv[5]); w.w = pk2(xv[6], xv[7]);
                    *(u32x4*)(XB + off) = w;
                    u32x2 lw; lw.x = pk_bf8(xv[0] - bflo(w.x), xv[1] - bfhi(w.x), xv[2] - bflo(w.y), xv[3] - bfhi(w.y));
                    lw.y = pk_bf8(xv[4] - bflo(w.z), xv[5] - bfhi(w.z), xv[6] - bflo(w.w), xv[7] - bfhi(w.w));
                    *(u32x2*)(LO + off) = lw;
                    }
#pragma unroll
                    for (int e = 0; e < 8; ++e) ss += xv[e] * xv[e];
                }
            }
            ss += __shfl_xor(ss, 16); ss += __shfl_xor(ss, 32);
            if (fq == 0 && !(MODE == 1 && X)) rsq_out[(size_t)row * 16 + u.pn * 4 + wc] = ss;
        }
    }
};

template <class Epi> __device__ __forceinline__ void run_gemm(LAS unsigned char* lds, const bf16_t* A, const bf16_t* Bt, int N, int K, Epi& E, const float* rsqA = nullptr, const float* rsqB = nullptr, bool stagger = false) {
    int bx = blockIdx.x; asm volatile("" : "+s"(bx)); asm volatile("" : "+s"(K)); asm volatile("" : "+s"(N));
    pg8::Gemm g{A, Bt, M, N, K}; pg8::StaticOrder S; S.init(M, N, (int)gridDim.x, bx);
    if (rsqA) {
        int p0 = -1, p1 = -1, p2 = -1, p3 = -1; pg8::Unit u;
        for (int i = 0; S.next(i, u); ++i) { const int pm = u.pm; if (pm != p0 && pm != p1 && pm != p2 && pm != p3) { if (p0 < 0) p0 = pm; else if (p1 < 0) p1 = pm; else if (p2 < 0) p2 = pm; else p3 = pm; } }
        E.rt.p0 = p0; E.rt.p1 = p1; E.rt.p2 = p2; E.rt.p3 = p3;
        const int tid = TID();
        LAS float* tab = (LAS float*)(lds + LDS_RTAB);
        if (tid < 256) {
#pragma unroll
            for (int s = 0; s < 4; ++s) { const int pm = s == 0 ? p0 : (s == 1 ? p1 : (s == 2 ? p2 : p3));
                if (pm >= 0) { tab[s * 256 + tid] = row_rinv(rsqA, pm * 256 + tid); if (rsqB) tab[(4 + s) * 256 + tid] = row_rinv(rsqB, pm * 256 + tid); } }
        }
        __syncthreads();
    }
#ifndef STAGGER_TICKS
#define STAGGER_TICKS 2000
#endif
    if (stagger && ((bx >> 3) & 1)) { const unsigned long long t0 = __builtin_amdgcn_s_memrealtime(); while (__builtin_amdgcn_s_memrealtime() - t0 < (unsigned long long)STAGGER_TICKS) __builtin_amdgcn_s_sleep(16); }
    pg8::gemm_phase<Epi, pg8::StaticOrder, true, true>(lds, g, S, E);
    __syncthreads();
}

__device__ __forceinline__ void rowsq_pass(const bf16_t* P, float* rsq_out) {
    const int tid = TID(), lane = tid & 63, wave = tid >> 6;
    for (int base = (blockIdx.x * 8 + wave) * 4; base < M; base += gridDim.x * 8 * 4) {
        u32x4 v[4][2];
#pragma unroll
        for (int i = 0; i < 4; ++i) { const u32x4* pr = (const u32x4*)(P + (size_t)(base + i) * DM) + lane; v[i][0] = pr[0]; v[i][1] = pr[64]; }
#pragma unroll
        for (int i = 0; i < 4; ++i) {
            float s = 0.f;
#pragma unroll
            for (int h2 = 0; h2 < 2; ++h2) { const u32x4 w = v[i][h2];
                s += (bflo(w.x) * bflo(w.x) + bfhi(w.x) * bfhi(w.x)) + (bflo(w.y) * bflo(w.y) + bfhi(w.y) * bfhi(w.y)) + (bflo(w.z) * bflo(w.z) + bfhi(w.z) * bfhi(w.z)) + (bflo(w.w) * bflo(w.w) + bfhi(w.w) * bfhi(w.w)); }
#pragma unroll
            for (int o = 1; o < 64; o <<= 1) s += __shfl_xor(s, o);
            if (lane < 16) rsq_out[(size_t)(base + i) * 16 + lane] = (lane == 0) ? s : 0.f;
        }
    }
}

__device__ __forceinline__ int next_task(unsigned* ctr, LAS int* slot) {
    __syncthreads();
    if (TID() == 0) *slot = (int)atomicAdd(ctr, 1u);
    __syncthreads();
    return *slot;
}

__device__ __forceinline__ int colmap(int mode, int n) {
    if (mode == 1) return 256 * (n >> 7) + (n & 127);
    if (mode == 2) return 256 * (n >> 7) + 128 + (n & 127);
    if (mode == 3) return n < 1152 ? n : (n < 1170 ? 3456 + (n - 1152) : n - 18);
    return n;
}
__device__ __forceinline__ void conv_item(const float* W, int K, int N, bf16_t* WT, const float* gain, int mode, LAS float* scr, int item, int lane) {
    const int nblk = (N + 31) >> 5, kb = item / nblk, nb = item % nblk, k0 = 64 * kb, n0 = 32 * nb;
    if (mode != 3) {
        f32x4 v[8];
#pragma unroll
        for (int i = 0; i < 8; ++i) v[i] = *(const f32x4*)(W + (size_t)(k0 + 8 * i + (lane >> 3)) * N + n0 + 4 * (lane & 7));
#pragma unroll
        for (int i = 0; i < 8; ++i) {
            const int kk = 8 * i + (lane >> 3);
            f32x4 t = v[i];
            if (gain) t = t * gain[k0 + kk];
            LAS float* d = scr + kk * 33 + 4 * (lane & 7);
            d[0] = t[0]; d[1] = t[1]; d[2] = t[2]; d[3] = t[3];
        }
    } else {
#pragma unroll 16
        for (int i = 0; i < 32; ++i) {
            const int kk = 2 * i + (lane >> 5), n = n0 + (lane & 31);
            float v = (n < N) ? W[(size_t)(k0 + kk) * N + n] : 0.f;
            if (gain) v *= gain[k0 + kk];
            scr[kk * 33 + (lane & 31)] = v;
        }
    }
    LDSW();
    const int c = lane & 7;
#pragma unroll
    for (int j = 0; j < 4; ++j) {
        const int nl = (lane >> 3) + 8 * j, n = n0 + nl;
        const LAS float* s = scr + (8 * c) * 33 + nl;
        u32x4 o; o.x = pk2(s[0], s[33]); o.y = pk2(s[2 * 33], s[3 * 33]); o.z = pk2(s[4 * 33], s[5 * 33]); o.w = pk2(s[6 * 33], s[7 * 33]);
        if (n < N) *(u32x4*)(WT + (size_t)colmap(mode, n) * K + k0 + 8 * c) = o;
    }
    LDSW();
}
constexpr int IT_GU = (DM / 64) * (FF / 32), IT_D = (FF / 64) * (DM / 32), IT_IN = (DM / 64) * ((INW + 31) / 32), IT_SQ = (DM / 64) * (DM / 32),
              IT_PP = (PLE / 64) * (DM / 32), IT_W1 = (2048 / 64) * (256 / 32), IT_W2 = (256 / 64) * (64 / 32);
constexpr int IT_SETA = 2 * IT_GU + IT_D + IT_IN + 2 * IT_W1 + 2 * IT_W2;
constexpr int IT_SETB = 2 * IT_GU + IT_D + 2 * IT_SQ + IT_PP;
__device__ __forceinline__ void conv_one(unsigned char* ws, int LA, int LB, bool enA, int it, LAS float* scr, int lane) {
    unsigned char* wb = ws + WS_W;
    const size_t fa = (size_t)LA * DM * FF, fb = (size_t)LB * DM * FF;
    const float* W = nullptr; int K = 0, N = 0; bf16_t* WT = nullptr; const float* gain = nullptr; int mode = 0, rr = -1, r = it;
#define JOB(Wp, Kk, Nn, WTp, gp, md, items) { if (rr < 0 && r < (items)) { W = (Wp); K = (Kk); N = (Nn); WT = (bf16_t*)(WTp); gain = (gp); mode = (md); rr = r; } r -= (items); }
    JOB(inp(I_F1G) + fa, DM, FF, wb + W_GU1, inp(I_F1N) + LA * DM, 1, enA ? IT_GU : 0)
    JOB(inp(I_F1U) + fa, DM, FF, wb + W_GU1, inp(I_F1N) + LA * DM, 2, enA ? IT_GU : 0)
    JOB(inp(I_F1D) + fa, FF, DM, wb + W_D1, nullptr, 0, enA ? IT_D : 0)
    JOB(inp(I_WIN) + (size_t)LA * DM * INW, DM, INW, wb + W_IN, inp(I_MIXN) + LA * DM, 3, enA ? IT_IN : 0)
    JOB(inp(I_CW1) + (size_t)(LA * 2 + 0) * 2048 * 256, 2048, 256, wb + W_1T, nullptr, 0, enA ? IT_W1 : 0)
    JOB(inp(I_CW1) + (size_t)(LA * 2 + 1) * 2048 * 256, 2048, 256, wb + W_1T + 256 * 2048 * 2, nullptr, 0, enA ? IT_W1 : 0)
    JOB(inp(I_CW2) + (size_t)(LA * 2 + 0) * 256 * 64, 256, 64, wb + W_2T, nullptr, 0, enA ? IT_W2 : 0)
    JOB(inp(I_CW2) + (size_t)(LA * 2 + 1) * 256 * 64, 256, 64, wb + W_2T + 64 * 256 * 2, nullptr, 0, enA ? IT_W2 : 0)
    JOB(inp(I_F2G) + fb, DM, FF, wb + W_GU2, inp(I_F2N) + LB * DM, 1, IT_GU)
    JOB(inp(I_F2U) + fb, DM, FF, wb + W_GU2, inp(I_F2N) + LB * DM, 2, IT_GU)
    JOB(inp(I_F2D) + fb, FF, DM, wb + W_D2, nullptr, 0, IT_D)
    JOB(inp(I_WOUT) + (size_t)LB * DM * DM, DM, DM, wb + W_OUT, nullptr, 0, IT_SQ)
    JOB(inp(I_PLG) + (size_t)LB * DM * DM, DM, DM, wb + W_PG, inp(I_PLN) + LB * DM, 0, IT_SQ)
    JOB(inp(I_PLP) + (size_t)LB * PLE * DM, PLE, DM, wb + W_PP, nullptr, 0, IT_PP)
#undef JOB
    if (rr >= 0) conv_item(W, K, N, WT, gain, mode, scr, rr, lane);
}
__device__ __forceinline__ void posb_job(unsigned char* ws, int LA, int jid, int lane) {
    const int ty = jid >> 7, ng = (jid >> 5) & 3, ks = jid & 31, n = ng * 64 + lane;
    const float* w1 = inp(I_CW1) + (size_t)(LA * 2 + ty) * 2048 * 256; const float* pos = inp(I_CPOS) + (size_t)(LA * 2 + ty) * 2048;
    float acc = 0.f;
#pragma unroll 16
    for (int k = ks * 64; k < ks * 64 + 64; ++k) acc += pos[k] * w1[(size_t)k * 256 + n];
    ((float*)(ws + WS_W + W_POSB))[(ty * 32 + ks) * 256 + n] = acc;
}
__device__ __forceinline__ void phase_convert(const float* const* in, unsigned char* ws, float* out, int L, LAS unsigned char* lds) {
    const int tid = TID(), lane = tid & 63, wave = tid >> 6;
    const int gw = blockIdx.x * 8 + wave, NGW = gridDim.x * 8;
    LAS float* scr = (LAS float*)(lds + wave * 8704);
    if (gw < 256) posb_job(ws, 0, gw, lane);
    for (int it = gw; it < IT_SETA; it += NGW) conv_one(ws, 0, 0, true, it, scr, lane);
    {
        u32x4* z = (u32x4*)((bf16_t*)(ws + WS_W + W_IN) + (size_t)INW * DM);
        const int n16 = (ZW - INW) * DM / 8;
        for (int i = blockIdx.x * 512 + tid; i < n16; i += gridDim.x * 512) z[i] = (u32x4){0u, 0u, 0u, 0u};
    }
    {
        const float* x = inp(I_X); bf16_t* xb = (bf16_t*)(ws + WS_XB); float* rsq = (float*)(ws + WS_RSQ0);
        for (int m = gw; m < M; m += NGW) {
            const f32x4* xr = (const f32x4*)(x + (size_t)m * DM) + lane;
            u32x2* xbr = (u32x2*)(xb + (size_t)m * DM) + lane; unsigned* xlr = (unsigned*)(ws + WS_XB1 + (size_t)m * DM) + lane;
            float s = 0.f;
#pragma unroll
            for (int j = 0; j < 4; ++j) { const f32x4 v = xr[64 * j]; u32x2 w; w.x = pk2(v[0], v[1]); w.y = pk2(v[2], v[3]); xbr[64 * j] = w;
                xlr[64 * j] = pk_bf8(v[0] - bflo(w.x), v[1] - bfhi(w.x), v[2] - bflo(w.y), v[3] - bfhi(w.y));
                s += (v[0] * v[0] + v[1] * v[1]) + (v[2] * v[2] + v[3] * v[3]); }
#pragma unroll
            for (int o = 1; o < 64; o <<= 1) s += __shfl_xor(s, o);
            if (lane < 16) rsq[(size_t)m * 16 + lane] = (lane == 0) ? s : 0.f;
        }
    }
}
__device__ __forceinline__ void task_conv(unsigned char* ws, int L, int c, LAS unsigned char* lds) {
    const int tid = TID(), lane = tid & 63, wave = tid >> 6;
    LAS float* scr = (LAS float*)(lds + wave * 8704);
    const bool enA = L < DEPTH - 1;
    const int total = (enA ? IT_SETA : 0) + IT_SETB;
    if (enA && wave == 7) posb_job(ws, L + 1, c, lane);
    for (int i = 0; i < 6; ++i) { const int it = c * 48 + wave * 6 + i; if (it < total) conv_one(ws, L + 1, L, enA, it, scr, lane); }
    if (enA && tid < 55) { u32x4* z = (u32x4*)((bf16_t*)(ws + WS_W + W_IN) + (size_t)INW * DM); z[c * 55 + tid] = (u32x4){0u, 0u, 0u, 0u}; }
    {
        const f32x4* src = (const f32x4*)(inp(I_P) + (size_t)L * M * PLE); u32x4* dst = (u32x4*)(ws + WS_PB);
#pragma unroll
        for (int i = 0; i < 8; ++i) {
            const int idx = c * 4096 + i * 512 + tid;
            const f32x4 a = src[2 * idx], b = src[2 * idx + 1];
            u32x4 w; w.x = pk2(a[0], a[1]); w.y = pk2(a[2], a[3]); w.z = pk2(b[0], b[1]); w.w = pk2(b[2], b[3]); dst[idx] = w;
        }
    }
}

__device__ __forceinline__ void task_prep(const float* const* in, unsigned char* ws, int L, int tile, LAS unsigned char* lds) {
    const int tid = TID(), lane = tid & 63, wave = tid >> 6;
    bf16_t* z = (bf16_t*)(ws + WS_R1);
    const int row0 = tile * 64;
#pragma unroll
    for (int pass = 0; pass < 3; ++pass) {
        const int seg = pass * 64 + lane;
        int col = 0, gs = 8; const float* gp = inp(I_NQN); float scale = 1.f;
        if (seg < 48) { col = C_NQ + 8 * seg; gp = inp(I_NQN) + L * 64 + ((8 * seg) & 63); scale = 0.125f * LOG2E; }
        else if (seg < 64) { col = C_SK + 8 * (seg - 48); gp = inp(I_NKN) + (L * 3 + 1) * 64 + ((8 * seg) & 63); }
        else if (seg < 80) { col = C_WK + 8 * (seg - 64); gp = inp(I_NKN) + (L * 3 + 2) * 64 + ((8 * seg) & 63); }
        else if (seg < 112) { col = C_DQ + 8 * (seg - 80); gp = inp(I_DQN) + L * 32 + ((8 * seg) & 31); gs = 4; scale = 0.17677669529663689f * LOG2E; }
        else { col = C_DK + 8 * (seg - 112); gp = inp(I_DKN) + L * 32 + ((8 * seg) & 31); gs = 4; }
        const bool act = seg < 144;
        if (!act) { col = 0; }
        const f32x4 g0 = *(const f32x4*)gp, g1 = *(const f32x4*)(gp + 4);
        u32x4 w[8];
#pragma unroll
        for (int i = 0; i < 8; ++i) w[i] = *(const u32x4*)(z + (size_t)(row0 + wave + 8 * i) * ZW + col);
#pragma unroll
        for (int i = 0; i < 8; ++i) {
            float v[8] = {bflo(w[i].x), bfhi(w[i].x), bflo(w[i].y), bfhi(w[i].y), bflo(w[i].z), bfhi(w[i].z), bflo(w[i].w), bfhi(w[i].w)};
            float ss = 0.f;
#pragma unroll
            for (int e2 = 0; e2 < 8; ++e2) ss += v[e2] * v[e2];
            ss += __shfl_xor(ss, 1); ss += __shfl_xor(ss, 2);
            const float t4 = __shfl_xor(ss, 4); if (gs == 8) ss += t4;
            const float r = rsqrtf(ss / (float)(gs * 8) + EPS) * scale;
            u32x4 o; o.x = pk2(v[0] * r * g0[0], v[1] * r * g0[1]); o.y = pk2(v[2] * r * g0[2], v[3] * r * g0[3]);
            o.z = pk2(v[4] * r * g1[0], v[5] * r * g1[1]); o.w = pk2(v[6] * r * g1[2], v[7] * r * g1[3]);
            if (act) *(u32x4*)(z + (size_t)(row0 + wave + 8 * i) * ZW + col) = o;
        }
    }
    LAS bf16_t* tl = (LAS bf16_t*)lds;
#pragma unroll
    for (int i = 0; i < 8; ++i) {
        const int id = i * 512 + tid, row = id >> 6, ch = id & 63;
        const int col = ch < 16 ? C_SV + 8 * ch : (ch < 32 ? C_WV + 8 * (ch - 16) : C_DV + 8 * (ch - 32));
        *(LAS u32x4*)(tl + row * 520 + 8 * ch) = *(const u32x4*)(z + (size_t)(row0 + row) * ZW + col);
    }
    __syncthreads();
    const int b = row0 / T, t0 = row0 % T;
    bf16_t* vt = (bf16_t*)(ws + WS_VT);
#pragma unroll
    for (int i = 0; i < 8; ++i) {
        const int orow = tid, tch = i;
        const LAS bf16_t* s = tl + (tch * 8) * 520 + orow;
        u32x4 o;
        o.x = (unsigned)s[0] | ((unsigned)s[520] << 16); o.y = (unsigned)s[2 * 520] | ((unsigned)s[3 * 520] << 16);
        o.z = (unsigned)s[4 * 520] | ((unsigned)s[5 * 520] << 16); o.w = (unsigned)s[6 * 520] | ((unsigned)s[7 * 520] << 16);
        *(u32x4*)(vt + ((size_t)(b * 8) * 64 + orow) * T + t0 + 8 * tch) = o;
    }
}

__device__ __forceinline__ float gelu_tanh(float x) {
    const float y = 0.7978845608028654f * (x + 0.044715f * x * x * x);
    const float th = 1.0f - 2.0f * __builtin_amdgcn_rcpf(1.0f + __expf(2.0f * y));
    return 0.5f * x * (1.0f + th);
}
__device__ __forceinline__ void task_compress(const float* const* in, unsigned char* ws, int L, int task, LAS unsigned char* lds) {
    const int tid = TID(), lane = tid & 63, wave = tid >> 6;
    const int ty = task >> 8, b = (task >> 6) & 3, g = (task >> 5) & 1, i0 = (task & 31) * 16;
    const bf16_t* z = (const bf16_t*)(ws + WS_R1);
    LAS bf16_t* zt = (LAS bf16_t*)lds;
    LAS bf16_t* hid = (LAS bf16_t*)(lds + 39168);
    LAS float* ofp = (LAS float*)(lds + 39168 + 8448);
    const int ccol = (ty ? C_CV : C_CK) + 64 * g;
    for (int id = tid; id < 272 * 8; id += 512) {
        const int row = id >> 3, ch = id & 7, tok = 16 * i0 + row;
        u32x4 v = (u32x4){0u, 0u, 0u, 0u};
        if (tok < T) v = *(const u32x4*)(z + (size_t)(b * T + tok) * ZW + ccol + 8 * ch);
        *(LAS u32x4*)(zt + row * 72 + 8 * ch) = v;
    }
    __syncthreads();
    const bf16_t* w1t = (const bf16_t*)(ws + WS_W + W_1T) + (size_t)ty * 256 * 2048;
    const bf16_t* w2t = (const bf16_t*)(ws + WS_W + W_2T) + (size_t)ty * 64 * 256;
    const float* posb = (const float*)(ws + WS_W + W_POSB) + ty * 32 * 256;
    const int r16 = lane & 15, kq = lane >> 4;
    f32x4 acc[2] = {(f32x4){0.f, 0.f, 0.f, 0.f}, (f32x4){0.f, 0.f, 0.f, 0.f}};
    const bf16_t* b0p = w1t + (size_t)(16 * (2 * wave) + r16) * 2048 + 8 * kq;
    const bf16_t* b1p = b0p + 16 * 2048;
#pragma unroll 8
    for (int kc = 0; kc < 64; ++kc) {
        const bf16x8 a = *(const LAS bf16x8*)(zt + (16 * r16 + (kc >> 1)) * 72 + (kc & 1) * 32 + 8 * kq);
        const bf16x8 w0 = *(const bf16x8*)(b0p + 32 * kc), w1 = *(const bf16x8*)(b1p + 32 * kc);
        acc[0] = mfma16(a, w0, acc[0]); acc[1] = mfma16(a, w1, acc[1]);
    }
#pragma unroll
    for (int j = 0; j < 2; ++j) {
        const int n = 16 * (2 * wave + j) + r16;
        float pbias = 0.f;
#pragma unroll
        for (int ks = 0; ks < 32; ++ks) pbias += posb[ks * 256 + n];
#pragma unroll
        for (int i = 0; i < 4; ++i) hid[(4 * kq + i) * 264 + n] = f2bf(gelu_tanh(acc[j][i] + pbias));
    }
    __syncthreads();
    if (wave < 4) {
        f32x4 a2 = (f32x4){0.f, 0.f, 0.f, 0.f};
        const bf16_t* bp = w2t + (size_t)(16 * wave + r16) * 256 + 8 * kq;
#pragma unroll
        for (int kc = 0; kc < 8; ++kc) {
            const bf16x8 a = *(const LAS bf16x8*)(hid + r16 * 264 + 32 * kc + 8 * kq);
            const bf16x8 w = *(const bf16x8*)(bp + 32 * kc);
            a2 = mfma16(a, w, a2);
        }
#pragma unroll
        for (int i = 0; i < 4; ++i) ofp[(4 * kq + i) * 64 + 16 * wave + r16] = a2[i];
    }
    __syncthreads();
    if (tid < 256) {
        const int row = tid >> 4, c4 = (tid & 15) * 4, i = i0 + row;
        f32x4 o = *(const LAS f32x4*)(ofp + row * 64 + c4);
        float ss = (o[0] * o[0] + o[1] * o[1]) + (o[2] * o[2] + o[3] * o[3]);
        ss += __shfl_xor(ss, 1); ss += __shfl_xor(ss, 2); ss += __shfl_xor(ss, 4); ss += __shfl_xor(ss, 8);
        if (ty == 0) {
            const float r = rsqrtf(ss * (1.0f / 64.0f) + EPS);
            const f32x4 gn = *(const f32x4*)(inp(I_NKN) + (L * 3 + 0) * 64 + c4);
            o = o * r * gn;
        }
        if (i >= 511) o = (f32x4){0.f, 0.f, 0.f, 0.f};
        if (ty == 0) {
            u32x2 w; w.x = pk2(o[0], o[1]); w.y = pk2(o[2], o[3]);
            *(u32x2*)((bf16_t*)(ws + WS_KC) + ((size_t)(b * 2 + g) * 512 + i) * 64 + c4) = w;
        } else {
            bf16_t* vct = (bf16_t*)(ws + WS_VCT) + (size_t)(b * 2 + g) * 64 * 512;
#pragma unroll
            for (int e = 0; e < 4; ++e) vct[(size_t)(c4 + e) * 512 + i] = f2bf(o[e]);
        }
    }
}

__device__ __forceinline__ float hgrn_lb(const float* logits, int L, int j) {
    if (L == 0) return 0.f;
    const float a0 = logits[j], a1 = logits[384 + j], a2 = logits[768 + j], a3 = logits[1152 + j];
    const float mx = fmaxf(fmaxf(a0, a1), fmaxf(a2, a3));
    const float e0 = __expf(a0 - mx), e1 = __expf(a1 - mx), e2 = __expf(a2 - mx), e3 = __expf(a3 - mx);
    const float inv = 1.0f / (e0 + e1 + e2 + e3);
    float s = e1; if (L >= 2) s += e2; if (L >= 3) s += e3;
    return s * inv;
}
__device__ __forceinline__ void task_hgrn_local(const float* const* in, unsigned char* ws, int L, int task, LAS unsigned char* lds) {
    const int tid = TID(), lane = tid & 63, wave = tid >> 6;
    {
        const int chunk = task * 8 + wave;
        const int bh = chunk >> 7, c = chunk & 127, b = bh / 6, h = bh % 6;
        const bf16_t* z = (const bf16_t*)(ws + WS_R1) + (size_t)(b * T + c * 64) * ZW;
        LAS bf16_t* klT = (LAS bf16_t*)(lds + wave * 18432);
        LAS bf16_t* vT = klT + 64 * 72;
        const float lb = hgrn_lb(inp(I_LBLOG), L, h * 64 + lane);
        LAS bf16_t* rawf = klT;
        (void)rawf;
        u32x4 rf[8], ri[8];
#pragma unroll
        for (int i = 0; i < 8; ++i) {
            const int row = (lane >> 3) + 8 * i, ch = lane & 7;
            rf[i] = *(const u32x4*)(z + (size_t)row * ZW + C_HF + 64 * h + 8 * ch);
            ri[i] = *(const u32x4*)(z + (size_t)row * ZW + C_HI + 64 * h + 8 * ch);
        }
#pragma unroll
        for (int i = 0; i < 8; ++i) {
            const int row = (lane >> 3) + 8 * i, ch = lane & 7;
            *(LAS u32x4*)(klT + row * 72 + 8 * ch) = rf[i];
            *(LAS u32x4*)(vT + row * 72 + 8 * ch) = ri[i];
        }
        LDSW();
        float suffix = 0.f;
        bf16_t colf[64], colv[64];
#pragma unroll
        for (int s2 = 0; s2 < 64; ++s2) { colf[s2] = klT[s2 * 72 + lane]; colv[s2] = vT[s2 * 72 + lane]; }
        LDSW();
#pragma unroll
        for (int s = 63; s >= 0; --s) {
            const float fr = bf2f(colf[s]);
            const float sg = sigmoidf_(fr);
            const float f = lb + (1.0f - lb) * sg;
            const float ig = (1.0f - lb) * (1.0f - sg);
            klT[lane * 72 + s] = f2bf(ig * __expf(suffix));
            vT[lane * 72 + s] = colv[s];
            suffix += __logf(f);
        }
        ((float*)(ws + WS_HD))[(size_t)chunk * 64 + lane] = __expf(suffix);
        LDSW();
        const int r32 = lane & 31, hi = lane >> 5;
        float* hs = (float*)(ws + WS_HS) + (size_t)chunk * 4096;
#pragma unroll
        for (int kb = 0; kb < 2; ++kb)
#pragma unroll
            for (int vb = 0; vb < 2; ++vb) {
                f32x16 cacc = {};
#pragma unroll
                for (int cc = 0; cc < 4; ++cc) {
                    const bf16x8 a = *(const LAS bf16x8*)(klT + (32 * kb + r32) * 72 + 16 * cc + 8 * hi);
                    const bf16x8 bb = *(const LAS bf16x8*)(vT + (32 * vb + r32) * 72 + 16 * cc + 8 * hi);
                    cacc = mfma32(a, bb, cacc);
                }
#pragma unroll
                for (int r = 0; r < 16; ++r) hs[(32 * kb + crow(r, hi)) * 64 + 32 * vb + r32] = cacc[r];
            }
    }
}
__device__ __forceinline__ void task_hgrn_scan(unsigned char* ws, int task) {
    const int tid = TID();
    const int bh = task >> 3, k = (task & 7) * 8 + (tid >> 6), v = tid & 63;
    float* hs = (float*)(ws + WS_HS) + (size_t)bh * 128 * 4096 + k * 64 + v;
    const float* hd = (const float*)(ws + WS_HD) + (size_t)bh * 128 * 64 + k;
    float S = 0.f;
#pragma unroll 16
    for (int c = 0; c < 128; ++c) {
        const float a = hs[(size_t)c * 4096], d = hd[c * 64];
        hs[(size_t)c * 4096] = S;
        S = d * S + a;
    }
}
__device__ __forceinline__ void task_hgrn_out(const float* const* in, unsigned char* ws, int L, int task, LAS unsigned char* lds) {
    const int tid = TID(), lane = tid & 63, wave = tid >> 6;
    if (wave < 4) {
        const int chunk = task * 4 + wave;
        const int bh = chunk >> 7, c = chunk & 127, b = bh / 6, h = bh % 6;
        const size_t row0 = (size_t)(b * T + c * 64);
        const bf16_t* z = (const bf16_t*)(ws + WS_R1) + row0 * ZW;
        LAS bf16_t* ke = (LAS bf16_t*)(lds + wave * 36864);
        LAS bf16_t* qe = ke + 64 * 72;
        LAS bf16_t* vT = qe + 64 * 72;
        LAS bf16_t* sT = vT + 64 * 72;
        const float lb = hgrn_lb(inp(I_LBLOG), L, h * 64 + lane);
        {
            u32x4 rq[8], rf[8], ri[8];
#pragma unroll
            for (int i = 0; i < 8; ++i) {
                const int row = (lane >> 3) + 8 * i, ch = lane & 7;
                rq[i] = *(const u32x4*)(z + (size_t)row * ZW + C_HQ + 64 * h + 8 * ch);
                rf[i] = *(const u32x4*)(z + (size_t)row * ZW + C_HF + 64 * h + 8 * ch);
                ri[i] = *(const u32x4*)(z + (size_t)row * ZW + C_HI + 64 * h + 8 * ch);
            }
#pragma unroll
            for (int i = 0; i < 8; ++i) {
                const int row = (lane >> 3) + 8 * i, ch = lane & 7;
                *(LAS u32x4*)(qe + row * 72 + 8 * ch) = rq[i];
                *(LAS u32x4*)(ke + row * 72 + 8 * ch) = rf[i];
                *(LAS u32x4*)(sT + row * 72 + 8 * ch) = ri[i];
            }
        }
        LDSW();
        float ref = 0.f;
#pragma unroll 8
        for (int s = 0; s < 32; ++s) {
            const float fr = bf2f(ke[s * 72 + lane]);
            ref += __logf(lb + (1.0f - lb) * sigmoidf_(fr));
        }
        float cum = 0.f;
#pragma unroll 8
        for (int s = 0; s < 64; ++s) {
            const float fr = bf2f(ke[s * 72 + lane]);
            const float qv = bf2f(qe[s * 72 + lane]);
            const bf16_t vraw = sT[s * 72 + lane];
            const float sg = sigmoidf_(fr);
            const float f = lb + (1.0f - lb) * sg;
            const float ig = (1.0f - lb) * (1.0f - sg);
            cum += __logf(f);
            qe[s * 72 + lane] = f2bf(qv * sigmoidf_(qv) * __expf(cum - ref));
            ke[s * 72 + lane] = f2bf(ig * __expf(ref - cum));
            vT[lane * 72 + s] = vraw;
        }
        LDSW();
        const float* hs = (const float*)(ws + WS_HS) + (size_t)chunk * 4096;
        const float eref = __expf(ref);
        {
            f32x4 hv[16];
#pragma unroll
            for (int i = 0; i < 16; ++i) hv[i] = *(const f32x4*)(hs + ((lane >> 4) + 4 * i) * 64 + (lane & 15) * 4);
#pragma unroll
            for (int i = 0; i < 16; ++i) {
                const int k = (lane >> 4) + 4 * i, v4 = (lane & 15) * 4;
                const float er = __shfl(eref, k);
                sT[(v4 + 0) * 72 + k] = f2bf(hv[i][0] * er); sT[(v4 + 1) * 72 + k] = f2bf(hv[i][1] * er);
                sT[(v4 + 2) * 72 + k] = f2bf(hv[i][2] * er); sT[(v4 + 3) * 72 + k] = f2bf(hv[i][3] * er);
            }
        }
        LDSW();
        const int r32 = lane & 31, hi = lane >> 5;
        f32x16 O[2][2] = {};
#pragma unroll
        for (int tb = 0; tb < 2; ++tb) {
            bf16x8 qf[4];
#pragma unroll
            for (int cc = 0; cc < 4; ++cc) qf[cc] = *(const LAS bf16x8*)(qe + (32 * tb + r32) * 72 + 16 * cc + 8 * hi);
#pragma unroll
            for (int vb = 0; vb < 2; ++vb)
#pragma unroll
                for (int cc = 0; cc < 4; ++cc) {
                    const bf16x8 a = *(const LAS bf16x8*)(sT + (32 * vb + r32) * 72 + 16 * cc + 8 * hi);
                    O[vb][tb] = mfma32(a, qf[cc], O[vb][tb]);
                }
#pragma unroll
            for (int sb = 0; sb <= tb; ++sb) {
                f32x16 sc = {};
#pragma unroll
                for (int cc = 0; cc < 4; ++cc) {
                    const bf16x8 a = *(const LAS bf16x8*)(ke + (32 * sb + r32) * 72 + 16 * cc + 8 * hi);
                    sc = mfma32(a, qf[cc], sc);
                }
                unsigned P[8];
#pragma unroll
                for (int j = 0; j < 8; ++j) {
                    float p0 = sc[2 * j], p1 = sc[2 * j + 1];
                    if (sb == tb) { if (crow(2 * j, hi) > r32) p0 = 0.f; if (crow(2 * j + 1, hi) > r32) p1 = 0.f; }
                    P[j] = pk2(p0, p1);
                }
#pragma unroll
                for (int vb = 0; vb < 2; ++vb)
#pragma unroll
                    for (int c2 = 0; c2 < 2; ++c2) {
                        const u32x2 a0 = *(const LAS u32x2*)(vT + (32 * vb + r32) * 72 + 32 * sb + 16 * c2 + 4 * hi);
                        const u32x2 a1 = *(const LAS u32x2*)(vT + (32 * vb + r32) * 72 + 32 * sb + 16 * c2 + 8 + 4 * hi);
                        const bf16x8 vf = as_bf16x8((u32x4){a0.x, a0.y, a1.x, a1.y});
                        const bf16x8 pf = as_bf16x8((u32x4){P[4 * c2], P[4 * c2 + 1], P[4 * c2 + 2], P[4 * c2 + 3]});
                        O[vb][tb] = mfma32(vf, pf, O[vb][tb]);
                    }
            }
        }
        LDSW();
        const float* on = inp(I_HON) + L * 64;
#pragma unroll
        for (int tb = 0; tb < 2; ++tb) {
            float ss = 0.f;
#pragma unroll
            for (int vb = 0; vb < 2; ++vb)
#pragma unroll
                for (int r = 0; r < 16; ++r) ss += O[vb][tb][r] * O[vb][tb][r];
            ss += __shfl_xor(ss, 32);
            const float rn = rsqrtf(ss * (1.0f / 64.0f) + EPS);
#pragma unroll
            for (int vb = 0; vb < 2; ++vb)
#pragma unroll
                for (int r = 0; r < 16; ++r) { const int v = 32 * vb + crow(r, hi); ke[(32 * tb + r32) * 72 + v] = f2bf(O[vb][tb][r] * rn * on[v]); }
        }
        LDSW();
        bf16_t* mixed = (bf16_t*)(ws + WS_MIX) + row0 * DM + 640 + 64 * h;
#pragma unroll
        for (int i = 0; i < 8; ++i) {
            const int t = i * 8 + (lane >> 3), ch = lane & 7;
            const u32x4 ov = *(const LAS u32x4*)(ke + t * 72 + 8 * ch);
            const u32x4 gv = *(const u32x4*)(z + (size_t)t * ZW + C_HG + 64 * h + 8 * ch);
            u32x4 w;
            { const float g0 = bflo(gv.x), g1 = bfhi(gv.x); w.x = pk2(bflo(ov.x) * g0 * sigmoidf_(g0), bfhi(ov.x) * g1 * sigmoidf_(g1)); }
            { const float g0 = bflo(gv.y), g1 = bfhi(gv.y); w.y = pk2(bflo(ov.y) * g0 * sigmoidf_(g0), bfhi(ov.y) * g1 * sigmoidf_(g1)); }
            { const float g0 = bflo(gv.z), g1 = bfhi(gv.z); w.z = pk2(bflo(ov.z) * g0 * sigmoidf_(g0), bfhi(ov.z) * g1 * sigmoidf_(g1)); }
            { const float g0 = bflo(gv.w), g1 = bfhi(gv.w); w.w = pk2(bflo(ov.w) * g0 * sigmoidf_(g0), bfhi(ov.w) * g1 * sigmoidf_(g1)); }
            *(u32x4*)(mixed + (size_t)t * DM + 8 * ch) = w;
        }
    }
}

constexpr int ATT_K = 0, ATT_V = 18432, ATT_LUT = 35840, ATT_STAGE = 36864;
__device__ __forceinline__ void build_lut(LAS float* lut, const float* rel_bias, int head) {
    const int d = TID();
    if (d <= 128) {
        int bk = d;
        if (d >= 16) { const int far = 16 + (int)(__logf((float)d * (1.0f / 16.0f)) / 2.0794415416798357f * 16.0f); bk = far < 31 ? far : 31; }
        lut[d] = rel_bias[bk * 10 + head] * LOG2E;
    }
}
template <int NMAP, bool HAS_SEL, bool FAST>
__device__ __forceinline__ void attn_tile(const LAS unsigned char* Kb, const LAS unsigned char* Vb, const bf16x8 (&qr)[4], int tq, int k0, int win, float c31, const LAS float* lut, bool sel,
                                          f32x16 (&O)[NMAP][2], float (&l)[NMAP], int r32, int hi) {
    unsigned P[NMAP][2][8];
#pragma unroll
    for (int kh2 = 0; kh2 < 2; ++kh2) {
        f32x16 S[NMAP];
        const float ini = FAST ? ((HAS_SEL && !sel) ? -30000.f : c31) : 0.f;
#pragma unroll
        for (int mp = 0; mp < NMAP; ++mp)
#pragma unroll
            for (int r = 0; r < 16; ++r) S[mp][r] = ini;
#pragma unroll
        for (int c = 0; c < 4; ++c) {
            const bf16x8 kf = *(const LAS bf16x8*)(Kb + (32 * kh2 + r32) * 144 + (16 * c + 8 * hi) * 2);
            const int mp = (NMAP == 2) ? (c >> 1) : 0;
            S[mp] = mfma32(kf, qr[c], S[mp]);
        }
#pragma unroll
        for (int mp = 0; mp < NMAP; ++mp) {
            float p[16];
            if (FAST) {
#pragma unroll
                for (int r = 0; r < 16; ++r) p[r] = ex2(S[mp][r]);
            } else {
#pragma unroll
                for (int r = 0; r < 16; ++r) {
                    const int d = tq - (k0 + 32 * kh2 + crow(r, hi));
                    const bool valid = sel && d >= 0 && d < win;
                    const int dc = d < 0 ? 0 : (d > 128 ? 128 : d);
                    const float e = ex2(S[mp][r] + lut[dc]);
                    p[r] = valid ? e : 0.f;
                }
            }
            float s = 0.f;
#pragma unroll
            for (int r = 0; r < 16; ++r) s += p[r];
            l[mp] += s;
#pragma unroll
            for (int j = 0; j < 8; ++j) P[mp][kh2][j] = pk2(p[2 * j], p[2 * j + 1]);
        }
#pragma unroll
        for (int c2 = 0; c2 < 2; ++c2)
#pragma unroll
            for (int db = 0; db < 2; ++db) {
                const int cc = 2 * kh2 + c2;
                const u32x2 a0 = *(const LAS u32x2*)(Vb + (32 * db + r32) * 136 + (16 * cc + 4 * hi) * 2);
                const u32x2 a1 = *(const LAS u32x2*)(Vb + (32 * db + r32) * 136 + (16 * cc + 8 + 4 * hi) * 2);
                const bf16x8 vf = as_bf16x8((u32x4){a0.x, a0.y, a1.x, a1.y});
#pragma unroll
                for (int mp = 0; mp < NMAP; ++mp) {
                    const bf16x8 pf = as_bf16x8((u32x4){P[mp][kh2][4 * c2], P[mp][kh2][4 * c2 + 1], P[mp][kh2][4 * c2 + 2], P[mp][kh2][4 * c2 + 3]});
                    O[mp][db] = mfma32(vf, pf, O[mp][db]);
                }
            }
    }
}
template <bool HAS_SEL>
__device__ __forceinline__ void attn_tile1_fast(const LAS unsigned char* Kb, const LAS unsigned char* Vb, const bf16x8 (&qr)[4], float c31, bool sel,
                                                f32x16 (&O)[1][2], float (&l)[1], int r32, int hi) {
    const float ini = (HAS_SEL && !sel) ? -30000.f : c31;
    f32x16 S[2];
#pragma unroll
    for (int kh2 = 0; kh2 < 2; ++kh2) {
#pragma unroll
        for (int r = 0; r < 16; ++r) S[kh2][r] = ini;
#pragma unroll
        for (int c = 0; c < 4; ++c) {
            const bf16x8 kf = *(const LAS bf16x8*)(Kb + (32 * kh2 + r32) * 144 + (16 * c + 8 * hi) * 2);
            S[kh2] = mfma32(kf, qr[c], S[kh2]);
        }
    }
    float s = 0.f;
#pragma unroll
    for (int kh2 = 0; kh2 < 2; ++kh2) {
        float p[16]; unsigned P[8];
#pragma unroll
        for (int r = 0; r < 16; ++r) { p[r] = ex2(S[kh2][r]); s += p[r]; }
#pragma unroll
        for (int j = 0; j < 8; ++j) P[j] = pk2(p[2 * j], p[2 * j + 1]);
#pragma unroll
        for (int c2 = 0; c2 < 2; ++c2)
#pragma unroll
            for (int db = 0; db < 2; ++db) {
                const int cc = 2 * kh2 + c2;
                const u32x2 a0 = *(const LAS u32x2*)(Vb + (32 * db + r32) * 136 + (16 * cc + 4 * hi) * 2);
                const u32x2 a1 = *(const LAS u32x2*)(Vb + (32 * db + r32) * 136 + (16 * cc + 8 + 4 * hi) * 2);
                const bf16x8 vf = as_bf16x8((u32x4){a0.x, a0.y, a1.x, a1.y});
                const bf16x8 pf = as_bf16x8((u32x4){P[4 * c2], P[4 * c2 + 1], P[4 * c2 + 2], P[4 * c2 + 3]});
                O[0][db] = mfma32(vf, pf, O[0][db]);
            }
    }
    l[0] += s;
}
__device__ __forceinline__ void attn_tile2_fast(const LAS unsigned char* Kb, const LAS unsigned char* Vb, const bf16x8 (&qr)[4], const f32x16& cini,
                                                f32x16 (&O)[2][2], float (&l)[2], int r32, int hi) {
#pragma unroll
    for (int mp = 0; mp < 2; ++mp) {
        f32x16 S[2];
#pragma unroll
        for (int kh2 = 0; kh2 < 2; ++kh2) {
            const bf16x8 kf0 = *(const LAS bf16x8*)(Kb + (32 * kh2 + r32) * 144 + (32 * mp + 8 * hi) * 2);
            const bf16x8 kf1 = *(const LAS bf16x8*)(Kb + (32 * kh2 + r32) * 144 + (32 * mp + 16 + 8 * hi) * 2);
            S[kh2] = mfma32(kf0, qr[2 * mp], cini);
            S[kh2] = mfma32(kf1, qr[2 * mp + 1], S[kh2]);
        }
        float s = 0.f;
#pragma unroll
        for (int kh2 = 0; kh2 < 2; ++kh2) {
            float p[16]; unsigned P[8];
#pragma unroll
            for (int r = 0; r < 16; ++r) { p[r] = ex2(S[kh2][r]); s += p[r]; }
#pragma unroll
            for (int j = 0; j < 8; ++j) P[j] = pk2(p[2 * j], p[2 * j + 1]);
#pragma unroll
            for (int c2 = 0; c2 < 2; ++c2)
#pragma unroll
                for (int db = 0; db < 2; ++db) {
                    const int cc = 2 * kh2 + c2;
                    const u32x2 a0 = *(const LAS u32x2*)(Vb + (32 * db + r32) * 136 + (16 * cc + 4 * hi) * 2);
                    const u32x2 a1 = *(const LAS u32x2*)(Vb + (32 * db + r32) * 136 + (16 * cc + 8 + 4 * hi) * 2);
                    const bf16x8 vf = as_bf16x8((u32x4){a0.x, a0.y, a1.x, a1.y});
                    const bf16x8 pf = as_bf16x8((u32x4){P[4 * c2], P[4 * c2 + 1], P[4 * c2 + 2], P[4 * c2 + 3]});
                    O[mp][db] = mfma32(vf, pf, O[mp][db]);
                }
        }
        l[mp] += s;
    }
}
template <int NMAP, bool HAS_SEL>
__device__ __forceinline__ void attn_pass(LAS unsigned char* lds, const bf16_t* Kth, size_t kts, const bf16_t* Vth, int m_lo, int m_hi,
                                          const bf16x8 (&qr)[4], int tq, int qw0, int win, const LAS float* lut, u32x4 selw,
                                          f32x16 (&O)[NMAP][2], float (&l)[NMAP]) {
    const int tid = TID(), lane = tid & 63, r32 = lane & 31, hi = lane >> 5;
    const float c31 = lut[128];
    f32x16 cini;
#pragma unroll
    for (int r = 0; r < 16; ++r) cini[r] = c31;
    asm volatile("" : "+v"(cini));
    u32x4 kreg = *(const u32x4*)(Kth + (size_t)m_lo * kts), vreg = *(const u32x4*)(Vth + (size_t)m_lo * 64);
    int buf = 0;
    for (int m = m_lo; m <= m_hi; ++m) {
        *(LAS u32x4*)(lds + ATT_K + buf * 9216 + (tid >> 3) * 144 + (tid & 7) * 16) = kreg;
        { LAS u32x2* vp = (LAS u32x2*)(lds + ATT_V + buf * 8704 + (tid >> 3) * 136 + (tid & 7) * 16); vp[0] = (u32x2){vreg.x, vreg.y}; vp[1] = (u32x2){vreg.z, vreg.w}; }
        __syncthreads();
        if (m < m_hi) { kreg = *(const u32x4*)(Kth + (size_t)(m + 1) * kts); vreg = *(const u32x4*)(Vth + (size_t)(m + 1) * 64); }
        const int k0 = 64 * m, dmin = qw0 - (k0 + 63), dmax = qw0 + 31 - k0;
        bool sel = true;
        if (HAS_SEL) { const unsigned w = m < 32 ? selw.x : (m < 64 ? selw.y : (m < 96 ? selw.z : selw.w)); sel = (w >> (m & 31)) & 1u; }
        bool active = dmax >= 0 && dmin < win;
        if (HAS_SEL) active = active && (__any(sel) != 0);
        if (active) {
            if (NMAP == 1) {
                const LAS unsigned char* Kb = lds + ATT_K + buf * 9216;
                const LAS unsigned char* Vb = lds + ATT_V + buf * 8704;
                if (dmin >= 128 && dmax < win) { if constexpr (NMAP == 1) attn_tile1_fast<HAS_SEL>(Kb, Vb, qr, c31, sel, O, l, r32, hi); }
                else attn_tile<NMAP, HAS_SEL, false>(Kb, Vb, qr, tq, k0, win, c31, lut, sel, O, l, r32, hi);
            } else if (NMAP == 2 && dmin >= 128 && dmax < win) {
                if constexpr (NMAP == 2) attn_tile2_fast(lds + ATT_K + buf * 9216, lds + ATT_V + buf * 8704, qr, cini, O, l, r32, hi);
            } else {
            const bool fast = false;
            const LAS unsigned char* Kb = lds + ATT_K + buf * 9216;
            const LAS unsigned char* Vb = lds + ATT_V + buf * 8704;
            unsigned P[NMAP][2][8];
#pragma unroll
            for (int kh2 = 0; kh2 < 2; ++kh2) {
                f32x16 S[NMAP];
#pragma unroll
                for (int mp = 0; mp < NMAP; ++mp) { const float ini = fast ? c31 : 0.f;
#pragma unroll
                    for (int r = 0; r < 16; ++r) S[mp][r] = ini; }
#pragma unroll
                for (int c = 0; c < 4; ++c) {
                    const bf16x8 kf = *(const LAS bf16x8*)(Kb + (32 * kh2 + r32) * 144 + (16 * c + 8 * hi) * 2);
                    const int mp = (NMAP == 2) ? (c >> 1) : 0;
                    S[mp] = mfma32(kf, qr[c], S[mp]);
                }
#pragma unroll
                for (int mp = 0; mp < NMAP; ++mp) {
                    float p[16];
                    if (fast) {
#pragma unroll
                        for (int r = 0; r < 16; ++r) { const float e = ex2(S[mp][r]); p[r] = sel ? e : 0.f; }
                    } else {
#pragma unroll
                        for (int r = 0; r < 16; ++r) {
                            const int d = tq - (k0 + 32 * kh2 + crow(r, hi));
                            const bool valid = sel && d >= 0 && d < win;
                            const int dc = d < 0 ? 0 : (d > 128 ? 128 : d);
                            const float e = ex2(S[mp][r] + lut[dc]);
                            p[r] = valid ? e : 0.f;
                        }
                    }
                    float s = 0.f;
#pragma unroll
                    for (int r = 0; r < 16; ++r) s += p[r];
                    l[mp] += s;
#pragma unroll
                    for (int j = 0; j < 8; ++j) P[mp][kh2][j] = pk2(p[2 * j], p[2 * j + 1]);
                }
            }
#pragma unroll
            for (int db = 0; db < 2; ++db)
#pragma unroll
                for (int cc = 0; cc < 4; ++cc) {
                    const u32x2 a0 = *(const LAS u32x2*)(Vb + (32 * db + r32) * 136 + (16 * cc + 4 * hi) * 2);
                    const u32x2 a1 = *(const LAS u32x2*)(Vb + (32 * db + r32) * 136 + (16 * cc + 8 + 4 * hi) * 2);
                    const bf16x8 vf = as_bf16x8((u32x4){a0.x, a0.y, a1.x, a1.y});
#pragma unroll
                    for (int mp = 0; mp < NMAP; ++mp) {
                        const bf16x8 pf = as_bf16x8((u32x4){P[mp][cc >> 1][4 * (cc & 1)], P[mp][cc >> 1][4 * (cc & 1) + 1], P[mp][cc >> 1][4 * (cc & 1) + 2], P[mp][cc >> 1][4 * (cc & 1) + 3]});
                        O[mp][db] = mfma32(vf, pf, O[mp][db]);
                    }
                }
            }
        }
        buf ^= 1;
    }
    __syncthreads();
}
template <bool ADD>
__device__ __forceinline__ void store_ot(LAS unsigned char* stage, const float (&val)[2][16], bf16_t* dst, int ld, const bf16_t* addsrc = nullptr, int ldadd = 0) {
    const int lane = TID() & 63, r32 = lane & 31, hi = lane >> 5;
    LAS bf16_t* st = (LAS bf16_t*)stage;
#pragma unroll
    for (int db = 0; db < 2; ++db)
#pragma unroll
        for (int r = 0; r < 16; ++r) st[r32 * 72 + 32 * db + crow(r, hi)] = f2bf(val[db][r]);
    LDSW();
#pragma unroll
    for (int i = 0; i < 4; ++i) {
        const int row = i * 8 + (lane >> 3), ch = lane & 7;
        u32x4 v = *(const LAS u32x4*)(st + row * 72 + 8 * ch);
        bf16_t* gp = dst + (size_t)row * ld + 8 * ch;
        if (ADD) {
            const u32x4 o = *(const u32x4*)(addsrc + (size_t)row * ldadd + 8 * ch);
            v.x = pk2(bflo(v.x) + bflo(o.x), bfhi(v.x) + bfhi(o.x)); v.y = pk2(bflo(v.y) + bflo(o.y), bfhi(v.y) + bfhi(o.y));
            v.z = pk2(bflo(v.z) + bflo(o.z), bfhi(v.z) + bfhi(o.z)); v.w = pk2(bflo(v.w) + bflo(o.w), bfhi(v.w) + bfhi(o.w));
        }
        *(u32x4*)gp = v;
    }
    LDSW();
}

__device__ __forceinline__ void task_diff(const float* const* in, unsigned char* ws, int L, int task, LAS unsigned char* lds) {
    const int tid = TID(), lane = tid & 63, wave = tid >> 6, r32 = lane & 31, hi = lane >> 5;
    const int qb = 31 - (task >> 4), b = (task >> 2) & 3, hd = task & 3;
    const bf16_t* z = (const bf16_t*)(ws + WS_R1);
    LAS float* lut = (LAS float*)(lds + ATT_LUT);
    build_lut(lut, inp(I_RELB), 6 + hd);
    __syncthreads();
    const int q0 = 256 * qb, qw0 = q0 + 32 * wave, tq = qw0 + r32;
    bf16x8 qr[4];
#pragma unroll
    for (int c = 0; c < 4; ++c) qr[c] = *(const bf16x8*)(z + (size_t)(b * T + tq) * ZW + C_DQ + 64 * hd + 16 * c + 8 * hi);
    const bf16_t* Kth = z + (size_t)(b * T + (tid >> 3)) * ZW + C_DK + 64 * hd + (tid & 7) * 8;
    const bf16_t* Vth = (const bf16_t*)(ws + WS_VT) + ((size_t)(b * 8 + 4 + hd) * 64 + (tid >> 3)) * T + (tid & 7) * 8;
    f32x16 O[2][2] = {}; float l[2] = {0.f, 0.f};
    attn_pass<2, false>(lds, Kth, (size_t)64 * ZW, Vth, 0, 4 * qb + 3, qr, tq, qw0, 1 << 30, lut, (u32x4){0u, 0u, 0u, 0u}, O, l);
    const float* lp = inp(I_DLAM) + L * 128;
    float s01 = 0.f, s23 = 0.f;
#pragma unroll
    for (int i = 0; i < 32; ++i) { s01 += lp[i] * lp[32 + i]; s23 += lp[64 + i] * lp[96 + i]; }
    const float lam_init = 0.8f - 0.6f * __expf(-0.3f * (float)L);
    const float lam = __expf(s01) - __expf(s23) + lam_init;
    const float l0 = l[0] + __shfl_xor(l[0], 32), l1 = l[1] + __shfl_xor(l[1], 32);
    const float i0 = __builtin_amdgcn_rcpf(l0), i1 = lam * __builtin_amdgcn_rcpf(l1);
    float val[2][16]; float ss = 0.f;
#pragma unroll
    for (int db = 0; db < 2; ++db)
#pragma unroll
        for (int r = 0; r < 16; ++r) { const float o = O[0][db][r] * i0 - O[1][db][r] * i1; val[db][r] = o; ss += o * o; }
    ss += __shfl_xor(ss, 32);
    const float rn = rsqrtf(ss * (1.0f / 64.0f) + EPS) * (1.0f - lam_init);
    const float* sub = inp(I_DSUB) + L * 64;
#pragma unroll
    for (int db = 0; db < 2; ++db)
#pragma unroll
        for (int r = 0; r < 16; ++r) val[db][r] *= rn * sub[32 * db + crow(r, hi)];
    store_ot<false>(lds + ATT_STAGE + wave * 4608, val, (bf16_t*)(ws + WS_MIX) + (size_t)(b * T + qw0) * DM + 384 + 64 * hd, DM);
}

__device__ __forceinline__ void task_nsa_sw(const float* const* in, unsigned char* ws, int L, int task, LAS unsigned char* lds) {
    const int tid = TID(), lane = tid & 63, wave = tid >> 6, r32 = lane & 31, hi = lane >> 5;
    const int qb = 31 - task / 24, rem = task % 24, b = rem / 6, h = rem % 6, g = h / 3;
    const bf16_t* z = (const bf16_t*)(ws + WS_R1);
    LAS float* lut = (LAS float*)(lds + ATT_LUT);
    build_lut(lut, inp(I_RELB), h);
    __syncthreads();
    const int q0 = 256 * qb, qw0 = q0 + 32 * wave, tq = qw0 + r32;
    const bf16_t* zq = z + (size_t)(b * T + tq) * ZW;
    bf16x8 qr[4];
#pragma unroll
    for (int c = 0; c < 4; ++c) qr[c] = *(const bf16x8*)(zq + C_NQ + 64 * h + 16 * c + 8 * hi);
    const u32x4 selw = *(const u32x4*)((const unsigned*)(ws + WS_SELM) + ((size_t)(b * 2 + g) * T + tq) * 4);
    const float g1 = sigmoidf_(bf2f(zq[C_NG + 3 * h + 1])), g2 = sigmoidf_(bf2f(zq[C_NG + 3 * h + 2]));
    float val[2][16];
    {
        const bf16_t* Kth = z + (size_t)(b * T + (tid >> 3)) * ZW + C_SK + 64 * g + (tid & 7) * 8;
        const bf16_t* Vth = (const bf16_t*)(ws + WS_VT) + ((size_t)(b * 8 + g) * 64 + (tid >> 3)) * T + (tid & 7) * 8;
        f32x16 O[1][2] = {}; float l[1] = {0.f};
        attn_pass<1, true>(lds, Kth, (size_t)64 * ZW, Vth, 0, 4 * qb + 3, qr, tq, qw0, 1 << 30, lut, selw, O, l);
        const float lt = l[0] + __shfl_xor(l[0], 32), sc = g1 / lt;
#pragma unroll
        for (int db = 0; db < 2; ++db)
#pragma unroll
            for (int r = 0; r < 16; ++r) val[db][r] = O[0][db][r] * sc;
    }
    {
        const bf16_t* Kth = z + (size_t)(b * T + (tid >> 3)) * ZW + C_WK + 64 * g + (tid & 7) * 8;
        const bf16_t* Vth = (const bf16_t*)(ws + WS_VT) + ((size_t)(b * 8 + 2 + g) * 64 + (tid >> 3)) * T + (tid & 7) * 8;
        f32x16 O[1][2] = {}; float l[1] = {0.f};
        const int m_lo = q0 >= 512 ? (q0 >> 6) - 8 : 0;
        attn_pass<1, false>(lds, Kth, (size_t)64 * ZW, Vth, m_lo, 4 * qb + 3, qr, tq, qw0, 512, lut, (u32x4){0u, 0u, 0u, 0u}, O, l);
        const float lt = l[0] + __shfl_xor(l[0], 32), sc = g2 / lt;
#pragma unroll
        for (int db = 0; db < 2; ++db)
#pragma unroll
            for (int r = 0; r < 16; ++r) val[db][r] += O[0][db][r] * sc;
    }
    store_ot<true>(lds + ATT_STAGE + wave * 4608, val, (bf16_t*)(ws + WS_MIX) + (size_t)(b * T + qw0) * DM + 64 * h, DM, (const bf16_t*)(ws + WS_OCB) + (size_t)(b * T + qw0) * 384 + 64 * h, 384);
}

__device__ __forceinline__ unsigned wave_max_u32(unsigned v) {
    unsigned t;
    t = (unsigned)__builtin_amdgcn_update_dpp(0, (int)v, 0xB1, 0xF, 0xF, false); v = t > v ? t : v;
    t = (unsigned)__builtin_amdgcn_update_dpp(0, (int)v, 0x4E, 0xF, 0xF, false); v = t > v ? t : v;
    t = (unsigned)__builtin_amdgcn_update_dpp(0, (int)v, 0x141, 0xF, 0xF, false); v = t > v ? t : v;
    t = (unsigned)__builtin_amdgcn_update_dpp(0, (int)v, 0x140, 0xF, 0xF, false); v = t > v ? t : v;
    t = (unsigned)__builtin_amdgcn_update_dpp(0, (int)v, 0x142, 0xA, 0xF, false); v = t > v ? t : v;
    t = (unsigned)__builtin_amdgcn_update_dpp(0, (int)v, 0x143, 0xC, 0xF, false); v = t > v ? t : v;
    return (unsigned)__builtin_amdgcn_readlane((int)v, 63);
}
constexpr int NC_IMP = 18432, NC_IMPW = 129, NC_LINV = NC_IMP + 3 * 64 * NC_IMPW * 4;
__device__ __forceinline__ void task_nsa_c(const float* const* in, unsigned char* ws, int L, int task, LAS unsigned char* lds) {
    const int tid = TID(), lane = tid & 63, wave = tid >> 6, r32 = lane & 31, hi = lane >> 5;
    const int cur = 127 - (task >> 3), b = (task >> 1) & 3, g = task & 1;
    const bf16_t* z = (const bf16_t*)(ws + WS_R1);
    LAS float* imp = (LAS float*)(lds + NC_IMP);
    LAS float* linv = (LAS float*)(lds + NC_LINV);
    const int q0 = 64 * cur;
    const int rh = wave >> 1, half = wave & 1, h = 3 * g + (rh < 3 ? rh : 0);
    const int ql = 32 * half + r32, tq = q0 + ql;
    const bf16_t* zq = z + (size_t)(b * T + tq) * ZW;
    bf16x8 qr[4];
#pragma unroll
    for (int c = 0; c < 4; ++c) qr[c] = *(const bf16x8*)(zq + C_NQ + 64 * h + 16 * c + 8 * hi);
    const bf16_t* Kth = (const bf16_t*)(ws + WS_KC) + ((size_t)(b * 2 + g) * 512 + (tid >> 3)) * 64 + (tid & 7) * 8;
    const bf16_t* Vth = (const bf16_t*)(ws + WS_VCT) + ((size_t)(b * 2 + g) * 64 + (tid >> 3)) * 512 + (tid & 7) * 8;
    const int ntiles = ((4 * cur + 2) >> 6) + 1;
    f32x16 O[2] = {}; float l = 0.f, carry = 0.f;
    u32x4 kreg = *(const u32x4*)(Kth), vreg = *(const u32x4*)(Vth);
    for (int m = 0; m < ntiles; ++m) {
        __syncthreads();
        *(LAS u32x4*)(lds + (tid >> 3) * 144 + (tid & 7) * 16) = kreg;
        { LAS u32x2* vp = (LAS u32x2*)(lds + 9216 + (tid >> 3) * 136 + (tid & 7) * 16); vp[0] = (u32x2){vreg.x, vreg.y}; vp[1] = (u32x2){vreg.z, vreg.w}; }
        __syncthreads();
        if (m + 1 < ntiles) { kreg = *(const u32x4*)(Kth + (size_t)(m + 1) * 64 * 64); vreg = *(const u32x4*)(Vth + (size_t)(m + 1) * 64); }
        if (wave < 6) {
            unsigned P[2][8]; float av[8], bq[8];
#pragma unroll
            for (int kh2 = 0; kh2 < 2; ++kh2) {
                f32x16 S = {};
#pragma unroll
                for (int c = 0; c < 4; ++c) { const bf16x8 kf = *(const LAS bf16x8*)(lds + (32 * kh2 + r32) * 144 + (16 * c + 8 * hi) * 2); S = mfma32(kf, qr[c], S); }
                float p[16];
#pragma unroll
                for (int r = 0; r < 16; ++r) { const int n = 64 * m + 32 * kh2 + crow(r, hi); const float e = ex2(S[r]); p[r] = (16 * n + 31 <= tq) ? e : 0.f; }
                float s = 0.f;
#pragma unroll
                for (int r = 0; r < 16; ++r) s += p[r];
                l += s;
#pragma unroll
                for (int j = 0; j < 8; ++j) P[kh2][j] = pk2(p[2 * j], p[2 * j + 1]);
#pragma unroll
                for (int j = 0; j < 4; ++j) { av[4 * kh2 + j] = p[4 * j] + p[4 * j + 1] + p[4 * j + 2] + 0.5f * p[4 * j + 3]; bq[4 * kh2 + j] = 0.5f * p[4 * j + 3]; }
            }
#pragma unroll
            for (int db = 0; db < 2; ++db)
#pragma unroll
                for (int cc = 0; cc < 4; ++cc) {
                    const u32x2 a0 = *(const LAS u32x2*)(lds + 9216 + (32 * db + r32) * 136 + (16 * cc + 4 * hi) * 2);
                    const u32x2 a1 = *(const LAS u32x2*)(lds + 9216 + (32 * db + r32) * 136 + (16 * cc + 8 + 4 * hi) * 2);
                    const bf16x8 vf = as_bf16x8((u32x4){a0.x, a0.y, a1.x, a1.y});
                    const bf16x8 pf = as_bf16x8((u32x4){P[cc >> 1][4 * (cc & 1)], P[cc >> 1][4 * (cc & 1) + 1], P[cc >> 1][4 * (cc & 1) + 2], P[cc >> 1][4 * (cc & 1) + 3]});
                    O[db] = mfma32(vf, pf, O[db]);
                }
            float recv[8];
#pragma unroll
            for (int jj = 0; jj < 8; ++jj) { auto rr = __builtin_amdgcn_permlane32_swap(__float_as_uint(bq[jj]), __float_as_uint(bq[jj]), false, false); recv[jj] = __uint_as_float(hi ? rr[0] : rr[1]); }
            LAS float* ip = imp + (rh * 64 + ql) * NC_IMPW + 16 * m + hi;
#pragma unroll
            for (int jj = 0; jj < 8; ++jj) {
                const float add = hi ? recv[jj] : (jj == 0 ? carry : recv[jj > 0 ? jj - 1 : 0]);
                ip[2 * jj] = av[jj] + add;
            }
            carry = recv[7];
        }
    }
    if (wave < 6) {
        const float lt = l + __shfl_xor(l, 32);
        const float li = (tq >= 31 && lt > 0.f) ? 1.0f / lt : 0.f;
        if (hi == 0) linv[rh * 64 + ql] = li;
        const float g0 = sigmoidf_(bf2f(zq[C_NG + 3 * h + 0]));
        bf16_t* mx = (bf16_t*)(ws + WS_OCB) + (size_t)(b * T + tq) * 384 + 64 * h;
        const float sc = li * g0;
#pragma unroll
        for (int db = 0; db < 2; ++db)
#pragma unroll
            for (int r = 0; r < 16; ++r) mx[32 * db + crow(r, hi)] = f2bf(O[db][r] * sc);
    }
    __syncthreads();
#pragma unroll 1
    for (int qi = 0; qi < 8; ++qi) {
        const int q = 8 * wave + qi;
        unsigned w0 = 0u, w1 = 0u, w2 = 0u, w3 = 0u;
        if (cur <= 15) { w0 = (1u << (cur + 1)) - 1u; }
        else {
            const float i0 = linv[q], i1 = linv[64 + q], i2 = linv[128 + q];
            const int ma = lane, mb = lane + 64;
            float va = 0.f, vb = 0.f;
            if (ma >= 1 && ma <= cur - 2) va = imp[(0 * 64 + q) * NC_IMPW + ma] * i0 + imp[(1 * 64 + q) * NC_IMPW + ma] * i1 + imp[(2 * 64 + q) * NC_IMPW + ma] * i2;
            if (mb <= cur - 2) vb = imp[(0 * 64 + q) * NC_IMPW + mb] * i0 + imp[(1 * 64 + q) * NC_IMPW + mb] * i1 + imp[(2 * 64 + q) * NC_IMPW + mb] * i2;
            unsigned ka = va > 0.f ? ((__float_as_uint(va) & ~127u) | (unsigned)(127 - ma)) : 0u;
            unsigned kb = vb > 0.f ? ((__float_as_uint(vb) & ~127u) | (unsigned)(127 - mb)) : 0u;
            w0 = 1u;
#pragma unroll 1
            for (int it = 0; it < 13; ++it) {
                const unsigned best = wave_max_u32(ka > kb ? ka : kb);
                if (best != 0u) {
                    const int mw = 127 - (int)(best & 127u);
                    const unsigned bit = 1u << (mw & 31);
                    if (mw < 32) w0 |= bit; else if (mw < 64) w1 |= bit; else if (mw < 96) w2 |= bit; else w3 |= bit;
                    if (ka == best) ka = 0u;
                    if (kb == best) kb = 0u;
                }
            }
#pragma unroll
            for (int f = 0; f < 2; ++f) {
                const int mw = cur - f; const unsigned bit = 1u << (mw & 31);
                if (mw < 32) w0 |= bit; else if (mw < 64) w1 |= bit; else if (mw < 96) w2 |= bit; else w3 |= bit;
            }
        }
        if (lane == 0) *(u32x4*)((unsigned*)(ws + WS_SELM) + ((size_t)(b * 2 + g) * T + q0 + q) * 4) = (u32x4){w0, w1, w2, w3};
    }
}

#define XB_TMO      128
#define XB_XCNT(j)  (256  + 64 * (j))
#define XB_XSUB(j)  (1280 + 64 * (j))
#define XB_XGEN(j)  (2304 + 64 * (j))
#define XB_TOP      3328
#define XB_TOPGEN   3392
#define XCD_BAR_WORDS 3456
#define XB_SPIN_CAP (1u << 18)

__device__ __forceinline__ unsigned xb_ld(unsigned* p)              { return __hip_atomic_load(p, __ATOMIC_RELAXED, __HIP_MEMORY_SCOPE_AGENT); }
__device__ __forceinline__ unsigned xb_add(unsigned* p, unsigned v) { return __hip_atomic_fetch_add(p, v, __ATOMIC_RELAXED, __HIP_MEMORY_SCOPE_AGENT); }
__device__ __forceinline__ unsigned xb_xcc_id() { return (unsigned)__builtin_amdgcn_s_getreg((3 << 11) | 20) & 0xFu; }
#define XB_SPIN(cond, bar) do { unsigned _sp = 0; while (cond) { __builtin_amdgcn_s_sleep(1); \
    if ((++_sp & 255u) == 0u) { if (xb_ld(&(bar)[XB_TMO])) break; if (_sp > XB_SPIN_CAP) { atomicAdd(&(bar)[XB_TMO], 1u); break; } } } } while (0)

struct XcdBarrier {
    unsigned* bar; unsigned x;
    volatile LAS unsigned* st;
};

__device__ __forceinline__ XcdBarrier xcd_barrier_post(unsigned* bar, volatile LAS unsigned* st) {
    XcdBarrier b; b.bar = bar; b.x = xb_xcc_id(); b.st = st;
    if (threadIdx.x == 0) (void)xb_add(&bar[XB_XCNT(b.x)], 1u);
    return b;
}
__device__ __forceinline__ void xcd_barrier_complete(unsigned* bar, unsigned x, unsigned& nloc, unsigned& nx) {
    const unsigned G = gridDim.x * gridDim.y * gridDim.z;
    unsigned sum, cnt, mine, sp = 0u;
    for (;;) {
        sum = 0u; cnt = 0u; mine = 0u;
#pragma unroll
        for (unsigned j = 0; j < 16; ++j) { const unsigned c = xb_ld(&bar[XB_XCNT(j)]); sum += c; cnt += (c > 0u) ? 1u : 0u; mine = (j == x) ? c : mine; }
        if (sum == G) break;
        __builtin_amdgcn_s_sleep(1);
        if ((++sp & 255u) == 0u) { if (xb_ld(&bar[XB_TMO])) break; if (sp > XB_SPIN_CAP) { atomicAdd(&bar[XB_TMO], 1u); break; } }
    }
    nloc = mine > 0u ? mine : 1u; nx = cnt > 0u ? cnt : 1u;
}

__device__ __forceinline__ void xcd_barrier(const XcdBarrier& b) {
    asm volatile("s_waitcnt vmcnt(0)" ::: "memory");
    __syncthreads();
    if (threadIdx.x == 0) {
        unsigned* bar = b.bar;
        __builtin_amdgcn_s_waitcnt(0);
        unsigned nloc = b.st[0], nx = b.st[1];
        if (nloc == 0u) { xcd_barrier_complete(bar, b.x, nloc, nx); b.st[0] = nloc; b.st[1] = nx; }
        const unsigned old = xb_add(&bar[XB_XSUB(b.x)], 1u);
        const unsigned gen = old / nloc;
        if (old + 1u == (gen + 1u) * nloc) {
            __builtin_amdgcn_fence(__ATOMIC_RELEASE, "agent");
            asm volatile("s_waitcnt vmcnt(0)" ::: "memory");
            const unsigned og = xb_add(&bar[XB_TOP], 1u);
            const unsigned tg = og / nx;
            if (og + 1u == (tg + 1u) * nx) xb_add(&bar[XB_TOPGEN], 1u);
            else XB_SPIN(xb_ld(&bar[XB_TOPGEN]) == tg, bar);
            __builtin_amdgcn_fence(__ATOMIC_ACQUIRE, "agent");
            xb_add(&bar[XB_XGEN(b.x)], 1u);
            asm volatile("s_waitcnt vmcnt(0)" ::: "memory");
        } else {
            XB_SPIN(xb_ld(&bar[XB_XGEN(b.x)]) == gen, bar);
            __builtin_amdgcn_fence(__ATOMIC_ACQUIRE, "agent");
            asm volatile("s_waitcnt vmcnt(0)" ::: "memory");
        }
    }
    __syncthreads();
}

struct Args { const float* in[N_IN]; float* out; unsigned char* ws; int ph_lo, ph_hi; };
static_assert(sizeof(Args) == 8 * N_IN + 24, "Args has no padding");
constexpr int PH_PER_LAYER = 12, N_PHASES = DEPTH * PH_PER_LAYER;
#ifndef PH_HI
#ifdef REPJ
#define PH_HI (N_PHASES + DEPTH)
#else
#define PH_HI N_PHASES
#endif
#endif

__global__ void __launch_bounds__(512) mega(Args a) {
    extern __shared__ __attribute__((aligned(16))) unsigned char lds_raw[];
    LAS unsigned char* lds = (LAS unsigned char*)lds_raw;
    LAS int* slot = (LAS int*)(lds + LDS_MISC);
    cg::grid_group grid = cg::this_grid();
    const float* const* in = nullptr;
    volatile LAS unsigned* misc = (volatile LAS unsigned*)(lds + LDS_MISC);
    if (TID() < 16) misc[TID()] = 0u;
    __syncthreads();
    (void)xcd_barrier_post((unsigned*)(a.ws + WS_CTL) + 4096, misc + 8);
#ifndef DUP_GU
#define DUP_GU 0
#endif
#ifndef DUP_IN
#define DUP_IN 0
#endif
#ifndef DUP_DIFF
#define DUP_DIFF 0
#endif
#ifndef DUP_NSAC
#define DUP_NSAC 0
#endif
#ifndef DUP_SW
#define DUP_SW 0
#endif
#ifndef DUP_HOUT
#define DUP_HOUT 0
#endif
#ifndef DUP_M1
#define DUP_M1 0
#endif
#ifndef DUP_SYNC
#define DUP_SYNC 0
#endif
#ifndef DUP_CONV
#define DUP_CONV 0
#endif
#ifndef PHM
#define PHM 0xfff
#endif
#define TASK_LOOP(ctr, ntasks, BODY) { int t = next_task(ctr, slot); while (t < (ntasks)) { int nxt_ = 0; if (TID() == 0) nxt_ = (int)atomicAdd(ctr, 1u); \
        { BODY } __syncthreads(); if (TID() == 0) *slot = nxt_; __syncthreads(); t = *slot; } }
    for (int ph = a.ph_lo; ph < a.ph_hi; ++ph) {
#ifdef REPJ
        int L = ph / (PH_PER_LAYER + 1); const int k_ = ph - L * (PH_PER_LAYER + 1); const int j = k_ <= REPJ ? k_ : k_ - 1; const float amul = (k_ == REPJ) ? 0.f : 1.f;
#else
        int L = ph / PH_PER_LAYER; const int j = ph - L * PH_PER_LAYER; const float amul = 1.f;
#endif
        asm volatile("" : "+s"(L));
        unsigned long long ws_ = (unsigned long long)a.ws; asm volatile("" : "+s"(ws_)); unsigned char* ws = (unsigned char*)(GAS unsigned char*)ws_;
        unsigned long long out_ = (unsigned long long)a.out; asm volatile("" : "+s"(out_)); float* out_g = (float*)(GAS float*)out_;
        unsigned* ctl = (unsigned*)(ws + WS_CTL); bf16_t* r1 = (bf16_t*)(ws + WS_R1); bf16_t* mixed = (bf16_t*)(ws + WS_MIX); bf16_t* pb = (bf16_t*)(ws + WS_PB); unsigned char* wb = ws + WS_W; float* rsqp = (float*)(ws + WS_RSQP);
        float* rsq = (float*)(ws + ((L & 1) ? WS_RSQ1 : WS_RSQ0)); float* rsq_next = (float*)(ws + ((L & 1) ? WS_RSQ0 : WS_RSQ1));
        bf16_t* xb = (bf16_t*)(ws + WS_XB); unsigned char* xlo = ws + WS_XB1; bf16_t* xb1 = (L == 0) ? xb : mixed;
        if (j == 0 && L > 0) continue;
        if ((PHM >> j) & 1) switch (j) {
        case 0: phase_convert(in, ws, out_g, L, lds); break;
        case 1: { EpiSwiGLU E{r1, {}}; run_gemm(lds, xb1, (const bf16_t*)(wb + W_GU1), 2 * FF, DM, E, rsq); } break;
        case 2: { EpiRes<0> E{nullptr, xb, rsq, 0.5f * amul, nullptr, nullptr, nullptr, nullptr, nullptr, {}, xb1, xlo}; run_gemm(lds, r1, (const bf16_t*)(wb + W_D1), DM, FF, E, nullptr, nullptr, false); } break;
        case 3: { EpiZ E{r1, {}}; run_gemm(lds, xb, (const bf16_t*)(wb + W_IN), ZW, DM, E, rsq); } break;
        case 4: {
            unsigned* ctr = ctl + (L * 4 + 0) * 64;
            constexpr int NCMP = 512 << DUP_M1, NHL = 384 << DUP_M1;
            for (;;) { const int t = next_task(ctr, slot); if (t >= NCMP + NHL + 512) break;
                if (t < NCMP) task_compress(in, ws, L, t >> DUP_M1, lds); else if (t < NCMP + NHL) task_hgrn_local(in, ws, L, (t - NCMP) >> DUP_M1, lds); else task_prep(in, ws, L, t - NCMP - NHL, lds); }
        } break;
        case 5: {
            unsigned* ctr = ctl + (L * 4 + 1) * 64;
            constexpr int ND = 512 << DUP_DIFF, NC = 1024 << DUP_NSAC, NCV = 256;
            for (;;) { const int t = next_task(ctr, slot); if (t >= 192 + ND + NCV + NC) break;
                if (t < 192) task_hgrn_scan(ws, t);
                else if (t < 192 + ND + NCV) { const int u = t - 192;
                    if (u < 3 * NCV) { const int grp = u / 3, r = u - 3 * grp; if (r == 2) task_conv(ws, L, grp, lds); else task_diff(in, ws, L, (2 * grp + r) >> DUP_DIFF, lds); }
                    else task_diff(in, ws, L, (u - NCV) >> DUP_DIFF, lds); }
                else task_nsa_c(in, ws, L, (t - 192 - ND - NCV) >> DUP_NSAC, lds); }
        } break;
        case 6: {
            unsigned* ctr = ctl + (L * 4 + 2) * 64;
            constexpr int NS = 768 << DUP_SW, NH = 768 << DUP_HOUT;
            for (;;) { const int t = next_task(ctr, slot); if (t >= NS + NH) break;
                if (t < NS) task_nsa_sw(in, ws, L, t >> DUP_SW, lds); else task_hgrn_out(in, ws, L, (t - NS) >> DUP_HOUT, lds); }
        } break;
#ifdef EXTRA7
        case 7: if (amul == 0.f) { EpiZT<DM> E{(bf16_t*)(ws + WS_VT), {}}; run_gemm(lds, mixed, (const bf16_t*)(wb + W_OUT), DM, DM, E, rsq); }
                else { EpiRes<0> E{nullptr, xb, rsq, 1.0f * amul, nullptr, nullptr, nullptr, nullptr, nullptr, {}, xb, xlo}; run_gemm(lds, mixed, (const bf16_t*)(wb + W_OUT), DM, DM, E, nullptr, nullptr, false); } break;
#else
        case 7: { EpiRes<0> E{nullptr, xb, rsq, 1.0f * amul, nullptr, nullptr, nullptr, nullptr, nullptr, {}, xb, xlo}; run_gemm(lds, mixed, (const bf16_t*)(wb + W_OUT), DM, DM, E, nullptr, nullptr, false); } break;
#endif
        case 8: { EpiSwiGLU E{r1, {}}; run_gemm(lds, xb, (const bf16_t*)(wb + W_GU2), 2 * FF, DM, E, rsq); } break;
        case 9: { EpiRes<2> E{nullptr, nullptr, rsqp, 0.f, nullptr, nullptr, nullptr, nullptr, mixed, {}, nullptr, nullptr}; run_gemm(lds, pb, (const bf16_t*)(wb + W_PP), DM, PLE, E); } break;
        case 10: { EpiRes<0> E{nullptr, xb, rsq, 0.5f * amul, nullptr, nullptr, nullptr, nullptr, nullptr, {}, xb, xlo}; run_gemm(lds, r1, (const bf16_t*)(wb + W_D2), DM, FF, E, nullptr, nullptr, false); } break;
        default: { EpiRes<1> E{(L == DEPTH - 1) ? out_g : nullptr, mixed, rsq_next, 0.f, rsq, mixed, rsqp, inp(I_PLPOST) + L * DM, nullptr, {}, xb, xlo}; run_gemm(lds, xb, (const bf16_t*)(wb + W_PG), DM, DM, E, rsq, rsqp, false); } break;
        }
        if (ph + 1 < a.ph_hi) {
            if (ph == 0) { asm volatile("s_waitcnt vmcnt(0) lgkmcnt(0)" ::: "memory"); grid.sync(); __builtin_amdgcn_fence(__ATOMIC_ACQUIRE, "agent"); asm volatile("s_waitcnt vmcnt(0)" ::: "memory"); __syncthreads(); }
            else { XcdBarrier xb_; xb_.bar = (unsigned*)(ws + WS_CTL) + 4096; xb_.x = xb_xcc_id(); xb_.st = misc + 8; xcd_barrier(xb_); if (DUP_SYNC) xcd_barrier(xb_); }
        }
    }
}

#ifdef DUMPK
__global__ void __launch_bounds__(512) dump_kernel(float* out, unsigned char* ws) {
    bf16_t* mixed = (bf16_t*)(ws + WS_MIX); (void)mixed;
    for (size_t idx = (size_t)blockIdx.x * 512 + threadIdx.x; idx < (size_t)M * 1024; idx += (size_t)gridDim.x * 512) {
        const size_t m = idx >> 10; const int c = (int)(idx & 1023);
        float v = 0.f;
#if DUMPK == 3 || DUMPK == 40
        { const bf16_t* z = (const bf16_t*)(ws + WS_R1); v = bf2f(z[m * ZW + c]) + bf2f(z[m * ZW + 1024 + c]) + bf2f(z[m * ZW + 2048 + c]) + (c < 402 ? bf2f(z[m * ZW + 3072 + c]) : 0.f); }
#elif DUMPK == 41
        { const bf16_t* vt = (const bf16_t*)(ws + WS_VT); v = bf2f(vt[m * 512 + (c & 511)]); }
#elif DUMPK == 42
        { const float* hs = (const float*)(ws + WS_HS); const float* hd = (const float*)(ws + WS_HD); v = hs[m * 384 + (c % 384)] + hd[m * 6 + (c % 6)]; }
#elif DUMPK == 43
        { const bf16_t* kc = (const bf16_t*)(ws + WS_KC); const bf16_t* vct = (const bf16_t*)(ws + WS_VCT); v = bf2f(kc[m * 8 + (c & 7)]) + bf2f(vct[m * 8 + (c & 7)]); }
#elif DUMPK == 50 || DUMPK == 60
        v = (c < 384) ? bf2f(mixed[m * 1024 + c]) : 0.f;
#elif DUMPK == 51
        v = (c >= 384 && c < 640) ? bf2f(mixed[m * 1024 + c]) : 0.f;
#elif DUMPK == 52
        { const unsigned* selm = (const unsigned*)(ws + WS_SELM); v = (float)(selm[m * 8 + (c & 7)] & 0xffffu) + (float)(selm[m * 8 + (c & 7)] >> 16); }
#elif DUMPK == 53
        { const float* hs = (const float*)(ws + WS_HS); v = hs[m * 384 + (c % 384)]; }
#elif DUMPK == 61
        v = (c >= 640) ? bf2f(mixed[m * 1024 + c]) : 0.f;
#endif
        out[idx] = v;
    }
}
#endif

extern "C" void kernel_launch(void* const* d_in, const int* in_sizes, int n_in, void* d_out, int out_size, void* d_ws, size_t ws_size, hipStream_t stream) {
    static int grid = 0;
    if (grid == 0) {
        if (n_in != N_IN || out_size != M * DM || ws_size < WS_END) { fprintf(stderr, "kernel_launch: unexpected shapes (n_in %d out %d ws %zu)\n", n_in, out_size, ws_size); grid = -1; return; }
        int dev = 0, cus = 0, per_cu = 0;
        hipGetDevice(&dev); hipDeviceGetAttribute(&cus, hipDeviceAttributeMultiprocessorCount, dev);
        if (hipFuncSetAttribute((const void*)mega, hipFuncAttributeMaxDynamicSharedMemorySize, LDS_BYTES) != hipSuccess) { fprintf(stderr, "hipFuncSetAttribute failed\n"); }
        if (hipOccupancyMaxActiveBlocksPerMultiprocessor(&per_cu, (const void*)mega, 512, LDS_BYTES) != hipSuccess || per_cu < 1) { fprintf(stderr, "occupancy query: %d\n", per_cu); per_cu = 1; }
        (void)hipGetLastError();
        grid = cus;
    }
    if (grid < 0) return;
    hipMemsetAsync((char*)d_ws + WS_CTL, 0, 64 * 1024, stream);
    Args a{};
    for (int i = 0; i < N_IN; ++i) a.in[i] = (const float*)d_in[i];
    a.out = (float*)d_out; a.ws = (unsigned char*)d_ws; a.ph_lo = 0; a.ph_hi = PH_HI;
    void* args[] = {&a};
    hipError_t e = hipLaunchCooperativeKernel((const void*)mega, dim3(grid), dim3(512), args, LDS_BYTES, stream);
    if (e != hipSuccess) fprintf(stderr, "cooperative launch failed: %s (grid %d)\n", hipGetErrorString(e), grid);
#ifdef DUMPK
    dump_kernel<<<dim3(1024), dim3(512), 0, stream>>>((float*)d_out, (unsigned char*)d_ws);
#endif
}
```
